# Optimizing an MI355X kernel written in HIP

```python
import math
import jax, jax.numpy as jnp
from jax import lax
import numpy as np

D_MODEL = 2048
BATCH = 4
SEQ = 4096
DEPTH = 4

GRID_W = 64
CTX_LEN = 256
N_MIXERS = 3
N_A = (DEPTH + 2) // 3
N_B = (DEPTH + 1) // 3
N_C = DEPTH // 3

A_HEADS = 16
A_KV_HEADS = 4
A_GROUP = A_HEADS // A_KV_HEADS
A_HEAD_DIM = D_MODEL // A_HEADS

LRU_WIDTH = D_MODEL
LRU_BLOCKS = 8
LRU_BLOCK = LRU_WIDTH // LRU_BLOCKS
CONV_W = 4
LRU_C = 8.0

MLA_HEADS = 16
MLA_Q_LORA = 512
MLA_KV_LORA = 512
MLA_QK_NOPE = 128
MLA_QK_ROPE = 64
MLA_V_DIM = 128

D_FF = 4 * D_MODEL

Q_BLOCK = 128
ROPE_THETA = 10000.0
EPS = 1e-6
DN_ALPHA = (2 * DEPTH) ** 0.25
DN_BETA = (8 * DEPTH) ** -0.25

kernel_name = 'hybrid_gqa_rglru_mla_diffusion_trunk'


def layer_norm(x, g, b):
    xf = x.astype(jnp.float32)
    mu = jnp.mean(xf, -1, keepdims=True)
    var = jnp.mean(jnp.square(xf - mu), -1, keepdims=True)
    return ((xf - mu) * lax.rsqrt(var + EPS) * g + b).astype(x.dtype)


def rms_norm(x, g):
    xf = x.astype(jnp.float32)
    return (xf * lax.rsqrt(jnp.mean(jnp.square(xf), -1, keepdims=True) + EPS) * g).astype(x.dtype)


def axial_tables(rows, rot_dim):
    row = jnp.repeat(jnp.arange(rows), GRID_W).astype(jnp.float32)
    col = (jnp.arange(rows * GRID_W) % GRID_W).astype(jnp.float32)
    m = rot_dim // 2
    inv = ROPE_THETA ** (-(jnp.arange(m // 2, dtype=jnp.float32) * 2.0) / m)
    ang_r = row[:, None] * inv
    ang_c = col[:, None] * inv
    return (jnp.cos(ang_r), jnp.sin(ang_r), jnp.cos(ang_c), jnp.sin(ang_c))


def _rot_half(x, cos, sin):
    shape = (cos.shape[0],) + (1,) * (x.ndim - 3) + (cos.shape[1],)
    c = cos.reshape(shape)
    s = sin.reshape(shape)
    x1, x2 = jnp.split(x, 2, axis=-1)
    return jnp.concatenate([x1 * c - x2 * s, x2 * c + x1 * s], axis=-1)


def rope_2d(x, tabs):
    cr, sr, cc, sc = tabs
    xr, xc = jnp.split(x.astype(jnp.float32), 2, axis=-1)
    return jnp.concatenate([_rot_half(xr, cr, sr), _rot_half(xc, cc, sc)], axis=-1).astype(x.dtype)


def block_attention(q, k, v, scale):
    bsz, s = q.shape[:2]
    nb = s // Q_BLOCK
    qb = jnp.moveaxis(q.reshape((bsz, nb, Q_BLOCK) + q.shape[2:]), 1, 0)

    def one_block(qi):
        sc = jnp.einsum('bqkgd,btkd->bkgqt', qi, k, preferred_element_type=jnp.float32) * scale
        p = jax.nn.softmax(sc, axis=-1).astype(v.dtype)
        return jnp.einsum('bkgqt,btkd->bqkgd', p, v)

    o = lax.map(one_block, qb)
    return jnp.moveaxis(o, 0, 1).reshape((bsz, s) + o.shape[3:])


def gqa_mixer(h_lat, h_ctx, wq, wk, wv, wo, q_g, k_g, tabs, need_ctx_out):
    def q_proj(h):
        bsz, t, _ = h.shape
        return rms_norm((h @ wq).reshape(bsz, t, A_KV_HEADS, A_GROUP, A_HEAD_DIM), q_g)

    def kv_proj(h):
        bsz, t, _ = h.shape
        k = rms_norm((h @ wk).reshape(bsz, t, A_KV_HEADS, A_HEAD_DIM), k_g)
        v = (h @ wv).reshape(bsz, t, A_KV_HEADS, A_HEAD_DIM)
        return k, v

    scale = A_HEAD_DIM ** -0.5
    k_c, v_c = kv_proj(h_ctx)
    q_l = rope_2d(q_proj(h_lat), tabs)
    k_l, v_l = kv_proj(h_lat)
    k_l = rope_2d(k_l, tabs)
    o_l = block_attention(q_l, jnp.concatenate([k_c, k_l], 1), jnp.concatenate([v_c, v_l], 1), scale)
    out_l = o_l.reshape(h_lat.shape[0], h_lat.shape[1], -1) @ wo
    out_c = None
    if need_ctx_out:
        o_c = block_attention(q_proj(h_ctx), k_c, v_c, scale)
        out_c = o_c.reshape(h_ctx.shape[0], h_ctx.shape[1], -1) @ wo
    return out_l, out_c


def centered_dwconv(u, w, b):
    t = u.shape[1]
    left = CONV_W // 2
    right = CONV_W - 1 - left
    up = jnp.pad(u, ((0, 0), (left, right), (0, 0)))
    return sum(up[:, j:j + t] * w[j] for j in range(CONV_W)) + b


def linear_scan(a, b, h0):
    b = b.at[:, 0].add(a[:, 0] * h0)

    def comb(l, r):
        return (l[0] * r[0], r[0] * l[1] + r[1])

    return lax.associative_scan(comb, (a, b), axis=1)[1]


def rglru_mixer(h_lat, h_ctx, wx, wy, conv_w, conv_b, ra_w, ra_b, ix_w, ix_b, lam, wo, need_ctx_out):
    dt = h_lat.dtype

    def coeffs(u, d):
        shp = u.shape
        ub = u.reshape(shp[0], shp[1], LRU_BLOCKS, LRU_BLOCK)
        r = jax.nn.sigmoid(jnp.einsum('btnk,nkj->btnj', ub, ra_w[d]).reshape(shp) + ra_b[d])
        gi = jax.nn.sigmoid(jnp.einsum('btnk,nkj->btnj', ub, ix_w[d]).reshape(shp) + ix_b[d])
        log_a = LRU_C * r.astype(jnp.float32) * jax.nn.log_sigmoid(lam[d].astype(jnp.float32))
        a = jnp.exp(log_a)
        bx = jnp.sqrt(-jnp.expm1(2.0 * log_a)) * (gi * u).astype(jnp.float32)
        return a, bx

    def scan_fwd(u, h0):
        a, bx = coeffs(u, 0)
        return linear_scan(a, bx, h0)

    def scan_bwd(u, h0):
        a, bx = coeffs(u, 1)
        return jnp.flip(linear_scan(jnp.flip(a, 1), jnp.flip(bx, 1), h0), 1)

    u_c = centered_dwconv(h_ctx @ wx, conv_w, conv_b)
    u_l = centered_dwconv(h_lat @ wx, conv_w, conv_b)
    zeros = jnp.zeros((h_ctx.shape[0], LRU_WIDTH), jnp.float32)
    hc_f = scan_fwd(u_c, zeros)
    hc_b = scan_bwd(u_c, zeros)
    hl_f = scan_fwd(u_l, hc_f[:, -1])
    hl_b = scan_bwd(u_l, hc_b[:, 0])
    out_l = ((hl_f + hl_b).astype(dt) * jax.nn.gelu(h_lat @ wy)) @ wo
    out_c = None
    if need_ctx_out:
        out_c = ((hc_f + hc_b).astype(dt) * jax.nn.gelu(h_ctx @ wy)) @ wo
    return out_l, out_c


def mla_mixer(h_lat, h_ctx, wq_a, q_a_g, wq_b, wkv_a, kv_a_g, wkv_b, wo, tabs, need_ctx_out):
    def q_proj(h, rotary):
        bsz, t, _ = h.shape
        q = (rms_norm(h @ wq_a, q_a_g) @ wq_b).reshape(bsz, t, MLA_HEADS, MLA_QK_NOPE + MLA_QK_ROPE)
        q_nope, q_pe = jnp.split(q, [MLA_QK_NOPE], axis=-1)
        if rotary:
            q_pe = rope_2d(q_pe, tabs)
        return jnp.concatenate([q_nope, q_pe], -1)[:, :, :, None, :]

    def kv_proj(h, rotary):
        bsz, t, _ = h.shape
        ckv, k_pe = jnp.split(h @ wkv_a, [MLA_KV_LORA], axis=-1)
        kv = (rms_norm(ckv, kv_a_g) @ wkv_b).reshape(bsz, t, MLA_HEADS, MLA_QK_NOPE + MLA_V_DIM)
        k_nope, v = jnp.split(kv, [MLA_QK_NOPE], axis=-1)
        k_pe = k_pe[:, :, None, :]
        if rotary:
            k_pe = rope_2d(k_pe, tabs)
        k = jnp.concatenate([k_nope, jnp.broadcast_to(k_pe, (bsz, t, MLA_HEADS, MLA_QK_ROPE))], -1)
        return k, v

    scale = (MLA_QK_NOPE + MLA_QK_ROPE) ** -0.5
    k_c, v_c = kv_proj(h_ctx, False)
    k_l, v_l = kv_proj(h_lat, True)
    o_l = block_attention(q_proj(h_lat, True), jnp.concatenate([k_c, k_l], 1),
                          jnp.concatenate([v_c, v_l], 1), scale)
    out_l = o_l.reshape(h_lat.shape[0], h_lat.shape[1], -1) @ wo
    out_c = None
    if need_ctx_out:
        o_c = block_attention(q_proj(h_ctx, False), k_c, v_c, scale)
        out_c = o_c.reshape(h_ctx.shape[0], h_ctx.shape[1], -1) @ wo
    return out_l, out_c


def sq_relu_mlp(h, w1, w2):
    return jnp.square(jax.nn.relu(h @ w1)) @ w2


def setup_inputs(seed: int = 0) -> dict:
    key = jax.random.key(seed)
    ks = iter(jax.random.split(key, 48))
    f32 = jnp.float32
    d = D_MODEL

    def nrm(shape, scale):
        return jax.random.normal(next(ks), shape, f32) * scale

    x = nrm((BATCH, SEQ, d), 1.0)
    c = nrm((BATCH, d), 1.0)
    ctx = nrm((BATCH, CTX_LEN, d), 1.0)
    c_ctx = nrm((d,), 1.0)
    ada_w = nrm((DEPTH, d, 6 * d), 0.5 * d ** -0.5)
    ada_b = nrm((DEPTH, 6 * d), 0.01)
    ln_g = 1.0 + nrm((DEPTH, 2, d), 0.01)
    ln_b = nrm((DEPTH, 2, d), 0.01)
    mlp_w1 = nrm((DEPTH, d, D_FF), d ** -0.5)
    mlp_w2 = nrm((DEPTH, D_FF, d), D_FF ** -0.5 * DN_BETA)
    gqa_wq = nrm((N_A, d, A_HEADS * A_HEAD_DIM), d ** -0.5)
    gqa_wk = nrm((N_A, d, A_KV_HEADS * A_HEAD_DIM), d ** -0.5)
    gqa_wv = nrm((N_A, d, A_KV_HEADS * A_HEAD_DIM), d ** -0.5)
    gqa_wo = nrm((N_A, A_HEADS * A_HEAD_DIM, d), (A_HEADS * A_HEAD_DIM) ** -0.5 * DN_BETA)
    gqa_q_g = 1.0 + nrm((N_A, A_HEAD_DIM), 0.01)
    gqa_k_g = 1.0 + nrm((N_A, A_HEAD_DIM), 0.01)
    lru_wx = nrm((N_B, d, LRU_WIDTH), d ** -0.5)
    lru_wy = nrm((N_B, d, LRU_WIDTH), d ** -0.5)
    lru_conv_w = nrm((N_B, CONV_W, LRU_WIDTH), CONV_W ** -0.5)
    lru_conv_b = nrm((N_B, LRU_WIDTH), 0.01)
    lru_ra_w = nrm((N_B, 2, LRU_BLOCKS, LRU_BLOCK, LRU_BLOCK), LRU_BLOCK ** -0.5)
    lru_ra_b = nrm((N_B, 2, LRU_WIDTH), 0.01)
    lru_ix_w = nrm((N_B, 2, LRU_BLOCKS, LRU_BLOCK, LRU_BLOCK), LRU_BLOCK ** -0.5)
    lru_ix_b = nrm((N_B, 2, LRU_WIDTH), 0.01)
    a0 = jax.random.uniform(next(ks), (N_B, 2, LRU_WIDTH), f32, 0.9, 0.999)
    s = a0 ** (1.0 / LRU_C)
    lru_lam = jnp.log(s) - jnp.log1p(-s)
    lru_wo = nrm((N_B, LRU_WIDTH, d), LRU_WIDTH ** -0.5 * DN_BETA)
    mla_wq_a = nrm((N_C, d, MLA_Q_LORA), d ** -0.5)
    mla_q_a_g = 1.0 + nrm((N_C, MLA_Q_LORA), 0.01)
    mla_wq_b = nrm((N_C, MLA_Q_LORA, MLA_HEADS * (MLA_QK_NOPE + MLA_QK_ROPE)), MLA_Q_LORA ** -0.5)
    mla_wkv_a = nrm((N_C, d, MLA_KV_LORA + MLA_QK_ROPE), d ** -0.5)
    mla_kv_a_g = 1.0 + nrm((N_C, MLA_KV_LORA), 0.01)
    mla_wkv_b = nrm((N_C, MLA_KV_LORA, MLA_HEADS * (MLA_QK_NOPE + MLA_V_DIM)), MLA_KV_LORA ** -0.5)
    mla_wo = nrm((N_C, MLA_HEADS * MLA_V_DIM, d), (MLA_HEADS * MLA_V_DIM) ** -0.5 * DN_BETA)
    return {'x': x, 'c': c, 'ctx': ctx, 'c_ctx': c_ctx, 'ada_w': ada_w, 'ada_b': ada_b,
            'ln_g': ln_g, 'ln_b': ln_b, 'mlp_w1': mlp_w1, 'mlp_w2': mlp_w2,
            'gqa_wq': gqa_wq, 'gqa_wk': gqa_wk, 'gqa_wv': gqa_wv, 'gqa_wo': gqa_wo,
            'gqa_q_g': gqa_q_g, 'gqa_k_g': gqa_k_g,
            'lru_wx': lru_wx, 'lru_wy': lru_wy, 'lru_conv_w': lru_conv_w, 'lru_conv_b': lru_conv_b,
            'lru_ra_w': lru_ra_w, 'lru_ra_b': lru_ra_b, 'lru_ix_w': lru_ix_w, 'lru_ix_b': lru_ix_b,
            'lru_lam': lru_lam, 'lru_wo': lru_wo,
            'mla_wq_a': mla_wq_a, 'mla_q_a_g': mla_q_a_g, 'mla_wq_b': mla_wq_b, 'mla_wkv_a': mla_wkv_a,
            'mla_kv_a_g': mla_kv_a_g, 'mla_wkv_b': mla_wkv_b, 'mla_wo': mla_wo}


def reference(x, c, ctx, c_ctx, ada_w, ada_b, ln_g, ln_b, mlp_w1, mlp_w2,
              gqa_wq, gqa_wk, gqa_wv, gqa_wo, gqa_q_g, gqa_k_g,
              lru_wx, lru_wy, lru_conv_w, lru_conv_b, lru_ra_w, lru_ra_b, lru_ix_w, lru_ix_b,
              lru_lam, lru_wo,
              mla_wq_a, mla_q_a_g, mla_wq_b, mla_wkv_a, mla_kv_a_g, mla_wkv_b, mla_wo):
    n_lat = x.shape[1]
    rows = n_lat // GRID_W
    tabs_gqa = axial_tables(rows, A_HEAD_DIM)
    tabs_mla = axial_tables(rows, MLA_QK_ROPE)
    sc_c = jax.nn.silu(c)
    sc_ctx = jax.nn.silu(c_ctx)
    hctx = ctx
    for i in range(DEPTH):
        kind = i % N_MIXERS
        slot = i // N_MIXERS
        last = i == DEPTH - 1
        m_l = jnp.split((sc_c @ ada_w[i] + ada_b[i])[:, None, :], 6, axis=-1)
        m_c = jnp.split(sc_ctx @ ada_w[i] + ada_b[i], 6, axis=-1)
        h_l = x * (1.0 + m_l[1]) + m_l[0]
        h_c = hctx * (1.0 + m_c[1]) + m_c[0]
        if kind == 0:
            o_l, o_c = gqa_mixer(h_l, h_c, gqa_wq[slot], gqa_wk[slot], gqa_wv[slot], gqa_wo[slot],
                                 gqa_q_g[slot], gqa_k_g[slot], tabs_gqa, not last)
        elif kind == 1:
            o_l, o_c = rglru_mixer(h_l, h_c, lru_wx[slot], lru_wy[slot], lru_conv_w[slot], lru_conv_b[slot],
                                   lru_ra_w[slot], lru_ra_b[slot], lru_ix_w[slot], lru_ix_b[slot],
                                   lru_lam[slot], lru_wo[slot], not last)
        else:
            o_l, o_c = mla_mixer(h_l, h_c, mla_wq_a[slot], mla_q_a_g[slot], mla_wq_b[slot], mla_wkv_a[slot],
                                 mla_kv_a_g[slot], mla_wkv_b[slot], mla_wo[slot], tabs_mla, not last)
        x = layer_norm(DN_ALPHA * x + (1.0 + m_l[2]) * o_l, ln_g[i, 0], ln_b[i, 0])
        f_l = sq_relu_mlp(x * (1.0 + m_l[4]) + m_l[3], mlp_w1[i], mlp_w2[i])
        x = layer_norm(DN_ALPHA * x + (1.0 + m_l[5]) * f_l, ln_g[i, 1], ln_b[i, 1])
        if not last:
            hctx = layer_norm(DN_ALPHA * hctx + (1.0 + m_c[2]) * o_c, ln_g[i, 0], ln_b[i, 0])
            f_c = sq_relu_mlp(hctx * (1.0 + m_c[4]) + m_c[3], mlp_w1[i], mlp_w2[i])
            hctx = layer_norm(DN_ALPHA * hctx + (1.0 + m_c[5]) * f_c, ln_g[i, 1], ln_b[i, 1])
    return x
```

```cpp
#include <hip/hip_runtime.h>
#include <cstdio>
#include <cstdint>
#include <cmath>

#define LAS __attribute__((address_space(3)))
#define GAS __attribute__((address_space(1)))
typedef unsigned short bf16_t;
typedef short bf16x8 __attribute__((ext_vector_type(8)));
typedef short s16x4 __attribute__((ext_vector_type(4)));
typedef float f32x4 __attribute__((ext_vector_type(4)));
typedef float f32x2 __attribute__((ext_vector_type(2)));
typedef float f32x16 __attribute__((ext_vector_type(16)));
typedef unsigned u32x4 __attribute__((ext_vector_type(4)));
typedef unsigned u32x2 __attribute__((ext_vector_type(2)));

__device__ __forceinline__ unsigned cvt_pk_bf16(float lo, float hi) { unsigned r; asm volatile("v_cvt_pk_bf16_f32 %0, %1, %2" : "=v"(r) : "v"(lo), "v"(hi)); return r; }
__device__ __forceinline__ float bf_lo(unsigned w) { return __uint_as_float(w << 16); }
__device__ __forceinline__ float bf_hi(unsigned w) { return __uint_as_float(w & 0xffff0000u); }
__device__ __forceinline__ float bf2f(bf16_t h) { return __uint_as_float(((unsigned)h) << 16); }
__device__ __forceinline__ bf16_t f2bf(float f) { return (bf16_t)(cvt_pk_bf16(f, f) & 0xffffu); }

constexpr int DM = 2048, NB = 4, SEQ = 4096, CTX = 256, TB = SEQ + CTX  , R = NB * TB  , DFF = 8192, DEPTH = 4;
constexpr float LN_EPS = 1e-6f;
constexpr float DN_ALPHA = 1.6817928305074290861f;

namespace pg8 {
constexpr int BM = 256, BK = 64, HALF = 128, HTB = HALF * BK * 2, STAGE_BYTES = 8 * HTB, NXCD = 8, WGM = 8;
__host__ __device__ __forceinline__ int lds_byte(int r, int c) { const int st = (r >> 4) * 2 + (c >> 5), rr = r & 15, cc = c & 31, ob = rr * 64 + cc * 2; return st * 1024 + (ob ^ (((ob >> 9) & 1) << 5)); }
__host__ __device__ __forceinline__ void stage_rc(int b, int& Rr, int& C) { const int st = b / 1024, sb = b % 1024, swz = sb ^ (((sb >> 9) & 1) << 5); Rr = (st >> 1) * 16 + swz / 64; C = (st & 1) * 32 + (swz % 64) / 2; }
__host__ __device__ __forceinline__ int perm32(int rho) { const int n = rho >> 4, i = rho & 15; return 8 * (i >> 2) + 4 * n + (i & 3); }

struct Unit { int pm, pn; };
struct Gemm { const bf16_t* A; const bf16_t* Bt; int M, N, K, lda, ldb, a_blk; };

struct StaticOrder {
    int nM, nN, nwg, G, c;
    __device__ void init(int M, int N, int G_, int c_) { nM = M / BM; nN = N / BM; nwg = nM * nN; G = G_; c = c_; }
    __device__ bool next(int i, Unit& u) const {
        const long L = (long)i * G + c; if (L >= nwg) return false;
        int wgid = (int)L; { const int q = nwg / NXCD, r = nwg % NXCD, xcd = wgid % NXCD, off = wgid / NXCD; wgid = (xcd < r ? xcd * (q + 1) : r * (q + 1) + (xcd - r) * q) + off; }
        const int nig = WGM * nN, gid = wgid / nig, fm = gid * WGM, gsz = (nM - fm) < WGM ? (nM - fm) : WGM;
        u.pm = fm + ((wgid % nig) % gsz); u.pn = (wgid % nig) / gsz; return true;
    }
};

template <class F> struct EpiRow8 {
    static constexpr bool PERM = true;
    F f;
    __device__ __forceinline__ void operator()(const f32x4 (&acc)[2][2][4][2], const Unit& u, int wr, int wc, int fr, int fq) {
        const int row0 = u.pm * BM + wr * 64 + fr, colb = u.pn * BM + wc * 32 + 8 * fq;
        f.begin(u, colb);
#pragma unroll
        for (int ai = 0; ai < 2; ++ai)
#pragma unroll
            for (int m = 0; m < 4; ++m) {
                const int row = row0 + ai * HALF + m * 16;
#pragma unroll
                for (int bj = 0; bj < 2; ++bj) f.row8(row, bj, colb + bj * HALF, acc[ai][bj][m][0], acc[ai][bj][m][1]);
            }
    }
};

template <class Epi, class Sched, bool ALIGN_EPI = true, bool SP2 = true>
__device__ __forceinline__ void gemm_phase(LAS unsigned char* lds, const Gemm g, const Sched& S, Epi& E) {
    const int tid = threadIdx.x, wid = __builtin_amdgcn_readfirstlane(tid >> 6), lane = tid & 63, wr = wid >> 2, wc = wid & 3, fr = lane & 15, fq = lane >> 4;
    const int K = g.K, nt = K / BK;
    unsigned voffA[2], voffB[2];
#pragma unroll
    for (int i = 0; i < 2; ++i) { int Rr, C; stage_rc(tid * 16 + i * 8192, Rr, C); const int Rb = Epi::PERM ? ((Rr & ~31) + perm32(Rr & 31)) : Rr;
        voffA[i] = (unsigned)(Rr * g.lda + C) * 2u; voffB[i] = (unsigned)(Rb * g.ldb + C) * 2u; }
    const size_t kstep = (size_t)(BK * 2);
    const size_t hstepA = (size_t)HALF * g.lda * 2, hstepB = (size_t)HALF * g.ldb * 2;
    const size_t tstepA = 2 * hstepA, tstepB = 2 * hstepB;
    const unsigned ldsw = (unsigned)wid * 1024u;
    const int aoff = lds_byte(wr * 64 + fr, fq * 8), boff = lds_byte(wc * 32 + fr, fq * 8);
#define PG8_SA(b, h) (((b) * 2 + (h)) * HTB)
#define PG8_SB(b, h) ((4 + (b) * 2 + (h)) * HTB)
#define PG8_STAGE(bufoff, gbase, voff) do { _Pragma("unroll") for (int _i = 0; _i < 2; ++_i) \
        __builtin_amdgcn_global_load_lds((const unsigned*)((const char*)(gbase) + (voff)[_i]), (LAS unsigned*)(lds + (bufoff) + ldsw + _i * 8192), 16, 0, 0); } while (0)
#define PG8_LDA(dst, b, h) do { _Pragma("unroll") for (int m = 0; m < 4; ++m) _Pragma("unroll") for (int k = 0; k < 2; ++k) dst[m][k] = *(const LAS bf16x8*)(lds + PG8_SA(b, h) + aoff + m * 2048 + k * 1024); } while (0)
#define PG8_LDB(dst, b, h) do { _Pragma("unroll") for (int n = 0; n < 2; ++n) _Pragma("unroll") for (int k = 0; k < 2; ++k) dst[n][k] = *(const LAS bf16x8*)(lds + PG8_SB(b, h) + boff + n * 2048 + k * 1024); } while (0)
#define PG8_MMA(ai, bj, At, Bt) do { __builtin_amdgcn_s_setprio(1); _Pragma("unroll") for (int m = 0; m < 4; ++m) _Pragma("unroll") for (int n = 0; n < 2; ++n) _Pragma("unroll") for (int k = 0; k < 2; ++k) \
        acc[ai][bj][m][n] = __builtin_amdgcn_mfma_f32_16x16x32_bf16(Bt[n][k], At[m][k], acc[ai][bj][m][n], 0, 0, 0); __builtin_amdgcn_s_setprio(0); } while (0)
#define PG8_WAIT_V(n) asm volatile("s_waitcnt vmcnt(" #n ")" ::: "memory")
#define PG8_WAIT_L(n) asm volatile("s_waitcnt lgkmcnt(" #n ")" ::: "memory")
#define PG8_BAR __builtin_amdgcn_s_barrier()
#define PG8_SCHED __builtin_amdgcn_sched_barrier(0)
    Unit cur, nxt; int ui = 0;
    if (!S.next(0, cur)) return;
    f32x4 acc[2][2][4][2];
#pragma unroll
    for (int a = 0; a < 2; ++a)
#pragma unroll
        for (int b = 0; b < 2; ++b)
#pragma unroll
            for (int m = 0; m < 4; ++m)
#pragma unroll
                for (int n = 0; n < 2; ++n) acc[a][b][m][n] = (f32x4){0.f, 0.f, 0.f, 0.f};
    bf16x8 At[4][2], B0[2][2], B1[2][2];
    const char* cA = (const char*)g.A + (size_t)cur.pm * tstepA + (size_t)(g.a_blk ? (cur.pn & 7) * 512 : 0); const char* cB = (const char*)g.Bt + (size_t)cur.pn * tstepB;
    if constexpr (SP2) {
        PG8_STAGE(PG8_SB(0, 0), cB, voffB); PG8_STAGE(PG8_SB(0, 1), cB + hstepB, voffB); PG8_STAGE(PG8_SA(0, 0), cA, voffA); PG8_STAGE(PG8_SA(0, 1), cA + hstepA, voffA);
        if (wr == 1) PG8_BAR;
        PG8_WAIT_V(2); PG8_BAR;
        PG8_STAGE(PG8_SB(1, 0), cB + kstep, voffB); PG8_STAGE(PG8_SA(1, 0), cA + kstep, voffA); PG8_STAGE(PG8_SB(1, 1), cB + hstepB + kstep, voffB);
        PG8_WAIT_V(6); PG8_BAR;
    } else {
        PG8_STAGE(PG8_SB(0, 0), cB, voffB); PG8_STAGE(PG8_SA(0, 0), cA, voffA); PG8_STAGE(PG8_SB(0, 1), cB + hstepB, voffB); PG8_STAGE(PG8_SA(0, 1), cA + hstepA, voffA);
        if (wr == 1) PG8_BAR;
        PG8_WAIT_V(4); PG8_BAR;
        PG8_STAGE(PG8_SB(1, 0), cB + kstep, voffB); PG8_STAGE(PG8_SA(1, 0), cA + kstep, voffA); PG8_STAGE(PG8_SB(1, 1), cB + hstepB + kstep, voffB);
        PG8_WAIT_V(6); PG8_BAR;
    }
    for (;;) {
        const bool has_next = S.next(ui + 1, nxt);
        const char* nA = has_next ? (const char*)g.A + (size_t)nxt.pm * tstepA + (size_t)(g.a_blk ? (nxt.pn & 7) * 512 : 0) : cA; const char* nB = has_next ? (const char*)g.Bt + (size_t)nxt.pn * tstepB : cB;
#pragma unroll 1
        for (int t = 0; t < nt; t += 2) {
            const bool last = (t == nt - 2);
            const char* a1 = cA + (size_t)(t + 1) * kstep;
            const char* a2 = last ? nA : cA + (size_t)(t + 2) * kstep; const char* b2 = last ? nB : cB + (size_t)(t + 2) * kstep;
            const char* a3 = a2 + kstep; const char* b3 = b2 + kstep;
            if constexpr (SP2) {
            PG8_LDB(B0, 0, 0); PG8_LDB(B1, 0, 1); PG8_SCHED; PG8_LDA(At, 0, 0); PG8_STAGE(PG8_SA(1, 1), a1 + hstepA, voffA);
            PG8_WAIT_V(8); PG8_WAIT_L(0); PG8_BAR; PG8_MMA(0, 0, At, B0); PG8_MMA(0, 1, At, B1); PG8_BAR; PG8_SCHED;
            PG8_LDA(At, 0, 1); PG8_STAGE(PG8_SB(0, 0), b2, voffB); PG8_STAGE(PG8_SB(0, 1), b2 + hstepB, voffB); PG8_STAGE(PG8_SA(0, 0), a2, voffA);
            PG8_WAIT_V(8); PG8_WAIT_L(0); PG8_BAR; PG8_MMA(1, 0, At, B0); PG8_MMA(1, 1, At, B1); PG8_BAR; PG8_SCHED;
            PG8_LDB(B0, 1, 0); PG8_LDB(B1, 1, 1); PG8_SCHED; PG8_LDA(At, 1, 0); PG8_STAGE(PG8_SA(0, 1), a2 + hstepA, voffA);
            PG8_WAIT_V(8); PG8_WAIT_L(0); PG8_BAR; PG8_MMA(0, 0, At, B0); PG8_MMA(0, 1, At, B1); PG8_BAR; PG8_SCHED;
            PG8_LDA(At, 1, 1); PG8_STAGE(PG8_SB(1, 0), b3, voffB); PG8_STAGE(PG8_SB(1, 1), b3 + hstepB, voffB); PG8_STAGE(PG8_SA(1, 0), a3, voffA);
            PG8_WAIT_V(8); PG8_WAIT_L(0); PG8_BAR; PG8_MMA(1, 0, At, B0); PG8_MMA(1, 1, At, B1); PG8_BAR; PG8_SCHED;
            } else {
            PG8_LDB(B0, 0, 0); PG8_SCHED; PG8_LDA(At, 0, 0); PG8_STAGE(PG8_SA(1, 1), a1 + hstepA, voffA);
            PG8_WAIT_L(8); PG8_BAR; PG8_WAIT_L(0); PG8_MMA(0, 0, At, B0); PG8_BAR; PG8_SCHED;
            PG8_LDB(B1, 0, 1); PG8_STAGE(PG8_SB(0, 0), b2, voffB);
            PG8_BAR; PG8_WAIT_L(0); PG8_MMA(0, 1, At, B1); PG8_BAR;
            PG8_LDA(At, 0, 1); PG8_STAGE(PG8_SA(0, 0), a2, voffA);
            PG8_BAR; PG8_WAIT_L(0); PG8_MMA(1, 0, At, B0); PG8_BAR; PG8_SCHED;
            PG8_STAGE(PG8_SB(0, 1), b2 + hstepB, voffB);
            PG8_WAIT_V(6); PG8_BAR; PG8_MMA(1, 1, At, B1); PG8_BAR;
            PG8_LDB(B0, 1, 0); PG8_SCHED; PG8_LDA(At, 1, 0); PG8_STAGE(PG8_SA(0, 1), a2 + hstepA, voffA);
            PG8_WAIT_L(8); PG8_BAR; PG8_WAIT_L(0); PG8_MMA(0, 0, At, B0); PG8_BAR; PG8_SCHED;
            PG8_LDB(B1, 1, 1); PG8_STAGE(PG8_SB(1, 0), b3, voffB);
            PG8_BAR; PG8_WAIT_L(0); PG8_MMA(0, 1, At, B1); PG8_BAR;
            PG8_LDA(At, 1, 1); PG8_STAGE(PG8_SA(1, 0), a3, voffA);
            PG8_BAR; PG8_WAIT_L(0); PG8_MMA(1, 0, At, B0); PG8_BAR; PG8_SCHED;
            PG8_STAGE(PG8_SB(1, 1), b3 + hstepB, voffB);
            PG8_WAIT_V(6); PG8_BAR; PG8_MMA(1, 1, At, B1); PG8_BAR;
            }
        }
        if constexpr (ALIGN_EPI) { if (wr == 0) PG8_BAR; }
        E(acc, cur, wr, wc, fr, fq);
        if (!has_next) break;
#pragma unroll
        for (int a = 0; a < 2; ++a)
#pragma unroll
            for (int b = 0; b < 2; ++b)
#pragma unroll
                for (int m = 0; m < 4; ++m)
#pragma unroll
                    for (int n = 0; n < 2; ++n) acc[a][b][m][n] = (f32x4){0.f, 0.f, 0.f, 0.f};
        cur = nxt; cA = nA; cB = nB; ++ui;
        if constexpr (ALIGN_EPI) { if (wr == 1) PG8_BAR; }
    }
    PG8_WAIT_V(0);
    if constexpr (!ALIGN_EPI) { if (wr == 0) PG8_BAR; }
    PG8_BAR;
#undef PG8_SA
#undef PG8_SB
#undef PG8_STAGE
#undef PG8_LDA
#undef PG8_LDB
#undef PG8_MMA
#undef PG8_WAIT_V
#undef PG8_WAIT_L
#undef PG8_BAR
#undef PG8_SCHED
}
}

namespace att {
constexpr int NW = 8, QBLK = 32, KVBLK = 64, DV = 128;
constexpr float THR = 8.f;
#define SBAR() __builtin_amdgcn_sched_barrier(0)
__device__ __forceinline__ int crow(int r, int hi) { return (r & 3) + 8 * (r >> 2) + 4 * hi; }
template <int DQK> struct Cfg {
    static constexpr int KROW = DQK * 2;
    static constexpr int SHM_K = KVBLK * KROW, SHM_V = KVBLK * DV * 2;
    static constexpr int QPE_OFF = 2 * SHM_V + 2 * SHM_K + NW * 64 * 4;
    static constexpr int LDS_BYTES = QPE_OFF + (DQK == 192 ? NW * 4096 : 0);
    static constexpr int NQ = DQK / 16;
    static constexpr int NKC = DQK / 64;
};
template <int DQK> __device__ __forceinline__ int kswz(int row, int colB) { return row * (DQK * 2) + (colB ^ ((row & 7) << 4)); }

template <int DQK>
__device__ __forceinline__ void partialSM(f32x16& p0, f32x16& p1, float& m_reg, float& mn, float& alpha) {
    constexpr float SCALE = DQK == 128 ? 0.08838834764831845f : 0.07216878364870322f;
    constexpr float C = SCALE * 1.4426950408889634f;
    float pmax = p0[0];
#pragma unroll
    for (int r = 1; r < 16; ++r) pmax = fmaxf(pmax, p0[r]);
#pragma unroll
    for (int r = 0; r < 16; ++r) pmax = fmaxf(pmax, p1[r]);
    { auto rr = __builtin_amdgcn_permlane32_swap(__float_as_uint(pmax), __float_as_uint(pmax), false, false);
      pmax = fmaxf(__uint_as_float(rr[0]), __uint_as_float(rr[1])); }
    if (__builtin_expect(__all(pmax - m_reg <= THR / SCALE), 1)) { mn = m_reg; alpha = 1.f; }
    else { mn = fmaxf(m_reg, pmax); alpha = __builtin_amdgcn_exp2f((m_reg - mn) * C); m_reg = mn; }
    const float mnC = -mn * C;
#pragma unroll
    for (int r = 0; r < 16; ++r) p0[r] = fmaf(p0[r], C, mnC);
#pragma unroll
    for (int r = 0; r < 16; ++r) p1[r] = fmaf(p1[r], C, mnC);
#pragma unroll
    for (int r = 0; r < 16; ++r) p0[r] = __builtin_amdgcn_exp2f(p0[r]);
}
__device__ __forceinline__ void finishSM(f32x16& p0, f32x16& p1, float alpha, float& l_reg, bf16x8& pa0, bf16x8& pa1, bf16x8& pa2, bf16x8& pa3) {
#pragma unroll
    for (int r = 0; r < 16; ++r) p1[r] = __builtin_amdgcn_exp2f(p1[r]);
    float ps = 0;
#pragma unroll
    for (int r = 0; r < 16; ++r) ps += p0[r];
#pragma unroll
    for (int r = 0; r < 16; ++r) ps += p1[r];
    { auto rr = __builtin_amdgcn_permlane32_swap(__float_as_uint(ps), __float_as_uint(ps), false, false);
      ps = __uint_as_float(rr[0]) + __uint_as_float(rr[1]); }
    l_reg = l_reg * alpha + ps;
#define PK4(P, BASE, OUT) do { unsigned a0 = cvt_pk_bf16(P[BASE + 0], P[BASE + 1]), a1 = cvt_pk_bf16(P[BASE + 2], P[BASE + 3]);   \
    unsigned b0 = cvt_pk_bf16(P[BASE + 4], P[BASE + 5]), b1 = cvt_pk_bf16(P[BASE + 6], P[BASE + 7]);                              \
    auto r0 = __builtin_amdgcn_permlane32_swap(a0, b0, false, false); auto r1 = __builtin_amdgcn_permlane32_swap(a1, b1, false, false); \
    u32x4 w = {r0[0], r1[0], r0[1], r1[1]}; OUT = *reinterpret_cast<bf16x8*>(&w); } while (0)
    PK4(p0, 0, pa0); PK4(p0, 8, pa1); PK4(p1, 0, pa2); PK4(p1, 8, pa3);
#undef PK4
}
template <int DQK>
__device__ __forceinline__ void qkt(f32x16& p0, f32x16& p1, const char* Ks, const bf16x8* qr, const char* qpe, int r32, int hi) {
    p0 = f32x16{}; p1 = f32x16{};
#pragma unroll
    for (int d0 = 0; d0 < DQK / 16; ++d0) { const int cb = (d0 * 16 + hi * 8) * 2;
        bf16x8 b0 = *reinterpret_cast<const bf16x8*>(Ks + kswz<DQK>(r32, cb));
        bf16x8 b1 = *reinterpret_cast<const bf16x8*>(Ks + kswz<DQK>(32 + r32, cb));
        bf16x8 q; if (d0 < 8) q = qr[d0 < 8 ? d0 : 0]; else q = *reinterpret_cast<const bf16x8*>(qpe + (d0 - 8) * 1024);
        p0 = __builtin_amdgcn_mfma_f32_32x32x16_bf16(b0, q, p0, 0, 0, 0);
        p1 = __builtin_amdgcn_mfma_f32_32x32x16_bf16(b1, q, p1, 0, 0, 0);
        if (DQK == 192 && (d0 & 3) == 3 && d0 != 11) SBAR(); }
}
__device__ __forceinline__ int v_st(int k, int c) { const int kk = (k & ~0xC) | ((k & 4) << 1) | ((k & 8) >> 1); return ((kk >> 3) * 4 + (c >> 5)) * 512 + ((kk & 7) * 32 + (c & 31)) * 2; }
__device__ __forceinline__ int v_rd_base(int lane) { return ((lane & 3) << 3) | (((lane >> 2) & 3) << 6) | (((lane >> 4) & 1) << 5) | (((lane >> 5) & 1) << 8); }
constexpr int v_rd_off(int d0, int ks, int half) { return d0 * 512 + ks * 4096 + half * 2048; }
template <int OFF> __device__ __forceinline__ s16x4 tr_read(int vb) {
    s16x4 r; asm volatile("ds_read_b64_tr_b16 %0, %1 offset:%2" : "=&v"(r) : "v"(vb), "i"(OFF) : "memory"); return r;
}
template <int D0> __device__ __forceinline__ void pv_one(f32x16& od, int vb, bf16x8 pa0, bf16x8 pa1, bf16x8 pa2, bf16x8 pa3) {
    const s16x4 l0 = tr_read<v_rd_off(D0, 0, 0)>(vb), h0 = tr_read<v_rd_off(D0, 0, 1)>(vb), l1 = tr_read<v_rd_off(D0, 1, 0)>(vb), h1 = tr_read<v_rd_off(D0, 1, 1)>(vb);
    const s16x4 l2 = tr_read<v_rd_off(D0, 2, 0)>(vb), h2 = tr_read<v_rd_off(D0, 2, 1)>(vb), l3 = tr_read<v_rd_off(D0, 3, 0)>(vb), h3 = tr_read<v_rd_off(D0, 3, 1)>(vb);
    asm volatile("s_waitcnt lgkmcnt(0)" ::: "memory"); SBAR();
#define PK(L, H) (bf16x8){L[0], L[1], L[2], L[3], H[0], H[1], H[2], H[3]}
    od = __builtin_amdgcn_mfma_f32_32x32x16_bf16(pa0, PK(l0, h0), od, 0, 0, 0);
    od = __builtin_amdgcn_mfma_f32_32x32x16_bf16(pa1, PK(l1, h1), od, 0, 0, 0);
    od = __builtin_amdgcn_mfma_f32_32x32x16_bf16(pa2, PK(l2, h2), od, 0, 0, 0);
    od = __builtin_amdgcn_mfma_f32_32x32x16_bf16(pa3, PK(l3, h3), od, 0, 0, 0);
#undef PK
}
__device__ __forceinline__ void pv_d0(f32x16* o, int vb, bf16x8 pa0, bf16x8 pa1, bf16x8 pa2, bf16x8 pa3) {
    pv_one<0>(o[0], vb, pa0, pa1, pa2, pa3); pv_one<1>(o[1], vb, pa0, pa1, pa2, pa3); pv_one<2>(o[2], vb, pa0, pa1, pa2, pa3); pv_one<3>(o[3], vb, pa0, pa1, pa2, pa3);
}
__device__ __forceinline__ void unpack8(bf16x8 v, float* f) {
    const u32x4 w = *reinterpret_cast<const u32x4*>(&v);
    f[0] = bf_lo(w.x); f[1] = bf_hi(w.x); f[2] = bf_lo(w.y); f[3] = bf_hi(w.y); f[4] = bf_lo(w.z); f[5] = bf_hi(w.z); f[6] = bf_lo(w.w); f[7] = bf_hi(w.w);
}
__device__ __forceinline__ bf16x8 pack8(const float* f) {
    u32x4 w = {cvt_pk_bf16(f[0], f[1]), cvt_pk_bf16(f[2], f[3]), cvt_pk_bf16(f[4], f[5]), cvt_pk_bf16(f[6], f[7])}; return *reinterpret_cast<bf16x8*>(&w);
}
__device__ __forceinline__ void rope_pair(bf16x8& A, bf16x8& B, const f32x2* __restrict__ tab) {
    float a[8], b[8], ra[8], rb[8]; unpack8(A, a); unpack8(B, b);
#pragma unroll
    for (int j = 0; j < 8; ++j) { const f32x2 cs = tab[j]; ra[j] = a[j] * cs.x - b[j] * cs.y; rb[j] = b[j] * cs.x + a[j] * cs.y; }
    A = pack8(ra); B = pack8(rb);
}

template <int DQK, int LDQ, int LDK, int LDV, int LDO>
__device__ __forceinline__ void attn_body(const bf16_t* __restrict__ Qb, const bf16_t* __restrict__ Kh, const bf16_t* __restrict__ Vh, bf16_t* __restrict__ Ob, int seq, char* lds,
                                          const float* __restrict__ qg, const f32x2* __restrict__ tab, bool rope, int tok0) {
    using C = Cfg<DQK>;
    int tid_ = threadIdx.x; asm volatile("" : "+v"(tid_));
    const int tid = tid_, wid = tid >> 6, lane = tid & 63, r32 = lane & 31, hi = lane >> 5;
    char* V_lds = lds; char* K_lds = lds + 2 * C::SHM_V;
    float* wsf = (float*)(lds + 2 * C::SHM_V + 2 * C::SHM_K) + wid * 64; float* li_l = wsf; float* al_l = wsf + 32;
    char* qpe = lds + C::QPE_OFF + wid * 4096 + lane * 16;
    float m_reg = -1e30f, l_reg = 0; f32x16 o[4] = {}; bf16x8 qr[C::NQ];
    const bf16_t* Qw = Qb + (long)(wid * QBLK + r32) * LDQ + hi * 8;
#pragma unroll
    for (int d0 = 0; d0 < C::NQ; ++d0) qr[d0] = *reinterpret_cast<const bf16x8*>(Qw + d0 * 16);
    {
        const int t = tok0 + wid * QBLK + r32, prow = t >> 6, pcol = t & 63;
        if constexpr (DQK == 128) {
            float ss = 0.f;
#pragma unroll
            for (int d0 = 0; d0 < 8; ++d0) { float f[8]; unpack8(qr[d0], f);
#pragma unroll
                for (int j = 0; j < 8; ++j) ss += f[j] * f[j]; }
            ss += __shfl_xor(ss, 32);
            const float rstd = 1.0f / sqrtf(ss * (1.0f / 128.0f) + 1e-6f);
#pragma unroll
            for (int d0 = 0; d0 < 8; ++d0) { float f[8]; unpack8(qr[d0], f);
#pragma unroll
                for (int j = 0; j < 8; ++j) f[j] = f[j] * rstd * qg[d0 * 16 + hi * 8 + j];
                qr[d0] = pack8(f); }
            if (rope) {
                const f32x2* tr = tab + prow * 32 + hi * 8; const f32x2* tc = tab + pcol * 32 + hi * 8;
                rope_pair(qr[0], qr[2], tr); rope_pair(qr[1], qr[3], tr + 16);
                rope_pair(qr[4], qr[6], tc); rope_pair(qr[5], qr[7], tc + 16);
            }
        } else {
            if (rope) {
                const f32x2* tr = tab + prow * 16 + hi * 8; const f32x2* tc = tab + pcol * 16 + hi * 8;
                rope_pair(qr[8], qr[9], tr); rope_pair(qr[10], qr[11], tc);
            }
        }
    }
    if constexpr (DQK == 192) {
#pragma unroll
        for (int d0 = 8; d0 < 12; ++d0) *reinterpret_cast<bf16x8*>(qpe + (d0 - 8) * 1024) = qr[d0];
        asm volatile("s_waitcnt lgkmcnt(0)" ::: "memory");
    }
    const int sr = tid >> 4, sc = (tid & 15) * 8, vst0 = v_st(sr, sc), vst1 = v_st(32 + sr, sc);
    const int vb0 = (int)(uintptr_t)V_lds + v_rd_base(lane);
    const int sr2 = tid >> 3, sc2 = 128 + (tid & 7) * 8;
    struct Slot { bf16x8 vs0, vs1, ks0, ks1, ks2; };
    Slot sA, sBs;
#define sB (*(DQK == 192 ? &sA : &sBs))
#define SLOAD(S, k0) do { S.vs0 = *reinterpret_cast<const bf16x8*>(&Vh[(long)((k0) + sr) * LDV + sc]); S.vs1 = *reinterpret_cast<const bf16x8*>(&Vh[(long)((k0) + 32 + sr) * LDV + sc]); \
    S.ks0 = *reinterpret_cast<const bf16x8*>(&Kh[(long)((k0) + sr) * LDK + sc]); S.ks1 = *reinterpret_cast<const bf16x8*>(&Kh[(long)((k0) + 32 + sr) * LDK + sc]); \
    if constexpr (DQK == 192) S.ks2 = *reinterpret_cast<const bf16x8*>(&Kh[(long)((k0) + sr2) * LDK + sc2]); } while (0)
#define SWRITE(b, S) do { *(bf16x8*)(V_lds + (b) * C::SHM_V + vst0) = S.vs0; *(bf16x8*)(V_lds + (b) * C::SHM_V + vst1) = S.vs1; \
    *(bf16x8*)(K_lds + (b) * C::SHM_K + kswz<DQK>(sr, sc * 2)) = S.ks0; *(bf16x8*)(K_lds + (b) * C::SHM_K + kswz<DQK>(32 + sr, sc * 2)) = S.ks1; \
    if constexpr (DQK == 192) *(bf16x8*)(K_lds + (b) * C::SHM_K + kswz<DQK>(sr2, sc2 * 2)) = S.ks2; } while (0)
#define SWAIT() do { if constexpr (DQK == 192) asm volatile("s_waitcnt vmcnt(0)" ::: "memory"); else asm volatile("s_waitcnt vmcnt(4)" ::: "memory"); } while (0)
#define RESC(a) do { if (__any((a) < 1.f)) { if (hi == 0) al_l[r32] = (a); asm volatile("s_waitcnt lgkmcnt(0)" ::: "memory"); \
    _Pragma("unroll") for (int d = 0; d < 4; ++d) _Pragma("unroll") for (int r = 0; r < 16; ++r) o[d][r] *= al_l[crow(r, hi)]; } } while (0)
    f32x16 pA0, pA1, pB0, pB1; float mnA, mnB, alA, alB; bf16x8 pa0, pa1, pa2, pa3; const int NT = seq / KVBLK;
    SLOAD(sA, 0); asm volatile("s_waitcnt vmcnt(0)" ::: "memory"); SWRITE(0, sA); __syncthreads();
    qkt<DQK>(pA0, pA1, K_lds, qr, qpe, r32, hi); partialSM<DQK>(pA0, pA1, m_reg, mnA, alA);
    SLOAD(sB, KVBLK); if constexpr (DQK != 192) { if (2 < NT) SLOAD(sA, 2 * KVBLK); }
    SWAIT(); SWRITE(1, sB); __syncthreads();
    for (int j = 1; j + 1 < NT; j += 2) {
        SBAR(); qkt<DQK>(pB0, pB1, K_lds + C::SHM_K, qr, qpe, r32, hi);
        finishSM(pA0, pA1, alA, l_reg, pa0, pa1, pa2, pa3); SBAR();
        SLOAD(sB, (j + (DQK == 192 ? 1 : 2)) * KVBLK); SBAR();
        pv_d0(o, vb0, pa0, pa1, pa2, pa3); partialSM<DQK>(pB0, pB1, m_reg, mnB, alB);
        __syncthreads(); SWAIT(); SWRITE(0, sA);
        RESC(alB); __syncthreads();
        SBAR(); qkt<DQK>(pA0, pA1, K_lds, qr, qpe, r32, hi);
        finishSM(pB0, pB1, alB, l_reg, pa0, pa1, pa2, pa3); SBAR();
        if (DQK == 192 || j + 3 < NT) SLOAD(sA, (j + (DQK == 192 ? 2 : 3)) * KVBLK); SBAR();
        pv_d0(o, vb0 + C::SHM_V, pa0, pa1, pa2, pa3); partialSM<DQK>(pA0, pA1, m_reg, mnA, alA);
        __syncthreads(); SWAIT(); SWRITE(1, sB);
        RESC(alA); __syncthreads();
    }
    SBAR(); qkt<DQK>(pB0, pB1, K_lds + C::SHM_K, qr, qpe, r32, hi);
    finishSM(pA0, pA1, alA, l_reg, pa0, pa1, pa2, pa3); SBAR();
    pv_d0(o, vb0, pa0, pa1, pa2, pa3); partialSM<DQK>(pB0, pB1, m_reg, mnB, alB);
    __syncthreads(); RESC(alB);
    finishSM(pB0, pB1, alB, l_reg, pa0, pa1, pa2, pa3); SBAR();
    pv_d0(o, vb0 + C::SHM_V, pa0, pa1, pa2, pa3);
    if (hi == 0) li_l[r32] = l_reg; asm volatile("s_waitcnt lgkmcnt(0)" ::: "memory");
    float rli[16];
#pragma unroll
    for (int r = 0; r < 16; ++r) rli[r] = __builtin_amdgcn_rcpf(li_l[crow(r, hi)]);
    bf16_t* Ow = Ob + (long)(wid * QBLK) * LDO;
#pragma unroll
    for (int r = 0; r < 16; ++r) { const int orow = crow(r, hi);
#pragma unroll
        for (int d0 = 0; d0 < 4; ++d0) Ow[(long)orow * LDO + d0 * 32 + r32] = f2bf(o[d0][r] * rli[r]); }
    __syncthreads();
#undef sB
#undef SLOAD
#undef SWRITE
#undef SWAIT
#undef RESC
}
}

constexpr size_t MiB = 1u << 20;
constexpr size_t WS_CTL = 0, CTL_ZERO_BYTES = 1 * MiB;
constexpr size_t WS_MODS = 1 * MiB;
constexpr size_t WS_TAB = 2 * MiB;
constexpr size_t WS_X = 4 * MiB;
constexpr size_t WS_H = 140 * MiB;
constexpr size_t WS_OUTF = 208 * MiB;
constexpr size_t WS_W1T = 344 * MiB, WS_W2T = 472 * MiB;
constexpr size_t WS_GQAW = 600 * MiB;
constexpr size_t WS_LRUW = 640 * MiB;
constexpr size_t WS_MLAW = 668 * MiB;
constexpr size_t WS_BIG = 688 * MiB;
constexpr size_t WS_ACT = WS_BIG;
constexpr size_t WS_GQ = WS_BIG, WS_GK = WS_BIG + 68 * MiB, WS_GV = WS_BIG + 85 * MiB, WS_GO = WS_BIG + 102 * MiB;
constexpr size_t WS_MAP = WS_BIG, WS_MQAN = WS_BIG + 85 * MiB, WS_MCKVN = WS_BIG + 102 * MiB, WS_MQ = WS_BIG + 119 * MiB, WS_MK = WS_BIG + 221 * MiB, WS_MV = WS_BIG + 323 * MiB, WS_MO = WS_BIG + 391 * MiB;
constexpr size_t WS_LUP = WS_BIG, WS_LG = WS_BIG  , WS_LGY = WS_BIG + 68 * MiB, WS_LU = WS_BIG + 136 * MiB, WS_LAF = WS_BIG + 204 * MiB, WS_LGUF = WS_BIG + 340 * MiB,
                 WS_LAB = WS_BIG + 476 * MiB, WS_LGUB = WS_BIG + 612 * MiB, WS_LPS = WS_BIG + 748 * MiB, WS_LCIN = WS_BIG + 766 * MiB;
static_assert(WS_LGUF == WS_LAF + (size_t)R * DM * 4 && WS_LAB == WS_LGUF + (size_t)R * DM * 4 && WS_LGUB == WS_LAB + (size_t)R * DM * 4, "gate outputs are consecutive");
constexpr size_t WS_END = WS_BIG + 776 * MiB;
constexpr int NCH = 136;

#define XB_TMO      128
#define XB_XCNT(j)  (256  + 64 * (j))
#define XB_XSUB(j)  (1280 + 64 * (j))
#define XB_XGEN(j)  (2304 + 64 * (j))
#define XB_TOP      3328
#define XB_TOPGEN   3392
#define XCD_BAR_WORDS 3456
#define XB_SPIN_CAP (1u << 22)
__device__ __forceinline__ unsigned xb_ld(unsigned* p)              { return __hip_atomic_load(p, __ATOMIC_RELAXED, __HIP_MEMORY_SCOPE_AGENT); }
__device__ __forceinline__ unsigned xb_add(unsigned* p, unsigned v) { return __hip_atomic_fetch_add(p, v, __ATOMIC_RELAXED, __HIP_MEMORY_SCOPE_AGENT); }
__device__ __forceinline__ unsigned xb_xcc_id() { return (unsigned)__builtin_amdgcn_s_getreg((3 << 11) | 20) & 0xFu; }
#define XB_SPIN(cond, bar) do { unsigned _sp = 0; while (cond) { __builtin_amdgcn_s_sleep(1); \
    if ((++_sp & 255u) == 0u) { if (xb_ld(&(bar)[XB_TMO])) break; if (_sp > XB_SPIN_CAP) { atomicAdd(&(bar)[XB_TMO], 1u); break; } } } } while (0)
struct XcdBarrier { unsigned* bar; unsigned x; volatile LAS unsigned* st; };
__device__ __forceinline__ XcdBarrier xcd_barrier_post(unsigned* bar, volatile LAS unsigned* st) {
    XcdBarrier b; b.bar = bar; b.x = xb_xcc_id(); b.st = st;
    if (threadIdx.x == 0) (void)xb_add(&bar[XB_XCNT(b.x)], 1u);
    return b;
}
__device__ __forceinline__ void xcd_barrier_complete(unsigned* bar, unsigned x, unsigned& nloc, unsigned& nx) {
    const unsigned G = gridDim.x * gridDim.y * gridDim.z;
    unsigned sum, cnt, mine, sp = 0u;
    for (;;) {
        sum = 0u; cnt = 0u; mine = 0u;
#pragma unroll
        for (unsigned j = 0; j < 16; ++j) { const unsigned c = xb_ld(&bar[XB_XCNT(j)]); sum += c; cnt += (c > 0u) ? 1u : 0u; mine = (j == x) ? c : mine; }
        if (sum == G) break;
        __builtin_amdgcn_s_sleep(1);
        if ((++sp & 255u) == 0u) { if (xb_ld(&bar[XB_TMO])) break; if (sp > XB_SPIN_CAP) { atomicAdd(&bar[XB_TMO], 1u); break; } }
    }
    nloc = mine > 0u ? mine : 1u; nx = cnt > 0u ? cnt : 1u;
}
__device__ __forceinline__ void xcd_barrier(const XcdBarrier& b) {
    asm volatile("s_waitcnt vmcnt(0)" ::: "memory");
    __syncthreads();
    if (threadIdx.x == 0) {
        unsigned* bar = b.bar;
        __builtin_amdgcn_s_waitcnt(0);
        unsigned nloc = b.st[0], nx = b.st[1];
        if (nloc == 0u) { xcd_barrier_complete(bar, b.x, nloc, nx); b.st[0] = nloc; b.st[1] = nx; }
        const unsigned old = xb_add(&bar[XB_XSUB(b.x)], 1u);
        const unsigned gen = old / nloc;
        if (old + 1u == (gen + 1u) * nloc) {
            __builtin_amdgcn_fence(__ATOMIC_RELEASE, "agent");
            asm volatile("s_waitcnt vmcnt(0)" ::: "memory");
            const unsigned og = xb_add(&bar[XB_TOP], 1u);
            const unsigned tg = og / nx;
            if (og + 1u == (tg + 1u) * nx) xb_add(&bar[XB_TOPGEN], 1u);
            else XB_SPIN(xb_ld(&bar[XB_TOPGEN]) == tg, bar);
            __builtin_amdgcn_fence(__ATOMIC_ACQUIRE, "agent");
            xb_add(&bar[XB_XGEN(b.x)], 1u);
            asm volatile("s_waitcnt vmcnt(0)" ::: "memory");
        } else {
            XB_SPIN(xb_ld(&bar[XB_XGEN(b.x)]) == gen, bar);
            __builtin_amdgcn_fence(__ATOMIC_ACQUIRE, "agent");
            asm volatile("s_waitcnt vmcnt(0)" ::: "memory");
        }
    }
    __syncthreads();
}

struct Args {
    const float *x, *c, *ctx, *c_ctx, *ada_w, *ada_b, *ln_g, *ln_b, *mlp_w1, *mlp_w2;
    const float *gqa_wq, *gqa_wk, *gqa_wv, *gqa_wo, *gqa_q_g, *gqa_k_g;
    const float *lru_wx, *lru_wy, *lru_conv_w, *lru_conv_b, *lru_ra_w, *lru_ra_b, *lru_ix_w, *lru_ix_b, *lru_lam, *lru_wo;
    const float *mla_wq_a, *mla_q_a_g, *mla_wq_b, *mla_wkv_a, *mla_kv_a_g, *mla_wkv_b, *mla_wo;
    float* out; unsigned char* ws; int ph_lo, ph_hi;
};

constexpr int NWAVES = 8;
constexpr int RING_BYTES = 131072, LDSCTL_OFF = RING_BYTES, LDS_BYTES = 147456;

__device__ __forceinline__ float wave_sum(float v) {
#pragma unroll
    for (int o = 1; o < 64; o <<= 1) v += __shfl_xor(v, o);
    return v;
}
__device__ __forceinline__ float sigmoidf_(float v) { return __builtin_amdgcn_rcpf(1.0f + __builtin_amdgcn_exp2f(-1.4426950408889634f * v)); }

__device__ __forceinline__ void ph_mods(const Args& a, LAS unsigned char* lds, int vcu, int G) {
    LAS float* S = (LAS float*)lds; LAS float* red = (LAS float*)(lds + 40960);
    const int tid = threadIdx.x, wave = tid >> 6, lane = tid & 63;
    for (int i = tid; i < 5 * DM; i += 512) { const int bi = i / DM, k = i % DM; const float v = bi < 4 ? a.c[bi * DM + k] : a.c_ctx[k]; S[i] = v / (1.0f + expf(-v)); }
    __syncthreads();
    float* mods = (float*)(a.ws + WS_MODS);
    for (int item = vcu; item < 768; item += G) {
        const int l = item / 192, n0 = (item % 192) * 64, ksub = wave * 4 + (lane >> 4), cl = lane & 15;
        const float* wp = a.ada_w + ((size_t)l * DM + ksub) * 12288 + n0 + cl * 4;
        float acc[5][4];
#pragma unroll
        for (int i = 0; i < 5; ++i)
#pragma unroll
            for (int j = 0; j < 4; ++j) acc[i][j] = 0.f;
#pragma unroll 8
        for (int it = 0; it < 64; ++it) {
            const f32x4 w = *(const f32x4*)(wp + (size_t)it * 32 * 12288); const int k = ksub + 32 * it;
#pragma unroll
            for (int i = 0; i < 5; ++i) { const float s = S[i * DM + k];
#pragma unroll
                for (int j = 0; j < 4; ++j) acc[i][j] += s * w[j]; }
        }
#pragma unroll
        for (int i = 0; i < 5; ++i)
#pragma unroll
            for (int j = 0; j < 4; ++j) red[(ksub * 5 + i) * 64 + cl * 4 + j] = acc[i][j];
        __syncthreads();
        if (tid < 320) { const int i = tid / 64, cc = tid % 64; float s = 0.f;
            for (int ks = 0; ks < 32; ++ks) s += red[(ks * 5 + i) * 64 + cc];
            mods[(size_t)(l * 5 + i) * 12288 + n0 + cc] = s + a.ada_b[l * 12288 + n0 + cc]; }
        __syncthreads();
    }
}
__device__ __forceinline__ void tr_item(const float* __restrict__ W, int ldw, int k0, int n0, bf16_t* __restrict__ WT, int ldt, int drow0, LAS float* scr, int lane) {
#pragma unroll 8
    for (int i = 0; i < 32; ++i) { const int kk = 2 * i + (lane >> 5); scr[kk * 33 + (lane & 31)] = W[(size_t)(k0 + kk) * ldw + n0 + (lane & 31)]; }
    asm volatile("s_waitcnt lgkmcnt(0)" ::: "memory");
    const int c = lane & 7;
#pragma unroll
    for (int j = 0; j < 4; ++j) { const int n = (lane >> 3) + 8 * j; const LAS float* s = scr + (8 * c) * 33 + n;
        u32x4 o; o.x = cvt_pk_bf16(s[0 * 33], s[1 * 33]); o.y = cvt_pk_bf16(s[2 * 33], s[3 * 33]); o.z = cvt_pk_bf16(s[4 * 33], s[5 * 33]); o.w = cvt_pk_bf16(s[6 * 33], s[7 * 33]);
        *(u32x4*)(WT + (size_t)(drow0 + n) * ldt + k0 + 8 * c) = o; }
    asm volatile("s_waitcnt lgkmcnt(0)" ::: "memory");
}
__device__ __forceinline__ void ph_transposes(const Args& a, LAS unsigned char* lds, int vcu, int G) {
    const int tid = threadIdx.x, wave = tid >> 6, lane = tid & 63;
    LAS float* scr = (LAS float*)(lds + wave * 8704);
    const int gw = vcu * NWAVES + wave, NGW = G * NWAVES;
    unsigned char* ws = a.ws;
    constexpr int NITEMS = 87872;
    for (int it = gw; it < NITEMS; it += NGW) {
        int r = it;
#define TR_DO(src, K_, N_, dst, drow) do { const int nblk = (N_) / 32, kb = ri / nblk, nb = ri % nblk; tr_item((src), (N_), 64 * kb, 32 * nb, (dst), (K_), (drow) + 32 * nb, scr, lane); } while (0)
        if (r < 32768) { const int l = r / 8192, ri = r % 8192; TR_DO(a.mlp_w1 + (size_t)l * DM * DFF, DM, DFF, (bf16_t*)(ws + WS_W1T) + (size_t)l * DFF * DM, 0); continue; } r -= 32768;
        if (r < 32768) { const int l = r / 8192, ri = r % 8192; TR_DO(a.mlp_w2 + (size_t)l * DFF * DM, DFF, DM, (bf16_t*)(ws + WS_W2T) + (size_t)l * DM * DFF, 0); continue; } r -= 32768;
        if (r < 4096) { const int s = r / 2048, ri = r % 2048; TR_DO(a.gqa_wq + (size_t)s * DM * DM, DM, DM, (bf16_t*)(ws + WS_GQAW + s * 20 * MiB), 0); continue; } r -= 4096;
        if (r < 1024) { const int s = r / 512, ri = r % 512; TR_DO(a.gqa_wk + (size_t)s * DM * 512, DM, 512, (bf16_t*)(ws + WS_GQAW + s * 20 * MiB), 2048); continue; } r -= 1024;
        if (r < 1024) { const int s = r / 512, ri = r % 512; TR_DO(a.gqa_wv + (size_t)s * DM * 512, DM, 512, (bf16_t*)(ws + WS_GQAW + s * 20 * MiB), 2560); continue; } r -= 1024;
        if (r < 4096) { const int s = r / 2048, ri = r % 2048; TR_DO(a.gqa_wo + (size_t)s * DM * DM, DM, DM, (bf16_t*)(ws + WS_GQAW + s * 20 * MiB + 12 * MiB), 0); continue; } r -= 4096;
        if (r < 2048) { const int ri = r; TR_DO(a.lru_wx, DM, DM, (bf16_t*)(ws + WS_LRUW), 0); continue; } r -= 2048;
        if (r < 2048) { const int ri = r; TR_DO(a.lru_wy, DM, DM, (bf16_t*)(ws + WS_LRUW), 2048); continue; } r -= 2048;
        if (r < 1024) { const int blk = r / 32, ri = r % 32, ty = blk / 16, d = (blk % 16) / 8, n = blk % 8, which = d * 2 + ty;
            const float* src = (ty == 0 ? a.lru_ra_w : a.lru_ix_w) + (size_t)(d * 8 + n) * 65536;
            TR_DO(src, 256, 256, (bf16_t*)(ws + WS_LRUW + 16 * MiB), (which * 8 + n) * 256); continue; } r -= 1024;
        if (r < 2048) { const int ri = r; TR_DO(a.lru_wo, DM, DM, (bf16_t*)(ws + WS_LRUW + 20 * MiB), 0); continue; } r -= 2048;
        if (r < 512) { const int ri = r; TR_DO(a.mla_wq_a, DM, 512, (bf16_t*)(ws + WS_MLAW), 0); continue; } r -= 512;
        if (r < 576) { const int ri = r; TR_DO(a.mla_wkv_a, DM, 576, (bf16_t*)(ws + WS_MLAW), 512); continue; } r -= 576;
        if (r < 768) { const int ri = r; TR_DO(a.mla_wq_b, 512, 3072, (bf16_t*)(ws + WS_MLAW + 5 * MiB), 0); continue; } r -= 768;
        if (r < 1024) { const int ri = r, nb = ri % 128, kb = ri / 128, n0 = 32 * nb, h = n0 >> 8, j0 = n0 & 255;
            const int drow = j0 < 128 ? h * 128 + j0 : 2048 + h * 128 + (j0 - 128);
            tr_item(a.mla_wkv_b, 4096, 64 * kb, n0, (bf16_t*)(ws + WS_MLAW + 8 * MiB), 512, drow, scr, lane); continue; } r -= 1024;
        { const int ri = r; TR_DO(a.mla_wo, DM, DM, (bf16_t*)(ws + WS_MLAW + 12 * MiB), 0); }
#undef TR_DO
    }
    { u32x4* z = (u32x4*)(ws + WS_MLAW + (size_t)1088 * DM * 2); const int gt = vcu * 512 + tid;
      for (int i = gt; i < 49152; i += G * 512) z[i] = (u32x4){0u, 0u, 0u, 0u}; }
    if (vcu == 1 % G) { float* ll = (float*)(ws + WS_TAB + 32768); for (int i = tid; i < 2 * DM; i += 512) ll[i] = -8.0f * log1pf(expf(-a.lru_lam[i])); }
    if (vcu == 0) {
        f32x2* tg = (f32x2*)(ws + WS_TAB); f32x2* tm = (f32x2*)(ws + WS_TAB + 16384);
        for (int i = tid; i < 64 * 32; i += 512) { const int pos = i / 32, f = i % 32; const float inv = powf(10000.0f, -((float)f * 2.0f) / 64.0f); const float ang = (float)pos * inv; tg[i] = (f32x2){cosf(ang), sinf(ang)}; }
        for (int i = tid; i < 64 * 16; i += 512) { const int pos = i / 16, f = i % 16; const float inv = powf(10000.0f, -((float)f * 2.0f) / 32.0f); const float ang = (float)pos * inv; tm[i] = (f32x2){cosf(ang), sinf(ang)}; }
    }
}

#define ROW_DECODE(r) const int b_ = (r) / TB, p_ = (r) % TB; const bool isctx_ = p_ < CTX; const int mi_ = isctx_ ? 4 : b_; (void)b_; (void)mi_
__device__ __forceinline__ const float* mods_ptr(const Args& a, int l, int mi) { return (const float*)(a.ws + WS_MODS) + (size_t)(l * 5 + mi) * 12288; }

__device__ __forceinline__ void ph_init(const Args& a, int gw, int NGW, int lane) {
    float* X = (float*)(a.ws + WS_X); bf16_t* H = (bf16_t*)(a.ws + WS_H);
    for (int r = gw; r < R; r += NGW) {
        ROW_DECODE(r);
        const float* src = isctx_ ? a.ctx + ((size_t)b_ * CTX + p_) * DM : a.x + ((size_t)b_ * SEQ + (p_ - CTX)) * DM;
        const float* m = mods_ptr(a, 0, mi_);
#pragma unroll
        for (int it = 0; it < 8; ++it) { const int idx = it * 256 + lane * 4;
            const f32x4 v = *(const f32x4*)(src + idx), m0 = *(const f32x4*)(m + idx), m1 = *(const f32x4*)(m + DM + idx);
            *(f32x4*)(X + (size_t)r * DM + idx) = v;
            const f32x4 h = v * (1.0f + m1) + m0;
            *(u32x2*)(H + (size_t)r * DM + idx) = (u32x2){cvt_pk_bf16(h[0], h[1]), cvt_pk_bf16(h[2], h[3])}; }
    }
}
template <bool LAST>
__device__ __forceinline__ void ph_ln(const Args& a, int l, int which, int gw, int NGW, int lane) {
    float* X = (float*)(a.ws + WS_X); bf16_t* H = (bf16_t*)(a.ws + WS_H); const float* O = (const float*)(a.ws + WS_OUTF);
    const float* lg = a.ln_g + (size_t)(l * 2 + which) * DM; const float* lb = a.ln_b + (size_t)(l * 2 + which) * DM;
    for (int r = gw; r < R; r += NGW) {
        ROW_DECODE(r);
        if (LAST && isctx_) continue;
        const float* m = mods_ptr(a, l, mi_);
        const float* gate = m + (which == 0 ? 2 : 5) * DM;
        const float* sc = which == 0 ? m + 4 * DM : mods_ptr(a, LAST ? l : l + 1, mi_) + 1 * DM;
        const float* sh = which == 0 ? m + 3 * DM : mods_ptr(a, LAST ? l : l + 1, mi_);
        f32x4 v[8]; float s = 0.f;
#pragma unroll
        for (int it = 0; it < 8; ++it) { const int idx = it * 256 + lane * 4;
            const f32x4 xv = *(const f32x4*)(X + (size_t)r * DM + idx), ov = *(const f32x4*)(O + (size_t)r * DM + idx), g = *(const f32x4*)(gate + idx);
            v[it] = DN_ALPHA * xv + (1.0f + g) * ov; s += (v[it][0] + v[it][1]) + (v[it][2] + v[it][3]); }
        const float mean = wave_sum(s) * (1.0f / DM); float q = 0.f;
#pragma unroll
        for (int it = 0; it < 8; ++it) { v[it] = v[it] - mean; q += (v[it][0] * v[it][0] + v[it][1] * v[it][1]) + (v[it][2] * v[it][2] + v[it][3] * v[it][3]); }
        const float rstd = 1.0f / sqrtf(wave_sum(q) * (1.0f / DM) + LN_EPS);
#pragma unroll
        for (int it = 0; it < 8; ++it) { const int idx = it * 256 + lane * 4;
            const f32x4 xn = v[it] * rstd * *(const f32x4*)(lg + idx) + *(const f32x4*)(lb + idx);
            if (LAST) { *(f32x4*)(a.out + ((size_t)b_ * SEQ + (p_ - CTX)) * DM + idx) = xn; }
            else { *(f32x4*)(X + (size_t)r * DM + idx) = xn;
                const f32x4 h = xn * (1.0f + *(const f32x4*)(sc + idx)) + *(const f32x4*)(sh + idx);
                *(u32x2*)(H + (size_t)r * DM + idx) = (u32x2){cvt_pk_bf16(h[0], h[1]), cvt_pk_bf16(h[2], h[3])}; } }
    }
}
__device__ __forceinline__ void ph_knorm(const Args& a, const float* kg, int gw, int NGW, int lane) {
    bf16_t* K = (bf16_t*)(a.ws + WS_GK); const f32x2* tab = (const f32x2*)(a.ws + WS_TAB);
    const int li = lane & 15;
    float g[8];
#pragma unroll
    for (int j = 0; j < 8; ++j) g[j] = kg[li * 8 + j];
    for (int r = gw; r < R; r += NGW) {
        ROW_DECODE(r);
        bf16x8 raw = *(const bf16x8*)(K + (size_t)r * 512 + lane * 8);
        float f[8]; att::unpack8(raw, f);
        float ss = 0.f;
#pragma unroll
        for (int j = 0; j < 8; ++j) ss += f[j] * f[j];
        ss += __shfl_xor(ss, 1); ss += __shfl_xor(ss, 2); ss += __shfl_xor(ss, 4); ss += __shfl_xor(ss, 8);
        const float rstd = 1.0f / sqrtf(ss * (1.0f / 128.0f) + 1e-6f);
#pragma unroll
        for (int j = 0; j < 8; ++j) f[j] = f[j] * rstd * g[j];
        if (!isctx_) {
            const int t = p_ - CTX, pos = (li & 8) ? (t & 63) : (t >> 6);
            const f32x2* tp = tab + pos * 32 + (li & 3) * 8;
            const bool second = (li & 4) != 0;
#pragma unroll
            for (int j = 0; j < 8; ++j) { const float other = __shfl_xor(f[j], 4); const f32x2 cs = tp[j];
                f[j] = second ? f[j] * cs.x + other * cs.y : f[j] * cs.x - other * cs.y; }
        }
        *(bf16x8*)(K + (size_t)r * 512 + lane * 8) = att::pack8(f);
    }
}
__device__ __forceinline__ void ph_mla_norm(const Args& a, int gw, int NGW, int lane) {
    const float* AP = (const float*)(a.ws + WS_MAP); bf16_t* QAN = (bf16_t*)(a.ws + WS_MQAN); bf16_t* CKVN = (bf16_t*)(a.ws + WS_MCKVN); bf16_t* K = (bf16_t*)(a.ws + WS_MK);
    const f32x2* tab = (const f32x2*)(a.ws + WS_TAB + 16384);
    for (int r = gw; r < R; r += NGW) {
        ROW_DECODE(r);
        const float* ap = AP + (size_t)r * 1280;
#pragma unroll
        for (int part = 0; part < 2; ++part) {
            const f32x4 v0 = *(const f32x4*)(ap + part * 512 + lane * 8), v1 = *(const f32x4*)(ap + part * 512 + lane * 8 + 4);
            float ss = (v0[0] * v0[0] + v0[1] * v0[1]) + (v0[2] * v0[2] + v0[3] * v0[3]) + (v1[0] * v1[0] + v1[1] * v1[1]) + (v1[2] * v1[2] + v1[3] * v1[3]);
            const float rstd = 1.0f / sqrtf(wave_sum(ss) * (1.0f / 512.0f) + 1e-6f);
            const float* gp = (part == 0 ? a.mla_q_a_g : a.mla_kv_a_g) + lane * 8;
            const f32x4 g0 = *(const f32x4*)gp, g1 = *(const f32x4*)(gp + 4);
            const f32x4 o0 = v0 * rstd * g0, o1 = v1 * rstd * g1;
            u32x4 w = {cvt_pk_bf16(o0[0], o0[1]), cvt_pk_bf16(o0[2], o0[3]), cvt_pk_bf16(o1[0], o1[1]), cvt_pk_bf16(o1[2], o1[3])};
            *(u32x4*)((part == 0 ? QAN : CKVN) + (size_t)r * 512 + lane * 8) = w;
        }
        float v = ap[1024 + lane];
        if (!isctx_) {
            const int t = p_ - CTX, pos = (lane & 32) ? (t & 63) : (t >> 6);
            const f32x2 cs = tab[pos * 16 + (lane & 15)];
            const float other = __shfl_xor(v, 16);
            v = (lane & 16) ? v * cs.x + other * cs.y : v * cs.x - other * cs.y;
        }
        const bf16_t kb = f2bf(v);
#pragma unroll
        for (int h = 0; h < 16; ++h) K[(size_t)r * 3072 + h * 192 + 128 + lane] = kb;
    }
}
__device__ __forceinline__ void ph_conv(const Args& a, int gw, int NGW, int lane) {
    const bf16_t* UP = (const bf16_t*)(a.ws + WS_LUP); bf16_t* U = (bf16_t*)(a.ws + WS_LU);
    for (int r = gw; r < R; r += NGW) {
        ROW_DECODE(r);
        const int lo = isctx_ ? 0 : CTX, hi = isctx_ ? CTX : TB;
#pragma unroll
        for (int it = 0; it < 4; ++it) { const int idx = it * 512 + lane * 8;
            float acc[8];
            { const f32x4 b0 = *(const f32x4*)(a.lru_conv_b + idx), b1 = *(const f32x4*)(a.lru_conv_b + idx + 4);
              acc[0] = b0[0]; acc[1] = b0[1]; acc[2] = b0[2]; acc[3] = b0[3]; acc[4] = b1[0]; acc[5] = b1[1]; acc[6] = b1[2]; acc[7] = b1[3]; }
#pragma unroll
            for (int j = 0; j < 4; ++j) { const int pp = p_ + j - 2;
                if (pp >= lo && pp < hi) {
                    float f[8]; att::unpack8(*(const bf16x8*)(UP + (size_t)(r + j - 2) * DM + idx), f);
                    const f32x4 w0 = *(const f32x4*)(a.lru_conv_w + j * DM + idx), w1 = *(const f32x4*)(a.lru_conv_w + j * DM + idx + 4);
                    acc[0] += f[0] * w0[0]; acc[1] += f[1] * w0[1]; acc[2] += f[2] * w0[2]; acc[3] += f[3] * w0[3];
                    acc[4] += f[4] * w1[0]; acc[5] += f[5] * w1[1]; acc[6] += f[6] * w1[2]; acc[7] += f[7] * w1[3]; } }
            *(bf16x8*)(U + (size_t)r * DM + idx) = att::pack8(acc); }
    }
}
__device__ __forceinline__ void ph_scan1(const Args& a, int gw, int NGW, int lane) {
    float* PS = (float*)(a.ws + WS_LPS);
    for (int item = gw; item < NB * NCH * 2 * 8; item += NGW) {
        const int cg = item & 7, dir = (item >> 3) & 1, bq = item >> 4, b = bq / NCH, q = bq % NCH;
        const float* A = (const float*)(a.ws + (dir ? WS_LAB : WS_LAF)); const float* GU = (const float*)(a.ws + (dir ? WS_LGUB : WS_LGUF));
        const size_t base = ((size_t)b * TB + q * 32) * DM + cg * 256 + lane * 4;
        f32x4 h = {0.f, 0.f, 0.f, 0.f}, P = {1.f, 1.f, 1.f, 1.f};
#pragma unroll 8
        for (int i = 0; i < 32; ++i) { const int rr = dir ? 31 - i : i;
            const f32x4 av = *(const f32x4*)(A + base + (size_t)rr * DM), gv = *(const f32x4*)(GU + base + (size_t)rr * DM);
            f32x4 s; s[0] = sqrtf(fmaxf(1.0f - av[0] * av[0], 0.f)); s[1] = sqrtf(fmaxf(1.0f - av[1] * av[1], 0.f)); s[2] = sqrtf(fmaxf(1.0f - av[2] * av[2], 0.f)); s[3] = sqrtf(fmaxf(1.0f - av[3] * av[3], 0.f));
            h = av * h + s * gv; P = P * av; }
        float* o = PS + ((size_t)(bq * 2 + dir) * 2) * DM + cg * 256 + lane * 4;
        *(f32x4*)o = P; *(f32x4*)(o + DM) = h;
    }
}
__device__ __forceinline__ void ph_scan2(const Args& a, int gtid, int NGT) {
    const float* PS = (const float*)(a.ws + WS_LPS); float* CIN = (float*)(a.ws + WS_LCIN);
    for (int t = gtid; t < NB * 2 * DM; t += NGT) {
        const int c = t % DM, dir = (t / DM) & 1, b = t / (2 * DM);
        float carry = 0.f;
        for (int i = 0; i < NCH; ++i) {
            const int q = dir == 0 ? i : (i < 8 ? 7 - i : NCH - 1 - (i - 8));
            const size_t bq = (size_t)b * NCH + q;
            CIN[(bq * 2 + dir) * DM + c] = carry;
            const float P = PS[((bq * 2 + dir) * 2) * DM + c], S = PS[((bq * 2 + dir) * 2 + 1) * DM + c];
            carry = P * carry + S;
        }
    }
}
__device__ __forceinline__ void ph_scan3(const Args& a, int gw, int NGW, int lane) {
    const float* CIN = (const float*)(a.ws + WS_LCIN); const bf16_t* GY = (const bf16_t*)(a.ws + WS_LGY); bf16_t* Gout = (bf16_t*)(a.ws + WS_LG);
    const float* AF = (const float*)(a.ws + WS_LAF); const float* GUF = (const float*)(a.ws + WS_LGUF); const float* AB = (const float*)(a.ws + WS_LAB); const float* GUB = (const float*)(a.ws + WS_LGUB);
    for (int item = gw; item < NB * NCH * 8; item += NGW) {
        const int cg = item & 7, bq = item >> 3, b = bq / NCH, q = bq % NCH;
        const size_t base = ((size_t)b * TB + q * 32) * DM + cg * 256 + lane * 4;
        f32x4 hf[32];
        f32x4 h = *(const f32x4*)(CIN + ((size_t)bq * 2 + 0) * DM + cg * 256 + lane * 4);
#pragma unroll
        for (int i = 0; i < 32; ++i) {
            const f32x4 av = *(const f32x4*)(AF + base + (size_t)i * DM), gv = *(const f32x4*)(GUF + base + (size_t)i * DM);
            f32x4 s; s[0] = sqrtf(fmaxf(1.0f - av[0] * av[0], 0.f)); s[1] = sqrtf(fmaxf(1.0f - av[1] * av[1], 0.f)); s[2] = sqrtf(fmaxf(1.0f - av[2] * av[2], 0.f)); s[3] = sqrtf(fmaxf(1.0f - av[3] * av[3], 0.f));
            h = av * h + s * gv; hf[i] = h; }
        h = *(const f32x4*)(CIN + ((size_t)bq * 2 + 1) * DM + cg * 256 + lane * 4);
#pragma unroll
        for (int i = 31; i >= 0; --i) {
            const f32x4 av = *(const f32x4*)(AB + base + (size_t)i * DM), gv = *(const f32x4*)(GUB + base + (size_t)i * DM);
            f32x4 s; s[0] = sqrtf(fmaxf(1.0f - av[0] * av[0], 0.f)); s[1] = sqrtf(fmaxf(1.0f - av[1] * av[1], 0.f)); s[2] = sqrtf(fmaxf(1.0f - av[2] * av[2], 0.f)); s[3] = sqrtf(fmaxf(1.0f - av[3] * av[3], 0.f));
            h = av * h + s * gv;
            const u32x2 gy = *(const u32x2*)(GY + base + (size_t)i * DM);
            const f32x4 o = (hf[i] + h) * (f32x4){bf_lo(gy.x), bf_hi(gy.x), bf_lo(gy.y), bf_hi(gy.y)};
            *(u32x2*)(Gout + base + (size_t)i * DM) = (u32x2){cvt_pk_bf16(o[0], o[1]), cvt_pk_bf16(o[2], o[3])}; }
    }
}

__device__ __forceinline__ void st_bf16x8(bf16_t* p, f32x4 v0, f32x4 v1) {
    u32x4 w = {cvt_pk_bf16(v0[0], v0[1]), cvt_pk_bf16(v0[2], v0[3]), cvt_pk_bf16(v1[0], v1[1]), cvt_pk_bf16(v1[2], v1[3])}; *(u32x4*)p = w; }
struct FStoreF32 { float* O; int ld;
    __device__ __forceinline__ void begin(const pg8::Unit&, int) {}
    __device__ __forceinline__ void row8(int row, int, int col, f32x4 v0, f32x4 v1) { float* p = O + (size_t)row * ld + col; *(f32x4*)p = v0; *(f32x4*)(p + 4) = v1; } };
struct FBf16 { bf16_t* O; int ld;
    __device__ __forceinline__ void begin(const pg8::Unit&, int) {}
    __device__ __forceinline__ void row8(int row, int, int col, f32x4 v0, f32x4 v1) { st_bf16x8(O + (size_t)row * ld + col, v0, v1); } };
struct FQkv { bf16_t *Q, *K, *V; bf16_t* base; int ld, coff;
    __device__ __forceinline__ void begin(const pg8::Unit& u, int) { if (u.pn < 8) { base = Q; ld = 2048; coff = 0; } else if (u.pn < 10) { base = K; ld = 512; coff = 2048; } else { base = V; ld = 512; coff = 2560; } }
    __device__ __forceinline__ void row8(int row, int, int col, f32x4 v0, f32x4 v1) { st_bf16x8(base + (size_t)row * ld + (col - coff), v0, v1); } };
struct FRelu2 { bf16_t* O;
    __device__ __forceinline__ void begin(const pg8::Unit&, int) {}
    __device__ __forceinline__ void row8(int row, int, int col, f32x4 v0, f32x4 v1) {
#pragma unroll
        for (int i = 0; i < 4; ++i) { const float a = fmaxf(v0[i], 0.f), b = fmaxf(v1[i], 0.f); v0[i] = a * a; v1[i] = b * b; }
        st_bf16x8(O + (size_t)row * DFF + col, v0, v1); } };
__device__ __forceinline__ float gelu_tanh(float x) { const float z = 1.5957691216057308f * (x + 0.044715f * x * x * x); return x * __builtin_amdgcn_rcpf(1.0f + __builtin_amdgcn_exp2f(-1.4426950408889634f * z)); }
struct FLruXY { bf16_t *UP, *GY; bool gy;
    __device__ __forceinline__ void begin(const pg8::Unit& u, int) { gy = u.pn >= 8; }
    __device__ __forceinline__ void row8(int row, int, int col, f32x4 v0, f32x4 v1) {
        if (gy) {
#pragma unroll
            for (int i = 0; i < 4; ++i) { v0[i] = gelu_tanh(v0[i]); v1[i] = gelu_tanh(v1[i]); }
            st_bf16x8(GY + (size_t)row * DM + (col - 2048), v0, v1);
        } else st_bf16x8(UP + (size_t)row * DM + col, v0, v1); } };
struct EpiGates {
    static constexpr bool PERM = true;
    float* OUT4; const bf16_t* U; const float *ra_b, *ix_b, *lam;
    __device__ __forceinline__ void operator()(const f32x4 (&acc)[2][2][4][2], const pg8::Unit& u, int wr, int wc, int fr, int fq) const {
        const int which = u.pn >> 3, dir = which >> 1, ty = which & 1, ch0 = (u.pn & 7) * 256 + wc * 32 + 8 * fq, row0 = u.pm * 256 + wr * 64 + fr;
        float* dst = OUT4 + (size_t)which * ((size_t)R * DM);
        const float* bp = (ty == 0 ? ra_b : ix_b) + dir * DM;
#pragma unroll
        for (int bj = 0; bj < 2; ++bj) {
            const int ch = ch0 + bj * 128;
            const f32x4 b0 = *(const f32x4*)(bp + ch), b1 = *(const f32x4*)(bp + ch + 4);
            f32x4 l0 = {0.f, 0.f, 0.f, 0.f}, l1 = {0.f, 0.f, 0.f, 0.f};
            if (ty == 0) { l0 = *(const f32x4*)(lam + dir * DM + ch) * 1.4426950408889634f; l1 = *(const f32x4*)(lam + dir * DM + ch + 4) * 1.4426950408889634f; }
#pragma unroll
            for (int ai = 0; ai < 2; ++ai)
#pragma unroll
                for (int m = 0; m < 4; ++m) {
                    const int row = row0 + ai * 128 + m * 16;
                    const f32x4 x0 = acc[ai][bj][m][0] + b0, x1 = acc[ai][bj][m][1] + b1; f32x4 o0, o1;
                    if (ty == 0) {
#pragma unroll
                        for (int j = 0; j < 4; ++j) { o0[j] = __builtin_amdgcn_exp2f(l0[j] * sigmoidf_(x0[j])); o1[j] = __builtin_amdgcn_exp2f(l1[j] * sigmoidf_(x1[j])); }
                    } else {
                        const u32x4 uw = *(const u32x4*)(U + (size_t)row * DM + ch);
                        o0[0] = sigmoidf_(x0[0]) * bf_lo(uw.x); o0[1] = sigmoidf_(x0[1]) * bf_hi(uw.x); o0[2] = sigmoidf_(x0[2]) * bf_lo(uw.y); o0[3] = sigmoidf_(x0[3]) * bf_hi(uw.y);
                        o1[0] = sigmoidf_(x1[0]) * bf_lo(uw.z); o1[1] = sigmoidf_(x1[1]) * bf_hi(uw.z); o1[2] = sigmoidf_(x1[2]) * bf_lo(uw.w); o1[3] = sigmoidf_(x1[3]) * bf_hi(uw.w);
                    }
                    float* p = dst + (size_t)row * DM + ch; *(f32x4*)p = o0; *(f32x4*)(p + 4) = o1;
                    __builtin_amdgcn_sched_barrier(0);
                }
        }
    } };
struct FKvb { bf16_t *K, *V;
    __device__ __forceinline__ void begin(const pg8::Unit&, int) {}
    __device__ __forceinline__ void row8(int row, int, int col, f32x4 v0, f32x4 v1) {
        bf16_t* p = col < 2048 ? K + (size_t)row * 3072 + (col >> 7) * 192 + (col & 127) : V + (size_t)row * DM + (col - 2048);
        st_bf16x8(p, v0, v1); } };

template <class F>
__device__ __forceinline__ void run_gemm(LAS unsigned char* lds, const bf16_t* A, int lda, const bf16_t* Bt, int ldb, int N, int K, int a_blk, F f, int G) {
    pg8::Gemm g{A, Bt, R, N, K, lda, ldb, a_blk}; pg8::StaticOrder S; S.init(R, N, G, (int)blockIdx.x);
    pg8::EpiRow8<F> E{f};
    pg8::gemm_phase<pg8::EpiRow8<F>, pg8::StaticOrder, true, true>(lds, g, S, E);
}

__device__ __forceinline__ void ph_attn_gqa(const Args& a, char* lds, const float* qg, bool ctx_units, int vcu, int G) {
    const bf16_t* Q = (const bf16_t*)(a.ws + WS_GQ); const bf16_t* K = (const bf16_t*)(a.ws + WS_GK); const bf16_t* V = (const bf16_t*)(a.ws + WS_GV); bf16_t* O = (bf16_t*)(a.ws + WS_GO);
    const f32x2* tab = (const f32x2*)(a.ws + WS_TAB);
    const int nun = ctx_units ? 1088 : 1024;
    for (int id = vcu; id < nun; id += G) {
        int b, h, row0, seq, tok0; bool rope;
        if (id < 1024) { const int bk = id >> 6; b = bk >> 2; h = (bk & 3) * 4 + ((id & 63) >> 4); const int qb = id & 15; row0 = b * TB + CTX + qb * 256; seq = TB; tok0 = qb * 256; rope = true; }
        else { const int j = id - 1024; b = j >> 4; h = j & 15; row0 = b * TB; seq = CTX; tok0 = 0; rope = false; }
        const int kvh = h >> 2;
        att::attn_body<128, 2048, 512, 512, 2048>(Q + (size_t)row0 * 2048 + h * 128, K + (size_t)b * TB * 512 + kvh * 128, V + (size_t)b * TB * 512 + kvh * 128,
                                                  O + (size_t)row0 * 2048 + h * 128, seq, lds, qg, tab, rope, tok0);
    }
}
__device__ __forceinline__ void ph_attn_mla(const Args& a, char* lds, bool ctx_units, int vcu, int G) {
    const bf16_t* Q = (const bf16_t*)(a.ws + WS_MQ); const bf16_t* K = (const bf16_t*)(a.ws + WS_MK); const bf16_t* V = (const bf16_t*)(a.ws + WS_MV); bf16_t* O = (bf16_t*)(a.ws + WS_MO);
    const f32x2* tab = (const f32x2*)(a.ws + WS_TAB + 16384);
    const int nun = ctx_units ? 1088 : 1024;
    for (int id = vcu; id < nun; id += G) {
        int b, h, row0, seq, tok0; bool rope;
        if (id < 1024) { const int bh = id >> 4; b = bh >> 4; h = bh & 15; const int qb = id & 15; row0 = b * TB + CTX + qb * 256; seq = TB; tok0 = qb * 256; rope = true; }
        else { const int j = id - 1024; b = j >> 4; h = j & 15; row0 = b * TB; seq = CTX; tok0 = 0; rope = false; }
        att::attn_body<192, 3072, 3072, 2048, 2048>(Q + (size_t)row0 * 3072 + h * 192, K + (size_t)b * TB * 3072 + h * 192, V + (size_t)b * TB * DM + h * 128,
                                                    O + (size_t)row0 * DM + h * 128, seq, lds, nullptr, tab, rope, tok0);
    }
}

constexpr int NPHASES = 39;
__global__ void __launch_bounds__(NWAVES * 64, 2) trunk_fwd(Args a) {
    extern __shared__ __attribute__((aligned(16))) unsigned char lds_raw[];
    LAS unsigned char* lds = (LAS unsigned char*)lds_raw;
    const int tid = threadIdx.x, lane = tid & 63, wave = __builtin_amdgcn_readfirstlane(tid >> 6);
    const int G = gridDim.x; const int bx = blockIdx.x; const int vcu = (G % 8 == 0) ? (bx % 8) * (G / 8) + bx / 8 : bx;
    const int gw = vcu * NWAVES + wave, NGW = G * NWAVES;
    unsigned char* ws = a.ws;
    for (int u = tid; u < (LDS_BYTES - LDSCTL_OFF) / 4; u += NWAVES * 64) ((LAS unsigned*)(lds + LDSCTL_OFF))[u] = 0u;
    __syncthreads();
    const int lo = a.ph_lo, hi = a.ph_hi;
    const bool use_bar = (hi - lo) > 1;
    XcdBarrier bar; bar.bar = (unsigned*)(ws + WS_CTL) + 1024; bar.x = 0; bar.st = nullptr;
    if (use_bar) bar = xcd_barrier_post((unsigned*)(ws + WS_CTL) + 1024, (volatile LAS unsigned*)(lds + LDSCTL_OFF + 64));
    int ph = 0;
#ifndef PH_FILTER
#define PH_FILTER(p) true
#endif
#define PH_BEGIN if (PH_FILTER(ph) && ph >= lo && ph < hi) {
#define PH_END   if (ph + 1 < hi) xcd_barrier(bar); } ++ph;

    PH_BEGIN ph_mods(a, lds, vcu, G); __syncthreads(); ph_transposes(a, lds, vcu, G); PH_END
    PH_BEGIN ph_init(a, gw, NGW, lane); PH_END

    bf16_t* const Hb = (bf16_t*)(ws + WS_H);
    float* const OUTF = (float*)(ws + WS_OUTF);
    bf16_t* const ACT = (bf16_t*)(ws + WS_ACT);

#define MLP_PHASES(L, LASTL) \
    PH_BEGIN ph_ln<false>(a, L, 0, gw, NGW, lane); PH_END \
    PH_BEGIN run_gemm(lds, Hb, DM, (const bf16_t*)(ws + WS_W1T) + (size_t)(L) * DFF * DM, DM, DFF, DM, 0, FRelu2{ACT}, G); PH_END \
    PH_BEGIN run_gemm(lds, ACT, DFF, (const bf16_t*)(ws + WS_W2T) + (size_t)(L) * DM * DFF, DFF, DM, DFF, 0, FStoreF32{OUTF, DM}, G); PH_END \
    PH_BEGIN ph_ln<LASTL>(a, L, 1, gw, NGW, lane); PH_END

#define GQA_LAYER(L, SLOT, LASTL) \
    PH_BEGIN run_gemm(lds, Hb, DM, (const bf16_t*)(ws + WS_GQAW + (SLOT) * 20 * MiB), DM, 3072, DM, 0, FQkv{(bf16_t*)(ws + WS_GQ), (bf16_t*)(ws + WS_GK), (bf16_t*)(ws + WS_GV), nullptr, 0, 0}, G); PH_END \
    PH_BEGIN ph_knorm(a, a.gqa_k_g + (SLOT) * 128, gw, NGW, lane); PH_END \
    PH_BEGIN ph_attn_gqa(a, (char*)lds_raw, a.gqa_q_g + (SLOT) * 128, true, vcu, G); PH_END \
    PH_BEGIN run_gemm(lds, (const bf16_t*)(ws + WS_GO), DM, (const bf16_t*)(ws + WS_GQAW + (SLOT) * 20 * MiB + 12 * MiB), DM, DM, DM, 0, FStoreF32{OUTF, DM}, G); PH_END \
    MLP_PHASES(L, LASTL)

    GQA_LAYER(0, 0, false)
    PH_BEGIN run_gemm(lds, Hb, DM, (const bf16_t*)(ws + WS_LRUW), DM, 4096, DM, 0, FLruXY{(bf16_t*)(ws + WS_LUP), (bf16_t*)(ws + WS_LGY), false}, G); PH_END
    PH_BEGIN ph_conv(a, gw, NGW, lane); PH_END
    PH_BEGIN { EpiGates eg{(float*)(ws + WS_LAF), (const bf16_t*)(ws + WS_LU), a.lru_ra_b, a.lru_ix_b, (const float*)(ws + WS_TAB + 32768)};
               pg8::Gemm g{(const bf16_t*)(ws + WS_LU), (const bf16_t*)(ws + WS_LRUW + 16 * MiB), R, 8192, 256, DM, 256, 1}; pg8::StaticOrder S; S.init(R, 8192, G, (int)blockIdx.x);
               pg8::gemm_phase<EpiGates, pg8::StaticOrder, true, true>(lds, g, S, eg); } PH_END
    PH_BEGIN ph_scan1(a, gw, NGW, lane); PH_END
    PH_BEGIN ph_scan2(a, vcu * 512 + tid, G * 512); PH_END
    PH_BEGIN ph_scan3(a, gw, NGW, lane); PH_END
    PH_BEGIN run_gemm(lds, (const bf16_t*)(ws + WS_LG), DM, (const bf16_t*)(ws + WS_LRUW + 20 * MiB), DM, DM, DM, 0, FStoreF32{OUTF, DM}, G); PH_END
    MLP_PHASES(1, false)
    PH_BEGIN run_gemm(lds, Hb, DM, (const bf16_t*)(ws + WS_MLAW), DM, 1280, DM, 0, FStoreF32{(float*)(ws + WS_MAP), 1280}, G); PH_END
    PH_BEGIN ph_mla_norm(a, gw, NGW, lane); PH_END
    PH_BEGIN run_gemm(lds, (const bf16_t*)(ws + WS_MQAN), 512, (const bf16_t*)(ws + WS_MLAW + 5 * MiB), 512, 3072, 512, 0, FBf16{(bf16_t*)(ws + WS_MQ), 3072}, G); PH_END
    PH_BEGIN run_gemm(lds, (const bf16_t*)(ws + WS_MCKVN), 512, (const bf16_t*)(ws + WS_MLAW + 8 * MiB), 512, 4096, 512, 0, FKvb{(bf16_t*)(ws + WS_MK), (bf16_t*)(ws + WS_MV)}, G); PH_END
    PH_BEGIN ph_attn_mla(a, (char*)lds_raw, true, vcu, G); PH_END
    PH_BEGIN run_gemm(lds, (const bf16_t*)(ws + WS_MO), DM, (const bf16_t*)(ws + WS_MLAW + 12 * MiB), DM, DM, DM, 0, FStoreF32{OUTF, DM}, G); PH_END
    MLP_PHASES(2, false)
    GQA_LAYER(3, 1, true)
#undef PH_BEGIN
#undef PH_END
}

#ifndef MK_SPLIT
#define MK_SPLIT 1
#endif
extern "C" void kernel_launch(void* const* d_in, const int* in_sizes, int n_in, void* d_out, int out_size, void* d_ws, size_t ws_size, hipStream_t stream) {
    static int grid = 0;
    if (grid == 0) {
        if (n_in != 33 || in_sizes[0] != NB * SEQ * DM || out_size != NB * SEQ * DM || ws_size < WS_END) {
            fprintf(stderr, "kernel_launch: unexpected shapes: n_in %d in0 %d out %d ws %zu (need %zu)\n", n_in, n_in > 0 ? in_sizes[0] : -1, out_size, ws_size, (size_t)WS_END); grid = -1; return; }
        int dev = 0, cus = 0;
        if (hipGetDevice(&dev) != hipSuccess || hipDeviceGetAttribute(&cus, hipDeviceAttributeMultiprocessorCount, dev) != hipSuccess) { grid = -1; return; }
        if (hipFuncSetAttribute((const void*)trunk_fwd, hipFuncAttributeMaxDynamicSharedMemorySize, LDS_BYTES) != hipSuccess) { fprintf(stderr, "kernel_launch: hipFuncSetAttribute failed\n"); grid = -1; return; }
        int per_cu = 0;
        if (hipOccupancyMaxActiveBlocksPerMultiprocessor(&per_cu, (const void*)trunk_fwd, NWAVES * 64, LDS_BYTES) != hipSuccess || per_cu < 1)
            fprintf(stderr, "kernel_launch: occupancy query reports %d workgroups per CU\n", per_cu);
        (void)hipGetLastError();
        grid = cus;
    }
    if (grid < 0) return;
    if (hipMemsetAsync((char*)d_ws + WS_CTL, 0, CTL_ZERO_BYTES, stream) != hipSuccess) return;
    Args a{};
    const float** p = (const float**)&a;
    for (int i = 0; i < 33; ++i) p[i] = (const float*)d_in[i];
    a.out = (float*)d_out; a.ws = (unsigned char*)d_ws;
#if MK_SPLIT
    for (int k = 0; k < NPHASES; ++k) { a.ph_lo = k; a.ph_hi = k + 1; hipLaunchKernelGGL(trunk_fwd, dim3(grid), dim3(NWAVES * 64), LDS_BYTES, stream, a); }
#else
    a.ph_lo = 0; a.ph_hi = NPHASES; hipLaunchKernelGGL(trunk_fwd, dim3(grid), dim3(NWAVES * 64), LDS_BYTES, stream, a);
#endif
    const hipError_t le = hipPeekAtLastError();
    if (le != hipSuccess) fprintf(stderr, "kernel_launch: launch failed: %s\n", hipGetErrorName(le));
}
```

```cpp
#include <hip/hip_runtime.h>
#include <cstdio>
#include <cstdint>
#include <cmath>

#define LAS __attribute__((address_space(3)))
#define GAS __attribute__((address_space(1)))
typedef unsigned short bf16_t;
typedef short bf16x8 __attribute__((ext_vector_type(8)));
typedef short s16x4 __attribute__((ext_vector_type(4)));
typedef float f32x4 __attribute__((ext_vector_type(4)));
typedef float f32x2 __attribute__((ext_vector_type(2)));
typedef float f32x16 __attribute__((ext_vector_type(16)));
typedef unsigned u32x4 __attribute__((ext_vector_type(4)));
typedef unsigned u32x2 __attribute__((ext_vector_type(2)));

__device__ __forceinline__ unsigned cvt_pk_bf16(float lo, float hi) { unsigned r; asm volatile("v_cvt_pk_bf16_f32 %0, %1, %2" : "=v"(r) : "v"(lo), "v"(hi)); return r; }
__device__ __forceinline__ float bf_lo(unsigned w) { return __uint_as_float(w << 16); }
__device__ __forceinline__ float bf_hi(unsigned w) { return __uint_as_float(w & 0xffff0000u); }
__device__ __forceinline__ float bf2f(bf16_t h) { return __uint_as_float(((unsigned)h) << 16); }
__device__ __forceinline__ bf16_t f2bf(float f) { return (bf16_t)(cvt_pk_bf16(f, f) & 0xffffu); }

constexpr int DM = 2048, NB = 4, SEQ = 4096, CTX = 256, TB = SEQ + CTX  , R = NB * TB  , DFF = 8192, DEPTH = 4;
constexpr float LN_EPS = 1e-6f;
constexpr float DN_ALPHA = 1.6817928305074290861f;

namespace pg8 {
constexpr int BM = 256, BK = 64, HALF = 128, HTB = HALF * BK * 2, STAGE_BYTES = 8 * HTB, NXCD = 8, WGM = 8;
__host__ __device__ __forceinline__ int lds_byte(int r, int c) { const int st = (r >> 4) * 2 + (c >> 5), rr = r & 15, cc = c & 31, ob = rr * 64 + cc * 2; return st * 1024 + (ob ^ (((ob >> 9) & 1) << 5)); }
__host__ __device__ __forceinline__ void stage_rc(int b, int& Rr, int& C) { const int st = b / 1024, sb = b % 1024, swz = sb ^ (((sb >> 9) & 1) << 5); Rr = (st >> 1) * 16 + swz / 64; C = (st & 1) * 32 + (swz % 64) / 2; }
__host__ __device__ __forceinline__ int perm32(int rho) { const int n = rho >> 4, i = rho & 15; return 8 * (i >> 2) + 4 * n + (i & 3); }

struct Unit { int pm, pn; };
struct Gemm { const bf16_t* A; const bf16_t* Bt; int M, N, K, lda, ldb, a_blk; };

struct StaticOrder {
    int nM, nN, nwg, G, c;
    __device__ void init(int M, int N, int G_, int c_) { nM = M / BM; nN = N / BM; nwg = nM * nN; G = G_; c = c_; }
    __device__ bool next(int i, Unit& u) const {
        const long L = (long)i * G + c; if (L >= nwg) return false;
        int wgid = (int)L; { const int q = nwg / NXCD, r = nwg % NXCD, xcd = wgid % NXCD, off = wgid / NXCD; wgid = (xcd < r ? xcd * (q + 1) : r * (q + 1) + (xcd - r) * q) + off; }
        const int nig = WGM * nN, gid = wgid / nig, fm = gid * WGM, gsz = (nM - fm) < WGM ? (nM - fm) : WGM;
        u.pm = fm + ((wgid % nig) % gsz); u.pn = (wgid % nig) / gsz; return true;
    }
};

template <class F> struct EpiRow8 {
    static constexpr bool PERM = true;
    F f;
    __device__ __forceinline__ void operator()(const f32x4 (&acc)[2][2][4][2], const Unit& u, int wr, int wc, int fr, int fq) {
        const int row0 = u.pm * BM + wr * 64 + fr, colb = u.pn * BM + wc * 32 + 8 * fq;
        f.begin(u, colb);
#pragma unroll
        for (int ai = 0; ai < 2; ++ai)
#pragma unroll
            for (int m = 0; m < 4; ++m) {
                const int row = row0 + ai * HALF + m * 16;
#pragma unroll
                for (int bj = 0; bj < 2; ++bj) f.row8(row, bj, colb + bj * HALF, acc[ai][bj][m][0], acc[ai][bj][m][1]);
            }
    }
};

template <class Epi, class Sched, bool ALIGN_EPI = true, bool SP2 = true>
__device__ __forceinline__ void gemm_phase(LAS unsigned char* lds, const Gemm g, const Sched& S, Epi& E) {
    const int tid = threadIdx.x, wid = __builtin_amdgcn_readfirstlane(tid >> 6), lane = tid & 63, wr = wid >> 2, wc = wid & 3, fr = lane & 15, fq = lane >> 4;
    const int K = g.K, nt = K / BK;
    unsigned voffA[2], voffB[2];
#pragma unroll
    for (int i = 0; i < 2; ++i) { int Rr, C; stage_rc(tid * 16 + i * 8192, Rr, C); const int Rb = Epi::PERM ? ((Rr & ~31) + perm32(Rr & 31)) : Rr;
        voffA[i] = (unsigned)(Rr * g.lda + C) * 2u; voffB[i] = (unsigned)(Rb * g.ldb + C) * 2u; }
    const size_t kstep = (size_t)(BK * 2);
    const size_t hstepA = (size_t)HALF * g.lda * 2, hstepB = (size_t)HALF * g.ldb * 2;
    const size_t tstepA = 2 * hstepA, tstepB = 2 * hstepB;
    const unsigned ldsw = (unsigned)wid * 1024u;
    const int aoff = lds_byte(wr * 64 + fr, fq * 8), boff = lds_byte(wc * 32 + fr, fq * 8);
#define PG8_SA(b, h) (((b) * 2 + (h)) * HTB)
#define PG8_SB(b, h) ((4 + (b) * 2 + (h)) * HTB)
#define PG8_STAGE(bufoff, gbase, voff) do { _Pragma("unroll") for (int _i = 0; _i < 2; ++_i) \
        __builtin_amdgcn_global_load_lds((const unsigned*)((const char*)(gbase) + (voff)[_i]), (LAS unsigned*)(lds + (bufoff) + ldsw + _i * 8192), 16, 0, 0); } while (0)
#define PG8_LDA(dst, b, h) do { _Pragma("unroll") for (int m = 0; m < 4; ++m) _Pragma("unroll") for (int k = 0; k < 2; ++k) dst[m][k] = *(const LAS bf16x8*)(lds + PG8_SA(b, h) + aoff + m * 2048 + k * 1024); } while (0)
#define PG8_LDB(dst, b, h) do { _Pragma("unroll") for (int n = 0; n < 2; ++n) _Pragma("unroll") for (int k = 0; k < 2; ++k) dst[n][k] = *(const LAS bf16x8*)(lds + PG8_SB(b, h) + boff + n * 2048 + k * 1024); } while (0)
#define PG8_MMA(ai, bj, At, Bt) do { __builtin_amdgcn_s_setprio(1); _Pragma("unroll") for (int m = 0; m < 4; ++m) _Pragma("unroll") for (int n = 0; n < 2; ++n) _Pragma("unroll") for (int k = 0; k < 2; ++k) \
        acc[ai][bj][m][n] = __builtin_amdgcn_mfma_f32_16x16x32_bf16(Bt[n][k], At[m][k], acc[ai][bj][m][n], 0, 0, 0); __builtin_amdgcn_s_setprio(0); } while (0)
#define PG8_WAIT_V(n) asm volatile("s_waitcnt vmcnt(" #n ")" ::: "memory")
#define PG8_WAIT_L(n) asm volatile("s_waitcnt lgkmcnt(" #n ")" ::: "memory")
#define PG8_BAR __builtin_amdgcn_s_barrier()
#define PG8_SCHED __builtin_amdgcn_sched_barrier(0)
    Unit cur, nxt; int ui = 0;
    if (!S.next(0, cur)) return;
    f32x4 acc[2][2][4][2];
#pragma unroll
    for (int a = 0; a < 2; ++a)
#pragma unroll
        for (int b = 0; b < 2; ++b)
#pragma unroll
            for (int m = 0; m < 4; ++m)
#pragma unroll
                for (int n = 0; n < 2; ++n) acc[a][b][m][n] = (f32x4){0.f, 0.f, 0.f, 0.f};
    bf16x8 At[4][2], B0[2][2], B1[2][2];
    const char* cA = (const char*)g.A + (size_t)cur.pm * tstepA + (size_t)(g.a_blk ? (cur.pn & 7) * 512 : 0); const char* cB = (const char*)g.Bt + (size_t)cur.pn * tstepB;
    if constexpr (SP2) {
        PG8_STAGE(PG8_SB(0, 0), cB, voffB); PG8_STAGE(PG8_SB(0, 1), cB + hstepB, voffB); PG8_STAGE(PG8_SA(0, 0), cA, voffA); PG8_STAGE(PG8_SA(0, 1), cA + hstepA, voffA);
        if (wr == 1) PG8_BAR;
        PG8_WAIT_V(2); PG8_BAR;
        PG8_STAGE(PG8_SB(1, 0), cB + kstep, voffB); PG8_STAGE(PG8_SA(1, 0), cA + kstep, voffA); PG8_STAGE(PG8_SB(1, 1), cB + hstepB + kstep, voffB);
        PG8_WAIT_V(6); PG8_BAR;
    } else {
        PG8_STAGE(PG8_SB(0, 0), cB, voffB); PG8_STAGE(PG8_SA(0, 0), cA, voffA); PG8_STAGE(PG8_SB(0, 1), cB + hstepB, voffB); PG8_STAGE(PG8_SA(0, 1), cA + hstepA, voffA);
        if (wr == 1) PG8_BAR;
        PG8_WAIT_V(4); PG8_BAR;
        PG8_STAGE(PG8_SB(1, 0), cB + kstep, voffB); PG8_STAGE(PG8_SA(1, 0), cA + kstep, voffA); PG8_STAGE(PG8_SB(1, 1), cB + hstepB + kstep, voffB);
        PG8_WAIT_V(6); PG8_BAR;
    }
    for (;;) {
        const bool has_next = S.next(ui + 1, nxt);
        const char* nA = has_next ? (const char*)g.A + (size_t)nxt.pm * tstepA + (size_t)(g.a_blk ? (nxt.pn & 7) * 512 : 0) : cA; const char* nB = has_next ? (const char*)g.Bt + (size_t)nxt.pn * tstepB : cB;
#pragma unroll 1
        for (int t = 0; t < nt; t += 2) {
            const bool last = (t == nt - 2);
            const char* a1 = cA + (size_t)(t + 1) * kstep;
            const char* a2 = last ? nA : cA + (size_t)(t + 2) * kstep; const char* b2 = last ? nB : cB + (size_t)(t + 2) * kstep;
            const char* a3 = a2 + kstep; const char* b3 = b2 + kstep;
            if constexpr (SP2) {
            PG8_LDB(B0, 0, 0); PG8_LDB(B1, 0, 1); PG8_SCHED; PG8_LDA(At, 0, 0); PG8_STAGE(PG8_SA(1, 1), a1 + hstepA, voffA);
            PG8_WAIT_V(8); PG8_WAIT_L(0); PG8_BAR; PG8_MMA(0, 0, At, B0); PG8_MMA(0, 1, At, B1); PG8_BAR; PG8_SCHED;
            PG8_LDA(At, 0, 1); PG8_STAGE(PG8_SB(0, 0), b2, voffB); PG8_STAGE(PG8_SB(0, 1), b2 + hstepB, voffB); PG8_STAGE(PG8_SA(0, 0), a2, voffA);
            PG8_WAIT_V(8); PG8_WAIT_L(0); PG8_BAR; PG8_MMA(1, 0, At, B0); PG8_MMA(1, 1, At, B1); PG8_BAR; PG8_SCHED;
            PG8_LDB(B0, 1, 0); PG8_LDB(B1, 1, 1); PG8_SCHED; PG8_LDA(At, 1, 0); PG8_STAGE(PG8_SA(0, 1), a2 + hstepA, voffA);
            PG8_WAIT_V(8); PG8_WAIT_L(0); PG8_BAR; PG8_MMA(0, 0, At, B0); PG8_MMA(0, 1, At, B1); PG8_BAR; PG8_SCHED;
            PG8_LDA(At, 1, 1); PG8_STAGE(PG8_SB(1, 0), b3, voffB); PG8_STAGE(PG8_SB(1, 1), b3 + hstepB, voffB); PG8_STAGE(PG8_SA(1, 0), a3, voffA);
            PG8_WAIT_V(8); PG8_WAIT_L(0); PG8_BAR; PG8_MMA(1, 0, At, B0); PG8_MMA(1, 1, At, B1); PG8_BAR; PG8_SCHED;
            } else {
            PG8_LDB(B0, 0, 0); PG8_SCHED; PG8_LDA(At, 0, 0); PG8_STAGE(PG8_SA(1, 1), a1 + hstepA, voffA);
            PG8_WAIT_L(8); PG8_BAR; PG8_WAIT_L(0); PG8_MMA(0, 0, At, B0); PG8_BAR; PG8_SCHED;
            PG8_LDB(B1, 0, 1); PG8_STAGE(PG8_SB(0, 0), b2, voffB);
            PG8_BAR; PG8_WAIT_L(0); PG8_MMA(0, 1, At, B1); PG8_BAR;
            PG8_LDA(At, 0, 1); PG8_STAGE(PG8_SA(0, 0), a2, voffA);
            PG8_BAR; PG8_WAIT_L(0); PG8_MMA(1, 0, At, B0); PG8_BAR; PG8_SCHED;
            PG8_STAGE(PG8_SB(0, 1), b2 + hstepB, voffB);
            PG8_WAIT_V(6); PG8_BAR; PG8_MMA(1, 1, At, B1); PG8_BAR;
            PG8_LDB(B0, 1, 0); PG8_SCHED; PG8_LDA(At, 1, 0); PG8_STAGE(PG8_SA(0, 1), a2 + hstepA, voffA);
            PG8_WAIT_L(8); PG8_BAR; PG8_WAIT_L(0); PG8_MMA(0, 0, At, B0); PG8_BAR; PG8_SCHED;
            PG8_LDB(B1, 1, 1); PG8_STAGE(PG8_SB(1, 0), b3, voffB);
            PG8_BAR; PG8_WAIT_L(0); PG8_MMA(0, 1, At, B1); PG8_BAR;
            PG8_LDA(At, 1, 1); PG8_STAGE(PG8_SA(1, 0), a3, voffA);
            PG8_BAR; PG8_WAIT_L(0); PG8_MMA(1, 0, At, B0); PG8_BAR; PG8_SCHED;
            PG8_STAGE(PG8_SB(1, 1), b3 + hstepB, voffB);
            PG8_WAIT_V(6); PG8_BAR; PG8_MMA(1, 1, At, B1); PG8_BAR;
            }
        }
        if constexpr (ALIGN_EPI) { if (wr == 0) PG8_BAR; }
        E(acc, cur, wr, wc, fr, fq);
        if (!has_next) break;
#pragma unroll
        for (int a = 0; a < 2; ++a)
#pragma unroll
            for (int b = 0; b < 2; ++b)
#pragma unroll
                for (int m = 0; m < 4; ++m)
#pragma unroll
                    for (int n = 0; n < 2; ++n) acc[a][b][m][n] = (f32x4){0.f, 0.f, 0.f, 0.f};
        cur = nxt; cA = nA; cB = nB; ++ui;
        if constexpr (ALIGN_EPI) { if (wr == 1) PG8_BAR; }
    }
    PG8_WAIT_V(0);
    if constexpr (!ALIGN_EPI) { if (wr == 0) PG8_BAR; }
    PG8_BAR;
#undef PG8_SA
#undef PG8_SB
#undef PG8_STAGE
#undef PG8_LDA
#undef PG8_LDB
#undef PG8_MMA
#undef PG8_WAIT_V
#undef PG8_WAIT_L
#undef PG8_BAR
#undef PG8_SCHED
}
}

namespace att {
constexpr int NW = 8, QBLK = 32, KVBLK = 64, DV = 128;
constexpr float THR = 8.f;
#define SBAR() __builtin_amdgcn_sched_barrier(0)
__device__ __forceinline__ int crow(int r, int hi) { return (r & 3) + 8 * (r >> 2) + 4 * hi; }
template <int DQK> struct Cfg {
    static constexpr int KROW = DQK * 2;
    static constexpr int SHM_K = KVBLK * KROW, SHM_V = KVBLK * DV * 2;
    static constexpr int QPE_OFF = 2 * SHM_V + 2 * SHM_K + NW * 64 * 4;
    static constexpr int LDS_BYTES = QPE_OFF + (DQK == 192 ? NW * 4096 : 0);
    static constexpr int NQ = DQK / 16;
    static constexpr int NKC = DQK / 64;
};
template <int DQK> __device__ __forceinline__ int kswz(int row, int colB) { return row * (DQK * 2) + (colB ^ ((row & 7) << 4)); }

template <int DQK>
__device__ __forceinline__ void partialSM(f32x16& p0, f32x16& p1, float& m_reg, float& mn, float& alpha) {
    constexpr float SCALE = DQK == 128 ? 0.08838834764831845f : 0.07216878364870322f;
    constexpr float C = SCALE * 1.4426950408889634f;
    float pmax = p0[0];
#pragma unroll
    for (int r = 1; r < 16; ++r) pmax = fmaxf(pmax, p0[r]);
#pragma unroll
    for (int r = 0; r < 16; ++r) pmax = fmaxf(pmax, p1[r]);
    { auto rr = __builtin_amdgcn_permlane32_swap(__float_as_uint(pmax), __float_as_uint(pmax), false, false);
      pmax = fmaxf(__uint_as_float(rr[0]), __uint_as_float(rr[1])); }
    if (__builtin_expect(__all(pmax - m_reg <= THR / SCALE), 1)) { mn = m_reg; alpha = 1.f; }
    else { mn = fmaxf(m_reg, pmax); alpha = __builtin_amdgcn_exp2f((m_reg - mn) * C); m_reg = mn; }
    const float mnC = -mn * C;
#pragma unroll
    for (int r = 0; r < 16; ++r) p0[r] = fmaf(p0[r], C, mnC);
#pragma unroll
    for (int r = 0; r < 16; ++r) p1[r] = fmaf(p1[r], C, mnC);
#pragma unroll
    for (int r = 0; r < 16; ++r) p0[r] = __builtin_amdgcn_exp2f(p0[r]);
}
__device__ __forceinline__ void finishSM(f32x16& p0, f32x16& p1, float alpha, float& l_reg, bf16x8& pa0, bf16x8& pa1, bf16x8& pa2, bf16x8& pa3) {
#pragma unroll
    for (int r = 0; r < 16; ++r) p1[r] = __builtin_amdgcn_exp2f(p1[r]);
    float ps = 0;
#pragma unroll
    for (int r = 0; r < 16; ++r) ps += p0[r];
#pragma unroll
    for (int r = 0; r < 16; ++r) ps += p1[r];
    { auto rr = __builtin_amdgcn_permlane32_swap(__float_as_uint(ps), __float_as_uint(ps), false, false);
      ps = __uint_as_float(rr[0]) + __uint_as_float(rr[1]); }
    l_reg = l_reg * alpha + ps;
#define PK4(P, BASE, OUT) do { unsigned a0 = cvt_pk_bf16(P[BASE + 0], P[BASE + 1]), a1 = cvt_pk_bf16(P[BASE + 2], P[BASE + 3]);   \
    unsigned b0 = cvt_pk_bf16(P[BASE + 4], P[BASE + 5]), b1 = cvt_pk_bf16(P[BASE + 6], P[BASE + 7]);                              \
    auto r0 = __builtin_amdgcn_permlane32_swap(a0, b0, false, false); auto r1 = __builtin_amdgcn_permlane32_swap(a1, b1, false, false); \
    u32x4 w = {r0[0], r1[0], r0[1], r1[1]}; OUT = *reinterpret_cast<bf16x8*>(&w); } while (0)
    PK4(p0, 0, pa0); PK4(p0, 8, pa1); PK4(p1, 0, pa2); PK4(p1, 8, pa3);
#undef PK4
}
template <int DQK>
__device__ __forceinline__ void qkt(f32x16& p0, f32x16& p1, const char* Ks, const bf16x8* qr, const char* qpe, int r32, int hi) {
    p0 = f32x16{}; p1 = f32x16{};
#pragma unroll
    for (int d0 = 0; d0 < DQK / 16; ++d0) { const int cb = (d0 * 16 + hi * 8) * 2;
        bf16x8 b0 = *reinterpret_cast<const bf16x8*>(Ks + kswz<DQK>(r32, cb));
        bf16x8 b1 = *reinterpret_cast<const bf16x8*>(Ks + kswz<DQK>(32 + r32, cb));
        bf16x8 q; if (d0 < 8) q = qr[d0 < 8 ? d0 : 0]; else q = *reinterpret_cast<const bf16x8*>(qpe + (d0 - 8) * 1024);
        p0 = __builtin_amdgcn_mfma_f32_32x32x16_bf16(b0, q, p0, 0, 0, 0);
        p1 = __builtin_amdgcn_mfma_f32_32x32x16_bf16(b1, q, p1, 0, 0, 0);
        if (DQK == 192 && (d0 & 3) == 3 && d0 != 11) SBAR(); }
}
__device__ __forceinline__ int v_st(int k, int c) { const int kk = (k & ~0xC) | ((k & 4) << 1) | ((k & 8) >> 1); return ((kk >> 3) * 4 + (c >> 5)) * 512 + ((kk & 7) * 32 + (c & 31)) * 2; }
__device__ __forceinline__ int v_rd_base(int lane) { return ((lane & 3) << 3) | (((lane >> 2) & 3) << 6) | (((lane >> 4) & 1) << 5) | (((lane >> 5) & 1) << 8); }
constexpr int v_rd_off(int d0, int ks, int half) { return d0 * 512 + ks * 4096 + half * 2048; }
template <int OFF> __device__ __forceinline__ s16x4 tr_read(int vb) {
    s16x4 r; asm volatile("ds_read_b64_tr_b16 %0, %1 offset:%2" : "=&v"(r) : "v"(vb), "i"(OFF) : "memory"); return r;
}
template <int D0> __device__ __forceinline__ void pv_one(f32x16& od, int vb, bf16x8 pa0, bf16x8 pa1, bf16x8 pa2, bf16x8 pa3) {
    const s16x4 l0 = tr_read<v_rd_off(D0, 0, 0)>(vb), h0 = tr_read<v_rd_off(D0, 0, 1)>(vb), l1 = tr_read<v_rd_off(D0, 1, 0)>(vb), h1 = tr_read<v_rd_off(D0, 1, 1)>(vb);
    const s16x4 l2 = tr_read<v_rd_off(D0, 2, 0)>(vb), h2 = tr_read<v_rd_off(D0, 2, 1)>(vb), l3 = tr_read<v_rd_off(D0, 3, 0)>(vb), h3 = tr_read<v_rd_off(D0, 3, 1)>(vb);
    asm volatile("s_waitcnt lgkmcnt(0)" ::: "memory"); SBAR();
#define PK(L, H) (bf16x8){L[0], L[1], L[2], L[3], H[0], H[1], H[2], H[3]}
    od = __builtin_amdgcn_mfma_f32_32x32x16_bf16(pa0, PK(l0, h0), od, 0, 0, 0);
    od = __builtin_amdgcn_mfma_f32_32x32x16_bf16(pa1, PK(l1, h1), od, 0, 0, 0);
    od = __builtin_amdgcn_mfma_f32_32x32x16_bf16(pa2, PK(l2, h2), od, 0, 0, 0);
    od = __builtin_amdgcn_mfma_f32_32x32x16_bf16(pa3, PK(l3, h3), od, 0, 0, 0);
#undef PK
}
__device__ __forceinline__ void pv_d0(f32x16* o, int vb, bf16x8 pa0, bf16x8 pa1, bf16x8 pa2, bf16x8 pa3) {
    pv_one<0>(o[0], vb, pa0, pa1, pa2, pa3); pv_one<1>(o[1], vb, pa0, pa1, pa2, pa3); pv_one<2>(o[2], vb, pa0, pa1, pa2, pa3); pv_one<3>(o[3], vb, pa0, pa1, pa2, pa3);
}
__device__ __forceinline__ void unpack8(bf16x8 v, float* f) {
    const u32x4 w = *reinterpret_cast<const u32x4*>(&v);
    f[0] = bf_lo(w.x); f[1] = bf_hi(w.x); f[2] = bf_lo(w.y); f[3] = bf_hi(w.y); f[4] = bf_lo(w.z); f[5] = bf_hi(w.z); f[6] = bf_lo(w.w); f[7] = bf_hi(w.w);
}
__device__ __forceinline__ bf16x8 pack8(const float* f) {
    u32x4 w = {cvt_pk_bf16(f[0], f[1]), cvt_pk_bf16(f[2], f[3]), cvt_pk_bf16(f[4], f[5]), cvt_pk_bf16(f[6], f[7])}; return *reinterpret_cast<bf16x8*>(&w);
}
__device__ __forceinline__ void rope_pair(bf16x8& A, bf16x8& B, const f32x2* __restrict__ tab) {
    float a[8], b[8], ra[8], rb[8]; unpack8(A, a); unpack8(B, b);
#pragma unroll
    for (int j = 0; j < 8; ++j) { const f32x2 cs = tab[j]; ra[j] = a[j] * cs.x - b[j] * cs.y; rb[j] = b[j] * cs.x + a[j] * cs.y; }
    A = pack8(ra); B = pack8(rb);
}

template <int DQK, int LDQ, int LDK, int LDV, int LDO>
__device__ __forceinline__ void attn_body(const bf16_t* __restrict__ Qb, const bf16_t* __restrict__ Kh, const bf16_t* __restrict__ Vh, bf16_t* __restrict__ Ob, int seq, char* lds,
                                          const float* __restrict__ qg, const f32x2* __restrict__ tab, bool rope, int tok0) {
    using C = Cfg<DQK>;
    int tid_ = threadIdx.x; asm volatile("" : "+v"(tid_));
    const int tid = tid_, wid = tid >> 6, lane = tid & 63, r32 = lane & 31, hi = lane >> 5;
    char* V_lds = lds; char* K_lds = lds + 2 * C::SHM_V;
    float* wsf = (float*)(lds + 2 * C::SHM_V + 2 * C::SHM_K) + wid * 64; float* li_l = wsf; float* al_l = wsf + 32;
    char* qpe = lds + C::QPE_OFF + wid * 4096 + lane * 16;
    float m_reg = -1e30f, l_reg = 0; f32x16 o[4] = {}; bf16x8 qr[C::NQ];
    const bf16_t* Qw = Qb + (long)(wid * QBLK + r32) * LDQ + hi * 8;
#pragma unroll
    for (int d0 = 0; d0 < C::NQ; ++d0) qr[d0] = *reinterpret_cast<const bf16x8*>(Qw + d0 * 16);
    {
        const int t = tok0 + wid * QBLK + r32, prow = t >> 6, pcol = t & 63;
        if constexpr (DQK == 128) {
            float ss = 0.f;
#pragma unroll
            for (int d0 = 0; d0 < 8; ++d0) { float f[8]; unpack8(qr[d0], f);
#pragma unroll
                for (int j = 0; j < 8; ++j) ss += f[j] * f[j]; }
            ss += __shfl_xor(ss, 32);
            const float rstd = 1.0f / sqrtf(ss * (1.0f / 128.0f) + 1e-6f);
#pragma unroll
            for (int d0 = 0; d0 < 8; ++d0) { float f[8]; unpack8(qr[d0], f);
#pragma unroll
                for (int j = 0; j < 8; ++j) f[j] = f[j] * rstd * qg[d0 * 16 + hi * 8 + j];
                qr[d0] = pack8(f); }
            if (rope) {
                const f32x2* tr = tab + prow * 32 + hi * 8; const f32x2* tc = tab + pcol * 32 + hi * 8;
                rope_pair(qr[0], qr[2], tr); rope_pair(qr[1], qr[3], tr + 16);
                rope_pair(qr[4], qr[6], tc); rope_pair(qr[5], qr[7], tc + 16);
            }
        } else {
            if (rope) {
                const f32x2* tr = tab + prow * 16 + hi * 8; const f32x2* tc = tab + pcol * 16 + hi * 8;
                rope_pair(qr[8], qr[9], tr); rope_pair(qr[10], qr[11], tc);
            }
        }
    }
    if constexpr (DQK == 192) {
#pragma unroll
        for (int d0 = 8; d0 < 12; ++d0) *reinterpret_cast<bf16x8*>(qpe + (d0 - 8) * 1024) = qr[d0];
        asm volatile("s_waitcnt lgkmcnt(0)" ::: "memory");
    }
    const int sr = tid >> 4, sc = (tid & 15) * 8, vst0 = v_st(sr, sc), vst1 = v_st(32 + sr, sc);
    const int vb0 = (int)(uintptr_t)V_lds + v_rd_base(lane);
    const int sr2 = tid >> 3, sc2 = 128 + (tid & 7) * 8;
    struct Slot { bf16x8 vs0, vs1, ks0, ks1, ks2; };
    Slot sA, sBs;
#define sB (*(DQK == 192 ? &sA : &sBs))
#define SLOAD(S, k0) do { S.vs0 = *reinterpret_cast<const bf16x8*>(&Vh[(long)((k0) + sr) * LDV + sc]); S.vs1 = *reinterpret_cast<const bf16x8*>(&Vh[(long)((k0) + 32 + sr) * LDV + sc]); \
    S.ks0 = *reinterpret_cast<const bf16x8*>(&Kh[(long)((k0) + sr) * LDK + sc]); S.ks1 = *reinterpret_cast<const bf16x8*>(&Kh[(long)((k0) + 32 + sr) * LDK + sc]); \
    if constexpr (DQK == 192) S.ks2 = *reinterpret_cast<const bf16x8*>(&Kh[(long)((k0) + sr2) * LDK + sc2]); } while (0)
#define SWRITE(b, S) do { *(bf16x8*)(V_lds + (b) * C::SHM_V + vst0) = S.vs0; *(bf16x8*)(V_lds + (b) * C::SHM_V + vst1) = S.vs1; \
    *(bf16x8*)(K_lds + (b) * C::SHM_K + kswz<DQK>(sr, sc * 2)) = S.ks0; *(bf16x8*)(K_lds + (b) * C::SHM_K + kswz<DQK>(32 + sr, sc * 2)) = S.ks1; \
    if constexpr (DQK == 192) *(bf16x8*)(K_lds + (b) * C::SHM_K + kswz<DQK>(sr2, sc2 * 2)) = S.ks2; } while (0)
#define SWAIT() do { if constexpr (DQK == 192) asm volatile("s_waitcnt vmcnt(0)" ::: "memory"); else asm volatile("s_waitcnt vmcnt(4)" ::: "memory"); } while (0)
#define RESC(a) do { if (__any((a) < 1.f)) { if (hi == 0) al_l[r32] = (a); asm volatile("s_waitcnt lgkmcnt(0)" ::: "memory"); \
    _Pragma("unroll") for (int d = 0; d < 4; ++d) _Pragma("unroll") for (int r = 0; r < 16; ++r) o[d][r] *= al_l[crow(r, hi)]; } } while (0)
    f32x16 pA0, pA1, pB0, pB1; float mnA, mnB, alA, alB; bf16x8 pa0, pa1, pa2, pa3; const int NT = seq / KVBLK;
    SLOAD(sA, 0); asm volatile("s_waitcnt vmcnt(0)" ::: "memory"); SWRITE(0, sA); __syncthreads();
    qkt<DQK>(pA0, pA1, K_lds, qr, qpe, r32, hi); partialSM<DQK>(pA0, pA1, m_reg, mnA, alA);
    SLOAD(sB, KVBLK); if constexpr (DQK != 192) { if (2 < NT) SLOAD(sA, 2 * KVBLK); }
    SWAIT(); SWRITE(1, sB); __syncthreads();
    for (int j = 1; j + 1 < NT; j += 2) {
        SBAR(); qkt<DQK>(pB0, pB1, K_lds + C::SHM_K, qr, qpe, r32, hi);
        finishSM(pA0, pA1, alA, l_reg, pa0, pa1, pa2, pa3); SBAR();
        SLOAD(sB, (j + (DQK == 192 ? 1 : 2)) * KVBLK); SBAR();
        pv_d0(o, vb0, pa0, pa1, pa2, pa3); partialSM<DQK>(pB0, pB1, m_reg, mnB, alB);
        __syncthreads(); SWAIT(); SWRITE(0, sA);
        RESC(alB); __syncthreads();
        SBAR(); qkt<DQK>(pA0, pA1, K_lds, qr, qpe, r32, hi);
        finishSM(pB0, pB1, alB, l_reg, pa0, pa1, pa2, pa3); SBAR();
        if (DQK == 192 || j + 3 < NT) SLOAD(sA, (j + (DQK == 192 ? 2 : 3)) * KVBLK); SBAR();
        pv_d0(o, vb0 + C::SHM_V, pa0, pa1, pa2, pa3); partialSM<DQK>(pA0, pA1, m_reg, mnA, alA);
        __syncthreads(); SWAIT(); SWRITE(1, sB);
        RESC(alA); __syncthreads();
    }
    SBAR(); qkt<DQK>(pB0, pB1, K_lds + C::SHM_K, qr, qpe, r32, hi);
    finishSM(pA0, pA1, alA, l_reg, pa0, pa1, pa2, pa3); SBAR();
    pv_d0(o, vb0, pa0, pa1, pa2, pa3); partialSM<DQK>(pB0, pB1, m_reg, mnB, alB);
    __syncthreads(); RESC(alB);
    finishSM(pB0, pB1, alB, l_reg, pa0, pa1, pa2, pa3); SBAR();
    pv_d0(o, vb0 + C::SHM_V, pa0, pa1, pa2, pa3);
    if (hi == 0) li_l[r32] = l_reg; asm volatile("s_waitcnt lgkmcnt(0)" ::: "memory");
    float rli[16];
#pragma unroll
    for (int r = 0; r < 16; ++r) rli[r] = __builtin_amdgcn_rcpf(li_l[crow(r, hi)]);
    bf16_t* Ow = Ob + (long)(wid * QBLK) * LDO;
#pragma unroll
    for (int r = 0; r < 16; ++r) { const int orow = crow(r, hi);
#pragma unroll
        for (int d0 = 0; d0 < 4; ++d0) Ow[(long)orow * LDO + d0 * 32 + r32] = f2bf(o[d0][r] * rli[r]); }
    __syncthreads();
#undef sB
#undef SLOAD
#undef SWRITE
#undef SWAIT
#undef RESC
}
}

constexpr size_t MiB = 1u << 20;
constexpr size_t WS_CTL = 0, CTL_ZERO_BYTES = 1 * MiB;
constexpr size_t WS_MODS = 1 * MiB;
constexpr size_t WS_TAB = 2 * MiB;
constexpr size_t WS_X = 4 * MiB;
constexpr size_t WS_H = 140 * MiB;
constexpr size_t WS_OUTF = 208 * MiB;
constexpr size_t WS_W1T = 344 * MiB, WS_W2T = 472 * MiB;
constexpr size_t WS_GQAW = 600 * MiB;
constexpr size_t WS_LRUW = 640 * MiB;
constexpr size_t WS_MLAW = 668 * MiB;
constexpr size_t WS_BIG = 688 * MiB;
constexpr size_t WS_ACT = WS_BIG;
constexpr size_t WS_GQ = WS_BIG, WS_GK = WS_BIG + 68 * MiB, WS_GV = WS_BIG + 85 * MiB, WS_GO = WS_BIG + 102 * MiB;
constexpr size_t WS_MAP = WS_BIG, WS_MQAN = WS_BIG + 85 * MiB, WS_MCKVN = WS_BIG + 102 * MiB, WS_MQ = WS_BIG + 119 * MiB, WS_MK = WS_BIG + 221 * MiB, WS_MV = WS_BIG + 323 * MiB, WS_MO = WS_BIG + 391 * MiB;
constexpr size_t WS_LUP = WS_BIG, WS_LG = WS_BIG  , WS_LGY = WS_BIG + 68 * MiB, WS_LU = WS_BIG + 136 * MiB, WS_LAF = WS_BIG + 204 * MiB, WS_LGUF = WS_BIG + 340 * MiB,
                 WS_LAB = WS_BIG + 476 * MiB, WS_LGUB = WS_BIG + 612 * MiB, WS_LPS = WS_BIG + 748 * MiB, WS_LCIN = WS_BIG + 766 * MiB;
static_assert(WS_LGUF == WS_LAF + (size_t)R * DM * 4 && WS_LAB == WS_LGUF + (size_t)R * DM * 4 && WS_LGUB == WS_LAB + (size_t)R * DM * 4, "gate outputs are consecutive");
constexpr size_t WS_END = WS_BIG + 776 * MiB;
constexpr int NCH = 136;

#define XB_TMO      128
#define XB_XCNT(j)  (256  + 64 * (j))
#define XB_XSUB(j)  (1280 + 64 * (j))
#define XB_XGEN(j)  (2304 + 64 * (j))
#define XB_TOP      3328
#define XB_TOPGEN   3392
#define XCD_BAR_WORDS 3456
#define XB_SPIN_CAP (1u << 22)
__device__ __forceinline__ unsigned xb_ld(unsigned* p)              { return __hip_atomic_load(p, __ATOMIC_RELAXED, __HIP_MEMORY_SCOPE_AGENT); }
__device__ __forceinline__ unsigned xb_add(unsigned* p, unsigned v) { return __hip_atomic_fetch_add(p, v, __ATOMIC_RELAXED, __HIP_MEMORY_SCOPE_AGENT); }
__device__ __forceinline__ unsigned xb_xcc_id() { return (unsigned)__builtin_amdgcn_s_getreg((3 << 11) | 20) & 0xFu; }
#define XB_SPIN(cond, bar) do { unsigned _sp = 0; while (cond) { __builtin_amdgcn_s_sleep(1); \
    if ((++_sp & 255u) == 0u) { if (xb_ld(&(bar)[XB_TMO])) break; if (_sp > XB_SPIN_CAP) { atomicAdd(&(bar)[XB_TMO], 1u); break; } } } } while (0)
struct XcdBarrier { unsigned* bar; unsigned x; volatile LAS unsigned* st; };
__device__ __forceinline__ XcdBarrier xcd_barrier_post(unsigned* bar, volatile LAS unsigned* st) {
    XcdBarrier b; b.bar = bar; b.x = xb_xcc_id(); b.st = st;
    if (threadIdx.x == 0) (void)xb_add(&bar[XB_XCNT(b.x)], 1u);
    return b;
}
__device__ __forceinline__ void xcd_barrier_complete(unsigned* bar, unsigned x, unsigned& nloc, unsigned& nx) {
    const unsigned G = gridDim.x * gridDim.y * gridDim.z;
    unsigned sum, cnt, mine, sp = 0u;
    for (;;) {
        sum = 0u; cnt = 0u; mine = 0u;
#pragma unroll
        for (unsigned j = 0; j < 16; ++j) { const unsigned c = xb_ld(&bar[XB_XCNT(j)]); sum += c; cnt += (c > 0u) ? 1u : 0u; mine = (j == x) ? c : mine; }
        if (sum == G) break;
        __builtin_amdgcn_s_sleep(1);
        if ((++sp & 255u) == 0u) { if (xb_ld(&bar[XB_TMO])) break; if (sp > XB_SPIN_CAP) { atomicAdd(&bar[XB_TMO], 1u); break; } }
    }
    nloc = mine > 0u ? mine : 1u; nx = cnt > 0u ? cnt : 1u;
}
__device__ __forceinline__ void xcd_barrier(const XcdBarrier& b) {
    asm volatile("s_waitcnt vmcnt(0)" ::: "memory");
    __syncthreads();
    if (threadIdx.x == 0) {
        unsigned* bar = b.bar;
        __builtin_amdgcn_s_waitcnt(0);
        unsigned nloc = b.st[0], nx = b.st[1];
        if (nloc == 0u) { xcd_barrier_complete(bar, b.x, nloc, nx); b.st[0] = nloc; b.st[1] = nx; }
        const unsigned old = xb_add(&bar[XB_XSUB(b.x)], 1u);
        const unsigned gen = old / nloc;
        if (old + 1u == (gen + 1u) * nloc) {
            __builtin_amdgcn_fence(__ATOMIC_RELEASE, "agent");
            asm volatile("s_waitcnt vmcnt(0)" ::: "memory");
            const unsigned og = xb_add(&bar[XB_TOP], 1u);
            const unsigned tg = og / nx;
            if (og + 1u == (tg + 1u) * nx) xb_add(&bar[XB_TOPGEN], 1u);
            else XB_SPIN(xb_ld(&bar[XB_TOPGEN]) == tg, bar);
            __builtin_amdgcn_fence(__ATOMIC_ACQUIRE, "agent");
            xb_add(&bar[XB_XGEN(b.x)], 1u);
            asm volatile("s_waitcnt vmcnt(0)" ::: "memory");
        } else {
            XB_SPIN(xb_ld(&bar[XB_XGEN(b.x)]) == gen, bar);
            __builtin_amdgcn_fence(__ATOMIC_ACQUIRE, "agent");
            asm volatile("s_waitcnt vmcnt(0)" ::: "memory");
        }
    }
    __syncthreads();
}

struct Args {
    const float *x, *c, *ctx, *c_ctx, *ada_w, *ada_b, *ln_g, *ln_b, *mlp_w1, *mlp_w2;
    const float *gqa_wq, *gqa_wk, *gqa_wv, *gqa_wo, *gqa_q_g, *gqa_k_g;
    const float *lru_wx, *lru_wy, *lru_conv_w, *lru_conv_b, *lru_ra_w, *lru_ra_b, *lru_ix_w, *lru_ix_b, *lru_lam, *lru_wo;
    const float *mla_wq_a, *mla_q_a_g, *mla_wq_b, *mla_wkv_a, *mla_kv_a_g, *mla_wkv_b, *mla_wo;
    float* out; unsigned char* ws; int ph_lo, ph_hi;
};

constexpr int NWAVES = 8;
constexpr int RING_BYTES = 131072, LDSCTL_OFF = RING_BYTES, LDS_BYTES = 147456;

__device__ __forceinline__ float wave_sum(float v) {
#pragma unroll
    for (int o = 1; o < 64; o <<= 1) v += __shfl_xor(v, o);
    return v;
}
__device__ __forceinline__ float sigmoidf_(float v) { return __builtin_amdgcn_rcpf(1.0f + __builtin_amdgcn_exp2f(-1.4426950408889634f * v)); }

__device__ __forceinline__ void ph_mods(const Args& a, LAS unsigned char* lds, int vcu, int G) {
    LAS float* S = (LAS float*)lds; LAS float* red = (LAS float*)(lds + 40960);
    const int tid = threadIdx.x, wave = tid >> 6, lane = tid & 63;
    for (int i = tid; i < 5 * DM; i += 512) { const int bi = i / DM, k = i % DM; const float v = bi < 4 ? a.c[bi * DM + k] : a.c_ctx[k]; S[i] = v / (1.0f + expf(-v)); }
    __syncthreads();
    float* mods = (float*)(a.ws + WS_MODS);
    for (int item = vcu; item < 768; item += G) {
        const int l = item / 192, n0 = (item % 192) * 64, ksub = wave * 4 + (lane >> 4), cl = lane & 15;
        const float* wp = a.ada_w + ((size_t)l * DM + ksub) * 12288 + n0 + cl * 4;
        float acc[5][4];
#pragma unroll
        for (int i = 0; i < 5; ++i)
#pragma unroll
            for (int j = 0; j < 4; ++j) acc[i][j] = 0.f;
#pragma unroll 8
        for (int it = 0; it < 64; ++it) {
            const f32x4 w = *(const f32x4*)(wp + (size_t)it * 32 * 12288); const int k = ksub + 32 * it;
#pragma unroll
            for (int i = 0; i < 5; ++i) { const float s = S[i * DM + k];
#pragma unroll
                for (int j = 0; j < 4; ++j) acc[i][j] += s * w[j]; }
        }
#pragma unroll
        for (int i = 0; i < 5; ++i)
#pragma unroll
            for (int j = 0; j < 4; ++j) red[(ksub * 5 + i) * 64 + cl * 4 + j] = acc[i][j];
        __syncthreads();
        if (tid < 320) { const int i = tid / 64, cc = tid % 64; float s = 0.f;
            for (int ks = 0; ks < 32; ++ks) s += red[(ks * 5 + i) * 64 + cc];
            mods[(size_t)(l * 5 + i) * 12288 + n0 + cc] = s + a.ada_b[l * 12288 + n0 + cc]; }
        __syncthreads();
    }
}
__device__ __forceinline__ void tr_item(const float* __restrict__ W, int ldw, int k0, int n0, bf16_t* __restrict__ WT, int ldt, int drow0, LAS float* scr, int lane) {
#pragma unroll 8
    for (int i = 0; i < 32; ++i) { const int kk = 2 * i + (lane >> 5); scr[kk * 33 + (lane & 31)] = W[(size_t)(k0 + kk) * ldw + n0 + (lane & 31)]; }
    asm volatile("s_waitcnt lgkmcnt(0)" ::: "memory");
    const int c = lane & 7;
#pragma unroll
    for (int j = 0; j < 4; ++j) { const int n = (lane >> 3) + 8 * j; const LAS float* s = scr + (8 * c) * 33 + n;
        u32x4 o; o.x = cvt_pk_bf16(s[0 * 33], s[1 * 33]); o.y = cvt_pk_bf16(s[2 * 33], s[3 * 33]); o.z = cvt_pk_bf16(s[4 * 33], s[5 * 33]); o.w = cvt_pk_bf16(s[6 * 33], s[7 * 33]);
        *(u32x4*)(WT + (size_t)(drow0 + n) * ldt + k0 + 8 * c) = o; }
    asm volatile("s_waitcnt lgkmcnt(0)" ::: "memory");
}
__device__ __forceinline__ void ph_transposes(const Args& a, LAS unsigned char* lds, int vcu, int G) {
    const int tid = threadIdx.x, wave = tid >> 6, lane = tid & 63;
    LAS float* scr = (LAS float*)(lds + wave * 8704);
    const int gw = vcu * NWAVES + wave, NGW = G * NWAVES;
    unsigned char* ws = a.ws;
    constexpr int NITEMS = 87872;
    for (int it = gw; it < NITEMS; it += NGW) {
        int r = it;
#define TR_DO(src, K_, N_, dst, drow) do { const int nblk = (N_) / 32, kb = ri / nblk, nb = ri % nblk; tr_item((src), (N_), 64 * kb, 32 * nb, (dst), (K_), (drow) + 32 * nb, scr, lane); } while (0)
        if (r < 32768) { const int l = r / 8192, ri = r % 8192; TR_DO(a.mlp_w1 + (size_t)l * DM * DFF, DM, DFF, (bf16_t*)(ws + WS_W1T) + (size_t)l * DFF * DM, 0); continue; } r -= 32768;
        if (r < 32768) { const int l = r / 8192, ri = r % 8192; TR_DO(a.mlp_w2 + (size_t)l * DFF * DM, DFF, DM, (bf16_t*)(ws + WS_W2T) + (size_t)l * DM * DFF, 0); continue; } r -= 32768;
        if (r < 4096) { const int s = r / 2048, ri = r % 2048; TR_DO(a.gqa_wq + (size_t)s * DM * DM, DM, DM, (bf16_t*)(ws + WS_GQAW + s * 20 * MiB), 0); continue; } r -= 4096;
        if (r < 1024) { const int s = r / 512, ri = r % 512; TR_DO(a.gqa_wk + (size_t)s * DM * 512, DM, 512, (bf16_t*)(ws + WS_GQAW + s * 20 * MiB), 2048); continue; } r -= 1024;
        if (r < 1024) { const int s = r / 512, ri = r % 512; TR_DO(a.gqa_wv + (size_t)s * DM * 512, DM, 512, (bf16_t*)(ws + WS_GQAW + s * 20 * MiB), 2560); continue; } r -= 1024;
        if (r < 4096) { const int s = r / 2048, ri = r % 2048; TR_DO(a.gqa_wo + (size_t)s * DM * DM, DM, DM, (bf16_t*)(ws + WS_GQAW + s * 20 * MiB + 12 * MiB), 0); continue; } r -= 4096;
        if (r < 2048) { const int ri = r; TR_DO(a.lru_wx, DM, DM, (bf16_t*)(ws + WS_LRUW), 0); continue; } r -= 2048;
        if (r < 2048) { const int ri = r; TR_DO(a.lru_wy, DM, DM, (bf16_t*)(ws + WS_LRUW), 2048); continue; } r -= 2048;
        if (r < 1024) { const int blk = r / 32, ri = r % 32, ty = blk / 16, d = (blk % 16) / 8, n = blk % 8, which = d * 2 + ty;
            const float* src = (ty == 0 ? a.lru_ra_w : a.lru_ix_w) + (size_t)(d * 8 + n) * 65536;
            TR_DO(src, 256, 256, (bf16_t*)(ws + WS_LRUW + 16 * MiB), (which * 8 + n) * 256); continue; } r -= 1024;
        if (r < 2048) { const int ri = r; TR_DO(a.lru_wo, DM, DM, (bf16_t*)(ws + WS_LRUW + 20 * MiB), 0); continue; } r -= 2048;
        if (r < 512) { const int ri = r; TR_DO(a.mla_wq_a, DM, 512, (bf16_t*)(ws + WS_MLAW), 0); continue; } r -= 512;
        if (r < 576) { const int ri = r; TR_DO(a.mla_wkv_a, DM, 576, (bf16_t*)(ws + WS_MLAW), 512); continue; } r -= 576;
        if (r < 768) { const int ri = r; TR_DO(a.mla_wq_b, 512, 3072, (bf16_t*)(ws + WS_MLAW + 5 * MiB), 0); continue; } r -= 768;
        if (r < 1024) { const int ri = r, nb = ri % 128, kb = ri / 128, n0 = 32 * nb, h = n0 >> 8, j0 = n0 & 255;
            const int drow = j0 < 128 ? h * 128 + j0 : 2048 + h * 128 + (j0 - 128);
            tr_item(a.mla_wkv_b, 4096, 64 * kb, n0, (bf16_t*)(ws + WS_MLAW + 8 * MiB), 512, drow, scr, lane); continue; } r -= 1024;
        { const int ri = r; TR_DO(a.mla_wo, DM, DM, (bf16_t*)(ws + WS_MLAW + 12 * MiB), 0); }
#undef TR_DO
    }
    { u32x4* z = (u32x4*)(ws + WS_MLAW + (size_t)1088 * DM * 2); const int gt = vcu * 512 + tid;
      for (int i = gt; i < 49152; i += G * 512) z[i] = (u32x4){0u, 0u, 0u, 0u}; }
    if (vcu == 1 % G) { float* ll = (float*)(ws + WS_TAB + 32768); for (int i = tid; i < 2 * DM; i += 512) ll[i] = -8.0f * log1pf(expf(-a.lru_lam[i])); }
    if (vcu == 0) {
        f32x2* tg = (f32x2*)(ws + WS_TAB); f32x2* tm = (f32x2*)(ws + WS_TAB + 16384);
        for (int i = tid; i < 64 * 32; i += 512) { const int pos = i / 32, f = i % 32; const float inv = powf(10000.0f, -((float)f * 2.0f) / 64.0f); const float ang = (float)pos * inv; tg[i] = (f32x2){cosf(ang), sinf(ang)}; }
        for (int i = tid; i < 64 * 16; i += 512) { const int pos = i / 16, f = i % 16; const float inv = powf(10000.0f, -((float)f * 2.0f) / 32.0f); const float ang = (float)pos * inv; tm[i] = (f32x2){cosf(ang), sinf(ang)}; }
    }
}

#define ROW_DECODE(r) const int b_ = (r) / TB, p_ = (r) % TB; const bool isctx_ = p_ < CTX; const int mi_ = isctx_ ? 4 : b_; (void)b_; (void)mi_
__device__ __forceinline__ const float* mods_ptr(const Args& a, int l, int mi) { return (const float*)(a.ws + WS_MODS) + (size_t)(l * 5 + mi) * 12288; }

__device__ __forceinline__ void ph_init(const Args& a, int gw, int NGW, int lane) {
    float* X = (float*)(a.ws + WS_X); bf16_t* H = (bf16_t*)(a.ws + WS_H);
    for (int r = gw; r < R; r += NGW) {
        ROW_DECODE(r);
        const float* src = isctx_ ? a.ctx + ((size_t)b_ * CTX + p_) * DM : a.x + ((size_t)b_ * SEQ + (p_ - CTX)) * DM;
        const float* m = mods_ptr(a, 0, mi_);
#pragma unroll
        for (int it = 0; it < 8; ++it) { const int idx = it * 256 + lane * 4;
            const f32x4 v = *(const f32x4*)(src + idx), m0 = *(const f32x4*)(m + idx), m1 = *(const f32x4*)(m + DM + idx);
            *(f32x4*)(X + (size_t)r * DM + idx) = v;
            const f32x4 h = v * (1.0f + m1) + m0;
            *(u32x2*)(H + (size_t)r * DM + idx) = (u32x2){cvt_pk_bf16(h[0], h[1]), cvt_pk_bf16(h[2], h[3])}; }
    }
}
template <bool LAST>
__device__ __forceinline__ void ph_ln(const Args& a, int l, int which, int gw, int NGW, int lane) {
    float* X = (float*)(a.ws + WS_X); bf16_t* H = (bf16_t*)(a.ws + WS_H); const float* O = (const float*)(a.ws + WS_OUTF);
    const float* lg = a.ln_g + (size_t)(l * 2 + which) * DM; const float* lb = a.ln_b + (size_t)(l * 2 + which) * DM;
    for (int r = gw; r < R; r += NGW) {
        ROW_DECODE(r);
        if (LAST && isctx_) continue;
        const float* m = mods_ptr(a, l, mi_);
        const float* gate = m + (which == 0 ? 2 : 5) * DM;
        const float* sc = which == 0 ? m + 4 * DM : mods_ptr(a, LAST ? l : l + 1, mi_) + 1 * DM;
        const float* sh = which == 0 ? m + 3 * DM : mods_ptr(a, LAST ? l : l + 1, mi_);
        f32x4 v[8]; float s = 0.f;
#pragma unroll
        for (int it = 0; it < 8; ++it) { const int idx = it * 256 + lane * 4;
            const f32x4 xv = *(const f32x4*)(X + (size_t)r * DM + idx), ov = *(const f32x4*)(O + (size_t)r * DM + idx), g = *(const f32x4*)(gate + idx);
            v[it] = DN_ALPHA * xv + (1.0f + g) * ov; s += (v[it][0] + v[it][1]) + (v[it][2] + v[it][3]); }
        const float mean = wave_sum(s) * (1.0f / DM); float q = 0.f;
#pragma unroll
        for (int it = 0; it < 8; ++it) { v[it] = v[it] - mean; q += (v[it][0] * v[it][0] + v[it][1] * v[it][1]) + (v[it][2] * v[it][2] + v[it][3] * v[it][3]); }
        const float rstd = 1.0f / sqrtf(wave_sum(q) * (1.0f / DM) + LN_EPS);
#pragma unroll
        for (int it = 0; it < 8; ++it) { const int idx = it * 256 + lane * 4;
            const f32x4 xn = v[it] * rstd * *(const f32x4*)(lg + idx) + *(const f32x4*)(lb + idx);
            if (LAST) { *(f32x4*)(a.out + ((size_t)b_ * SEQ + (p_ - CTX)) * DM + idx) = xn; }
            else { *(f32x4*)(X + (size_t)r * DM + idx) = xn;
                const f32x4 h = xn * (1.0f + *(const f32x4*)(sc + idx)) + *(const f32x4*)(sh + idx);
                *(u32x2*)(H + (size_t)r * DM + idx) = (u32x2){cvt_pk_bf16(h[0], h[1]), cvt_pk_bf16(h[2], h[3])}; } }
    }
}
__device__ __forceinline__ void ph_knorm(const Args& a, const float* kg, int gw, int NGW, int lane) {
    bf16_t* K = (bf16_t*)(a.ws + WS_GK); const f32x2* tab = (const f32x2*)(a.ws + WS_TAB);
    const int li = lane & 15;
    float g[8];
#pragma unroll
    for (int j = 0; j < 8; ++j) g[j] = kg[li * 8 + j];
    for (int r = gw; r < R; r += NGW) {
        ROW_DECODE(r);
        bf16x8 raw = *(const bf16x8*)(K + (size_t)r * 512 + lane * 8);
        float f[8]; att::unpack8(raw, f);
        float ss = 0.f;
#pragma unroll
        for (int j = 0; j < 8; ++j) ss += f[j] * f[j];
        ss += __shfl_xor(ss, 1); ss += __shfl_xor(ss, 2); ss += __shfl_xor(ss, 4); ss += __shfl_xor(ss, 8);
        const float rstd = 1.0f / sqrtf(ss * (1.0f / 128.0f) + 1e-6f);
#pragma unroll
        for (int j = 0; j < 8; ++j) f[j] = f[j] * rstd * g[j];
        if (!isctx_) {
            const int t = p_ - CTX, pos = (li & 8) ? (t & 63) : (t >> 6);
            const f32x2* tp = tab + pos * 32 + (li & 3) * 8;
            const bool second = (li & 4) != 0;
#pragma unroll
            for (int j = 0; j < 8; ++j) { const float other = __shfl_xor(f[j], 4); const f32x2 cs = tp[j];
                f[j] = second ? f[j] * cs.x + other * cs.y : f[j] * cs.x - other * cs.y; }
        }
        *(bf16x8*)(K + (size_t)r * 512 + lane * 8) = att::pack8(f);
    }
}
__device__ __forceinline__ void ph_mla_norm(const Args& a, int gw, int NGW, int lane) {
    const float* AP = (const float*)(a.ws + WS_MAP); bf16_t* QAN = (bf16_t*)(a.ws + WS_MQAN); bf16_t* CKVN = (bf16_t*)(a.ws + WS_MCKVN); bf16_t* K = (bf16_t*)(a.ws + WS_MK);
    const f32x2* tab = (const f32x2*)(a.ws + WS_TAB + 16384);
    for (int r = gw; r < R; r += NGW) {
        ROW_DECODE(r);
        const float* ap = AP + (size_t)r * 1280;
#pragma unroll
        for (int part = 0; part < 2; ++part) {
            const f32x4 v0 = *(const f32x4*)(ap + part * 512 + lane * 8), v1 = *(const f32x4*)(ap + part * 512 + lane * 8 + 4);
            float ss = (v0[0] * v0[0] + v0[1] * v0[1]) + (v0[2] * v0[2] + v0[3] * v0[3]) + (v1[0] * v1[0] + v1[1] * v1[1]) + (v1[2] * v1[2] + v1[3] * v1[3]);
            const float rstd = 1.0f / sqrtf(wave_sum(ss) * (1.0f / 512.0f) + 1e-6f);
            const float* gp = (part == 0 ? a.mla_q_a_g : a.mla_kv_a_g) + lane * 8;
            const f32x4 g0 = *(const f32x4*)gp, g1 = *(const f32x4*)(gp + 4);
            const f32x4 o0 = v0 * rstd * g0, o1 = v1 * rstd * g1;
            u32x4 w = {cvt_pk_bf16(o0[0], o0[1]), cvt_pk_bf16(o0[2], o0[3]), cvt_pk_bf16(o1[0], o1[1]), cvt_pk_bf16(o1[2], o1[3])};
            *(u32x4*)((part == 0 ? QAN : CKVN) + (size_t)r * 512 + lane * 8) = w;
        }
        float v = ap[1024 + lane];
        if (!isctx_) {
            const int t = p_ - CTX, pos = (lane & 32) ? (t & 63) : (t >> 6);
            const f32x2 cs = tab[pos * 16 + (lane & 15)];
            const float other = __shfl_xor(v, 16);
            v = (lane & 16) ? v * cs.x + other * cs.y : v * cs.x - other * cs.y;
        }
        const bf16_t kb = f2bf(v);
#pragma unroll
        for (int h = 0; h < 16; ++h) K[(size_t)r * 3072 + h * 192 + 128 + lane] = kb;
    }
}
__device__ __forceinline__ void ph_conv(const Args& a, int gw, int NGW, int lane) {
    const bf16_t* UP = (const bf16_t*)(a.ws + WS_LUP); bf16_t* U = (bf16_t*)(a.ws + WS_LU);
    for (int r = gw; r < R; r += NGW) {
        ROW_DECODE(r);
        const int lo = isctx_ ? 0 : CTX, hi = isctx_ ? CTX : TB;
#pragma unroll
        for (int it = 0; it < 4; ++it) { const int idx = it * 512 + lane * 8;
            float acc[8];
            { const f32x4 b0 = *(const f32x4*)(a.lru_conv_b + idx), b1 = *(const f32x4*)(a.lru_conv_b + idx + 4);
              acc[0] = b0[0]; acc[1] = b0[1]; acc[2] = b0[2]; acc[3] = b0[3]; acc[4] = b1[0]; acc[5] = b1[1]; acc[6] = b1[2]; acc[7] = b1[3]; }
#pragma unroll
            for (int j = 0; j < 4; ++j) { const int pp = p_ + j - 2;
                if (pp >= lo && pp < hi) {
                    float f[8]; att::unpack8(*(const bf16x8*)(UP + (size_t)(r + j - 2) * DM + idx), f);
                    const f32x4 w0 = *(const f32x4*)(a.lru_conv_w + j * DM + idx), w1 = *(const f32x4*)(a.lru_conv_w + j * DM + idx + 4);
                    acc[0] += f[0] * w0[0]; acc[1] += f[1] * w0[1]; acc[2] += f[2] * w0[2]; acc[3] += f[3] * w0[3];
                    acc[4] += f[4] * w1[0]; acc[5] += f[5] * w1[1]; acc[6] += f[6] * w1[2]; acc[7] += f[7] * w1[3]; } }
            *(bf16x8*)(U + (size_t)r * DM + idx) = att::pack8(acc); }
    }
}
__device__ __forceinline__ void ph_scan1(const Args& a, int gw, int NGW, int lane) {
    float* PS = (float*)(a.ws + WS_LPS);
    for (int item = gw; item < NB * NCH * 2 * 8; item += NGW) {
        const int cg = item & 7, dir = (item >> 3) & 1, bq = item >> 4, b = bq / NCH, q = bq % NCH;
        const float* A = (const float*)(a.ws + (dir ? WS_LAB : WS_LAF)); const float* GU = (const float*)(a.ws + (dir ? WS_LGUB : WS_LGUF));
        const size_t base = ((size_t)b * TB + q * 32) * DM + cg * 256 + lane * 4;
        f32x4 h = {0.f, 0.f, 0.f, 0.f}, P = {1.f, 1.f, 1.f, 1.f};
#pragma unroll 8
        for (int i = 0; i < 32; ++i) { const int rr = dir ? 31 - i : i;
            const f32x4 av = *(const f32x4*)(A + base + (size_t)rr * DM), gv = *(const f32x4*)(GU + base + (size_t)rr * DM);
            f32x4 s; s[0] = sqrtf(fmaxf(1.0f - av[0] * av[0], 0.f)); s[1] = sqrtf(fmaxf(1.0f - av[1] * av[1], 0.f)); s[2] = sqrtf(fmaxf(1.0f - av[2] * av[2], 0.f)); s[3] = sqrtf(fmaxf(1.0f - av[3] * av[3], 0.f));
            h = av * h + s * gv; P = P * av; }
        float* o = PS + ((size_t)(bq * 2 + dir) * 2) * DM + cg * 256 + lane * 4;
        *(f32x4*)o = P; *(f32x4*)(o + DM) = h;
    }
}
__device__ __forceinline__ void ph_scan2(const Args& a, int gtid, int NGT) {
    const float* PS = (const float*)(a.ws + WS_LPS); float* CIN = (float*)(a.ws + WS_LCIN);
    for (int t = gtid; t < NB * 2 * DM; t += NGT) {
        const int c = t % DM, dir = (t / DM) & 1, b = t / (2 * DM);
        float carry = 0.f;
        for (int i = 0; i < NCH; ++i) {
            const int q = dir == 0 ? i : (i < 8 ? 7 - i : NCH - 1 - (i - 8));
            const size_t bq = (size_t)b * NCH + q;
            CIN[(bq * 2 + dir) * DM + c] = carry;
            const float P = PS[((bq * 2 + dir) * 2) * DM + c], S = PS[((bq * 2 + dir) * 2 + 1) * DM + c];
            carry = P * carry + S;
        }
    }
}
__device__ __forceinline__ void ph_scan3(const Args& a, int gw, int NGW, int lane) {
    const float* CIN = (const float*)(a.ws + WS_LCIN); const bf16_t* GY = (const bf16_t*)(a.ws + WS_LGY); bf16_t* Gout = (bf16_t*)(a.ws + WS_LG);
    const float* AF = (const float*)(a.ws + WS_LAF); const float* GUF = (const float*)(a.ws + WS_LGUF); const float* AB = (const float*)(a.ws + WS_LAB); const float* GUB = (const float*)(a.ws + WS_LGUB);
    for (int item = gw; item < NB * NCH * 8; item += NGW) {
        const int cg = item & 7, bq = item >> 3, b = bq / NCH, q = bq % NCH;
        const size_t base = ((size_t)b * TB + q * 32) * DM + cg * 256 + lane * 4;
        f32x4 hf[32];
        f32x4 h = *(const f32x4*)(CIN + ((size_t)bq * 2 + 0) * DM + cg * 256 + lane * 4);
#pragma unroll
        for (int i = 0; i < 32; ++i) {
            const f32x4 av = *(const f32x4*)(AF + base + (size_t)i * DM), gv = *(const f32x4*)(GUF + base + (size_t)i * DM);
            f32x4 s; s[0] = sqrtf(fmaxf(1.0f - av[0] * av[0], 0.f)); s[1] = sqrtf(fmaxf(1.0f - av[1] * av[1], 0.f)); s[2] = sqrtf(fmaxf(1.0f - av[2] * av[2], 0.f)); s[3] = sqrtf(fmaxf(1.0f - av[3] * av[3], 0.f));
            h = av * h + s * gv; hf[i] = h; }
        h = *(const f32x4*)(CIN + ((size_t)bq * 2 + 1) * DM + cg * 256 + lane * 4);
#pragma unroll
        for (int i = 31; i >= 0; --i) {
            const f32x4 av = *(const f32x4*)(AB + base + (size_t)i * DM), gv = *(const f32x4*)(GUB + base + (size_t)i * DM);
            f32x4 s; s[0] = sqrtf(fmaxf(1.0f - av[0] * av[0], 0.f)); s[1] = sqrtf(fmaxf(1.0f - av[1] * av[1], 0.f)); s[2] = sqrtf(fmaxf(1.0f - av[2] * av[2], 0.f)); s[3] = sqrtf(fmaxf(1.0f - av[3] * av[3], 0.f));
            h = av * h + s * gv;
            const u32x2 gy = *(const u32x2*)(GY + base + (size_t)i * DM);
            const f32x4 o = (hf[i] + h) * (f32x4){bf_lo(gy.x), bf_hi(gy.x), bf_lo(gy.y), bf_hi(gy.y)};
            *(u32x2*)(Gout + base + (size_t)i * DM) = (u32x2){cvt_pk_bf16(o[0], o[1]), cvt_pk_bf16(o[2], o[3])}; }
    }
}

__device__ __forceinline__ void st_bf16x8(bf16_t* p, f32x4 v0, f32x4 v1) {
    u32x4 w = {cvt_pk_bf16(v0[0], v0[1]), cvt_pk_bf16(v0[2], v0[3]), cvt_pk_bf16(v1[0], v1[1]), cvt_pk_bf16(v1[2], v1[3])}; *(u32x4*)p = w; }
struct FStoreF32 { float* O; int ld;
    __device__ __forceinline__ void begin(const pg8::Unit&, int) {}
    __device__ __forceinline__ void row8(int row, int, int col, f32x4 v0, f32x4 v1) { float* p = O + (size_t)row * ld + col; *(f32x4*)p = v0; *(f32x4*)(p + 4) = v1; } };
struct FBf16 { bf16_t* O; int ld;
    __device__ __forceinline__ void begin(const pg8::Unit&, int) {}
    __device__ __forceinline__ void row8(int row, int, int col, f32x4 v0, f32x4 v1) { st_bf16x8(O + (size_t)row * ld + col, v0, v1); } };
struct FQkv { bf16_t *Q, *K, *V; bf16_t* base; int ld, coff;
    __device__ __forceinline__ void begin(const pg8::Unit& u, int) { if (u.pn < 8) { base = Q; ld = 2048; coff = 0; } else if (u.pn < 10) { base = K; ld = 512; coff = 2048; } else { base = V; ld = 512; coff = 2560; } }
    __device__ __forceinline__ void row8(int row, int, int col, f32x4 v0, f32x4 v1) { st_bf16x8(base + (size_t)row * ld + (col - coff), v0, v1); } };
struct FRelu2 { bf16_t* O;
    __device__ __forceinline__ void begin(const pg8::Unit&, int) {}
    __device__ __forceinline__ void row8(int row, int, int col, f32x4 v0, f32x4 v1) {
#pragma unroll
        for (int i = 0; i < 4; ++i) { const float a = fmaxf(v0[i], 0.f), b = fmaxf(v1[i], 0.f); v0[i] = a * a; v1[i] = b * b; }
        st_bf16x8(O + (size_t)row * DFF + col, v0, v1); } };
__device__ __forceinline__ float gelu_tanh(float x) { const float z = 1.5957691216057308f * (x + 0.044715f * x * x * x); return x * __builtin_amdgcn_rcpf(1.0f + __builtin_amdgcn_exp2f(-1.4426950408889634f * z)); }
struct FLruXY { bf16_t *UP, *GY; bool gy;
    __device__ __forceinline__ void begin(const pg8::Unit& u, int) { gy = u.pn >= 8; }
    __device__ __forceinline__ void row8(int row, int, int col, f32x4 v0, f32x4 v1) {
        if (gy) {
#pragma unroll
            for (int i = 0; i < 4; ++i) { v0[i] = gelu_tanh(v0[i]); v1[i] = gelu_tanh(v1[i]); }
            st_bf16x8(GY + (size_t)row * DM + (col - 2048), v0, v1);
        } else st_bf16x8(UP + (size_t)row * DM + col, v0, v1); } };
struct EpiGates {
    static constexpr bool PERM = true;
    float* OUT4; const bf16_t* U; const float *ra_b, *ix_b, *lam;
    __device__ __forceinline__ void operator()(const f32x4 (&acc)[2][2][4][2], const pg8::Unit& u, int wr, int wc, int fr, int fq) const {
        const int which = u.pn >> 3, dir = which >> 1, ty = which & 1, ch0 = (u.pn & 7) * 256 + wc * 32 + 8 * fq, row0 = u.pm * 256 + wr * 64 + fr;
        float* dst = OUT4 + (size_t)which * ((size_t)R * DM);
        const float* bp = (ty == 0 ? ra_b : ix_b) + dir * DM;
#pragma unroll
        for (int bj = 0; bj < 2; ++bj) {
            const int ch = ch0 + bj * 128;
            const f32x4 b0 = *(const f32x4*)(bp + ch), b1 = *(const f32x4*)(bp + ch + 4);
            f32x4 l0 = {0.f, 0.f, 0.f, 0.f}, l1 = {0.f, 0.f, 0.f, 0.f};
            if (ty == 0) { l0 = *(const f32x4*)(lam + dir * DM + ch) * 1.4426950408889634f; l1 = *(const f32x4*)(lam + dir * DM + ch + 4) * 1.4426950408889634f; }
#pragma unroll
            for (int ai = 0; ai < 2; ++ai)
#pragma unroll
                for (int m = 0; m < 4; ++m) {
                    const int row = row0 + ai * 128 + m * 16;
                    const f32x4 x0 = acc[ai][bj][m][0] + b0, x1 = acc[ai][bj][m][1] + b1; f32x4 o0, o1;
                    if (ty == 0) {
#pragma unroll
                        for (int j = 0; j < 4; ++j) { o0[j] = __builtin_amdgcn_exp2f(l0[j] * sigmoidf_(x0[j])); o1[j] = __builtin_amdgcn_exp2f(l1[j] * sigmoidf_(x1[j])); }
                    } else {
                        const u32x4 uw = *(const u32x4*)(U + (size_t)row * DM + ch);
                        o0[0] = sigmoidf_(x0[0]) * bf_lo(uw.x); o0[1] = sigmoidf_(x0[1]) * bf_hi(uw.x); o0[2] = sigmoidf_(x0[2]) * bf_lo(uw.y); o0[3] = sigmoidf_(x0[3]) * bf_hi(uw.y);
                        o1[0] = sigmoidf_(x1[0]) * bf_lo(uw.z); o1[1] = sigmoidf_(x1[1]) * bf_hi(uw.z); o1[2] = sigmoidf_(x1[2]) * bf_lo(uw.w); o1[3] = sigmoidf_(x1[3]) * bf_hi(uw.w);
                    }
                    float* p = dst + (size_t)row * DM + ch; *(f32x4*)p = o0; *(f32x4*)(p + 4) = o1;
                    __builtin_amdgcn_sched_barrier(0);
                }
        }
    } };
struct FKvb { bf16_t *K, *V;
    __device__ __forceinline__ void begin(const pg8::Unit&, int) {}
    __device__ __forceinline__ void row8(int row, int, int col, f32x4 v0, f32x4 v1) {
        bf16_t* p = col < 2048 ? K + (size_t)row * 3072 + (col >> 7) * 192 + (col & 127) : V + (size_t)row * DM + (col - 2048);
        st_bf16x8(p, v0, v1); } };

template <class F>
__device__ __forceinline__ void run_gemm(LAS unsigned char* lds, const bf16_t* A, int lda, const bf16_t* Bt, int ldb, int N, int K, int a_blk, F f, int G) {
    pg8::Gemm g{A, Bt, R, N, K, lda, ldb, a_blk}; pg8::StaticOrder S; S.init(R, N, G, (int)blockIdx.x);
    pg8::EpiRow8<F> E{f};
    pg8::gemm_phase<pg8::EpiRow8<F>, pg8::StaticOrder, true, true>(lds, g, S, E);
}

__device__ __forceinline__ void ph_attn_gqa(const Args& a, char* lds, const float* qg, bool ctx_units, int vcu, int G) {
    const bf16_t* Q = (const bf16_t*)(a.ws + WS_GQ); const bf16_t* K = (const bf16_t*)(a.ws + WS_GK); const bf16_t* V = (const bf16_t*)(a.ws + WS_GV); bf16_t* O = (bf16_t*)(a.ws + WS_GO);
    const f32x2* tab = (const f32x2*)(a.ws + WS_TAB);
    const int nun = ctx_units ? 1088 : 1024;
    for (int id = vcu; id < nun; id += G) {
        int b, h, row0, seq, tok0; bool rope;
        if (id < 1024) { const int bk = id >> 6; b = bk >> 2; h = (bk & 3) * 4 + ((id & 63) >> 4); const int qb = id & 15; row0 = b * TB + CTX + qb * 256; seq = TB; tok0 = qb * 256; rope = true; }
        else { const int j = id - 1024; b = j >> 4; h = j & 15; row0 = b * TB; seq = CTX; tok0 = 0; rope = false; }
        const int kvh = h >> 2;
        att::attn_body<128, 2048, 512, 512, 2048>(Q + (size_t)row0 * 2048 + h * 128, K + (size_t)b * TB * 512 + kvh * 128, V + (size_t)b * TB * 512 + kvh * 128,
                                                  O + (size_t)row0 * 2048 + h * 128, seq, lds, qg, tab, rope, tok0);
    }
}
__device__ __forceinline__ void ph_attn_mla(const Args& a, char* lds, bool ctx_units, int vcu, int G) {
    const bf16_t* Q = (const bf16_t*)(a.ws + WS_MQ); const bf16_t* K = (const bf16_t*)(a.ws + WS_MK); const bf16_t* V = (const bf16_t*)(a.ws + WS_MV); bf16_t* O = (bf16_t*)(a.ws + WS_MO);
    const f32x2* tab = (const f32x2*)(a.ws + WS_TAB + 16384);
    const int nun = ctx_units ? 1088 : 1024;
    for (int id = vcu; id < nun; id += G) {
        int b, h, row0, seq, tok0; bool rope;
        if (id < 1024) { const int bh = id >> 4; b = bh >> 4; h = bh & 15; const int qb = id & 15; row0 = b * TB + CTX + qb * 256; seq = TB; tok0 = qb * 256; rope = true; }
        else { const int j = id - 1024; b = j >> 4; h = j & 15; row0 = b * TB; seq = CTX; tok0 = 0; rope = false; }
        att::attn_body<192, 3072, 3072, 2048, 2048>(Q + (size_t)row0 * 3072 + h * 192, K + (size_t)b * TB * 3072 + h * 192, V + (size_t)b * TB * DM + h * 128,
                                                    O + (size_t)row0 * DM + h * 128, seq, lds, nullptr, tab, rope, tok0);
    }
}

constexpr int NPHASES = 39;
__global__ void __launch_bounds__(NWAVES * 64, 2) trunk_fwd(Args a) {
    extern __shared__ __attribute__((aligned(16))) unsigned char lds_raw[];
    LAS unsigned char* lds = (LAS unsigned char*)lds_raw;
    const int tid = threadIdx.x, lane = tid & 63, wave = __builtin_amdgcn_readfirstlane(tid >> 6);
    const int G = gridDim.x; const int bx = blockIdx.x; const int vcu = (G % 8 == 0) ? (bx % 8) * (G / 8) + bx / 8 : bx;
    const int gw = vcu * NWAVES + wave, NGW = G * NWAVES;
    unsigned char* ws = a.ws;
    for (int u = tid; u < (LDS_BYTES - LDSCTL_OFF) / 4; u += NWAVES * 64) ((LAS unsigned*)(lds + LDSCTL_OFF))[u] = 0u;
    __syncthreads();
    const int lo = a.ph_lo, hi = a.ph_hi;
    const bool use_bar = (hi - lo) > 1;
    XcdBarrier bar; bar.bar = (unsigned*)(ws + WS_CTL) + 1024; bar.x = 0; bar.st = nullptr;
    if (use_bar) bar = xcd_barrier_post((unsigned*)(ws + WS_CTL) + 1024, (volatile LAS unsigned*)(lds + LDSCTL_OFF + 64));
    int ph = 0;
#ifndef PH_FILTER
#define PH_FILTER(p) true
#endif
#define PH_BEGIN if (PH_FILTER(ph) && ph >= lo && ph < hi) {
#define PH_END   if (ph + 1 < hi) xcd_barrier(bar); } ++ph;

    PH_BEGIN ph_mods(a, lds, vcu, G); __syncthreads(); ph_transposes(a, lds, vcu, G); PH_END
    PH_BEGIN ph_init(a, gw, NGW, lane); PH_END

    bf16_t* const Hb = (bf16_t*)(ws + WS_H);
    float* const OUTF = (float*)(ws + WS_OUTF);
    bf16_t* const ACT = (bf16_t*)(ws + WS_ACT);

#define MLP_PHASES(L, LASTL) \
    PH_BEGIN ph_ln<false>(a, L, 0, gw, NGW, lane); PH_END \
    PH_BEGIN run_gemm(lds, Hb, DM, (const bf16_t*)(ws + WS_W1T) + (size_t)(L) * DFF * DM, DM, DFF, DM, 0, FRelu2{ACT}, G); PH_END \
    PH_BEGIN run_gemm(lds, ACT, DFF, (const bf16_t*)(ws + WS_W2T) + (size_t)(L) * DM * DFF, DFF, DM, DFF, 0, FStoreF32{OUTF, DM}, G); PH_END \
    PH_BEGIN ph_ln<LASTL>(a, L, 1, gw, NGW, lane); PH_END

#define GQA_LAYER(L, SLOT, LASTL) \
    PH_BEGIN run_gemm(lds, Hb, DM, (const bf16_t*)(ws + WS_GQAW + (SLOT) * 20 * MiB), DM, 3072, DM, 0, FQkv{(bf16_t*)(ws + WS_GQ), (bf16_t*)(ws + WS_GK), (bf16_t*)(ws + WS_GV), nullptr, 0, 0}, G); PH_END \
    PH_BEGIN ph_knorm(a, a.gqa_k_g + (SLOT) * 128, gw, NGW, lane); PH_END \
    PH_BEGIN ph_attn_gqa(a, (char*)lds_raw, a.gqa_q_g + (SLOT) * 128, true, vcu, G); PH_END \
    PH_BEGIN run_gemm(lds, (const bf16_t*)(ws + WS_GO), DM, (const bf16_t*)(ws + WS_GQAW + (SLOT) * 20 * MiB + 12 * MiB), DM, DM, DM, 0, FStoreF32{OUTF, DM}, G); PH_END \
    MLP_PHASES(L, LASTL)

    GQA_LAYER(0, 0, false)
    PH_BEGIN run_gemm(lds, Hb, DM, (const bf16_t*)(ws + WS_LRUW), DM, 4096, DM, 0, FLruXY{(bf16_t*)(ws + WS_LUP), (bf16_t*)(ws + WS_LGY), false}, G); PH_END
    PH_BEGIN ph_conv(a, gw, NGW, lane); PH_END
    PH_BEGIN { EpiGates eg{(float*)(ws + WS_LAF), (const bf16_t*)(ws + WS_LU), a.lru_ra_b, a.lru_ix_b, (const float*)(ws + WS_TAB + 32768)};
               pg8::Gemm g{(const bf16_t*)(ws + WS_LU), (const bf16_t*)(ws + WS_LRUW + 16 * MiB), R, 8192, 256, DM, 256, 1}; pg8::StaticOrder S; S.init(R, 8192, G, (int)blockIdx.x);
               pg8::gemm_phase<EpiGates, pg8::StaticOrder, true, true>(lds, g, S, eg); } PH_END
    PH_BEGIN ph_scan1(a, gw, NGW, lane); PH_END
    PH_BEGIN ph_scan2(a, vcu * 512 + tid, G * 512); PH_END
    PH_BEGIN ph_scan3(a, gw, NGW, lane); PH_END
    PH_BEGIN run_gemm(lds, (const bf16_t*)(ws + WS_LG), DM, (const bf16_t*)(ws + WS_LRUW + 20 * MiB), DM, DM, DM, 0, FStoreF32{OUTF, DM}, G); PH_END
    MLP_PHASES(1, false)
    PH_BEGIN run_gemm(lds, Hb, DM, (const bf16_t*)(ws + WS_MLAW), DM, 1280, DM, 0, FStoreF32{(float*)(ws + WS_MAP), 1280}, G); PH_END
    PH_BEGIN ph_mla_norm(a, gw, NGW, lane); PH_END
    PH_BEGIN run_gemm(lds, (const bf16_t*)(ws + WS_MQAN), 512, (const bf16_t*)(ws + WS_MLAW + 5 * MiB), 512, 3072, 512, 0, FBf16{(bf16_t*)(ws + WS_MQ), 3072}, G); PH_END
    PH_BEGIN run_gemm(lds, (const bf16_t*)(ws + WS_MCKVN), 512, (const bf16_t*)(ws + WS_MLAW + 8 * MiB), 512, 4096, 512, 0, FKvb{(bf16_t*)(ws + WS_MK), (bf16_t*)(ws + WS_MV)}, G); PH_END
    PH_BEGIN ph_attn_mla(a, (char*)lds_raw, true, vcu, G); PH_END
    PH_BEGIN run_gemm(lds, (const bf16_t*)(ws + WS_MO), DM, (const bf16_t*)(ws + WS_MLAW + 12 * MiB), DM, DM, DM, 0, FStoreF32{OUTF, DM}, G); PH_END
    MLP_PHASES(2, false)
    GQA_LAYER(3, 1, true)
#undef PH_BEGIN
#undef PH_END
}

#ifndef MK_SPLIT
#define MK_SPLIT 0
#endif
extern "C" void kernel_launch(void* const* d_in, const int* in_sizes, int n_in, void* d_out, int out_size, void* d_ws, size_t ws_size, hipStream_t stream) {
    static int grid = 0;
    if (grid == 0) {
        if (n_in != 33 || in_sizes[0] != NB * SEQ * DM || out_size != NB * SEQ * DM || ws_size < WS_END) {
            fprintf(stderr, "kernel_launch: unexpected shapes: n_in %d in0 %d out %d ws %zu (need %zu)\n", n_in, n_in > 0 ? in_sizes[0] : -1, out_size, ws_size, (size_t)WS_END); grid = -1; return; }
        int dev = 0, cus = 0;
        if (hipGetDevice(&dev) != hipSuccess || hipDeviceGetAttribute(&cus, hipDeviceAttributeMultiprocessorCount, dev) != hipSuccess) { grid = -1; return; }
        if (hipFuncSetAttribute((const void*)trunk_fwd, hipFuncAttributeMaxDynamicSharedMemorySize, LDS_BYTES) != hipSuccess) { fprintf(stderr, "kernel_launch: hipFuncSetAttribute failed\n"); grid = -1; return; }
        int per_cu = 0;
        if (hipOccupancyMaxActiveBlocksPerMultiprocessor(&per_cu, (const void*)trunk_fwd, NWAVES * 64, LDS_BYTES) != hipSuccess || per_cu < 1)
            fprintf(stderr, "kernel_launch: occupancy query reports %d workgroups per CU\n", per_cu);
        (void)hipGetLastError();
        grid = cus;
    }
    if (grid < 0) return;
    if (hipMemsetAsync((char*)d_ws + WS_CTL, 0, CTL_ZERO_BYTES, stream) != hipSuccess) return;
    Args a{};
    const float** p = (const float**)&a;
    for (int i = 0; i < 33; ++i) p[i] = (const float*)d_in[i];
    a.out = (float*)d_out; a.ws = (unsigned char*)d_ws;
#if MK_SPLIT
    for (int k = 0; k < NPHASES; ++k) { a.ph_lo = k; a.ph_hi = k + 1; hipLaunchKernelGGL(trunk_fwd, dim3(grid), dim3(NWAVES * 64), LDS_BYTES, stream, a); }
#else
    a.ph_lo = 0; a.ph_hi = NPHASES; hipLaunchKernelGGL(trunk_fwd, dim3(grid), dim3(NWAVES * 64), LDS_BYTES, stream, a);
#endif
    const hipError_t le = hipPeekAtLastError();
    if (le != hipSuccess) fprintf(stderr, "kernel_launch: launch failed: %s\n", hipGetErrorName(le));
}
```

```cpp
#include <hip/hip_runtime.h>
#include <cstdio>
#include <cstdint>
#include <cmath>

#define LAS __attribute__((address_space(3)))
#define GAS __attribute__((address_space(1)))
typedef unsigned short bf16_t;
typedef short bf16x8 __attribute__((ext_vector_type(8)));
typedef short s16x4 __attribute__((ext_vector_type(4)));
typedef float f32x4 __attribute__((ext_vector_type(4)));
typedef float f32x2 __attribute__((ext_vector_type(2)));
typedef float f32x16 __attribute__((ext_vector_type(16)));
typedef unsigned u32x4 __attribute__((ext_vector_type(4)));
typedef unsigned u32x2 __attribute__((ext_vector_type(2)));

__device__ __forceinline__ unsigned cvt_pk_bf16(float lo, float hi) { unsigned r; asm volatile("v_cvt_pk_bf16_f32 %0, %1, %2" : "=v"(r) : "v"(lo), "v"(hi)); return r; }
__device__ __forceinline__ float bf_lo(unsigned w) { return __uint_as_float(w << 16); }
__device__ __forceinline__ float bf_hi(unsigned w) { return __uint_as_float(w & 0xffff0000u); }
__device__ __forceinline__ float bf2f(bf16_t h) { return __uint_as_float(((unsigned)h) << 16); }
__device__ __forceinline__ bf16_t f2bf(float f) { return (bf16_t)(cvt_pk_bf16(f, f) & 0xffffu); }

constexpr int DM = 2048, NB = 4, SEQ = 4096, CTX = 256, TB = SEQ + CTX  , R = NB * TB  , DFF = 8192, DEPTH = 4;
constexpr float LN_EPS = 1e-6f;
constexpr float DN_ALPHA = 1.6817928305074290861f;

namespace pg8 {
constexpr int BM = 256, BK = 64, HALF = 128, HTB = HALF * BK * 2, STAGE_BYTES = 8 * HTB, NXCD = 8, WGM = 8;
__host__ __device__ __forceinline__ int lds_byte(int r, int c) { const int st = (r >> 4) * 2 + (c >> 5), rr = r & 15, cc = c & 31, ob = rr * 64 + cc * 2; return st * 1024 + (ob ^ (((ob >> 9) & 1) << 5)); }
__host__ __device__ __forceinline__ void stage_rc(int b, int& Rr, int& C) { const int st = b / 1024, sb = b % 1024, swz = sb ^ (((sb >> 9) & 1) << 5); Rr = (st >> 1) * 16 + swz / 64; C = (st & 1) * 32 + (swz % 64) / 2; }
__host__ __device__ __forceinline__ int perm32(int rho) { const int n = rho >> 4, i = rho & 15; return 8 * (i >> 2) + 4 * n + (i & 3); }

struct Unit { int pm, pn, k0, nk, slice; };
struct Gemm { const bf16_t* A; const bf16_t* Bt; int M, N, K, lda, ldb, a_blk; };

struct StaticOrder {
    int nM, nN, nwg, G, c, nt;
    __device__ __forceinline__ void init(int M, int N, int K, int G_, int c_) { nM = M / BM; nN = N / BM; nwg = nM * nN; G = G_; c = c_; nt = K / BK; }
    __device__ __forceinline__ Unit next(int i) const {
        const long L = (long)i * G + c; if (L >= nwg) return Unit{-1, 0, 0, 0, -1};
        int wgid = (int)L; { const int q = nwg / NXCD, r = nwg % NXCD, xcd = wgid % NXCD, off = wgid / NXCD; wgid = (xcd < r ? xcd * (q + 1) : r * (q + 1) + (xcd - r) * q) + off; }
        const int nig = WGM * nN, gid = wgid / nig, fm = gid * WGM, gsz = (nM - fm) < WGM ? (nM - fm) : WGM;
        return Unit{fm + ((wgid % nig) % gsz), (wgid % nig) / gsz, 0, nt, -1};
    }
};
struct LatOrder {
    int nN, nwg, G, c, nt, SK;
    __device__ __forceinline__ void init(int N, int K, int G_, int c_, int SK_) { nN = N / BM; nwg = 64 * nN; G = G_; c = c_; nt = K / BK; SK = SK_; }
    __device__ __forceinline__ Unit next(int i) const {
        const int nlat = c < nwg ? (nwg - c + G - 1) / G : 0;
        if (i < nlat) {
            int wgid = i * G + c; { const int q = nwg / NXCD, r = nwg % NXCD, xcd = wgid % NXCD, off = wgid / NXCD; wgid = (xcd < r ? xcd * (q + 1) : r * (q + 1) + (xcd - r) * q) + off; }
            const int nig = WGM * nN, gid = wgid / nig, fm = gid * WGM;
            const int lp = fm + ((wgid % nig) % WGM);
            return Unit{(lp >> 4) * 17 + 1 + (lp & 15), (wgid % nig) / WGM, 0, nt, -1};
        }
        if (SK > 0 && i == nlat && c < 4 * nN * SK) { const int t = c / SK, sl = c % SK, nks = nt / SK; return Unit{17 * (t / nN), t % nN, sl * nks, nks, sl}; }
        return Unit{-1, 0, 0, 0, -1};
    }
};

template <class F> struct EpiRow8 {
    static constexpr bool PERM = true;
    F f;
    __device__ __forceinline__ void operator()(const f32x4 (&acc)[2][2][4][2], const Unit& u, int wr, int wc, int fr, int fq) {
        const int row0 = u.pm * BM + wr * 64 + fr, colb = u.pn * BM + wc * 32 + 8 * fq;
        f.begin(u, colb);
#pragma unroll
        for (int ai = 0; ai < 2; ++ai)
#pragma unroll
            for (int m = 0; m < 4; ++m) {
                const int row = row0 + ai * HALF + m * 16;
#pragma unroll
                for (int bj = 0; bj < 2; ++bj) f.row8(row, bj, colb + bj * HALF, acc[ai][bj][m][0], acc[ai][bj][m][1]);
            }
    }
};

template <class Epi, class Sched, bool ALIGN_EPI = true, bool SP2 = true>
__device__ __forceinline__ void gemm_phase(LAS unsigned char* lds, const Gemm g, const Sched& S, Epi& E) {
    const int tid = threadIdx.x, wid = __builtin_amdgcn_readfirstlane(tid >> 6), lane = tid & 63, wr = wid >> 2, wc = wid & 3, fr = lane & 15, fq = lane >> 4;
    unsigned voffA[2], voffB[2];
#pragma unroll
    for (int i = 0; i < 2; ++i) { int Rr, C; stage_rc(tid * 16 + i * 8192, Rr, C); const int Rb = Epi::PERM ? ((Rr & ~31) + perm32(Rr & 31)) : Rr;
        voffA[i] = (unsigned)(Rr * g.lda + C) * 2u; voffB[i] = (unsigned)(Rb * g.ldb + C) * 2u; }
    const size_t kstep = (size_t)(BK * 2);
    const size_t hstepA = (size_t)HALF * g.lda * 2, hstepB = (size_t)HALF * g.ldb * 2;
    const size_t tstepA = 2 * hstepA, tstepB = 2 * hstepB;
    const unsigned ldsw = (unsigned)wid * 1024u;
    const int aoff = lds_byte(wr * 64 + fr, fq * 8), boff = lds_byte(wc * 32 + fr, fq * 8);
#define PG8_SA(b, h) (((b) * 2 + (h)) * HTB)
#define PG8_SB(b, h) ((4 + (b) * 2 + (h)) * HTB)
#define PG8_STAGE(bufoff, gbase, voff) do { _Pragma("unroll") for (int _i = 0; _i < 2; ++_i) \
        __builtin_amdgcn_global_load_lds((const unsigned*)((const char*)(gbase) + (voff)[_i]), (LAS unsigned*)(lds + (bufoff) + ldsw + _i * 8192), 16, 0, 0); } while (0)
#define PG8_LDA(dst, b, h) do { _Pragma("unroll") for (int m = 0; m < 4; ++m) _Pragma("unroll") for (int k = 0; k < 2; ++k) dst[m][k] = *(const LAS bf16x8*)(lds + PG8_SA(b, h) + aoff + m * 2048 + k * 1024); } while (0)
#define PG8_LDB(dst, b, h) do { _Pragma("unroll") for (int n = 0; n < 2; ++n) _Pragma("unroll") for (int k = 0; k < 2; ++k) dst[n][k] = *(const LAS bf16x8*)(lds + PG8_SB(b, h) + boff + n * 2048 + k * 1024); } while (0)
#define PG8_MMA(ai, bj, At, Bt) do { __builtin_amdgcn_s_setprio(1); _Pragma("unroll") for (int m = 0; m < 4; ++m) _Pragma("unroll") for (int n = 0; n < 2; ++n) _Pragma("unroll") for (int k = 0; k < 2; ++k) \
        acc[ai][bj][m][n] = __builtin_amdgcn_mfma_f32_16x16x32_bf16(Bt[n][k], At[m][k], acc[ai][bj][m][n], 0, 0, 0); __builtin_amdgcn_s_setprio(0); } while (0)
#define PG8_WAIT_V(n) asm volatile("s_waitcnt vmcnt(" #n ")" ::: "memory")
#define PG8_WAIT_L(n) asm volatile("s_waitcnt lgkmcnt(" #n ")" ::: "memory")
#define PG8_BAR __builtin_amdgcn_s_barrier()
#define PG8_SCHED __builtin_amdgcn_sched_barrier(0)
    Unit cur = S.next(0), nxt = cur; int ui = 0;
    if (cur.pm < 0) return;
    f32x4 acc[2][2][4][2];
#pragma unroll
    for (int a = 0; a < 2; ++a)
#pragma unroll
        for (int b = 0; b < 2; ++b)
#pragma unroll
            for (int m = 0; m < 4; ++m)
#pragma unroll
                for (int n = 0; n < 2; ++n) acc[a][b][m][n] = (f32x4){0.f, 0.f, 0.f, 0.f};
    bf16x8 At[4][2], B0[2][2], B1[2][2];
    const char* cA = (const char*)g.A + (size_t)cur.pm * tstepA + (size_t)(g.a_blk ? (cur.pn & 7) * 512 : 0) + (size_t)cur.k0 * kstep; const char* cB = (const char*)g.Bt + (size_t)cur.pn * tstepB + (size_t)cur.k0 * kstep;
    if constexpr (SP2) {
        PG8_STAGE(PG8_SB(0, 0), cB, voffB); PG8_STAGE(PG8_SB(0, 1), cB + hstepB, voffB); PG8_STAGE(PG8_SA(0, 0), cA, voffA); PG8_STAGE(PG8_SA(0, 1), cA + hstepA, voffA);
        if (wr == 1) PG8_BAR;
        PG8_WAIT_V(2); PG8_BAR;
        PG8_STAGE(PG8_SB(1, 0), cB + kstep, voffB); PG8_STAGE(PG8_SA(1, 0), cA + kstep, voffA); PG8_STAGE(PG8_SB(1, 1), cB + hstepB + kstep, voffB);
        PG8_WAIT_V(6); PG8_BAR;
    } else {
        PG8_STAGE(PG8_SB(0, 0), cB, voffB); PG8_STAGE(PG8_SA(0, 0), cA, voffA); PG8_STAGE(PG8_SB(0, 1), cB + hstepB, voffB); PG8_STAGE(PG8_SA(0, 1), cA + hstepA, voffA);
        if (wr == 1) PG8_BAR;
        PG8_WAIT_V(4); PG8_BAR;
        PG8_STAGE(PG8_SB(1, 0), cB + kstep, voffB); PG8_STAGE(PG8_SA(1, 0), cA + kstep, voffA); PG8_STAGE(PG8_SB(1, 1), cB + hstepB + kstep, voffB);
        PG8_WAIT_V(6); PG8_BAR;
    }
    for (;;) {
        nxt = S.next(ui + 1); const bool has_next = nxt.pm >= 0;
        const char* nA = has_next ? (const char*)g.A + (size_t)nxt.pm * tstepA + (size_t)(g.a_blk ? (nxt.pn & 7) * 512 : 0) + (size_t)nxt.k0 * kstep : cA; const char* nB = has_next ? (const char*)g.Bt + (size_t)nxt.pn * tstepB + (size_t)nxt.k0 * kstep : cB;
        const int nt = cur.nk;
#pragma unroll 1
        for (int t = 0; t < nt; t += 2) {
            const bool last = (t == nt - 2);
            const char* a1 = cA + (size_t)(t + 1) * kstep;
            const char* a2 = last ? nA : cA + (size_t)(t + 2) * kstep; const char* b2 = last ? nB : cB + (size_t)(t + 2) * kstep;
            const char* a3 = a2 + kstep; const char* b3 = b2 + kstep;
            if constexpr (SP2) {
            PG8_LDB(B0, 0, 0); PG8_LDB(B1, 0, 1); PG8_SCHED; PG8_LDA(At, 0, 0); PG8_STAGE(PG8_SA(1, 1), a1 + hstepA, voffA);
            PG8_WAIT_V(8); PG8_WAIT_L(0); PG8_BAR; PG8_MMA(0, 0, At, B0); PG8_MMA(0, 1, At, B1); PG8_BAR; PG8_SCHED;
            PG8_LDA(At, 0, 1); PG8_STAGE(PG8_SB(0, 0), b2, voffB); PG8_STAGE(PG8_SB(0, 1), b2 + hstepB, voffB); PG8_STAGE(PG8_SA(0, 0), a2, voffA);
            PG8_WAIT_V(8); PG8_WAIT_L(0); PG8_BAR; PG8_MMA(1, 0, At, B0); PG8_MMA(1, 1, At, B1); PG8_BAR; PG8_SCHED;
            PG8_LDB(B0, 1, 0); PG8_LDB(B1, 1, 1); PG8_SCHED; PG8_LDA(At, 1, 0); PG8_STAGE(PG8_SA(0, 1), a2 + hstepA, voffA);
            PG8_WAIT_V(8); PG8_WAIT_L(0); PG8_BAR; PG8_MMA(0, 0, At, B0); PG8_MMA(0, 1, At, B1); PG8_BAR; PG8_SCHED;
            PG8_LDA(At, 1, 1); PG8_STAGE(PG8_SB(1, 0), b3, voffB); PG8_STAGE(PG8_SB(1, 1), b3 + hstepB, voffB); PG8_STAGE(PG8_SA(1, 0), a3, voffA);
            PG8_WAIT_V(8); PG8_WAIT_L(0); PG8_BAR; PG8_MMA(1, 0, At, B0); PG8_MMA(1, 1, At, B1); PG8_BAR; PG8_SCHED;
            } else {
            PG8_LDB(B0, 0, 0); PG8_SCHED; PG8_LDA(At, 0, 0); PG8_STAGE(PG8_SA(1, 1), a1 + hstepA, voffA);
            PG8_WAIT_L(8); PG8_BAR; PG8_WAIT_L(0); PG8_MMA(0, 0, At, B0); PG8_BAR; PG8_SCHED;
            PG8_LDB(B1, 0, 1); PG8_STAGE(PG8_SB(0, 0), b2, voffB);
            PG8_BAR; PG8_WAIT_L(0); PG8_MMA(0, 1, At, B1); PG8_BAR;
            PG8_LDA(At, 0, 1); PG8_STAGE(PG8_SA(0, 0), a2, voffA);
            PG8_BAR; PG8_WAIT_L(0); PG8_MMA(1, 0, At, B0); PG8_BAR; PG8_SCHED;
            PG8_STAGE(PG8_SB(0, 1), b2 + hstepB, voffB);
            PG8_WAIT_V(6); PG8_BAR; PG8_MMA(1, 1, At, B1); PG8_BAR;
            PG8_LDB(B0, 1, 0); PG8_SCHED; PG8_LDA(At, 1, 0); PG8_STAGE(PG8_SA(0, 1), a2 + hstepA, voffA);
            PG8_WAIT_L(8); PG8_BAR; PG8_WAIT_L(0); PG8_MMA(0, 0, At, B0); PG8_BAR; PG8_SCHED;
            PG8_LDB(B1, 1, 1); PG8_STAGE(PG8_SB(1, 0), b3, voffB);
            PG8_BAR; PG8_WAIT_L(0); PG8_MMA(0, 1, At, B1); PG8_BAR;
            PG8_LDA(At, 1, 1); PG8_STAGE(PG8_SA(1, 0), a3, voffA);
            PG8_BAR; PG8_WAIT_L(0); PG8_MMA(1, 0, At, B0); PG8_BAR; PG8_SCHED;
            PG8_STAGE(PG8_SB(1, 1), b3 + hstepB, voffB);
            PG8_WAIT_V(6); PG8_BAR; PG8_MMA(1, 1, At, B1); PG8_BAR;
            }
        }
        if constexpr (ALIGN_EPI) { if (wr == 0) PG8_BAR; }
        E(acc, cur, wr, wc, fr, fq);
        if (!has_next) break;
#pragma unroll
        for (int a = 0; a < 2; ++a)
#pragma unroll
            for (int b = 0; b < 2; ++b)
#pragma unroll
                for (int m = 0; m < 4; ++m)
#pragma unroll
                    for (int n = 0; n < 2; ++n) acc[a][b][m][n] = (f32x4){0.f, 0.f, 0.f, 0.f};
        cur = nxt; cA = nA; cB = nB; ++ui;
        if constexpr (ALIGN_EPI) { if (wr == 1) PG8_BAR; }
    }
    PG8_WAIT_V(0);
    if constexpr (!ALIGN_EPI) { if (wr == 0) PG8_BAR; }
    PG8_BAR;
#undef PG8_SA
#undef PG8_SB
#undef PG8_STAGE
#undef PG8_LDA
#undef PG8_LDB
#undef PG8_MMA
#undef PG8_WAIT_V
#undef PG8_WAIT_L
#undef PG8_BAR
#undef PG8_SCHED
}
}

namespace att {
constexpr int NW = 8, QBLK = 32, KVBLK = 64, DV = 128;
constexpr float THR = 8.f;
#define SBAR() __builtin_amdgcn_sched_barrier(0)
__device__ __forceinline__ int crow(int r, int hi) { return (r & 3) + 8 * (r >> 2) + 4 * hi; }
template <int DQK> struct Cfg {
    static constexpr int KROW = DQK * 2;
    static constexpr int SHM_K = KVBLK * KROW, SHM_V = KVBLK * DV * 2;
    static constexpr int QPE_OFF = 2 * SHM_V + 2 * SHM_K + NW * 64 * 4;
    static constexpr int LDS_BYTES = QPE_OFF + (DQK == 192 ? NW * 4096 : 0);
    static constexpr int NQ = DQK / 16;
    static constexpr int NKC = DQK / 64;
};
template <int DQK> __device__ __forceinline__ int kswz(int row, int colB) { return row * (DQK * 2) + (colB ^ ((row & 7) << 4)); }

template <int DQK>
__device__ __forceinline__ void partialSM(f32x16& p0, f32x16& p1, float& m_reg, float& mn, float& alpha) {
    constexpr float SCALE = DQK == 128 ? 0.08838834764831845f : 0.07216878364870322f;
    constexpr float C = SCALE * 1.4426950408889634f;
    float pmax = p0[0];
#pragma unroll
    for (int r = 1; r < 16; ++r) pmax = fmaxf(pmax, p0[r]);
#pragma unroll
    for (int r = 0; r < 16; ++r) pmax = fmaxf(pmax, p1[r]);
    { auto rr = __builtin_amdgcn_permlane32_swap(__float_as_uint(pmax), __float_as_uint(pmax), false, false);
      pmax = fmaxf(__uint_as_float(rr[0]), __uint_as_float(rr[1])); }
    if (__builtin_expect(__all(pmax - m_reg <= THR / SCALE), 1)) { mn = m_reg; alpha = 1.f; }
    else { mn = fmaxf(m_reg, pmax); alpha = __builtin_amdgcn_exp2f((m_reg - mn) * C); m_reg = mn; }
    const float mnC = -mn * C;
#pragma unroll
    for (int r = 0; r < 16; ++r) p0[r] = fmaf(p0[r], C, mnC);
#pragma unroll
    for (int r = 0; r < 16; ++r) p1[r] = fmaf(p1[r], C, mnC);
#pragma unroll
    for (int r = 0; r < 16; ++r) p0[r] = __builtin_amdgcn_exp2f(p0[r]);
}
__device__ __forceinline__ void finishSM(f32x16& p0, f32x16& p1, float alpha, float& l_reg, bf16x8& pa0, bf16x8& pa1, bf16x8& pa2, bf16x8& pa3) {
#pragma unroll
    for (int r = 0; r < 16; ++r) p1[r] = __builtin_amdgcn_exp2f(p1[r]);
    float ps = 0;
#pragma unroll
    for (int r = 0; r < 16; ++r) ps += p0[r];
#pragma unroll
    for (int r = 0; r < 16; ++r) ps += p1[r];
    { auto rr = __builtin_amdgcn_permlane32_swap(__float_as_uint(ps), __float_as_uint(ps), false, false);
      ps = __uint_as_float(rr[0]) + __uint_as_float(rr[1]); }
    l_reg = l_reg * alpha + ps;
#define PK4(P, BASE, OUT) do { unsigned a0 = cvt_pk_bf16(P[BASE + 0], P[BASE + 1]), a1 = cvt_pk_bf16(P[BASE + 2], P[BASE + 3]);   \
    unsigned b0 = cvt_pk_bf16(P[BASE + 4], P[BASE + 5]), b1 = cvt_pk_bf16(P[BASE + 6], P[BASE + 7]);                              \
    auto r0 = __builtin_amdgcn_permlane32_swap(a0, b0, false, false); auto r1 = __builtin_amdgcn_permlane32_swap(a1, b1, false, false); \
    u32x4 w = {r0[0], r1[0], r0[1], r1[1]}; OUT = *reinterpret_cast<bf16x8*>(&w); } while (0)
    PK4(p0, 0, pa0); PK4(p0, 8, pa1); PK4(p1, 0, pa2); PK4(p1, 8, pa3);
#undef PK4
}
template <int DQK>
__device__ __forceinline__ void qkt(f32x16& p0, f32x16& p1, const char* Ks, const bf16x8* qr, const char* qpe, int r32, int hi) {
    p0 = f32x16{}; p1 = f32x16{};
#pragma unroll
    for (int d0 = 0; d0 < DQK / 16; ++d0) { const int cb = (d0 * 16 + hi * 8) * 2;
        bf16x8 b0 = *reinterpret_cast<const bf16x8*>(Ks + kswz<DQK>(r32, cb));
        bf16x8 b1 = *reinterpret_cast<const bf16x8*>(Ks + kswz<DQK>(32 + r32, cb));
        bf16x8 q; if (d0 < 8) q = qr[d0 < 8 ? d0 : 0]; else q = *reinterpret_cast<const bf16x8*>(qpe + (d0 - 8) * 1024);
        p0 = __builtin_amdgcn_mfma_f32_32x32x16_bf16(b0, q, p0, 0, 0, 0);
        p1 = __builtin_amdgcn_mfma_f32_32x32x16_bf16(b1, q, p1, 0, 0, 0);
        if (DQK == 192 && (d0 & 3) == 3 && d0 != 11) SBAR(); }
}
__device__ __forceinline__ int v_st(int k, int c) { const int kk = (k & ~0xC) | ((k & 4) << 1) | ((k & 8) >> 1); return ((kk >> 3) * 4 + (c >> 5)) * 512 + ((kk & 7) * 32 + (c & 31)) * 2; }
__device__ __forceinline__ int v_rd_base(int lane) { return ((lane & 3) << 3) | (((lane >> 2) & 3) << 6) | (((lane >> 4) & 1) << 5) | (((lane >> 5) & 1) << 8); }
constexpr int v_rd_off(int d0, int ks, int half) { return d0 * 512 + ks * 4096 + half * 2048; }
template <int OFF> __device__ __forceinline__ s16x4 tr_read(int vb) {
    s16x4 r; asm volatile("ds_read_b64_tr_b16 %0, %1 offset:%2" : "=&v"(r) : "v"(vb), "i"(OFF) : "memory"); return r;
}
template <int D0> __device__ __forceinline__ void pv_one(f32x16& od, int vb, bf16x8 pa0, bf16x8 pa1, bf16x8 pa2, bf16x8 pa3) {
    const s16x4 l0 = tr_read<v_rd_off(D0, 0, 0)>(vb), h0 = tr_read<v_rd_off(D0, 0, 1)>(vb), l1 = tr_read<v_rd_off(D0, 1, 0)>(vb), h1 = tr_read<v_rd_off(D0, 1, 1)>(vb);
    const s16x4 l2 = tr_read<v_rd_off(D0, 2, 0)>(vb), h2 = tr_read<v_rd_off(D0, 2, 1)>(vb), l3 = tr_read<v_rd_off(D0, 3, 0)>(vb), h3 = tr_read<v_rd_off(D0, 3, 1)>(vb);
    asm volatile("s_waitcnt lgkmcnt(0)" ::: "memory"); SBAR();
#define PK(L, H) (bf16x8){L[0], L[1], L[2], L[3], H[0], H[1], H[2], H[3]}
    od = __builtin_amdgcn_mfma_f32_32x32x16_bf16(pa0, PK(l0, h0), od, 0, 0, 0);
    od = __builtin_amdgcn_mfma_f32_32x32x16_bf16(pa1, PK(l1, h1), od, 0, 0, 0);
    od = __builtin_amdgcn_mfma_f32_32x32x16_bf16(pa2, PK(l2, h2), od, 0, 0, 0);
    od = __builtin_amdgcn_mfma_f32_32x32x16_bf16(pa3, PK(l3, h3), od, 0, 0, 0);
#undef PK
}
__device__ __forceinline__ void pv_d0(f32x16* o, int vb, bf16x8 pa0, bf16x8 pa1, bf16x8 pa2, bf16x8 pa3) {
    pv_one<0>(o[0], vb, pa0, pa1, pa2, pa3); pv_one<1>(o[1], vb, pa0, pa1, pa2, pa3); pv_one<2>(o[2], vb, pa0, pa1, pa2, pa3); pv_one<3>(o[3], vb, pa0, pa1, pa2, pa3);
}
__device__ __forceinline__ void unpack8(bf16x8 v, float* f) {
    const u32x4 w = *reinterpret_cast<const u32x4*>(&v);
    f[0] = bf_lo(w.x); f[1] = bf_hi(w.x); f[2] = bf_lo(w.y); f[3] = bf_hi(w.y); f[4] = bf_lo(w.z); f[5] = bf_hi(w.z); f[6] = bf_lo(w.w); f[7] = bf_hi(w.w);
}
__device__ __forceinline__ bf16x8 pack8(const float* f) {
    u32x4 w = {cvt_pk_bf16(f[0], f[1]), cvt_pk_bf16(f[2], f[3]), cvt_pk_bf16(f[4], f[5]), cvt_pk_bf16(f[6], f[7])}; return *reinterpret_cast<bf16x8*>(&w);
}
__device__ __forceinline__ void rope_pair(bf16x8& A, bf16x8& B, const f32x2* __restrict__ tab) {
    float a[8], b[8], ra[8], rb[8]; unpack8(A, a); unpack8(B, b);
#pragma unroll
    for (int j = 0; j < 8; ++j) { const f32x2 cs = tab[j]; ra[j] = a[j] * cs.x - b[j] * cs.y; rb[j] = b[j] * cs.x + a[j] * cs.y; }
    A = pack8(ra); B = pack8(rb);
}

template <int DQK, int LDQ, int LDK, int LDV, int LDO>
__device__ __forceinline__ void attn_body(const bf16_t* __restrict__ Qb, const bf16_t* __restrict__ Kh, const bf16_t* __restrict__ Vh, bf16_t* __restrict__ Ob, int seq, char* lds,
                                          const float* __restrict__ qg, const f32x2* __restrict__ tab, bool rope, int tok0) {
    using C = Cfg<DQK>;
    int tid_ = threadIdx.x; asm volatile("" : "+v"(tid_));
    const int tid = tid_, wid = tid >> 6, lane = tid & 63, r32 = lane & 31, hi = lane >> 5;
    char* V_lds = lds; char* K_lds = lds + 2 * C::SHM_V;
    float* wsf = (float*)(lds + 2 * C::SHM_V + 2 * C::SHM_K) + wid * 64; float* li_l = wsf; float* al_l = wsf + 32;
    char* qpe = lds + C::QPE_OFF + wid * 4096 + lane * 16;
    float m_reg = -1e30f, l_reg = 0; f32x16 o[4] = {}; bf16x8 qr[C::NQ];
    const bf16_t* Qw = Qb + (long)(wid * QBLK + r32) * LDQ + hi * 8;
#pragma unroll
    for (int d0 = 0; d0 < C::NQ; ++d0) qr[d0] = *reinterpret_cast<const bf16x8*>(Qw + d0 * 16);
    {
        const int t = tok0 + wid * QBLK + r32, prow = t >> 6, pcol = t & 63;
        if constexpr (DQK == 128) {
            float ss = 0.f;
#pragma unroll
            for (int d0 = 0; d0 < 8; ++d0) { float f[8]; unpack8(qr[d0], f);
#pragma unroll
                for (int j = 0; j < 8; ++j) ss += f[j] * f[j]; }
            ss += __shfl_xor(ss, 32);
            const float rstd = 1.0f / sqrtf(ss * (1.0f / 128.0f) + 1e-6f);
#pragma unroll
            for (int d0 = 0; d0 < 8; ++d0) { float f[8]; unpack8(qr[d0], f);
#pragma unroll
                for (int j = 0; j < 8; ++j) f[j] = f[j] * rstd * qg[d0 * 16 + hi * 8 + j];
                qr[d0] = pack8(f); }
            if (rope) {
                const f32x2* tr = tab + prow * 32 + hi * 8; const f32x2* tc = tab + pcol * 32 + hi * 8;
                rope_pair(qr[0], qr[2], tr); rope_pair(qr[1], qr[3], tr + 16);
                rope_pair(qr[4], qr[6], tc); rope_pair(qr[5], qr[7], tc + 16);
            }
        } else {
            if (rope) {
                const f32x2* tr = tab + prow * 16 + hi * 8; const f32x2* tc = tab + pcol * 16 + hi * 8;
                rope_pair(qr[8], qr[9], tr); rope_pair(qr[10], qr[11], tc);
            }
        }
    }
    if constexpr (DQK == 192) {
#pragma unroll
        for (int d0 = 8; d0 < 12; ++d0) *reinterpret_cast<bf16x8*>(qpe + (d0 - 8) * 1024) = qr[d0];
        asm volatile("s_waitcnt lgkmcnt(0)" ::: "memory");
    }
    const int sr = tid >> 4, sc = (tid & 15) * 8, vst0 = v_st(sr, sc), vst1 = v_st(32 + sr, sc);
    const int vb0 = (int)(uintptr_t)V_lds + v_rd_base(lane);
    const int sr2 = tid >> 3, sc2 = 128 + (tid & 7) * 8;
    struct Slot { bf16x8 vs0, vs1, ks0, ks1, ks2; };
    Slot sA, sBs;
#define sB (*(DQK == 192 ? &sA : &sBs))
#define SLOAD(S, k0) do { S.vs0 = *reinterpret_cast<const bf16x8*>(&Vh[(long)((k0) + sr) * LDV + sc]); S.vs1 = *reinterpret_cast<const bf16x8*>(&Vh[(long)((k0) + 32 + sr) * LDV + sc]); \
    S.ks0 = *reinterpret_cast<const bf16x8*>(&Kh[(long)((k0) + sr) * LDK + sc]); S.ks1 = *reinterpret_cast<const bf16x8*>(&Kh[(long)((k0) + 32 + sr) * LDK + sc]); \
    if constexpr (DQK == 192) S.ks2 = *reinterpret_cast<const bf16x8*>(&Kh[(long)((k0) + sr2) * LDK + sc2]); } while (0)
#define SWRITE(b, S) do { *(bf16x8*)(V_lds + (b) * C::SHM_V + vst0) = S.vs0; *(bf16x8*)(V_lds + (b) * C::SHM_V + vst1) = S.vs1; \
    *(bf16x8*)(K_lds + (b) * C::SHM_K + kswz<DQK>(sr, sc * 2)) = S.ks0; *(bf16x8*)(K_lds + (b) * C::SHM_K + kswz<DQK>(32 + sr, sc * 2)) = S.ks1; \
    if constexpr (DQK == 192) *(bf16x8*)(K_lds + (b) * C::SHM_K + kswz<DQK>(sr2, sc2 * 2)) = S.ks2; } while (0)
#define SWAIT() do { if constexpr (DQK == 192) asm volatile("s_waitcnt vmcnt(0)" ::: "memory"); else asm volatile("s_waitcnt vmcnt(4)" ::: "memory"); } while (0)
#define RESC(a) do { if (__any((a) < 1.f)) { if (hi == 0) al_l[r32] = (a); asm volatile("s_waitcnt lgkmcnt(0)" ::: "memory"); \
    _Pragma("unroll") for (int d = 0; d < 4; ++d) _Pragma("unroll") for (int r = 0; r < 16; ++r) o[d][r] *= al_l[crow(r, hi)]; } } while (0)
    f32x16 pA0, pA1, pB0, pB1; float mnA, mnB, alA, alB; bf16x8 pa0, pa1, pa2, pa3; const int NT = seq / KVBLK;
    SLOAD(sA, 0); asm volatile("s_waitcnt vmcnt(0)" ::: "memory"); SWRITE(0, sA); __syncthreads();
    qkt<DQK>(pA0, pA1, K_lds, qr, qpe, r32, hi); partialSM<DQK>(pA0, pA1, m_reg, mnA, alA);
    SLOAD(sB, KVBLK); if constexpr (DQK != 192) { if (2 < NT) SLOAD(sA, 2 * KVBLK); }
    SWAIT(); SWRITE(1, sB); __syncthreads();
    for (int j = 1; j + 1 < NT; j += 2) {
        SBAR(); qkt<DQK>(pB0, pB1, K_lds + C::SHM_K, qr, qpe, r32, hi);
        finishSM(pA0, pA1, alA, l_reg, pa0, pa1, pa2, pa3); SBAR();
        SLOAD(sB, (j + (DQK == 192 ? 1 : 2)) * KVBLK); SBAR();
        pv_d0(o, vb0, pa0, pa1, pa2, pa3); partialSM<DQK>(pB0, pB1, m_reg, mnB, alB);
        __syncthreads(); SWAIT(); SWRITE(0, sA);
        RESC(alB); __syncthreads();
        SBAR(); qkt<DQK>(pA0, pA1, K_lds, qr, qpe, r32, hi);
        finishSM(pB0, pB1, alB, l_reg, pa0, pa1, pa2, pa3); SBAR();
        if (DQK == 192 || j + 3 < NT) SLOAD(sA, (j + (DQK == 192 ? 2 : 3)) * KVBLK); SBAR();
        pv_d0(o, vb0 + C::SHM_V, pa0, pa1, pa2, pa3); partialSM<DQK>(pA0, pA1, m_reg, mnA, alA);
        __syncthreads(); SWAIT(); SWRITE(1, sB);
        RESC(alA); __syncthreads();
    }
    SBAR(); qkt<DQK>(pB0, pB1, K_lds + C::SHM_K, qr, qpe, r32, hi);
    finishSM(pA0, pA1, alA, l_reg, pa0, pa1, pa2, pa3); SBAR();
    pv_d0(o, vb0, pa0, pa1, pa2, pa3); partialSM<DQK>(pB0, pB1, m_reg, mnB, alB);
    __syncthreads(); RESC(alB);
    finishSM(pB0, pB1, alB, l_reg, pa0, pa1, pa2, pa3); SBAR();
    pv_d0(o, vb0 + C::SHM_V, pa0, pa1, pa2, pa3);
    if (hi == 0) li_l[r32] = l_reg; asm volatile("s_waitcnt lgkmcnt(0)" ::: "memory");
    float rli[16];
#pragma unroll
    for (int r = 0; r < 16; ++r) rli[r] = __builtin_amdgcn_rcpf(li_l[crow(r, hi)]);
    bf16_t* Ow = Ob + (long)(wid * QBLK) * LDO;
#pragma unroll
    for (int r = 0; r < 16; ++r) { const int orow = crow(r, hi);
#pragma unroll
        for (int d0 = 0; d0 < 4; ++d0) Ow[(long)orow * LDO + d0 * 32 + r32] = f2bf(o[d0][r] * rli[r]); }
    __syncthreads();
#undef sB
#undef SLOAD
#undef SWRITE
#undef SWAIT
#undef RESC
}
}

constexpr size_t MiB = 1u << 20;
constexpr size_t WS_CTL = 0, CTL_ZERO_BYTES = 1 * MiB;
constexpr size_t WS_MODS = 1 * MiB;
constexpr size_t WS_TAB = 2 * MiB;
constexpr size_t WS_X = 4 * MiB;
constexpr size_t WS_H = 140 * MiB;
constexpr size_t WS_OUTF = 208 * MiB;
constexpr size_t WS_W1T = 344 * MiB, WS_W2T = 472 * MiB;
constexpr size_t WS_GQAW = 600 * MiB;
constexpr size_t WS_LRUW = 640 * MiB;
constexpr size_t WS_MLAW = 668 * MiB;
constexpr size_t WS_BIG = 688 * MiB;
constexpr size_t WS_ACT = WS_BIG;
constexpr size_t WS_GQ = WS_BIG, WS_GK = WS_BIG + 68 * MiB, WS_GV = WS_BIG + 85 * MiB, WS_GO = WS_BIG + 102 * MiB;
constexpr size_t WS_MAP = WS_BIG, WS_MQAN = WS_BIG + 85 * MiB, WS_MCKVN = WS_BIG + 102 * MiB, WS_MQ = WS_BIG + 119 * MiB, WS_MK = WS_BIG + 221 * MiB, WS_MV = WS_BIG + 323 * MiB, WS_MO = WS_BIG + 391 * MiB;
constexpr size_t WS_LUP = WS_BIG, WS_LG = WS_BIG  , WS_LGY = WS_BIG + 68 * MiB, WS_LU = WS_BIG + 136 * MiB, WS_LAF = WS_BIG + 204 * MiB, WS_LGUF = WS_BIG + 340 * MiB,
                 WS_LAB = WS_BIG + 476 * MiB, WS_LGUB = WS_BIG + 612 * MiB, WS_LPS = WS_BIG + 748 * MiB, WS_LCIN = WS_BIG + 766 * MiB;
static_assert(WS_LGUF == WS_LAF + (size_t)R * DM * 4 && WS_LAB == WS_LGUF + (size_t)R * DM * 4 && WS_LGUB == WS_LAB + (size_t)R * DM * 4, "gate outputs are consecutive");
constexpr size_t WS_PART = WS_BIG + 776 * MiB;
constexpr size_t WS_END = WS_PART + 64 * MiB;
constexpr int NCH = 136;

#define XB_TMO      128
#define XB_XCNT(j)  (256  + 64 * (j))
#define XB_XSUB(j)  (1280 + 64 * (j))
#define XB_XGEN(j)  (2304 + 64 * (j))
#define XB_TOP      3328
#define XB_TOPGEN   3392
#define XCD_BAR_WORDS 3456
#define XB_SPIN_CAP (1u << 22)
__device__ __forceinline__ unsigned xb_ld(unsigned* p)              { return __hip_atomic_load(p, __ATOMIC_RELAXED, __HIP_MEMORY_SCOPE_AGENT); }
__device__ __forceinline__ unsigned xb_add(unsigned* p, unsigned v) { return __hip_atomic_fetch_add(p, v, __ATOMIC_RELAXED, __HIP_MEMORY_SCOPE_AGENT); }
__device__ __forceinline__ unsigned xb_xcc_id() { return (unsigned)__builtin_amdgcn_s_getreg((3 << 11) | 20) & 0xFu; }
#define XB_SPIN(cond, bar) do { unsigned _sp = 0; while (cond) { __builtin_amdgcn_s_sleep(1); \
    if ((++_sp & 255u) == 0u) { if (xb_ld(&(bar)[XB_TMO])) break; if (_sp > XB_SPIN_CAP) { atomicAdd(&(bar)[XB_TMO], 1u); break; } } } } while (0)
struct XcdBarrier { unsigned* bar; unsigned x; volatile LAS unsigned* st; };
__device__ __forceinline__ XcdBarrier xcd_barrier_post(unsigned* bar, volatile LAS unsigned* st) {
    XcdBarrier b; b.bar = bar; b.x = xb_xcc_id(); b.st = st;
    if (threadIdx.x == 0) (void)xb_add(&bar[XB_XCNT(b.x)], 1u);
    return b;
}
__device__ __forceinline__ void xcd_barrier_complete(unsigned* bar, unsigned x, unsigned& nloc, unsigned& nx) {
    const unsigned G = gridDim.x * gridDim.y * gridDim.z;
    unsigned sum, cnt, mine, sp = 0u;
    for (;;) {
        sum = 0u; cnt = 0u; mine = 0u;
#pragma unroll
        for (unsigned j = 0; j < 16; ++j) { const unsigned c = xb_ld(&bar[XB_XCNT(j)]); sum += c; cnt += (c > 0u) ? 1u : 0u; mine = (j == x) ? c : mine; }
        if (sum == G) break;
        __builtin_amdgcn_s_sleep(1);
        if ((++sp & 255u) == 0u) { if (xb_ld(&bar[XB_TMO])) break; if (sp > XB_SPIN_CAP) { atomicAdd(&bar[XB_TMO], 1u); break; } }
    }
    nloc = mine > 0u ? mine : 1u; nx = cnt > 0u ? cnt : 1u;
}
__device__ __forceinline__ void xcd_barrier(const XcdBarrier& b) {
    asm volatile("s_waitcnt vmcnt(0)" ::: "memory");
    __syncthreads();
    if (threadIdx.x == 0) {
        unsigned* bar = b.bar;
        __builtin_amdgcn_s_waitcnt(0);
        unsigned nloc = b.st[0], nx = b.st[1];
        if (nloc == 0u) { xcd_barrier_complete(bar, b.x, nloc, nx); b.st[0] = nloc; b.st[1] = nx; }
        const unsigned old = xb_add(&bar[XB_XSUB(b.x)], 1u);
        const unsigned gen = old / nloc;
        if (old + 1u == (gen + 1u) * nloc) {
            __builtin_amdgcn_fence(__ATOMIC_RELEASE, "agent");
            asm volatile("s_waitcnt vmcnt(0)" ::: "memory");
            const unsigned og = xb_add(&bar[XB_TOP], 1u);
            const unsigned tg = og / nx;
            if (og + 1u == (tg + 1u) * nx) xb_add(&bar[XB_TOPGEN], 1u);
            else XB_SPIN(xb_ld(&bar[XB_TOPGEN]) == tg, bar);
            __builtin_amdgcn_fence(__ATOMIC_ACQUIRE, "agent");
            xb_add(&bar[XB_XGEN(b.x)], 1u);
            asm volatile("s_waitcnt vmcnt(0)" ::: "memory");
        } else {
            XB_SPIN(xb_ld(&bar[XB_XGEN(b.x)]) == gen, bar);
            __builtin_amdgcn_fence(__ATOMIC_ACQUIRE, "agent");
            asm volatile("s_waitcnt vmcnt(0)" ::: "memory");
        }
    }
    __syncthreads();
}

#ifndef PROBE_N
#define PROBE_N 2
#endif
__device__ __forceinline__ int probe_count() { int n = PROBE_N; asm volatile("" : "+s"(n)); return n; }
#ifdef PROBE_GEMM
#define PROBE_REPEAT_GEMM for (int rep_ = 0, nrep_ = probe_count(); rep_ < nrep_; ++rep_)
#else
#define PROBE_REPEAT_GEMM
#endif
#ifdef PROBE_ATTN
#define PROBE_REPEAT_ATTN for (int rep_ = 0, nrep_ = probe_count(); rep_ < nrep_; ++rep_)
#else
#define PROBE_REPEAT_ATTN
#endif
struct Args {
    const float *x, *c, *ctx, *c_ctx, *ada_w, *ada_b, *ln_g, *ln_b, *mlp_w1, *mlp_w2;
    const float *gqa_wq, *gqa_wk, *gqa_wv, *gqa_wo, *gqa_q_g, *gqa_k_g;
    const float *lru_wx, *lru_wy, *lru_conv_w, *lru_conv_b, *lru_ra_w, *lru_ra_b, *lru_ix_w, *lru_ix_b, *lru_lam, *lru_wo;
    const float *mla_wq_a, *mla_q_a_g, *mla_wq_b, *mla_wkv_a, *mla_kv_a_g, *mla_wkv_b, *mla_wo;
    float* out; unsigned char* ws; int ph_lo, ph_hi;
};

constexpr int NWAVES = 8;
constexpr int RING_BYTES = 131072, LDSCTL_OFF = RING_BYTES, LDS_BYTES = 147456;

__device__ __forceinline__ float wave_sum(float v) {
#pragma unroll
    for (int o = 1; o < 64; o <<= 1) v += __shfl_xor(v, o);
    return v;
}
__device__ __forceinline__ float sigmoidf_(float v) { return __builtin_amdgcn_rcpf(1.0f + __builtin_amdgcn_exp2f(-1.4426950408889634f * v)); }

__device__ __forceinline__ void ph_mods(const Args& a, LAS unsigned char* lds, int vcu, int G) {
    LAS float* S = (LAS float*)lds; LAS float* red = (LAS float*)(lds + 40960);
    const int tid = threadIdx.x, wave = tid >> 6, lane = tid & 63;
    for (int i = tid; i < 5 * DM; i += 512) { const int bi = i / DM, k = i % DM; const float v = bi < 4 ? a.c[bi * DM + k] : a.c_ctx[k]; S[i] = v / (1.0f + expf(-v)); }
    __syncthreads();
    float* mods = (float*)(a.ws + WS_MODS);
    for (int item = vcu; item < 768; item += G) {
        const int l = item / 192, n0 = (item % 192) * 64, ksub = wave * 4 + (lane >> 4), cl = lane & 15;
        const float* wp = a.ada_w + ((size_t)l * DM + ksub) * 12288 + n0 + cl * 4;
        float acc[5][4];
#pragma unroll
        for (int i = 0; i < 5; ++i)
#pragma unroll
            for (int j = 0; j < 4; ++j) acc[i][j] = 0.f;
#pragma unroll 8
        for (int it = 0; it < 64; ++it) {
            const f32x4 w = *(const f32x4*)(wp + (size_t)it * 32 * 12288); const int k = ksub + 32 * it;
#pragma unroll
            for (int i = 0; i < 5; ++i) { const float s = S[i * DM + k];
#pragma unroll
                for (int j = 0; j < 4; ++j) acc[i][j] += s * w[j]; }
        }
#pragma unroll
        for (int i = 0; i < 5; ++i)
#pragma unroll
            for (int j = 0; j < 4; ++j) red[(ksub * 5 + i) * 64 + cl * 4 + j] = acc[i][j];
        __syncthreads();
        if (tid < 320) { const int i = tid / 64, cc = tid % 64; float s = 0.f;
            for (int ks = 0; ks < 32; ++ks) s += red[(ks * 5 + i) * 64 + cc];
            mods[(size_t)(l * 5 + i) * 12288 + n0 + cc] = s + a.ada_b[l * 12288 + n0 + cc]; }
        __syncthreads();
    }
}
__device__ __forceinline__ void tr_item(const float* __restrict__ W, int ldw, int k0, int n0, bf16_t* __restrict__ WT, int ldt, int drow0, LAS float* scr, int lane) {
#pragma unroll 8
    for (int i = 0; i < 32; ++i) { const int kk = 2 * i + (lane >> 5); scr[kk * 33 + (lane & 31)] = W[(size_t)(k0 + kk) * ldw + n0 + (lane & 31)]; }
    asm volatile("s_waitcnt lgkmcnt(0)" ::: "memory");
    const int c = lane & 7;
#pragma unroll
    for (int j = 0; j < 4; ++j) { const int n = (lane >> 3) + 8 * j; const LAS float* s = scr + (8 * c) * 33 + n;
        u32x4 o; o.x = cvt_pk_bf16(s[0 * 33], s[1 * 33]); o.y = cvt_pk_bf16(s[2 * 33], s[3 * 33]); o.z = cvt_pk_bf16(s[4 * 33], s[5 * 33]); o.w = cvt_pk_bf16(s[6 * 33], s[7 * 33]);
        *(u32x4*)(WT + (size_t)(drow0 + n) * ldt + k0 + 8 * c) = o; }
    asm volatile("s_waitcnt lgkmcnt(0)" ::: "memory");
}
__device__ __forceinline__ void ph_transposes(const Args& a, LAS unsigned char* lds, int vcu, int G) {
    const int tid = threadIdx.x, wave = tid >> 6, lane = tid & 63;
    LAS float* scr = (LAS float*)(lds + wave * 8704);
    const int gw = vcu * NWAVES + wave, NGW = G * NWAVES;
    unsigned char* ws = a.ws;
    constexpr int NITEMS = 87872;
    for (int it = gw; it < NITEMS; it += NGW) {
        int r = it;
#define TR_DO(src, K_, N_, dst, drow) do { const int nblk = (N_) / 32, kb = ri / nblk, nb = ri % nblk; tr_item((src), (N_), 64 * kb, 32 * nb, (dst), (K_), (drow) + 32 * nb, scr, lane); } while (0)
        if (r < 32768) { const int l = r / 8192, ri = r % 8192; TR_DO(a.mlp_w1 + (size_t)l * DM * DFF, DM, DFF, (bf16_t*)(ws + WS_W1T) + (size_t)l * DFF * DM, 0); continue; } r -= 32768;
        if (r < 32768) { const int l = r / 8192, ri = r % 8192; TR_DO(a.mlp_w2 + (size_t)l * DFF * DM, DFF, DM, (bf16_t*)(ws + WS_W2T) + (size_t)l * DM * DFF, 0); continue; } r -= 32768;
        if (r < 4096) { const int s = r / 2048, ri = r % 2048; TR_DO(a.gqa_wq + (size_t)s * DM * DM, DM, DM, (bf16_t*)(ws + WS_GQAW + s * 20 * MiB), 0); continue; } r -= 4096;
        if (r < 1024) { const int s = r / 512, ri = r % 512; TR_DO(a.gqa_wk + (size_t)s * DM * 512, DM, 512, (bf16_t*)(ws + WS_GQAW + s * 20 * MiB), 2048); continue; } r -= 1024;
        if (r < 1024) { const int s = r / 512, ri = r % 512; TR_DO(a.gqa_wv + (size_t)s * DM * 512, DM, 512, (bf16_t*)(ws + WS_GQAW + s * 20 * MiB), 2560); continue; } r -= 1024;
        if (r < 4096) { const int s = r / 2048, ri = r % 2048; TR_DO(a.gqa_wo + (size_t)s * DM * DM, DM, DM, (bf16_t*)(ws + WS_GQAW + s * 20 * MiB + 12 * MiB), 0); continue; } r -= 4096;
        if (r < 2048) { const int ri = r; TR_DO(a.lru_wx, DM, DM, (bf16_t*)(ws + WS_LRUW), 0); continue; } r -= 2048;
        if (r < 2048) { const int ri = r; TR_DO(a.lru_wy, DM, DM, (bf16_t*)(ws + WS_LRUW), 2048); continue; } r -= 2048;
        if (r < 1024) { const int blk = r / 32, ri = r % 32, ty = blk / 16, d = (blk % 16) / 8, n = blk % 8, which = d * 2 + ty;
            const float* src = (ty == 0 ? a.lru_ra_w : a.lru_ix_w) + (size_t)(d * 8 + n) * 65536;
            TR_DO(src, 256, 256, (bf16_t*)(ws + WS_LRUW + 16 * MiB), (which * 8 + n) * 256); continue; } r -= 1024;
        if (r < 2048) { const int ri = r; TR_DO(a.lru_wo, DM, DM, (bf16_t*)(ws + WS_LRUW + 20 * MiB), 0); continue; } r -= 2048;
        if (r < 512) { const int ri = r; TR_DO(a.mla_wq_a, DM, 512, (bf16_t*)(ws + WS_MLAW), 0); continue; } r -= 512;
        if (r < 576) { const int ri = r; TR_DO(a.mla_wkv_a, DM, 576, (bf16_t*)(ws + WS_MLAW), 512); continue; } r -= 576;
        if (r < 768) { const int ri = r; TR_DO(a.mla_wq_b, 512, 3072, (bf16_t*)(ws + WS_MLAW + 5 * MiB), 0); continue; } r -= 768;
        if (r < 1024) { const int ri = r, nb = ri % 128, kb = ri / 128, n0 = 32 * nb, h = n0 >> 8, j0 = n0 & 255;
            const int drow = j0 < 128 ? h * 128 + j0 : 2048 + h * 128 + (j0 - 128);
            tr_item(a.mla_wkv_b, 4096, 64 * kb, n0, (bf16_t*)(ws + WS_MLAW + 8 * MiB), 512, drow, scr, lane); continue; } r -= 1024;
        { const int ri = r; TR_DO(a.mla_wo, DM, DM, (bf16_t*)(ws + WS_MLAW + 12 * MiB), 0); }
#undef TR_DO
    }
    { u32x4* z = (u32x4*)(ws + WS_MLAW + (size_t)1088 * DM * 2); const int gt = vcu * 512 + tid;
      for (int i = gt; i < 49152; i += G * 512) z[i] = (u32x4){0u, 0u, 0u, 0u}; }
    if (vcu == 1 % G) { float* ll = (float*)(ws + WS_TAB + 32768); for (int i = tid; i < 2 * DM; i += 512) ll[i] = -8.0f * log1pf(expf(-a.lru_lam[i])); }
    if (vcu == 0) {
        f32x2* tg = (f32x2*)(ws + WS_TAB); f32x2* tm = (f32x2*)(ws + WS_TAB + 16384);
        for (int i = tid; i < 64 * 32; i += 512) { const int pos = i / 32, f = i % 32; const float inv = powf(10000.0f, -((float)f * 2.0f) / 64.0f); const float ang = (float)pos * inv; tg[i] = (f32x2){cosf(ang), sinf(ang)}; }
        for (int i = tid; i < 64 * 16; i += 512) { const int pos = i / 16, f = i % 16; const float inv = powf(10000.0f, -((float)f * 2.0f) / 32.0f); const float ang = (float)pos * inv; tm[i] = (f32x2){cosf(ang), sinf(ang)}; }
    }
}

#define ROW_DECODE(r) const int b_ = (r) / TB, p_ = (r) % TB; const bool isctx_ = p_ < CTX; const int mi_ = isctx_ ? 4 : b_; (void)b_; (void)mi_
__device__ __forceinline__ const float* mods_ptr(const Args& a, int l, int mi) { return (const float*)(a.ws + WS_MODS) + (size_t)(l * 5 + mi) * 12288; }

__device__ __forceinline__ void ph_init(const Args& a, int gw, int NGW, int lane) {
    float* X = (float*)(a.ws + WS_X); bf16_t* H = (bf16_t*)(a.ws + WS_H);
    for (int r = gw; r < R; r += NGW) {
        ROW_DECODE(r);
        const float* src = isctx_ ? a.ctx + ((size_t)b_ * CTX + p_) * DM : a.x + ((size_t)b_ * SEQ + (p_ - CTX)) * DM;
        const float* m = mods_ptr(a, 0, mi_);
#pragma unroll
        for (int it = 0; it < 8; ++it) { const int idx = it * 256 + lane * 4;
            const f32x4 v = *(const f32x4*)(src + idx), m0 = *(const f32x4*)(m + idx), m1 = *(const f32x4*)(m + DM + idx);
            *(f32x4*)(X + (size_t)r * DM + idx) = v;
            const f32x4 h = v * (1.0f + m1) + m0;
            *(u32x2*)(H + (size_t)r * DM + idx) = (u32x2){cvt_pk_bf16(h[0], h[1]), cvt_pk_bf16(h[2], h[3])}; }
    }
}
template <bool LAST, int CTXMODE>
__device__ __forceinline__ void ph_ln(const Args& a, int l, int which, int gw, int NGW, int lane) {
    float* X = (float*)(a.ws + WS_X); bf16_t* H = (bf16_t*)(a.ws + WS_H); const float* O = (const float*)(a.ws + WS_OUTF); const float* PART = (const float*)(a.ws + WS_PART);
    const float* lg = a.ln_g + (size_t)(l * 2 + which) * DM; const float* lb = a.ln_b + (size_t)(l * 2 + which) * DM;
    for (int r = gw; r < R; r += NGW) {
        ROW_DECODE(r);
        if ((LAST || CTXMODE == 2) && isctx_) continue;
        const float* m = mods_ptr(a, l, mi_);
        const float* gate = m + (which == 0 ? 2 : 5) * DM;
        const float* sc = which == 0 ? m + 4 * DM : mods_ptr(a, LAST ? l : l + 1, mi_) + 1 * DM;
        const float* sh = which == 0 ? m + 3 * DM : mods_ptr(a, LAST ? l : l + 1, mi_);
        f32x4 v[8]; float s = 0.f;
#pragma unroll
        for (int it = 0; it < 8; ++it) { const int idx = it * 256 + lane * 4;
            const f32x4 xv = *(const f32x4*)(X + (size_t)r * DM + idx), g = *(const f32x4*)(gate + idx); f32x4 ov;
            if (CTXMODE == 1 && isctx_) { const float* pp = PART + ((size_t)b_ * CTX + p_) * DM + idx; ov = *(const f32x4*)pp;
#pragma unroll
                for (int sl = 1; sl < 8; ++sl) ov += *(const f32x4*)(pp + (size_t)sl * (NB * CTX) * DM); }
            else ov = *(const f32x4*)(O + (size_t)r * DM + idx);
            v[it] = DN_ALPHA * xv + (1.0f + g) * ov; s += (v[it][0] + v[it][1]) + (v[it][2] + v[it][3]); }
        const float mean = wave_sum(s) * (1.0f / DM); float q = 0.f;
#pragma unroll
        for (int it = 0; it < 8; ++it) { v[it] = v[it] - mean; q += (v[it][0] * v[it][0] + v[it][1] * v[it][1]) + (v[it][2] * v[it][2] + v[it][3] * v[it][3]); }
        const float rstd = 1.0f / sqrtf(wave_sum(q) * (1.0f / DM) + LN_EPS);
#pragma unroll
        for (int it = 0; it < 8; ++it) { const int idx = it * 256 + lane * 4;
            const f32x4 xn = v[it] * rstd * *(const f32x4*)(lg + idx) + *(const f32x4*)(lb + idx);
            if (LAST) { *(f32x4*)(a.out + ((size_t)b_ * SEQ + (p_ - CTX)) * DM + idx) = xn; }
            else { *(f32x4*)(X + (size_t)r * DM + idx) = xn;
                const f32x4 h = xn * (1.0f + *(const f32x4*)(sc + idx)) + *(const f32x4*)(sh + idx);
                *(u32x2*)(H + (size_t)r * DM + idx) = (u32x2){cvt_pk_bf16(h[0], h[1]), cvt_pk_bf16(h[2], h[3])}; } }
    }
}
__device__ __forceinline__ void ph_knorm(const Args& a, const float* kg, int gw, int NGW, int lane) {
    bf16_t* K = (bf16_t*)(a.ws + WS_GK); const f32x2* tab = (const f32x2*)(a.ws + WS_TAB);
    const int li = lane & 15;
    float g[8];
#pragma unroll
    for (int j = 0; j < 8; ++j) g[j] = kg[li * 8 + j];
    for (int r = gw; r < R; r += NGW) {
        ROW_DECODE(r);
        bf16x8 raw = *(const bf16x8*)(K + (size_t)r * 512 + lane * 8);
        float f[8]; att::unpack8(raw, f);
        float ss = 0.f;
#pragma unroll
        for (int j = 0; j < 8; ++j) ss += f[j] * f[j];
        ss += __shfl_xor(ss, 1); ss += __shfl_xor(ss, 2); ss += __shfl_xor(ss, 4); ss += __shfl_xor(ss, 8);
        const float rstd = 1.0f / sqrtf(ss * (1.0f / 128.0f) + 1e-6f);
#pragma unroll
        for (int j = 0; j < 8; ++j) f[j] = f[j] * rstd * g[j];
        if (!isctx_) {
            const int t = p_ - CTX, pos = (li & 8) ? (t & 63) : (t >> 6);
            const f32x2* tp = tab + pos * 32 + (li & 3) * 8;
            const bool second = (li & 4) != 0;
#pragma unroll
            for (int j = 0; j < 8; ++j) { const float other = __shfl_xor(f[j], 4); const f32x2 cs = tp[j];
                f[j] = second ? f[j] * cs.x + other * cs.y : f[j] * cs.x - other * cs.y; }
        }
        *(bf16x8*)(K + (size_t)r * 512 + lane * 8) = att::pack8(f);
    }
}
__device__ __forceinline__ void ph_mla_norm(const Args& a, int gw, int NGW, int lane) {
    const float* AP = (const float*)(a.ws + WS_MAP); bf16_t* QAN = (bf16_t*)(a.ws + WS_MQAN); bf16_t* CKVN = (bf16_t*)(a.ws + WS_MCKVN); bf16_t* K = (bf16_t*)(a.ws + WS_MK);
    const f32x2* tab = (const f32x2*)(a.ws + WS_TAB + 16384);
    for (int r = gw; r < R; r += NGW) {
        ROW_DECODE(r);
        const float* ap = AP + (size_t)r * 1280;
#pragma unroll
        for (int part = 0; part < 2; ++part) {
            const f32x4 v0 = *(const f32x4*)(ap + part * 512 + lane * 8), v1 = *(const f32x4*)(ap + part * 512 + lane * 8 + 4);
            float ss = (v0[0] * v0[0] + v0[1] * v0[1]) + (v0[2] * v0[2] + v0[3] * v0[3]) + (v1[0] * v1[0] + v1[1] * v1[1]) + (v1[2] * v1[2] + v1[3] * v1[3]);
            const float rstd = 1.0f / sqrtf(wave_sum(ss) * (1.0f / 512.0f) + 1e-6f);
            const float* gp = (part == 0 ? a.mla_q_a_g : a.mla_kv_a_g) + lane * 8;
            const f32x4 g0 = *(const f32x4*)gp, g1 = *(const f32x4*)(gp + 4);
            const f32x4 o0 = v0 * rstd * g0, o1 = v1 * rstd * g1;
            u32x4 w = {cvt_pk_bf16(o0[0], o0[1]), cvt_pk_bf16(o0[2], o0[3]), cvt_pk_bf16(o1[0], o1[1]), cvt_pk_bf16(o1[2], o1[3])};
            *(u32x4*)((part == 0 ? QAN : CKVN) + (size_t)r * 512 + lane * 8) = w;
        }
        float v = ap[1024 + lane];
        if (!isctx_) {
            const int t = p_ - CTX, pos = (lane & 32) ? (t & 63) : (t >> 6);
            const f32x2 cs = tab[pos * 16 + (lane & 15)];
            const float other = __shfl_xor(v, 16);
            v = (lane & 16) ? v * cs.x + other * cs.y : v * cs.x - other * cs.y;
        }
        const bf16_t kb = f2bf(v);
#pragma unroll
        for (int h = 0; h < 16; ++h) K[(size_t)r * 3072 + h * 192 + 128 + lane] = kb;
    }
}
__device__ __forceinline__ void ph_conv(const Args& a, int gw, int NGW, int lane) {
    const bf16_t* UP = (const bf16_t*)(a.ws + WS_LUP); bf16_t* U = (bf16_t*)(a.ws + WS_LU);
    for (int r = gw; r < R; r += NGW) {
        ROW_DECODE(r);
        const int lo = isctx_ ? 0 : CTX, hi = isctx_ ? CTX : TB;
#pragma unroll
        for (int it = 0; it < 4; ++it) { const int idx = it * 512 + lane * 8;
            float acc[8];
            { const f32x4 b0 = *(const f32x4*)(a.lru_conv_b + idx), b1 = *(const f32x4*)(a.lru_conv_b + idx + 4);
              acc[0] = b0[0]; acc[1] = b0[1]; acc[2] = b0[2]; acc[3] = b0[3]; acc[4] = b1[0]; acc[5] = b1[1]; acc[6] = b1[2]; acc[7] = b1[3]; }
#pragma unroll
            for (int j = 0; j < 4; ++j) { const int pp = p_ + j - 2;
                if (pp >= lo && pp < hi) {
                    float f[8]; att::unpack8(*(const bf16x8*)(UP + (size_t)(r + j - 2) * DM + idx), f);
                    const f32x4 w0 = *(const f32x4*)(a.lru_conv_w + j * DM + idx), w1 = *(const f32x4*)(a.lru_conv_w + j * DM + idx + 4);
                    acc[0] += f[0] * w0[0]; acc[1] += f[1] * w0[1]; acc[2] += f[2] * w0[2]; acc[3] += f[3] * w0[3];
                    acc[4] += f[4] * w1[0]; acc[5] += f[5] * w1[1]; acc[6] += f[6] * w1[2]; acc[7] += f[7] * w1[3]; } }
            *(bf16x8*)(U + (size_t)r * DM + idx) = att::pack8(acc); }
    }
}
__device__ __forceinline__ void ph_scan1(const Args& a, int gw, int NGW, int lane) {
    float* PS = (float*)(a.ws + WS_LPS);
    for (int item = gw; item < NB * NCH * 2 * 8; item += NGW) {
        const int cg = item & 7, dir = (item >> 3) & 1, bq = item >> 4, b = bq / NCH, q = bq % NCH;
        const float* A = (const float*)(a.ws + (dir ? WS_LAB : WS_LAF)); const float* GU = (const float*)(a.ws + (dir ? WS_LGUB : WS_LGUF));
        const size_t base = ((size_t)b * TB + q * 32) * DM + cg * 256 + lane * 4;
        f32x4 h = {0.f, 0.f, 0.f, 0.f}, P = {1.f, 1.f, 1.f, 1.f};
#pragma unroll 8
        for (int i = 0; i < 32; ++i) { const int rr = dir ? 31 - i : i;
            const f32x4 av = *(const f32x4*)(A + base + (size_t)rr * DM), gv = *(const f32x4*)(GU + base + (size_t)rr * DM);
            f32x4 s; s[0] = sqrtf(fmaxf(1.0f - av[0] * av[0], 0.f)); s[1] = sqrtf(fmaxf(1.0f - av[1] * av[1], 0.f)); s[2] = sqrtf(fmaxf(1.0f - av[2] * av[2], 0.f)); s[3] = sqrtf(fmaxf(1.0f - av[3] * av[3], 0.f));
            h = av * h + s * gv; P = P * av; }
        float* o = PS + ((size_t)(bq * 2 + dir) * 2) * DM + cg * 256 + lane * 4;
        *(f32x4*)o = P; *(f32x4*)(o + DM) = h;
    }
}
__device__ __forceinline__ void ph_scan2(const Args& a, int gtid, int NGT) {
    const float* PS = (const float*)(a.ws + WS_LPS); float* CIN = (float*)(a.ws + WS_LCIN);
    for (int t = gtid; t < NB * 2 * DM; t += NGT) {
        const int c = t % DM, dir = (t / DM) & 1, b = t / (2 * DM);
        float carry = 0.f;
        for (int i = 0; i < NCH; ++i) {
            const int q = dir == 0 ? i : (i < 8 ? 7 - i : NCH - 1 - (i - 8));
            const size_t bq = (size_t)b * NCH + q;
            CIN[(bq * 2 + dir) * DM + c] = carry;
            const float P = PS[((bq * 2 + dir) * 2) * DM + c], S = PS[((bq * 2 + dir) * 2 + 1) * DM + c];
            carry = P * carry + S;
        }
    }
}
__device__ __forceinline__ void ph_scan3(const Args& a, int gw, int NGW, int lane) {
    const float* CIN = (const float*)(a.ws + WS_LCIN); const bf16_t* GY = (const bf16_t*)(a.ws + WS_LGY); bf16_t* Gout = (bf16_t*)(a.ws + WS_LG);
    const float* AF = (const float*)(a.ws + WS_LAF); const float* GUF = (const float*)(a.ws + WS_LGUF); const float* AB = (const float*)(a.ws + WS_LAB); const float* GUB = (const float*)(a.ws + WS_LGUB);
    for (int item = gw; item < NB * NCH * 8; item += NGW) {
        const int cg = item & 7, bq = item >> 3, b = bq / NCH, q = bq % NCH;
        const size_t base = ((size_t)b * TB + q * 32) * DM + cg * 256 + lane * 4;
        f32x4 hf[32];
        f32x4 h = *(const f32x4*)(CIN + ((size_t)bq * 2 + 0) * DM + cg * 256 + lane * 4);
#pragma unroll
        for (int i = 0; i < 32; ++i) {
            const f32x4 av = *(const f32x4*)(AF + base + (size_t)i * DM), gv = *(const f32x4*)(GUF + base + (size_t)i * DM);
            f32x4 s; s[0] = sqrtf(fmaxf(1.0f - av[0] * av[0], 0.f)); s[1] = sqrtf(fmaxf(1.0f - av[1] * av[1], 0.f)); s[2] = sqrtf(fmaxf(1.0f - av[2] * av[2], 0.f)); s[3] = sqrtf(fmaxf(1.0f - av[3] * av[3], 0.f));
            h = av * h + s * gv; hf[i] = h; }
        h = *(const f32x4*)(CIN + ((size_t)bq * 2 + 1) * DM + cg * 256 + lane * 4);
#pragma unroll
        for (int i = 31; i >= 0; --i) {
            const f32x4 av = *(const f32x4*)(AB + base + (size_t)i * DM), gv = *(const f32x4*)(GUB + base + (size_t)i * DM);
            f32x4 s; s[0] = sqrtf(fmaxf(1.0f - av[0] * av[0], 0.f)); s[1] = sqrtf(fmaxf(1.0f - av[1] * av[1], 0.f)); s[2] = sqrtf(fmaxf(1.0f - av[2] * av[2], 0.f)); s[3] = sqrtf(fmaxf(1.0f - av[3] * av[3], 0.f));
            h = av * h + s * gv;
            const u32x2 gy = *(const u32x2*)(GY + base + (size_t)i * DM);
            const f32x4 o = (hf[i] + h) * (f32x4){bf_lo(gy.x), bf_hi(gy.x), bf_lo(gy.y), bf_hi(gy.y)};
            *(u32x2*)(Gout + base + (size_t)i * DM) = (u32x2){cvt_pk_bf16(o[0], o[1]), cvt_pk_bf16(o[2], o[3])}; }
    }
}

__device__ __forceinline__ void st_bf16x8(bf16_t* p, f32x4 v0, f32x4 v1) {
    u32x4 w = {cvt_pk_bf16(v0[0], v0[1]), cvt_pk_bf16(v0[2], v0[3]), cvt_pk_bf16(v1[0], v1[1]), cvt_pk_bf16(v1[2], v1[3])}; *(u32x4*)p = w; }
struct FStoreF32 { float* O; int ld;
    __device__ __forceinline__ void begin(const pg8::Unit&, int) {}
    __device__ __forceinline__ void row8(int row, int, int col, f32x4 v0, f32x4 v1) { float* p = O + (size_t)row * ld + col; *(f32x4*)p = v0; *(f32x4*)(p + 4) = v1; } };
struct FOut { float* O; float* PART; float* dst; int rowadj;
    __device__ __forceinline__ void begin(const pg8::Unit& u, int) {
        if (u.slice >= 0) { dst = PART + (size_t)u.slice * (NB * CTX) * DM; rowadj = (u.pm / 17) * CTX - u.pm * 256; } else { dst = O; rowadj = 0; } }
    __device__ __forceinline__ void row8(int row, int, int col, f32x4 v0, f32x4 v1) { float* p = dst + (size_t)(row + rowadj) * DM + col; *(f32x4*)p = v0; *(f32x4*)(p + 4) = v1; } };
struct FBf16 { bf16_t* O; int ld;
    __device__ __forceinline__ void begin(const pg8::Unit&, int) {}
    __device__ __forceinline__ void row8(int row, int, int col, f32x4 v0, f32x4 v1) { st_bf16x8(O + (size_t)row * ld + col, v0, v1); } };
struct FQkv { bf16_t *Q, *K, *V; bf16_t* base; int ld, coff;
    __device__ __forceinline__ void begin(const pg8::Unit& u, int) { if (u.pn < 8) { base = Q; ld = 2048; coff = 0; } else if (u.pn < 10) { base = K; ld = 512; coff = 2048; } else { base = V; ld = 512; coff = 2560; } }
    __device__ __forceinline__ void row8(int row, int, int col, f32x4 v0, f32x4 v1) { st_bf16x8(base + (size_t)row * ld + (col - coff), v0, v1); } };
struct FRelu2 { bf16_t* O;
    __device__ __forceinline__ void begin(const pg8::Unit&, int) {}
    __device__ __forceinline__ void row8(int row, int, int col, f32x4 v0, f32x4 v1) {
#pragma unroll
        for (int i = 0; i < 4; ++i) { const float a = fmaxf(v0[i], 0.f), b = fmaxf(v1[i], 0.f); v0[i] = a * a; v1[i] = b * b; }
        st_bf16x8(O + (size_t)row * DFF + col, v0, v1); } };
__device__ __forceinline__ float gelu_tanh(float x) { const float z = 1.5957691216057308f * (x + 0.044715f * x * x * x); return x * __builtin_amdgcn_rcpf(1.0f + __builtin_amdgcn_exp2f(-1.4426950408889634f * z)); }
struct FLruXY { bf16_t *UP, *GY; bool gy;
    __device__ __forceinline__ void begin(const pg8::Unit& u, int) { gy = u.pn >= 8; }
    __device__ __forceinline__ void row8(int row, int, int col, f32x4 v0, f32x4 v1) {
        if (gy) {
#pragma unroll
            for (int i = 0; i < 4; ++i) { v0[i] = gelu_tanh(v0[i]); v1[i] = gelu_tanh(v1[i]); }
            st_bf16x8(GY + (size_t)row * DM + (col - 2048), v0, v1);
        } else st_bf16x8(UP + (size_t)row * DM + col, v0, v1); } };
struct EpiGates {
    static constexpr bool PERM = true;
    float* OUT4; const bf16_t* U; const float *ra_b, *ix_b, *lam;
    __device__ __forceinline__ void operator()(const f32x4 (&acc)[2][2][4][2], const pg8::Unit& u, int wr, int wc, int fr, int fq) const {
        const int which = u.pn >> 3, dir = which >> 1, ty = which & 1, ch0 = (u.pn & 7) * 256 + wc * 32 + 8 * fq, row0 = u.pm * 256 + wr * 64 + fr;
        float* dst = OUT4 + (size_t)which * ((size_t)R * DM);
        const float* bp = (ty == 0 ? ra_b : ix_b) + dir * DM;
#pragma unroll
        for (int bj = 0; bj < 2; ++bj) {
            const int ch = ch0 + bj * 128;
            const f32x4 b0 = *(const f32x4*)(bp + ch), b1 = *(const f32x4*)(bp + ch + 4);
            f32x4 l0 = {0.f, 0.f, 0.f, 0.f}, l1 = {0.f, 0.f, 0.f, 0.f};
            if (ty == 0) { l0 = *(const f32x4*)(lam + dir * DM + ch) * 1.4426950408889634f; l1 = *(const f32x4*)(lam + dir * DM + ch + 4) * 1.4426950408889634f; }
#pragma unroll
            for (int ai = 0; ai < 2; ++ai)
#pragma unroll
                for (int m = 0; m < 4; ++m) {
                    const int row = row0 + ai * 128 + m * 16;
                    const f32x4 x0 = acc[ai][bj][m][0] + b0, x1 = acc[ai][bj][m][1] + b1; f32x4 o0, o1;
                    if (ty == 0) {
#pragma unroll
                        for (int j = 0; j < 4; ++j) { o0[j] = __builtin_amdgcn_exp2f(l0[j] * sigmoidf_(x0[j])); o1[j] = __builtin_amdgcn_exp2f(l1[j] * sigmoidf_(x1[j])); }
                    } else {
                        const u32x4 uw = *(const u32x4*)(U + (size_t)row * DM + ch);
                        o0[0] = sigmoidf_(x0[0]) * bf_lo(uw.x); o0[1] = sigmoidf_(x0[1]) * bf_hi(uw.x); o0[2] = sigmoidf_(x0[2]) * bf_lo(uw.y); o0[3] = sigmoidf_(x0[3]) * bf_hi(uw.y);
                        o1[0] = sigmoidf_(x1[0]) * bf_lo(uw.z); o1[1] = sigmoidf_(x1[1]) * bf_hi(uw.z); o1[2] = sigmoidf_(x1[2]) * bf_lo(uw.w); o1[3] = sigmoidf_(x1[3]) * bf_hi(uw.w);
                    }
                    float* p = dst + (size_t)row * DM + ch; *(f32x4*)p = o0; *(f32x4*)(p + 4) = o1;
                    __builtin_amdgcn_sched_barrier(0);
                }
        }
    } };
struct FKvb { bf16_t *K, *V;
    __device__ __forceinline__ void begin(const pg8::Unit&, int) {}
    __device__ __forceinline__ void row8(int row, int, int col, f32x4 v0, f32x4 v1) {
        bf16_t* p = col < 2048 ? K + (size_t)row * 3072 + (col >> 7) * 192 + (col & 127) : V + (size_t)row * DM + (col - 2048);
        st_bf16x8(p, v0, v1); } };

template <class F>
__device__ __forceinline__ void run_gemm(LAS unsigned char* lds, const bf16_t* A, int lda, const bf16_t* Bt, int ldb, int N, int K, int a_blk, F f, int G) {
    pg8::Gemm g{A, Bt, R, N, K, lda, ldb, a_blk}; pg8::StaticOrder S; S.init(R, N, K, G, (int)blockIdx.x);
    pg8::EpiRow8<F> E{f};
    PROBE_REPEAT_GEMM
    pg8::gemm_phase<pg8::EpiRow8<F>, pg8::StaticOrder, true, true>(lds, g, S, E);
}

__device__ __forceinline__ void run_gemm_out(LAS unsigned char* lds, const bf16_t* A, int lda, const bf16_t* Bt, int K, int SK, float* OUTF, float* PART, int G) {
    pg8::Gemm g{A, Bt, R, DM, K, lda, K, 0}; pg8::LatOrder S; S.init(DM, K, G, (int)blockIdx.x, SK);
    pg8::EpiRow8<FOut> E{FOut{OUTF, PART, nullptr, 0}};
    PROBE_REPEAT_GEMM
    pg8::gemm_phase<pg8::EpiRow8<FOut>, pg8::LatOrder, true, true>(lds, g, S, E);
}
template <class F>
__device__ __forceinline__ void run_gemm_lat(LAS unsigned char* lds, const bf16_t* A, int lda, const bf16_t* Bt, int ldb, int N, int K, F f, int G) {
    pg8::Gemm g{A, Bt, R, N, K, lda, ldb, 0}; pg8::LatOrder S; S.init(N, K, G, (int)blockIdx.x, 0);
    pg8::EpiRow8<F> E{f};
    PROBE_REPEAT_GEMM
    pg8::gemm_phase<pg8::EpiRow8<F>, pg8::LatOrder, true, true>(lds, g, S, E);
}

__device__ __forceinline__ void ph_attn_gqa(const Args& a, char* lds, const float* qg, bool ctx_units, int vcu, int G) {
    const bf16_t* Q = (const bf16_t*)(a.ws + WS_GQ); const bf16_t* K = (const bf16_t*)(a.ws + WS_GK); const bf16_t* V = (const bf16_t*)(a.ws + WS_GV); bf16_t* O = (bf16_t*)(a.ws + WS_GO);
    const f32x2* tab = (const f32x2*)(a.ws + WS_TAB);
    const int nun = ctx_units ? 1088 : 1024;
    PROBE_REPEAT_ATTN
    for (int id = vcu; id < nun; id += G) {
        int b, h, row0, seq, tok0; bool rope;
        if (id < 1024) { const int bk = id >> 6; b = bk >> 2; h = (bk & 3) * 4 + ((id & 63) >> 4); const int qb = id & 15; row0 = b * TB + CTX + qb * 256; seq = TB; tok0 = qb * 256; rope = true; }
        else { const int j = id - 1024; b = j >> 4; h = j & 15; row0 = b * TB; seq = CTX; tok0 = 0; rope = false; }
        const int kvh = h >> 2;
        att::attn_body<128, 2048, 512, 512, 2048>(Q + (size_t)row0 * 2048 + h * 128, K + (size_t)b * TB * 512 + kvh * 128, V + (size_t)b * TB * 512 + kvh * 128,
                                                  O + (size_t)row0 * 2048 + h * 128, seq, lds, qg, tab, rope, tok0);
    }
}
__device__ __forceinline__ void ph_attn_mla(const Args& a, char* lds, bool ctx_units, int vcu, int G) {
    const bf16_t* Q = (const bf16_t*)(a.ws + WS_MQ); const bf16_t* K = (const bf16_t*)(a.ws + WS_MK); const bf16_t* V = (const bf16_t*)(a.ws + WS_MV); bf16_t* O = (bf16_t*)(a.ws + WS_MO);
    const f32x2* tab = (const f32x2*)(a.ws + WS_TAB + 16384);
    const int nun = ctx_units ? 1088 : 1024;
    PROBE_REPEAT_ATTN
    for (int id = vcu; id < nun; id += G) {
        int b, h, row0, seq, tok0; bool rope;
        if (id < 1024) { const int bh = id >> 4; b = bh >> 4; h = bh & 15; const int qb = id & 15; row0 = b * TB + CTX + qb * 256; seq = TB; tok0 = qb * 256; rope = true; }
        else { const int j = id - 1024; b = j >> 4; h = j & 15; row0 = b * TB; seq = CTX; tok0 = 0; rope = false; }
        att::attn_body<192, 3072, 3072, 2048, 2048>(Q + (size_t)row0 * 3072 + h * 192, K + (size_t)b * TB * 3072 + h * 192, V + (size_t)b * TB * DM + h * 128,
                                                    O + (size_t)row0 * DM + h * 128, seq, lds, nullptr, tab, rope, tok0);
    }
}

constexpr int NPHASES = 39;
__global__ void __launch_bounds__(NWAVES * 64, 2) trunk_fwd(Args a) {
    extern __shared__ __attribute__((aligned(16))) unsigned char lds_raw[];
    LAS unsigned char* lds = (LAS unsigned char*)lds_raw;
    const int tid = threadIdx.x, lane = tid & 63, wave = __builtin_amdgcn_readfirstlane(tid >> 6);
    const int G = gridDim.x; const int bx = blockIdx.x; const int vcu = (G % 8 == 0) ? (bx % 8) * (G / 8) + bx / 8 : bx;
    const int gw = vcu * NWAVES + wave, NGW = G * NWAVES;
    unsigned char* ws = a.ws;
    for (int u = tid; u < (LDS_BYTES - LDSCTL_OFF) / 4; u += NWAVES * 64) ((LAS unsigned*)(lds + LDSCTL_OFF))[u] = 0u;
    __syncthreads();
    const int lo = a.ph_lo, hi = a.ph_hi;
    const bool use_bar = (hi - lo) > 1;
    XcdBarrier bar; bar.bar = (unsigned*)(ws + WS_CTL) + 1024; bar.x = 0; bar.st = nullptr;
    if (use_bar) bar = xcd_barrier_post((unsigned*)(ws + WS_CTL) + 1024, (volatile LAS unsigned*)(lds + LDSCTL_OFF + 64));
    int ph = 0;
#ifndef PH_FILTER
#define PH_FILTER(p) true
#endif
#define PH_BEGIN if (PH_FILTER(ph) && ph >= lo && ph < hi) {
#define PH_END   if (ph + 1 < hi) xcd_barrier(bar); } ++ph;

    PH_BEGIN ph_mods(a, lds, vcu, G); __syncthreads(); ph_transposes(a, lds, vcu, G); PH_END
    PH_BEGIN ph_init(a, gw, NGW, lane); PH_END

    bf16_t* const Hb = (bf16_t*)(ws + WS_H);
    float* const OUTF = (float*)(ws + WS_OUTF);
    bf16_t* const ACT = (bf16_t*)(ws + WS_ACT);

    float* const PARTB = (float*)(ws + WS_PART);
#define MLP_PHASES(L) \
    PH_BEGIN ph_ln<false, 1>(a, L, 0, gw, NGW, lane); PH_END \
    PH_BEGIN run_gemm(lds, Hb, DM, (const bf16_t*)(ws + WS_W1T) + (size_t)(L) * DFF * DM, DM, DFF, DM, 0, FRelu2{ACT}, G); PH_END \
    PH_BEGIN run_gemm_out(lds, ACT, DFF, (const bf16_t*)(ws + WS_W2T) + (size_t)(L) * DM * DFF, DFF, 8, OUTF, PARTB, G); PH_END \
    PH_BEGIN ph_ln<false, 1>(a, L, 1, gw, NGW, lane); PH_END
#define MLP_PHASES_LAST(L) \
    PH_BEGIN ph_ln<false, 2>(a, L, 0, gw, NGW, lane); PH_END \
    PH_BEGIN run_gemm_lat(lds, Hb, DM, (const bf16_t*)(ws + WS_W1T) + (size_t)(L) * DFF * DM, DM, DFF, DM, FRelu2{ACT}, G); PH_END \
    PH_BEGIN run_gemm_out(lds, ACT, DFF, (const bf16_t*)(ws + WS_W2T) + (size_t)(L) * DM * DFF, DFF, 0, OUTF, PARTB, G); PH_END \
    PH_BEGIN ph_ln<true, 2>(a, L, 1, gw, NGW, lane); PH_END

#define GQA_LAYER(L, SLOT, LASTL) \
    PH_BEGIN run_gemm(lds, Hb, DM, (const bf16_t*)(ws + WS_GQAW + (SLOT) * 20 * MiB), DM, 3072, DM, 0, FQkv{(bf16_t*)(ws + WS_GQ), (bf16_t*)(ws + WS_GK), (bf16_t*)(ws + WS_GV), nullptr, 0, 0}, G); PH_END \
    PH_BEGIN ph_knorm(a, a.gqa_k_g + (SLOT) * 128, gw, NGW, lane); PH_END \
    PH_BEGIN ph_attn_gqa(a, (char*)lds_raw, a.gqa_q_g + (SLOT) * 128, !(LASTL), vcu, G); PH_END \
    PH_BEGIN run_gemm_out(lds, (const bf16_t*)(ws + WS_GO), DM, (const bf16_t*)(ws + WS_GQAW + (SLOT) * 20 * MiB + 12 * MiB), DM, (LASTL) ? 0 : 8, OUTF, PARTB, G); PH_END

    GQA_LAYER(0, 0, false)
    MLP_PHASES(0)
    PH_BEGIN run_gemm(lds, Hb, DM, (const bf16_t*)(ws + WS_LRUW), DM, 4096, DM, 0, FLruXY{(bf16_t*)(ws + WS_LUP), (bf16_t*)(ws + WS_LGY), false}, G); PH_END
    PH_BEGIN ph_conv(a, gw, NGW, lane); PH_END
    PH_BEGIN { EpiGates eg{(float*)(ws + WS_LAF), (const bf16_t*)(ws + WS_LU), a.lru_ra_b, a.lru_ix_b, (const float*)(ws + WS_TAB + 32768)};
               pg8::Gemm g{(const bf16_t*)(ws + WS_LU), (const bf16_t*)(ws + WS_LRUW + 16 * MiB), R, 8192, 256, DM, 256, 1}; pg8::StaticOrder S; S.init(R, 8192, 256, G, (int)blockIdx.x);
               PROBE_REPEAT_GEMM
               pg8::gemm_phase<EpiGates, pg8::StaticOrder, true, true>(lds, g, S, eg); } PH_END
    PH_BEGIN ph_scan1(a, gw, NGW, lane); PH_END
    PH_BEGIN ph_scan2(a, vcu * 512 + tid, G * 512); PH_END
    PH_BEGIN ph_scan3(a, gw, NGW, lane); PH_END
    PH_BEGIN run_gemm_out(lds, (const bf16_t*)(ws + WS_LG), DM, (const bf16_t*)(ws + WS_LRUW + 20 * MiB), DM, 8, OUTF, PARTB, G); PH_END
    MLP_PHASES(1)
    PH_BEGIN run_gemm(lds, Hb, DM, (const bf16_t*)(ws + WS_MLAW), DM, 1280, DM, 0, FStoreF32{(float*)(ws + WS_MAP), 1280}, G); PH_END
    PH_BEGIN ph_mla_norm(a, gw, NGW, lane); PH_END
    PH_BEGIN run_gemm(lds, (const bf16_t*)(ws + WS_MQAN), 512, (const bf16_t*)(ws + WS_MLAW + 5 * MiB), 512, 3072, 512, 0, FBf16{(bf16_t*)(ws + WS_MQ), 3072}, G); PH_END
    PH_BEGIN run_gemm(lds, (const bf16_t*)(ws + WS_MCKVN), 512, (const bf16_t*)(ws + WS_MLAW + 8 * MiB), 512, 4096, 512, 0, FKvb{(bf16_t*)(ws + WS_MK), (bf16_t*)(ws + WS_MV)}, G); PH_END
    PH_BEGIN ph_attn_mla(a, (char*)lds_raw, true, vcu, G); PH_END
    PH_BEGIN run_gemm_out(lds, (const bf16_t*)(ws + WS_MO), DM, (const bf16_t*)(ws + WS_MLAW + 12 * MiB), DM, 8, OUTF, PARTB, G); PH_END
    MLP_PHASES(2)
    GQA_LAYER(3, 1, true)
    MLP_PHASES_LAST(3)
#undef PH_BEGIN
#undef PH_END
}

#ifndef MK_SPLIT
#define MK_SPLIT 0
#endif
extern "C" void kernel_launch(void* const* d_in, const int* in_sizes, int n_in, void* d_out, int out_size, void* d_ws, size_t ws_size, hipStream_t stream) {
    static int grid = 0;
    if (grid == 0) {
        if (n_in != 33 || in_sizes[0] != NB * SEQ * DM || out_size != NB * SEQ * DM || ws_size < WS_END) {
            fprintf(stderr, "kernel_launch: unexpected shapes: n_in %d in0 %d out %d ws %zu (need %zu)\n", n_in, n_in > 0 ? in_sizes[0] : -1, out_size, ws_size, (size_t)WS_END); grid = -1; return; }
        int dev = 0, cus = 0;
        if (hipGetDevice(&dev) != hipSuccess || hipDeviceGetAttribute(&cus, hipDeviceAttributeMultiprocessorCount, dev) != hipSuccess) { grid = -1; return; }
        if (hipFuncSetAttribute((const void*)trunk_fwd, hipFuncAttributeMaxDynamicSharedMemorySize, LDS_BYTES) != hipSuccess) { fprintf(stderr, "kernel_launch: hipFuncSetAttribute failed\n"); grid = -1; return; }
        int per_cu = 0;
        if (hipOccupancyMaxActiveBlocksPerMultiprocessor(&per_cu, (const void*)trunk_fwd, NWAVES * 64, LDS_BYTES) != hipSuccess || per_cu < 1)
            fprintf(stderr, "kernel_launch: occupancy query reports %d workgroups per CU\n", per_cu);
        (void)hipGetLastError();
        grid = cus;
    }
    if (grid < 0) return;
    if (hipMemsetAsync((char*)d_ws + WS_CTL, 0, CTL_ZERO_BYTES, stream) != hipSuccess) return;
    Args a{};
    const float** p = (const float**)&a;
    for (int i = 0; i < 33; ++i) p[i] = (const float*)d_in[i];
    a.out = (float*)d_out; a.ws = (unsigned char*)d_ws;
#if MK_SPLIT
    for (int k = 0; k < NPHASES; ++k) { a.ph_lo = k; a.ph_hi = k + 1; hipLaunchKernelGGL(trunk_fwd, dim3(grid), dim3(NWAVES * 64), LDS_BYTES, stream, a); }
#else
    a.ph_lo = 0; a.ph_hi = NPHASES; hipLaunchKernelGGL(trunk_fwd, dim3(grid), dim3(NWAVES * 64), LDS_BYTES, stream, a);
#endif
    const hipError_t le = hipPeekAtLastError();
    if (le != hipSuccess) fprintf(stderr, "kernel_launch: launch failed: %s\n", hipGetErrorName(le));
}
```

```cpp
#include <hip/hip_runtime.h>
#include <cstdio>
#include <cstdint>
#include <cmath>

#define LAS __attribute__((address_space(3)))
#define GAS __attribute__((address_space(1)))
typedef unsigned short bf16_t;
typedef short bf16x8 __attribute__((ext_vector_type(8)));
typedef short s16x4 __attribute__((ext_vector_type(4)));
typedef float f32x4 __attribute__((ext_vector_type(4)));
typedef float f32x2 __attribute__((ext_vector_type(2)));
typedef float f32x16 __attribute__((ext_vector_type(16)));
typedef unsigned u32x4 __attribute__((ext_vector_type(4)));
typedef unsigned u32x2 __attribute__((ext_vector_type(2)));

__device__ __forceinline__ unsigned cvt_pk_bf16(float lo, float hi) { unsigned r; asm volatile("v_cvt_pk_bf16_f32 %0, %1, %2" : "=v"(r) : "v"(lo), "v"(hi)); return r; }
__device__ __forceinline__ float bf_lo(unsigned w) { return __uint_as_float(w << 16); }
__device__ __forceinline__ float bf_hi(unsigned w) { return __uint_as_float(w & 0xffff0000u); }
__device__ __forceinline__ float bf2f(bf16_t h) { return __uint_as_float(((unsigned)h) << 16); }
__device__ __forceinline__ bf16_t f2bf(float f) { return (bf16_t)(cvt_pk_bf16(f, f) & 0xffffu); }

constexpr int DM = 2048, NB = 4, SEQ = 4096, CTX = 256, TB = SEQ + CTX  , R = NB * TB  , DFF = 8192, DEPTH = 4;
constexpr float LN_EPS = 1e-6f;
constexpr float DN_ALPHA = 1.6817928305074290861f;

namespace pg8 {
constexpr int BM = 256, BK = 64, HALF = 128, HTB = HALF * BK * 2, STAGE_BYTES = 8 * HTB, NXCD = 8, WGM = 8;
__host__ __device__ __forceinline__ int lds_byte(int r, int c) { const int st = (r >> 4) * 2 + (c >> 5), rr = r & 15, cc = c & 31, ob = rr * 64 + cc * 2; return st * 1024 + (ob ^ (((ob >> 9) & 1) << 5)); }
__host__ __device__ __forceinline__ void stage_rc(int b, int& Rr, int& C) { const int st = b / 1024, sb = b % 1024, swz = sb ^ (((sb >> 9) & 1) << 5); Rr = (st >> 1) * 16 + swz / 64; C = (st & 1) * 32 + (swz % 64) / 2; }
__host__ __device__ __forceinline__ int perm32(int rho) { const int n = rho >> 4, i = rho & 15; return 8 * (i >> 2) + 4 * n + (i & 3); }

struct Unit { int pm, pn, k0, nk, slice; };
struct Gemm { const bf16_t* A; const bf16_t* Bt; int M, N, K, lda, ldb, a_blk; };

struct StaticOrder {
    int nM, nN, nwg, G, c, nt;
    __device__ __forceinline__ void init(int M, int N, int K, int G_, int c_) { nM = M / BM; nN = N / BM; nwg = nM * nN; G = G_; c = c_; nt = K / BK; }
    __device__ __forceinline__ Unit next(int i) const {
        const long L = (long)i * G + c; if (L >= nwg) return Unit{-1, 0, 0, 0, -1};
        int wgid = (int)L; { const int q = nwg / NXCD, r = nwg % NXCD, xcd = wgid % NXCD, off = wgid / NXCD; wgid = (xcd < r ? xcd * (q + 1) : r * (q + 1) + (xcd - r) * q) + off; }
        const int nig = WGM * nN, gid = wgid / nig, fm = gid * WGM, gsz = (nM - fm) < WGM ? (nM - fm) : WGM;
        return Unit{fm + ((wgid % nig) % gsz), (wgid % nig) / gsz, 0, nt, -1};
    }
};
struct LatOrder {
    int nN, nwg, G, c, nt, SK;
    __device__ __forceinline__ void init(int N, int K, int G_, int c_, int SK_) { nN = N / BM; nwg = 64 * nN; G = G_; c = c_; nt = K / BK; SK = SK_; }
    __device__ __forceinline__ Unit next(int i) const {
        const int nlat = c < nwg ? (nwg - c + G - 1) / G : 0;
        if (i < nlat) {
            int wgid = i * G + c; { const int q = nwg / NXCD, r = nwg % NXCD, xcd = wgid % NXCD, off = wgid / NXCD; wgid = (xcd < r ? xcd * (q + 1) : r * (q + 1) + (xcd - r) * q) + off; }
            const int nig = WGM * nN, gid = wgid / nig, fm = gid * WGM;
            const int lp = fm + ((wgid % nig) % WGM);
            return Unit{(lp >> 4) * 17 + 1 + (lp & 15), (wgid % nig) / WGM, 0, nt, -1};
        }
        if (SK > 0 && i == nlat && c < 4 * nN * SK) { const int t = c / SK, sl = c % SK, nks = nt / SK; return Unit{17 * (t / nN), t % nN, sl * nks, nks, sl}; }
        return Unit{-1, 0, 0, 0, -1};
    }
};

template <class F> struct EpiRow8 {
    static constexpr bool PERM = true;
    F f;
    __device__ __forceinline__ void operator()(const f32x4 (&acc)[2][2][4][2], const Unit& u, int wr, int wc, int fr, int fq) {
        const int row0 = u.pm * BM + wr * 64 + fr, colb = u.pn * BM + wc * 32 + 8 * fq;
        f.begin(u, colb);
#pragma unroll
        for (int ai = 0; ai < 2; ++ai)
#pragma unroll
            for (int m = 0; m < 4; ++m) {
                const int row = row0 + ai * HALF + m * 16;
#pragma unroll
                for (int bj = 0; bj < 2; ++bj) f.row8(row, bj, colb + bj * HALF, acc[ai][bj][m][0], acc[ai][bj][m][1]);
            }
    }
};

template <class Epi, class Sched, bool ALIGN_EPI = true, bool SP2 = true>
__device__ __forceinline__ void gemm_phase(LAS unsigned char* lds, const Gemm g, const Sched& S, Epi& E) {
    const int tid = threadIdx.x, wid = __builtin_amdgcn_readfirstlane(tid >> 6), lane = tid & 63, wr = wid >> 2, wc = wid & 3, fr = lane & 15, fq = lane >> 4;
    unsigned voffA[2], voffB[2];
#pragma unroll
    for (int i = 0; i < 2; ++i) { int Rr, C; stage_rc(tid * 16 + i * 8192, Rr, C); const int Rb = Epi::PERM ? ((Rr & ~31) + perm32(Rr & 31)) : Rr;
        voffA[i] = (unsigned)(Rr * g.lda + C) * 2u; voffB[i] = (unsigned)(Rb * g.ldb + C) * 2u; }
    const size_t kstep = (size_t)(BK * 2);
    const size_t hstepA = (size_t)HALF * g.lda * 2, hstepB = (size_t)HALF * g.ldb * 2;
    const size_t tstepA = 2 * hstepA, tstepB = 2 * hstepB;
    const unsigned ldsw = (unsigned)wid * 1024u;
    const int aoff = lds_byte(wr * 64 + fr, fq * 8), boff = lds_byte(wc * 32 + fr, fq * 8);
#define PG8_SA(b, h) (((b) * 2 + (h)) * HTB)
#define PG8_SB(b, h) ((4 + (b) * 2 + (h)) * HTB)
#define PG8_STAGE(bufoff, gbase, voff) do { _Pragma("unroll") for (int _i = 0; _i < 2; ++_i) \
        __builtin_amdgcn_global_load_lds((const unsigned*)((const char*)(gbase) + (voff)[_i]), (LAS unsigned*)(lds + (bufoff) + ldsw + _i * 8192), 16, 0, 0); } while (0)
#define PG8_LDA(dst, b, h) do { _Pragma("unroll") for (int m = 0; m < 4; ++m) _Pragma("unroll") for (int k = 0; k < 2; ++k) dst[m][k] = *(const LAS bf16x8*)(lds + PG8_SA(b, h) + aoff + m * 2048 + k * 1024); } while (0)
#define PG8_LDB(dst, b, h) do { _Pragma("unroll") for (int n = 0; n < 2; ++n) _Pragma("unroll") for (int k = 0; k < 2; ++k) dst[n][k] = *(const LAS bf16x8*)(lds + PG8_SB(b, h) + boff + n * 2048 + k * 1024); } while (0)
#define PG8_MMA(ai, bj, At, Bt) do { __builtin_amdgcn_s_setprio(1); _Pragma("unroll") for (int m = 0; m < 4; ++m) _Pragma("unroll") for (int n = 0; n < 2; ++n) _Pragma("unroll") for (int k = 0; k < 2; ++k) \
        acc[ai][bj][m][n] = __builtin_amdgcn_mfma_f32_16x16x32_bf16(Bt[n][k], At[m][k], acc[ai][bj][m][n], 0, 0, 0); __builtin_amdgcn_s_setprio(0); } while (0)
#define PG8_WAIT_V(n) asm volatile("s_waitcnt vmcnt(" #n ")" ::: "memory")
#define PG8_WAIT_L(n) asm volatile("s_waitcnt lgkmcnt(" #n ")" ::: "memory")
#define PG8_BAR __builtin_amdgcn_s_barrier()
#define PG8_SCHED __builtin_amdgcn_sched_barrier(0)
    Unit cur = S.next(0), nxt = cur; int ui = 0;
    if (cur.pm < 0) return;
    f32x4 acc[2][2][4][2];
#pragma unroll
    for (int a = 0; a < 2; ++a)
#pragma unroll
        for (int b = 0; b < 2; ++b)
#pragma unroll
            for (int m = 0; m < 4; ++m)
#pragma unroll
                for (int n = 0; n < 2; ++n) acc[a][b][m][n] = (f32x4){0.f, 0.f, 0.f, 0.f};
    bf16x8 At[4][2], B0[2][2], B1[2][2];
    const char* cA = (const char*)g.A + (size_t)cur.pm * tstepA + (size_t)(g.a_blk ? (cur.pn & 7) * 512 : 0) + (size_t)cur.k0 * kstep; const char* cB = (const char*)g.Bt + (size_t)cur.pn * tstepB + (size_t)cur.k0 * kstep;
    if constexpr (SP2) {
        PG8_STAGE(PG8_SB(0, 0), cB, voffB); PG8_STAGE(PG8_SB(0, 1), cB + hstepB, voffB); PG8_STAGE(PG8_SA(0, 0), cA, voffA); PG8_STAGE(PG8_SA(0, 1), cA + hstepA, voffA);
        if (wr == 1) PG8_BAR;
        PG8_WAIT_V(2); PG8_BAR;
        PG8_STAGE(PG8_SB(1, 0), cB + kstep, voffB); PG8_STAGE(PG8_SA(1, 0), cA + kstep, voffA); PG8_STAGE(PG8_SB(1, 1), cB + hstepB + kstep, voffB);
        PG8_WAIT_V(6); PG8_BAR;
    } else {
        PG8_STAGE(PG8_SB(0, 0), cB, voffB); PG8_STAGE(PG8_SA(0, 0), cA, voffA); PG8_STAGE(PG8_SB(0, 1), cB + hstepB, voffB); PG8_STAGE(PG8_SA(0, 1), cA + hstepA, voffA);
        if (wr == 1) PG8_BAR;
        PG8_WAIT_V(4); PG8_BAR;
        PG8_STAGE(PG8_SB(1, 0), cB + kstep, voffB); PG8_STAGE(PG8_SA(1, 0), cA + kstep, voffA); PG8_STAGE(PG8_SB(1, 1), cB + hstepB + kstep, voffB);
        PG8_WAIT_V(6); PG8_BAR;
    }
    for (;;) {
        nxt = S.next(ui + 1); const bool has_next = nxt.pm >= 0;
        const char* nA = has_next ? (const char*)g.A + (size_t)nxt.pm * tstepA + (size_t)(g.a_blk ? (nxt.pn & 7) * 512 : 0) + (size_t)nxt.k0 * kstep : cA; const char* nB = has_next ? (const char*)g.Bt + (size_t)nxt.pn * tstepB + (size_t)nxt.k0 * kstep : cB;
        const int nt = cur.nk;
#pragma unroll 1
        for (int t = 0; t < nt; t += 2) {
            const bool last = (t == nt - 2);
            const char* a1 = cA + (size_t)(t + 1) * kstep;
            const char* a2 = last ? nA : cA + (size_t)(t + 2) * kstep; const char* b2 = last ? nB : cB + (size_t)(t + 2) * kstep;
            const char* a3 = a2 + kstep; const char* b3 = b2 + kstep;
            if constexpr (SP2) {
            PG8_LDB(B0, 0, 0); PG8_LDB(B1, 0, 1); PG8_SCHED; PG8_LDA(At, 0, 0); PG8_STAGE(PG8_SA(1, 1), a1 + hstepA, voffA);
            PG8_WAIT_V(8); PG8_WAIT_L(0); PG8_BAR; PG8_MMA(0, 0, At, B0); PG8_MMA(0, 1, At, B1); PG8_BAR; PG8_SCHED;
            PG8_LDA(At, 0, 1); PG8_STAGE(PG8_SB(0, 0), b2, voffB); PG8_STAGE(PG8_SB(0, 1), b2 + hstepB, voffB); PG8_STAGE(PG8_SA(0, 0), a2, voffA);
            PG8_WAIT_V(8); PG8_WAIT_L(0); PG8_BAR; PG8_MMA(1, 0, At, B0); PG8_MMA(1, 1, At, B1); PG8_BAR; PG8_SCHED;
            PG8_LDB(B0, 1, 0); PG8_LDB(B1, 1, 1); PG8_SCHED; PG8_LDA(At, 1, 0); PG8_STAGE(PG8_SA(0, 1), a2 + hstepA, voffA);
            PG8_WAIT_V(8); PG8_WAIT_L(0); PG8_BAR; PG8_MMA(0, 0, At, B0); PG8_MMA(0, 1, At, B1); PG8_BAR; PG8_SCHED;
            PG8_LDA(At, 1, 1); PG8_STAGE(PG8_SB(1, 0), b3, voffB); PG8_STAGE(PG8_SB(1, 1), b3 + hstepB, voffB); PG8_STAGE(PG8_SA(1, 0), a3, voffA);
            PG8_WAIT_V(8); PG8_WAIT_L(0); PG8_BAR; PG8_MMA(1, 0, At, B0); PG8_MMA(1, 1, At, B1); PG8_BAR; PG8_SCHED;
            } else {
            PG8_LDB(B0, 0, 0); PG8_SCHED; PG8_LDA(At, 0, 0); PG8_STAGE(PG8_SA(1, 1), a1 + hstepA, voffA);
            PG8_WAIT_L(8); PG8_BAR; PG8_WAIT_L(0); PG8_MMA(0, 0, At, B0); PG8_BAR; PG8_SCHED;
            PG8_LDB(B1, 0, 1); PG8_STAGE(PG8_SB(0, 0), b2, voffB);
            PG8_BAR; PG8_WAIT_L(0); PG8_MMA(0, 1, At, B1); PG8_BAR;
            PG8_LDA(At, 0, 1); PG8_STAGE(PG8_SA(0, 0), a2, voffA);
            PG8_BAR; PG8_WAIT_L(0); PG8_MMA(1, 0, At, B0); PG8_BAR; PG8_SCHED;
            PG8_STAGE(PG8_SB(0, 1), b2 + hstepB, voffB);
            PG8_WAIT_V(6); PG8_BAR; PG8_MMA(1, 1, At, B1); PG8_BAR;
            PG8_LDB(B0, 1, 0); PG8_SCHED; PG8_LDA(At, 1, 0); PG8_STAGE(PG8_SA(0, 1), a2 + hstepA, voffA);
            PG8_WAIT_L(8); PG8_BAR; PG8_WAIT_L(0); PG8_MMA(0, 0, At, B0); PG8_BAR; PG8_SCHED;
            PG8_LDB(B1, 1, 1); PG8_STAGE(PG8_SB(1, 0), b3, voffB);
            PG8_BAR; PG8_WAIT_L(0); PG8_MMA(0, 1, At, B1); PG8_BAR;
            PG8_LDA(At, 1, 1); PG8_STAGE(PG8_SA(1, 0), a3, voffA);
            PG8_BAR; PG8_WAIT_L(0); PG8_MMA(1, 0, At, B0); PG8_BAR; PG8_SCHED;
            PG8_STAGE(PG8_SB(1, 1), b3 + hstepB, voffB);
            PG8_WAIT_V(6); PG8_BAR; PG8_MMA(1, 1, At, B1); PG8_BAR;
            }
        }
        if constexpr (ALIGN_EPI) { if (wr == 0) PG8_BAR; }
        E(acc, cur, wr, wc, fr, fq);
        if (!has_next) break;
#pragma unroll
        for (int a = 0; a < 2; ++a)
#pragma unroll
            for (int b = 0; b < 2; ++b)
#pragma unroll
                for (int m = 0; m < 4; ++m)
#pragma unroll
                    for (int n = 0; n < 2; ++n) acc[a][b][m][n] = (f32x4){0.f, 0.f, 0.f, 0.f};
        cur = nxt; cA = nA; cB = nB; ++ui;
        if constexpr (ALIGN_EPI) { if (wr == 1) PG8_BAR; }
    }
    PG8_WAIT_V(0);
    if constexpr (!ALIGN_EPI) { if (wr == 0) PG8_BAR; }
    PG8_BAR;
#undef PG8_SA
#undef PG8_SB
#undef PG8_STAGE
#undef PG8_LDA
#undef PG8_LDB
#undef PG8_MMA
#undef PG8_WAIT_V
#undef PG8_WAIT_L
#undef PG8_BAR
#undef PG8_SCHED
}
}

namespace att {
constexpr int NW = 8, QBLK = 32, KVBLK = 64, DV = 128;
constexpr float THR = 8.f;
#define SBAR() __builtin_amdgcn_sched_barrier(0)
__device__ __forceinline__ int crow(int r, int hi) { return (r & 3) + 8 * (r >> 2) + 4 * hi; }
template <int DQK> struct Cfg {
    static constexpr int KROW = DQK * 2;
    static constexpr int SHM_K = KVBLK * KROW, SHM_V = KVBLK * DV * 2;
    static constexpr int QPE_OFF = 2 * SHM_V + 2 * SHM_K + NW * 64 * 4;
    static constexpr int LDS_BYTES = QPE_OFF + (DQK == 192 ? NW * 4096 : 0);
    static constexpr int NQ = DQK / 16;
    static constexpr int NKC = DQK / 64;
};
template <int DQK> __device__ __forceinline__ int kswz(int row, int colB) { return row * (DQK * 2) + (colB ^ ((row & 7) << 4)); }

template <int DQK>
__device__ __forceinline__ void partialSM(f32x16& p0, f32x16& p1, float& m_reg, float& mn, float& alpha) {
    constexpr float SCALE = DQK == 128 ? 0.08838834764831845f : 0.07216878364870322f;
    constexpr float C = SCALE * 1.4426950408889634f;
    float pmax = p0[0];
#pragma unroll
    for (int r = 1; r < 16; ++r) pmax = fmaxf(pmax, p0[r]);
#pragma unroll
    for (int r = 0; r < 16; ++r) pmax = fmaxf(pmax, p1[r]);
    { auto rr = __builtin_amdgcn_permlane32_swap(__float_as_uint(pmax), __float_as_uint(pmax), false, false);
      pmax = fmaxf(__uint_as_float(rr[0]), __uint_as_float(rr[1])); }
    if (__builtin_expect(__all(pmax - m_reg <= THR / SCALE), 1)) { mn = m_reg; alpha = 1.f; }
    else { mn = fmaxf(m_reg, pmax); alpha = __builtin_amdgcn_exp2f((m_reg - mn) * C); m_reg = mn; }
    const float mnC = -mn * C;
#pragma unroll
    for (int r = 0; r < 16; ++r) p0[r] = fmaf(p0[r], C, mnC);
#pragma unroll
    for (int r = 0; r < 16; ++r) p1[r] = fmaf(p1[r], C, mnC);
#pragma unroll
    for (int r = 0; r < 16; ++r) p0[r] = __builtin_amdgcn_exp2f(p0[r]);
}
__device__ __forceinline__ void finishSM(f32x16& p0, f32x16& p1, float alpha, float& l_reg, bf16x8& pa0, bf16x8& pa1, bf16x8& pa2, bf16x8& pa3) {
#pragma unroll
    for (int r = 0; r < 16; ++r) p1[r] = __builtin_amdgcn_exp2f(p1[r]);
    float ps = 0;
#pragma unroll
    for (int r = 0; r < 16; ++r) ps += p0[r];
#pragma unroll
    for (int r = 0; r < 16; ++r) ps += p1[r];
    { auto rr = __builtin_amdgcn_permlane32_swap(__float_as_uint(ps), __float_as_uint(ps), false, false);
      ps = __uint_as_float(rr[0]) + __uint_as_float(rr[1]); }
    l_reg = l_reg * alpha + ps;
#define PK4(P, BASE, OUT) do { unsigned a0 = cvt_pk_bf16(P[BASE + 0], P[BASE + 1]), a1 = cvt_pk_bf16(P[BASE + 2], P[BASE + 3]);   \
    unsigned b0 = cvt_pk_bf16(P[BASE + 4], P[BASE + 5]), b1 = cvt_pk_bf16(P[BASE + 6], P[BASE + 7]);                              \
    auto r0 = __builtin_amdgcn_permlane32_swap(a0, b0, false, false); auto r1 = __builtin_amdgcn_permlane32_swap(a1, b1, false, false); \
    u32x4 w = {r0[0], r1[0], r0[1], r1[1]}; OUT = *reinterpret_cast<bf16x8*>(&w); } while (0)
    PK4(p0, 0, pa0); PK4(p0, 8, pa1); PK4(p1, 0, pa2); PK4(p1, 8, pa3);
#undef PK4
}
template <int DQK>
__device__ __forceinline__ void qkt(f32x16& p0, f32x16& p1, const char* Ks, const bf16x8* qr, const char* qpe, int r32, int hi) {
    p0 = f32x16{}; p1 = f32x16{};
#pragma unroll
    for (int d0 = 0; d0 < DQK / 16; ++d0) { const int cb = (d0 * 16 + hi * 8) * 2;
        bf16x8 b0 = *reinterpret_cast<const bf16x8*>(Ks + kswz<DQK>(r32, cb));
        bf16x8 b1 = *reinterpret_cast<const bf16x8*>(Ks + kswz<DQK>(32 + r32, cb));
        bf16x8 q; if (d0 < 8) q = qr[d0 < 8 ? d0 : 0]; else q = *reinterpret_cast<const bf16x8*>(qpe + (d0 - 8) * 1024);
        p0 = __builtin_amdgcn_mfma_f32_32x32x16_bf16(b0, q, p0, 0, 0, 0);
        p1 = __builtin_amdgcn_mfma_f32_32x32x16_bf16(b1, q, p1, 0, 0, 0);
        if (DQK == 192 && (d0 & 3) == 3 && d0 != 11) SBAR(); }
}
__device__ __forceinline__ int v_st(int k, int c) { const int kk = (k & ~0xC) | ((k & 4) << 1) | ((k & 8) >> 1); return ((kk >> 3) * 4 + (c >> 5)) * 512 + ((kk & 7) * 32 + (c & 31)) * 2; }
__device__ __forceinline__ int v_rd_base(int lane) { return ((lane & 3) << 3) | (((lane >> 2) & 3) << 6) | (((lane >> 4) & 1) << 5) | (((lane >> 5) & 1) << 8); }
constexpr int v_rd_off(int d0, int ks, int half) { return d0 * 512 + ks * 4096 + half * 2048; }
template <int OFF> __device__ __forceinline__ s16x4 tr_read(int vb) {
    s16x4 r; asm volatile("ds_read_b64_tr_b16 %0, %1 offset:%2" : "=&v"(r) : "v"(vb), "i"(OFF) : "memory"); return r;
}
template <int D0> __device__ __forceinline__ void pv_one(f32x16& od, int vb, bf16x8 pa0, bf16x8 pa1, bf16x8 pa2, bf16x8 pa3) {
    const s16x4 l0 = tr_read<v_rd_off(D0, 0, 0)>(vb), h0 = tr_read<v_rd_off(D0, 0, 1)>(vb), l1 = tr_read<v_rd_off(D0, 1, 0)>(vb), h1 = tr_read<v_rd_off(D0, 1, 1)>(vb);
    const s16x4 l2 = tr_read<v_rd_off(D0, 2, 0)>(vb), h2 = tr_read<v_rd_off(D0, 2, 1)>(vb), l3 = tr_read<v_rd_off(D0, 3, 0)>(vb), h3 = tr_read<v_rd_off(D0, 3, 1)>(vb);
    asm volatile("s_waitcnt lgkmcnt(0)" ::: "memory"); SBAR();
#define PK(L, H) (bf16x8){L[0], L[1], L[2], L[3], H[0], H[1], H[2], H[3]}
    od = __builtin_amdgcn_mfma_f32_32x32x16_bf16(pa0, PK(l0, h0), od, 0, 0, 0);
    od = __builtin_amdgcn_mfma_f32_32x32x16_bf16(pa1, PK(l1, h1), od, 0, 0, 0);
    od = __builtin_amdgcn_mfma_f32_32x32x16_bf16(pa2, PK(l2, h2), od, 0, 0, 0);
    od = __builtin_amdgcn_mfma_f32_32x32x16_bf16(pa3, PK(l3, h3), od, 0, 0, 0);
#undef PK
}
__device__ __forceinline__ void pv_d0(f32x16* o, int vb, bf16x8 pa0, bf16x8 pa1, bf16x8 pa2, bf16x8 pa3) {
    pv_one<0>(o[0], vb, pa0, pa1, pa2, pa3); pv_one<1>(o[1], vb, pa0, pa1, pa2, pa3); pv_one<2>(o[2], vb, pa0, pa1, pa2, pa3); pv_one<3>(o[3], vb, pa0, pa1, pa2, pa3);
}
__device__ __forceinline__ void unpack8(bf16x8 v, float* f) {
    const u32x4 w = *reinterpret_cast<const u32x4*>(&v);
    f[0] = bf_lo(w.x); f[1] = bf_hi(w.x); f[2] = bf_lo(w.y); f[3] = bf_hi(w.y); f[4] = bf_lo(w.z); f[5] = bf_hi(w.z); f[6] = bf_lo(w.w); f[7] = bf_hi(w.w);
}
__device__ __forceinline__ bf16x8 pack8(const float* f) {
    u32x4 w = {cvt_pk_bf16(f[0], f[1]), cvt_pk_bf16(f[2], f[3]), cvt_pk_bf16(f[4], f[5]), cvt_pk_bf16(f[6], f[7])}; return *reinterpret_cast<bf16x8*>(&w);
}
__device__ __forceinline__ void rope_pair(bf16x8& A, bf16x8& B, const f32x2* __restrict__ tab) {
    float a[8], b[8], ra[8], rb[8]; unpack8(A, a); unpack8(B, b);
#pragma unroll
    for (int j = 0; j < 8; ++j) { const f32x2 cs = tab[j]; ra[j] = a[j] * cs.x - b[j] * cs.y; rb[j] = b[j] * cs.x + a[j] * cs.y; }
    A = pack8(ra); B = pack8(rb);
}

template <int DQK, int LDQ, int LDK, int LDV, int LDO>
__device__ __forceinline__ void attn_body(const bf16_t* __restrict__ Qb, const bf16_t* __restrict__ Kh, const bf16_t* __restrict__ Vh, bf16_t* __restrict__ Ob, int seq, char* lds,
                                          const float* __restrict__ qg, const f32x2* __restrict__ tab, bool rope, int tok0) {
    using C = Cfg<DQK>;
    int tid_ = threadIdx.x; asm volatile("" : "+v"(tid_));
    const int tid = tid_, wid = tid >> 6, lane = tid & 63, r32 = lane & 31, hi = lane >> 5;
    char* V_lds = lds; char* K_lds = lds + 2 * C::SHM_V;
    float* wsf = (float*)(lds + 2 * C::SHM_V + 2 * C::SHM_K) + wid * 64; float* li_l = wsf; float* al_l = wsf + 32;
    char* qpe = lds + C::QPE_OFF + wid * 4096 + lane * 16;
    float m_reg = -1e30f, l_reg = 0; f32x16 o[4] = {}; bf16x8 qr[C::NQ];
    const bf16_t* Qw = Qb + (long)(wid * QBLK + r32) * LDQ + hi * 8;
#pragma unroll
    for (int d0 = 0; d0 < C::NQ; ++d0) qr[d0] = *reinterpret_cast<const bf16x8*>(Qw + d0 * 16);
    {
        const int t = tok0 + wid * QBLK + r32, prow = t >> 6, pcol = t & 63;
        if constexpr (DQK == 128) {
            float ss = 0.f;
#pragma unroll
            for (int d0 = 0; d0 < 8; ++d0) { float f[8]; unpack8(qr[d0], f);
#pragma unroll
                for (int j = 0; j < 8; ++j) ss += f[j] * f[j]; }
            ss += __shfl_xor(ss, 32);
            const float rstd = 1.0f / sqrtf(ss * (1.0f / 128.0f) + 1e-6f);
#pragma unroll
            for (int d0 = 0; d0 < 8; ++d0) { float f[8]; unpack8(qr[d0], f);
#pragma unroll
                for (int j = 0; j < 8; ++j) f[j] = f[j] * rstd * qg[d0 * 16 + hi * 8 + j];
                qr[d0] = pack8(f); }
            if (rope) {
                const f32x2* tr = tab + prow * 32 + hi * 8; const f32x2* tc = tab + pcol * 32 + hi * 8;
                rope_pair(qr[0], qr[2], tr); rope_pair(qr[1], qr[3], tr + 16);
                rope_pair(qr[4], qr[6], tc); rope_pair(qr[5], qr[7], tc + 16);
            }
        } else {
            if (rope) {
                const f32x2* tr = tab + prow * 16 + hi * 8; const f32x2* tc = tab + pcol * 16 + hi * 8;
                rope_pair(qr[8], qr[9], tr); rope_pair(qr[10], qr[11], tc);
            }
        }
    }
    if constexpr (DQK == 192) {
#pragma unroll
        for (int d0 = 8; d0 < 12; ++d0) *reinterpret_cast<bf16x8*>(qpe + (d0 - 8) * 1024) = qr[d0];
        asm volatile("s_waitcnt lgkmcnt(0)" ::: "memory");
    }
    const int sr = tid >> 4, sc = (tid & 15) * 8, vst0 = v_st(sr, sc), vst1 = v_st(32 + sr, sc);
    const int vb0 = (int)(uintptr_t)V_lds + v_rd_base(lane);
    const int sr2 = tid >> 3, sc2 = 128 + (tid & 7) * 8;
    struct Slot { bf16x8 vs0, vs1, ks0, ks1, ks2; };
    Slot sA, sBs;
#define sB (*(DQK == 192 ? &sA : &sBs))
#define SLOAD(S, k0) do { S.vs0 = *reinterpret_cast<const bf16x8*>(&Vh[(long)((k0) + sr) * LDV + sc]); S.vs1 = *reinterpret_cast<const bf16x8*>(&Vh[(long)((k0) + 32 + sr) * LDV + sc]); \
    S.ks0 = *reinterpret_cast<const bf16x8*>(&Kh[(long)((k0) + sr) * LDK + sc]); S.ks1 = *reinterpret_cast<const bf16x8*>(&Kh[(long)((k0) + 32 + sr) * LDK + sc]); \
    if constexpr (DQK == 192) S.ks2 = *reinterpret_cast<const bf16x8*>(&Kh[(long)((k0) + sr2) * LDK + sc2]); } while (0)
#define SWRITE(b, S) do { *(bf16x8*)(V_lds + (b) * C::SHM_V + vst0) = S.vs0; *(bf16x8*)(V_lds + (b) * C::SHM_V + vst1) = S.vs1; \
    *(bf16x8*)(K_lds + (b) * C::SHM_K + kswz<DQK>(sr, sc * 2)) = S.ks0; *(bf16x8*)(K_lds + (b) * C::SHM_K + kswz<DQK>(32 + sr, sc * 2)) = S.ks1; \
    if constexpr (DQK == 192) *(bf16x8*)(K_lds + (b) * C::SHM_K + kswz<DQK>(sr2, sc2 * 2)) = S.ks2; } while (0)
#define SWAIT() do { if constexpr (DQK == 192) asm volatile("s_waitcnt vmcnt(0)" ::: "memory"); else asm volatile("s_waitcnt vmcnt(4)" ::: "memory"); } while (0)
#define RESC(a) do { if (__any((a) < 1.f)) { if (hi == 0) al_l[r32] = (a); asm volatile("s_waitcnt lgkmcnt(0)" ::: "memory"); \
    _Pragma("unroll") for (int d = 0; d < 4; ++d) _Pragma("unroll") for (int r = 0; r < 16; ++r) o[d][r] *= al_l[crow(r, hi)]; } } while (0)
    f32x16 pA0, pA1, pB0, pB1; float mnA, mnB, alA, alB; bf16x8 pa0, pa1, pa2, pa3; const int NT = seq / KVBLK;
    SLOAD(sA, 0); asm volatile("s_waitcnt vmcnt(0)" ::: "memory"); SWRITE(0, sA); __syncthreads();
    qkt<DQK>(pA0, pA1, K_lds, qr, qpe, r32, hi); partialSM<DQK>(pA0, pA1, m_reg, mnA, alA);
    SLOAD(sB, KVBLK); if constexpr (DQK != 192) { if (2 < NT) SLOAD(sA, 2 * KVBLK); }
    SWAIT(); SWRITE(1, sB); __syncthreads();
    for (int j = 1; j + 1 < NT; j += 2) {
        SBAR(); qkt<DQK>(pB0, pB1, K_lds + C::SHM_K, qr, qpe, r32, hi);
        finishSM(pA0, pA1, alA, l_reg, pa0, pa1, pa2, pa3); SBAR();
        SLOAD(sB, (j + (DQK == 192 ? 1 : 2)) * KVBLK); SBAR();
        pv_d0(o, vb0, pa0, pa1, pa2, pa3); partialSM<DQK>(pB0, pB1, m_reg, mnB, alB);
        __syncthreads(); SWAIT(); SWRITE(0, sA);
        RESC(alB); __syncthreads();
        SBAR(); qkt<DQK>(pA0, pA1, K_lds, qr, qpe, r32, hi);
        finishSM(pB0, pB1, alB, l_reg, pa0, pa1, pa2, pa3); SBAR();
        if (DQK == 192 || j + 3 < NT) SLOAD(sA, (j + (DQK == 192 ? 2 : 3)) * KVBLK); SBAR();
        pv_d0(o, vb0 + C::SHM_V, pa0, pa1, pa2, pa3); partialSM<DQK>(pA0, pA1, m_reg, mnA, alA);
        __syncthreads(); SWAIT(); SWRITE(1, sB);
        RESC(alA); __syncthreads();
    }
    SBAR(); qkt<DQK>(pB0, pB1, K_lds + C::SHM_K, qr, qpe, r32, hi);
    finishSM(pA0, pA1, alA, l_reg, pa0, pa1, pa2, pa3); SBAR();
    pv_d0(o, vb0, pa0, pa1, pa2, pa3); partialSM<DQK>(pB0, pB1, m_reg, mnB, alB);
    __syncthreads(); RESC(alB);
    finishSM(pB0, pB1, alB, l_reg, pa0, pa1, pa2, pa3); SBAR();
    pv_d0(o, vb0 + C::SHM_V, pa0, pa1, pa2, pa3);
    if (hi == 0) li_l[r32] = l_reg; asm volatile("s_waitcnt lgkmcnt(0)" ::: "memory");
    float rli[16];
#pragma unroll
    for (int r = 0; r < 16; ++r) rli[r] = __builtin_amdgcn_rcpf(li_l[crow(r, hi)]);
    bf16_t* Ow = Ob + (long)(wid * QBLK) * LDO;
#pragma unroll
    for (int r = 0; r < 16; ++r) { const int orow = crow(r, hi);
#pragma unroll
        for (int d0 = 0; d0 < 4; ++d0) Ow[(long)orow * LDO + d0 * 32 + r32] = f2bf(o[d0][r] * rli[r]); }
    __syncthreads();
#undef sB
#undef SLOAD
#undef SWRITE
#undef SWAIT
#undef RESC
}
}

constexpr size_t MiB = 1u << 20;
constexpr size_t WS_CTL = 0, CTL_ZERO_BYTES = 1 * MiB;
constexpr size_t WS_MODS = 1 * MiB;
constexpr size_t WS_TAB = 2 * MiB;
constexpr size_t WS_X = 4 * MiB;
constexpr size_t WS_H = 140 * MiB;
constexpr size_t WS_OUTF = 208 * MiB;
constexpr size_t WS_W1T = 344 * MiB, WS_W2T = 472 * MiB;
constexpr size_t WS_GQAW = 600 * MiB;
constexpr size_t WS_LRUW = 640 * MiB;
constexpr size_t WS_MLAW = 668 * MiB;
constexpr size_t WS_BIG = 688 * MiB;
constexpr size_t WS_ACT = WS_BIG;
constexpr size_t WS_GQ = WS_BIG, WS_GK = WS_BIG + 68 * MiB, WS_GV = WS_BIG + 85 * MiB, WS_GO = WS_BIG + 102 * MiB;
constexpr size_t WS_MAP = WS_BIG, WS_MQAN = WS_BIG + 85 * MiB, WS_MCKVN = WS_BIG + 102 * MiB, WS_MQ = WS_BIG + 119 * MiB, WS_MK = WS_BIG + 221 * MiB, WS_MV = WS_BIG + 323 * MiB, WS_MO = WS_BIG + 391 * MiB;
constexpr size_t WS_LUP = WS_BIG, WS_LG = WS_BIG  , WS_LGY = WS_BIG + 68 * MiB, WS_LU = WS_BIG + 136 * MiB, WS_LAF = WS_BIG + 204 * MiB, WS_LGUF = WS_BIG + 272 * MiB,
                 WS_LAB = WS_BIG + 340 * MiB, WS_LGUB = WS_BIG + 408 * MiB, WS_LPS = WS_BIG + 476 * MiB, WS_LCIN = WS_BIG + 494 * MiB;
static_assert(WS_LGUF == WS_LAF + (size_t)R * DM * 2 && WS_LAB == WS_LGUF + (size_t)R * DM * 2 && WS_LGUB == WS_LAB + (size_t)R * DM * 2, "gate outputs are consecutive");
constexpr size_t WS_PART = WS_BIG + 776 * MiB;
constexpr size_t WS_END = WS_PART + 64 * MiB;
constexpr int NCH = 136;

#define XB_TMO      128
#define XB_XCNT(j)  (256  + 64 * (j))
#define XB_XSUB(j)  (1280 + 64 * (j))
#define XB_XGEN(j)  (2304 + 64 * (j))
#define XB_TOP      3328
#define XB_TOPGEN   3392
#define XCD_BAR_WORDS 3456
#define XB_SPIN_CAP (1u << 22)
__device__ __forceinline__ unsigned xb_ld(unsigned* p)              { return __hip_atomic_load(p, __ATOMIC_RELAXED, __HIP_MEMORY_SCOPE_AGENT); }
__device__ __forceinline__ unsigned xb_add(unsigned* p, unsigned v) { return __hip_atomic_fetch_add(p, v, __ATOMIC_RELAXED, __HIP_MEMORY_SCOPE_AGENT); }
__device__ __forceinline__ unsigned xb_xcc_id() { return (unsigned)__builtin_amdgcn_s_getreg((3 << 11) | 20) & 0xFu; }
#define XB_SPIN(cond, bar) do { unsigned _sp = 0; while (cond) { __builtin_amdgcn_s_sleep(1); \
    if ((++_sp & 255u) == 0u) { if (xb_ld(&(bar)[XB_TMO])) break; if (_sp > XB_SPIN_CAP) { atomicAdd(&(bar)[XB_TMO], 1u); break; } } } } while (0)
struct XcdBarrier { unsigned* bar; unsigned x; volatile LAS unsigned* st; };
__device__ __forceinline__ XcdBarrier xcd_barrier_post(unsigned* bar, volatile LAS unsigned* st) {
    XcdBarrier b; b.bar = bar; b.x = xb_xcc_id(); b.st = st;
    if (threadIdx.x == 0) (void)xb_add(&bar[XB_XCNT(b.x)], 1u);
    return b;
}
__device__ __forceinline__ void xcd_barrier_complete(unsigned* bar, unsigned x, unsigned& nloc, unsigned& nx) {
    const unsigned G = gridDim.x * gridDim.y * gridDim.z;
    unsigned sum, cnt, mine, sp = 0u;
    for (;;) {
        sum = 0u; cnt = 0u; mine = 0u;
#pragma unroll
        for (unsigned j = 0; j < 16; ++j) { const unsigned c = xb_ld(&bar[XB_XCNT(j)]); sum += c; cnt += (c > 0u) ? 1u : 0u; mine = (j == x) ? c : mine; }
        if (sum == G) break;
        __builtin_amdgcn_s_sleep(1);
        if ((++sp & 255u) == 0u) { if (xb_ld(&bar[XB_TMO])) break; if (sp > XB_SPIN_CAP) { atomicAdd(&bar[XB_TMO], 1u); break; } }
    }
    nloc = mine > 0u ? mine : 1u; nx = cnt > 0u ? cnt : 1u;
}
__device__ __forceinline__ void xcd_barrier(const XcdBarrier& b) {
    asm volatile("s_waitcnt vmcnt(0)" ::: "memory");
    __syncthreads();
    if (threadIdx.x == 0) {
        unsigned* bar = b.bar;
        __builtin_amdgcn_s_waitcnt(0);
        unsigned nloc = b.st[0], nx = b.st[1];
        if (nloc == 0u) { xcd_barrier_complete(bar, b.x, nloc, nx); b.st[0] = nloc; b.st[1] = nx; }
        const unsigned old = xb_add(&bar[XB_XSUB(b.x)], 1u);
        const unsigned gen = old / nloc;
        if (old + 1u == (gen + 1u) * nloc) {
            __builtin_amdgcn_fence(__ATOMIC_RELEASE, "agent");
            asm volatile("s_waitcnt vmcnt(0)" ::: "memory");
            const unsigned og = xb_add(&bar[XB_TOP], 1u);
            const unsigned tg = og / nx;
            if (og + 1u == (tg + 1u) * nx) xb_add(&bar[XB_TOPGEN], 1u);
            else XB_SPIN(xb_ld(&bar[XB_TOPGEN]) == tg, bar);
            __builtin_amdgcn_fence(__ATOMIC_ACQUIRE, "agent");
            xb_add(&bar[XB_XGEN(b.x)], 1u);
            asm volatile("s_waitcnt vmcnt(0)" ::: "memory");
        } else {
            XB_SPIN(xb_ld(&bar[XB_XGEN(b.x)]) == gen, bar);
            __builtin_amdgcn_fence(__ATOMIC_ACQUIRE, "agent");
            asm volatile("s_waitcnt vmcnt(0)" ::: "memory");
        }
    }
    __syncthreads();
}

#ifndef PROBE_N
#define PROBE_N 2
#endif
__device__ __forceinline__ int probe_count() { int n = PROBE_N; asm volatile("" : "+s"(n)); return n; }
#ifdef PROBE_GEMM
#define PROBE_REPEAT_GEMM for (int rep_ = 0, nrep_ = probe_count(); rep_ < nrep_; ++rep_)
#else
#define PROBE_REPEAT_GEMM
#endif
#ifdef PROBE_ATTN
#define PROBE_REPEAT_ATTN for (int rep_ = 0, nrep_ = probe_count(); rep_ < nrep_; ++rep_)
#else
#define PROBE_REPEAT_ATTN
#endif
struct Args {
    const float *x, *c, *ctx, *c_ctx, *ada_w, *ada_b, *ln_g, *ln_b, *mlp_w1, *mlp_w2;
    const float *gqa_wq, *gqa_wk, *gqa_wv, *gqa_wo, *gqa_q_g, *gqa_k_g;
    const float *lru_wx, *lru_wy, *lru_conv_w, *lru_conv_b, *lru_ra_w, *lru_ra_b, *lru_ix_w, *lru_ix_b, *lru_lam, *lru_wo;
    const float *mla_wq_a, *mla_q_a_g, *mla_wq_b, *mla_wkv_a, *mla_kv_a_g, *mla_wkv_b, *mla_wo;
    float* out; unsigned char* ws; int ph_lo, ph_hi;
};

constexpr int NWAVES = 8;
constexpr int RING_BYTES = 131072, LDSCTL_OFF = RING_BYTES, LDS_BYTES = 147456;

__device__ __forceinline__ float wave_sum(float v) {
#pragma unroll
    for (int o = 1; o < 64; o <<= 1) v += __shfl_xor(v, o);
    return v;
}
__device__ __forceinline__ float sigmoidf_(float v) { return __builtin_amdgcn_rcpf(1.0f + __builtin_amdgcn_exp2f(-1.4426950408889634f * v)); }

__device__ __forceinline__ void ph_mods(const Args& a, LAS unsigned char* lds, int vcu, int G) {
    LAS float* S = (LAS float*)lds; LAS float* red = (LAS float*)(lds + 40960);
    const int tid = threadIdx.x, wave = tid >> 6, lane = tid & 63;
    for (int i = tid; i < 5 * DM; i += 512) { const int bi = i / DM, k = i % DM; const float v = bi < 4 ? a.c[bi * DM + k] : a.c_ctx[k]; S[i] = v / (1.0f + expf(-v)); }
    __syncthreads();
    float* mods = (float*)(a.ws + WS_MODS);
    for (int item = vcu; item < 768; item += G) {
        const int l = item / 192, n0 = (item % 192) * 64, ksub = wave * 4 + (lane >> 4), cl = lane & 15;
        const float* wp = a.ada_w + ((size_t)l * DM + ksub) * 12288 + n0 + cl * 4;
        float acc[5][4];
#pragma unroll
        for (int i = 0; i < 5; ++i)
#pragma unroll
            for (int j = 0; j < 4; ++j) acc[i][j] = 0.f;
#pragma unroll 8
        for (int it = 0; it < 64; ++it) {
            const f32x4 w = *(const f32x4*)(wp + (size_t)it * 32 * 12288); const int k = ksub + 32 * it;
#pragma unroll
            for (int i = 0; i < 5; ++i) { const float s = S[i * DM + k];
#pragma unroll
                for (int j = 0; j < 4; ++j) acc[i][j] += s * w[j]; }
        }
#pragma unroll
        for (int i = 0; i < 5; ++i)
#pragma unroll
            for (int j = 0; j < 4; ++j) red[(ksub * 5 + i) * 64 + cl * 4 + j] = acc[i][j];
        __syncthreads();
        if (tid < 320) { const int i = tid / 64, cc = tid % 64; float s = 0.f;
            for (int ks = 0; ks < 32; ++ks) s += red[(ks * 5 + i) * 64 + cc];
            mods[(size_t)(l * 5 + i) * 12288 + n0 + cc] = s + a.ada_b[l * 12288 + n0 + cc]; }
        __syncthreads();
    }
}
__device__ __forceinline__ void tr_item(const float* __restrict__ W, int ldw, int k0, int n0, bf16_t* __restrict__ WT, int ldt, int drow0, LAS float* scr, int lane) {
#pragma unroll 8
    for (int i = 0; i < 32; ++i) { const int kk = 2 * i + (lane >> 5); scr[kk * 33 + (lane & 31)] = W[(size_t)(k0 + kk) * ldw + n0 + (lane & 31)]; }
    asm volatile("s_waitcnt lgkmcnt(0)" ::: "memory");
    const int c = lane & 7;
#pragma unroll
    for (int j = 0; j < 4; ++j) { const int n = (lane >> 3) + 8 * j; const LAS float* s = scr + (8 * c) * 33 + n;
        u32x4 o; o.x = cvt_pk_bf16(s[0 * 33], s[1 * 33]); o.y = cvt_pk_bf16(s[2 * 33], s[3 * 33]); o.z = cvt_pk_bf16(s[4 * 33], s[5 * 33]); o.w = cvt_pk_bf16(s[6 * 33], s[7 * 33]);
        *(u32x4*)(WT + (size_t)(drow0 + n) * ldt + k0 + 8 * c) = o; }
    asm volatile("s_waitcnt lgkmcnt(0)" ::: "memory");
}
__device__ __forceinline__ void ph_transposes(const Args& a, LAS unsigned char* lds, int vcu, int G) {
    const int tid = threadIdx.x, wave = tid >> 6, lane = tid & 63;
    LAS float* scr = (LAS float*)(lds + wave * 8704);
    const int gw = vcu * NWAVES + wave, NGW = G * NWAVES;
    unsigned char* ws = a.ws;
    constexpr int NITEMS = 87872;
    for (int it = gw; it < NITEMS; it += NGW) {
        int r = it;
#define TR_DO(src, K_, N_, dst, drow) do { const int nblk = (N_) / 32, kb = ri / nblk, nb = ri % nblk; tr_item((src), (N_), 64 * kb, 32 * nb, (dst), (K_), (drow) + 32 * nb, scr, lane); } while (0)
        if (r < 32768) { const int l = r / 8192, ri = r % 8192; TR_DO(a.mlp_w1 + (size_t)l * DM * DFF, DM, DFF, (bf16_t*)(ws + WS_W1T) + (size_t)l * DFF * DM, 0); continue; } r -= 32768;
        if (r < 32768) { const int l = r / 8192, ri = r % 8192; TR_DO(a.mlp_w2 + (size_t)l * DFF * DM, DFF, DM, (bf16_t*)(ws + WS_W2T) + (size_t)l * DM * DFF, 0); continue; } r -= 32768;
        if (r < 4096) { const int s = r / 2048, ri = r % 2048; TR_DO(a.gqa_wq + (size_t)s * DM * DM, DM, DM, (bf16_t*)(ws + WS_GQAW + s * 20 * MiB), 0); continue; } r -= 4096;
        if (r < 1024) { const int s = r / 512, ri = r % 512; TR_DO(a.gqa_wk + (size_t)s * DM * 512, DM, 512, (bf16_t*)(ws + WS_GQAW + s * 20 * MiB), 2048); continue; } r -= 1024;
        if (r < 1024) { const int s = r / 512, ri = r % 512; TR_DO(a.gqa_wv + (size_t)s * DM * 512, DM, 512, (bf16_t*)(ws + WS_GQAW + s * 20 * MiB), 2560); continue; } r -= 1024;
        if (r < 4096) { const int s = r / 2048, ri = r % 2048; TR_DO(a.gqa_wo + (size_t)s * DM * DM, DM, DM, (bf16_t*)(ws + WS_GQAW + s * 20 * MiB + 12 * MiB), 0); continue; } r -= 4096;
        if (r < 2048) { const int ri = r; TR_DO(a.lru_wx, DM, DM, (bf16_t*)(ws + WS_LRUW), 0); continue; } r -= 2048;
        if (r < 2048) { const int ri = r; TR_DO(a.lru_wy, DM, DM, (bf16_t*)(ws + WS_LRUW), 2048); continue; } r -= 2048;
        if (r < 1024) { const int blk = r / 32, ri = r % 32, ty = blk / 16, d = (blk % 16) / 8, n = blk % 8, which = d * 2 + ty;
            const float* src = (ty == 0 ? a.lru_ra_w : a.lru_ix_w) + (size_t)(d * 8 + n) * 65536;
            TR_DO(src, 256, 256, (bf16_t*)(ws + WS_LRUW + 16 * MiB), (which * 8 + n) * 256); continue; } r -= 1024;
        if (r < 2048) { const int ri = r; TR_DO(a.lru_wo, DM, DM, (bf16_t*)(ws + WS_LRUW + 20 * MiB), 0); continue; } r -= 2048;
        if (r < 512) { const int ri = r; TR_DO(a.mla_wq_a, DM, 512, (bf16_t*)(ws + WS_MLAW), 0); continue; } r -= 512;
        if (r < 576) { const int ri = r; TR_DO(a.mla_wkv_a, DM, 576, (bf16_t*)(ws + WS_MLAW), 512); continue; } r -= 576;
        if (r < 768) { const int ri = r; TR_DO(a.mla_wq_b, 512, 3072, (bf16_t*)(ws + WS_MLAW + 5 * MiB), 0); continue; } r -= 768;
        if (r < 1024) { const int ri = r, nb = ri % 128, kb = ri / 128, n0 = 32 * nb, h = n0 >> 8, j0 = n0 & 255;
            const int drow = j0 < 128 ? h * 128 + j0 : 2048 + h * 128 + (j0 - 128);
            tr_item(a.mla_wkv_b, 4096, 64 * kb, n0, (bf16_t*)(ws + WS_MLAW + 8 * MiB), 512, drow, scr, lane); continue; } r -= 1024;
        { const int ri = r; TR_DO(a.mla_wo, DM, DM, (bf16_t*)(ws + WS_MLAW + 12 * MiB), 0); }
#undef TR_DO
    }
    { u32x4* z = (u32x4*)(ws + WS_MLAW + (size_t)1088 * DM * 2); const int gt = vcu * 512 + tid;
      for (int i = gt; i < 49152; i += G * 512) z[i] = (u32x4){0u, 0u, 0u, 0u}; }
    if (vcu == 1 % G) { float* ll = (float*)(ws + WS_TAB + 32768); for (int i = tid; i < 2 * DM; i += 512) ll[i] = -8.0f * log1pf(expf(-a.lru_lam[i])); }
    if (vcu == 0) {
        f32x2* tg = (f32x2*)(ws + WS_TAB); f32x2* tm = (f32x2*)(ws + WS_TAB + 16384);
        for (int i = tid; i < 64 * 32; i += 512) { const int pos = i / 32, f = i % 32; const float inv = powf(10000.0f, -((float)f * 2.0f) / 64.0f); const float ang = (float)pos * inv; tg[i] = (f32x2){cosf(ang), sinf(ang)}; }
        for (int i = tid; i < 64 * 16; i += 512) { const int pos = i / 16, f = i % 16; const float inv = powf(10000.0f, -((float)f * 2.0f) / 32.0f); const float ang = (float)pos * inv; tm[i] = (f32x2){cosf(ang), sinf(ang)}; }
    }
}

#define ROW_DECODE(r) const int b_ = (r) / TB, p_ = (r) % TB; const bool isctx_ = p_ < CTX; const int mi_ = isctx_ ? 4 : b_; (void)b_; (void)mi_
__device__ __forceinline__ const float* mods_ptr(const Args& a, int l, int mi) { return (const float*)(a.ws + WS_MODS) + (size_t)(l * 5 + mi) * 12288; }

__device__ __forceinline__ void ph_init(const Args& a, int gw, int NGW, int lane) {
    bf16_t* X = (bf16_t*)(a.ws + WS_X); bf16_t* H = (bf16_t*)(a.ws + WS_H);
    for (int r = gw; r < R; r += NGW) {
        ROW_DECODE(r);
        const float* src = isctx_ ? a.ctx + ((size_t)b_ * CTX + p_) * DM : a.x + ((size_t)b_ * SEQ + (p_ - CTX)) * DM;
        const float* m = mods_ptr(a, 0, mi_);
#pragma unroll
        for (int it = 0; it < 8; ++it) { const int idx = it * 256 + lane * 4;
            const f32x4 v = *(const f32x4*)(src + idx), m0 = *(const f32x4*)(m + idx), m1 = *(const f32x4*)(m + DM + idx);
            *(u32x2*)(X + (size_t)r * DM + idx) = (u32x2){cvt_pk_bf16(v[0], v[1]), cvt_pk_bf16(v[2], v[3])};
            const f32x4 h = v * (1.0f + m1) + m0;
            *(u32x2*)(H + (size_t)r * DM + idx) = (u32x2){cvt_pk_bf16(h[0], h[1]), cvt_pk_bf16(h[2], h[3])}; }
    }
}
template <bool LAST, int CTXMODE>
__device__ __forceinline__ void ph_ln(const Args& a, int l, int which, int gw, int NGW, int lane) {
    bf16_t* X = (bf16_t*)(a.ws + WS_X); bf16_t* H = (bf16_t*)(a.ws + WS_H); const bf16_t* O = (const bf16_t*)(a.ws + WS_OUTF); const float* PART = (const float*)(a.ws + WS_PART);
    const float* lg = a.ln_g + (size_t)(l * 2 + which) * DM; const float* lb = a.ln_b + (size_t)(l * 2 + which) * DM;
    for (int r = gw; r < R; r += NGW) {
        ROW_DECODE(r);
        if ((LAST || CTXMODE == 2) && isctx_) continue;
        const float* m = mods_ptr(a, l, mi_);
        const float* gate = m + (which == 0 ? 2 : 5) * DM;
        const float* sc = which == 0 ? m + 4 * DM : mods_ptr(a, LAST ? l : l + 1, mi_) + 1 * DM;
        const float* sh = which == 0 ? m + 3 * DM : mods_ptr(a, LAST ? l : l + 1, mi_);
        float v[4][8]; float s = 0.f;
#pragma unroll
        for (int it = 0; it < 4; ++it) { const int idx = it * 512 + lane * 8;
            float xv[8], ov[8]; att::unpack8(*(const bf16x8*)(X + (size_t)r * DM + idx), xv);
            if (CTXMODE == 1 && isctx_) { const float* pp = PART + ((size_t)b_ * CTX + p_) * DM + idx;
                f32x4 o0 = *(const f32x4*)pp, o1 = *(const f32x4*)(pp + 4);
#pragma unroll
                for (int sl = 1; sl < 8; ++sl) { o0 += *(const f32x4*)(pp + (size_t)sl * (NB * CTX) * DM); o1 += *(const f32x4*)(pp + (size_t)sl * (NB * CTX) * DM + 4); }
                ov[0] = o0[0]; ov[1] = o0[1]; ov[2] = o0[2]; ov[3] = o0[3]; ov[4] = o1[0]; ov[5] = o1[1]; ov[6] = o1[2]; ov[7] = o1[3]; }
            else att::unpack8(*(const bf16x8*)(O + (size_t)r * DM + idx), ov);
            const f32x4 g0 = *(const f32x4*)(gate + idx), g1 = *(const f32x4*)(gate + idx + 4);
#pragma unroll
            for (int j = 0; j < 8; ++j) { v[it][j] = DN_ALPHA * xv[j] + (1.0f + (j < 4 ? g0[j] : g1[j - 4])) * ov[j]; s += v[it][j]; } }
        const float mean = wave_sum(s) * (1.0f / DM); float q = 0.f;
#pragma unroll
        for (int it = 0; it < 4; ++it)
#pragma unroll
            for (int j = 0; j < 8; ++j) { v[it][j] -= mean; q += v[it][j] * v[it][j]; }
        const float rstd = 1.0f / sqrtf(wave_sum(q) * (1.0f / DM) + LN_EPS);
#pragma unroll
        for (int it = 0; it < 4; ++it) { const int idx = it * 512 + lane * 8;
            const f32x4 lg0 = *(const f32x4*)(lg + idx), lg1 = *(const f32x4*)(lg + idx + 4), lb0 = *(const f32x4*)(lb + idx), lb1 = *(const f32x4*)(lb + idx + 4);
            float xn[8];
#pragma unroll
            for (int j = 0; j < 8; ++j) xn[j] = v[it][j] * rstd * (j < 4 ? lg0[j] : lg1[j - 4]) + (j < 4 ? lb0[j] : lb1[j - 4]);
            if (LAST) { float* op = a.out + ((size_t)b_ * SEQ + (p_ - CTX)) * DM + idx; *(f32x4*)op = (f32x4){xn[0], xn[1], xn[2], xn[3]}; *(f32x4*)(op + 4) = (f32x4){xn[4], xn[5], xn[6], xn[7]}; }
            else { *(bf16x8*)(X + (size_t)r * DM + idx) = att::pack8(xn);
                const f32x4 sc0 = *(const f32x4*)(sc + idx), sc1 = *(const f32x4*)(sc + idx + 4), sh0 = *(const f32x4*)(sh + idx), sh1 = *(const f32x4*)(sh + idx + 4);
                float hh[8];
#pragma unroll
                for (int j = 0; j < 8; ++j) hh[j] = xn[j] * (1.0f + (j < 4 ? sc0[j] : sc1[j - 4])) + (j < 4 ? sh0[j] : sh1[j - 4]);
                *(bf16x8*)(H + (size_t)r * DM + idx) = att::pack8(hh); } }
    }
}
__device__ __forceinline__ void ph_knorm(const Args& a, const float* kg, int gw, int NGW, int lane) {
    bf16_t* K = (bf16_t*)(a.ws + WS_GK); const f32x2* tab = (const f32x2*)(a.ws + WS_TAB);
    const int li = lane & 15;
    float g[8];
#pragma unroll
    for (int j = 0; j < 8; ++j) g[j] = kg[li * 8 + j];
    for (int r = gw; r < R; r += NGW) {
        ROW_DECODE(r);
        bf16x8 raw = *(const bf16x8*)(K + (size_t)r * 512 + lane * 8);
        float f[8]; att::unpack8(raw, f);
        float ss = 0.f;
#pragma unroll
        for (int j = 0; j < 8; ++j) ss += f[j] * f[j];
        ss += __shfl_xor(ss, 1); ss += __shfl_xor(ss, 2); ss += __shfl_xor(ss, 4); ss += __shfl_xor(ss, 8);
        const float rstd = 1.0f / sqrtf(ss * (1.0f / 128.0f) + 1e-6f);
#pragma unroll
        for (int j = 0; j < 8; ++j) f[j] = f[j] * rstd * g[j];
        if (!isctx_) {
            const int t = p_ - CTX, pos = (li & 8) ? (t & 63) : (t >> 6);
            const f32x2* tp = tab + pos * 32 + (li & 3) * 8;
            const bool second = (li & 4) != 0;
#pragma unroll
            for (int j = 0; j < 8; ++j) { const float other = __shfl_xor(f[j], 4); const f32x2 cs = tp[j];
                f[j] = second ? f[j] * cs.x + other * cs.y : f[j] * cs.x - other * cs.y; }
        }
        *(bf16x8*)(K + (size_t)r * 512 + lane * 8) = att::pack8(f);
    }
}
__device__ __forceinline__ void ph_mla_norm(const Args& a, int gw, int NGW, int lane) {
    const float* AP = (const float*)(a.ws + WS_MAP); bf16_t* QAN = (bf16_t*)(a.ws + WS_MQAN); bf16_t* CKVN = (bf16_t*)(a.ws + WS_MCKVN); bf16_t* K = (bf16_t*)(a.ws + WS_MK);
    const f32x2* tab = (const f32x2*)(a.ws + WS_TAB + 16384);
    for (int r = gw; r < R; r += NGW) {
        ROW_DECODE(r);
        const float* ap = AP + (size_t)r * 1280;
#pragma unroll
        for (int part = 0; part < 2; ++part) {
            const f32x4 v0 = *(const f32x4*)(ap + part * 512 + lane * 8), v1 = *(const f32x4*)(ap + part * 512 + lane * 8 + 4);
            float ss = (v0[0] * v0[0] + v0[1] * v0[1]) + (v0[2] * v0[2] + v0[3] * v0[3]) + (v1[0] * v1[0] + v1[1] * v1[1]) + (v1[2] * v1[2] + v1[3] * v1[3]);
            const float rstd = 1.0f / sqrtf(wave_sum(ss) * (1.0f / 512.0f) + 1e-6f);
            const float* gp = (part == 0 ? a.mla_q_a_g : a.mla_kv_a_g) + lane * 8;
            const f32x4 g0 = *(const f32x4*)gp, g1 = *(const f32x4*)(gp + 4);
            const f32x4 o0 = v0 * rstd * g0, o1 = v1 * rstd * g1;
            u32x4 w = {cvt_pk_bf16(o0[0], o0[1]), cvt_pk_bf16(o0[2], o0[3]), cvt_pk_bf16(o1[0], o1[1]), cvt_pk_bf16(o1[2], o1[3])};
            *(u32x4*)((part == 0 ? QAN : CKVN) + (size_t)r * 512 + lane * 8) = w;
        }
        float v = ap[1024 + lane];
        if (!isctx_) {
            const int t = p_ - CTX, pos = (lane & 32) ? (t & 63) : (t >> 6);
            const f32x2 cs = tab[pos * 16 + (lane & 15)];
            const float other = __shfl_xor(v, 16);
            v = (lane & 16) ? v * cs.x + other * cs.y : v * cs.x - other * cs.y;
        }
        const bf16_t kb = f2bf(v);
#pragma unroll
        for (int h = 0; h < 16; ++h) K[(size_t)r * 3072 + h * 192 + 128 + lane] = kb;
    }
}
__device__ __forceinline__ void ph_conv(const Args& a, int gw, int NGW, int lane) {
    const bf16_t* UP = (const bf16_t*)(a.ws + WS_LUP); bf16_t* U = (bf16_t*)(a.ws + WS_LU);
    for (int r = gw; r < R; r += NGW) {
        ROW_DECODE(r);
        const int lo = isctx_ ? 0 : CTX, hi = isctx_ ? CTX : TB;
#pragma unroll
        for (int it = 0; it < 4; ++it) { const int idx = it * 512 + lane * 8;
            float acc[8];
            { const f32x4 b0 = *(const f32x4*)(a.lru_conv_b + idx), b1 = *(const f32x4*)(a.lru_conv_b + idx + 4);
              acc[0] = b0[0]; acc[1] = b0[1]; acc[2] = b0[2]; acc[3] = b0[3]; acc[4] = b1[0]; acc[5] = b1[1]; acc[6] = b1[2]; acc[7] = b1[3]; }
#pragma unroll
            for (int j = 0; j < 4; ++j) { const int pp = p_ + j - 2;
                if (pp >= lo && pp < hi) {
                    float f[8]; att::unpack8(*(const bf16x8*)(UP + (size_t)(r + j - 2) * DM + idx), f);
                    const f32x4 w0 = *(const f32x4*)(a.lru_conv_w + j * DM + idx), w1 = *(const f32x4*)(a.lru_conv_w + j * DM + idx + 4);
                    acc[0] += f[0] * w0[0]; acc[1] += f[1] * w0[1]; acc[2] += f[2] * w0[2]; acc[3] += f[3] * w0[3];
                    acc[4] += f[4] * w1[0]; acc[5] += f[5] * w1[1]; acc[6] += f[6] * w1[2]; acc[7] += f[7] * w1[3]; } }
            *(bf16x8*)(U + (size_t)r * DM + idx) = att::pack8(acc); }
    }
}
__device__ __forceinline__ void scan_step(f32x4& h, u32x2 la, u32x2 gu, f32x4* Pacc) {
    f32x4 av = {__builtin_amdgcn_exp2f(bf_lo(la.x)), __builtin_amdgcn_exp2f(bf_hi(la.x)), __builtin_amdgcn_exp2f(bf_lo(la.y)), __builtin_amdgcn_exp2f(bf_hi(la.y))};
    const f32x4 gv = {bf_lo(gu.x), bf_hi(gu.x), bf_lo(gu.y), bf_hi(gu.y)};
    f32x4 s; s[0] = sqrtf(fmaxf(1.0f - av[0] * av[0], 0.f)); s[1] = sqrtf(fmaxf(1.0f - av[1] * av[1], 0.f)); s[2] = sqrtf(fmaxf(1.0f - av[2] * av[2], 0.f)); s[3] = sqrtf(fmaxf(1.0f - av[3] * av[3], 0.f));
    h = av * h + s * gv; if (Pacc) *Pacc = *Pacc * av;
}
__device__ __forceinline__ void ph_scan1(const Args& a, int gw, int NGW, int lane) {
    float* PS = (float*)(a.ws + WS_LPS);
    for (int item = gw; item < NB * NCH * 2 * 8; item += NGW) {
        const int cg = item & 7, dir = (item >> 3) & 1, bq = item >> 4, b = bq / NCH, q = bq % NCH;
        const bf16_t* A = (const bf16_t*)(a.ws + (dir ? WS_LAB : WS_LAF)); const bf16_t* GU = (const bf16_t*)(a.ws + (dir ? WS_LGUB : WS_LGUF));
        const size_t base = ((size_t)b * TB + q * 32) * DM + cg * 256 + lane * 4;
        f32x4 h = {0.f, 0.f, 0.f, 0.f}, P = {1.f, 1.f, 1.f, 1.f};
#pragma unroll 8
        for (int i = 0; i < 32; ++i) { const int rr = dir ? 31 - i : i;
            scan_step(h, *(const u32x2*)(A + base + (size_t)rr * DM), *(const u32x2*)(GU + base + (size_t)rr * DM), &P); }
        float* o = PS + ((size_t)(bq * 2 + dir) * 2) * DM + cg * 256 + lane * 4;
        *(f32x4*)o = P; *(f32x4*)(o + DM) = h;
    }
}
__device__ __forceinline__ void ph_scan2(const Args& a, int gtid, int NGT) {
    const float* PS = (const float*)(a.ws + WS_LPS); float* CIN = (float*)(a.ws + WS_LCIN);
    for (int t = gtid; t < NB * 2 * DM; t += NGT) {
        const int c = t % DM, dir = (t / DM) & 1, b = t / (2 * DM);
        float carry = 0.f;
        for (int i = 0; i < NCH; ++i) {
            const int q = dir == 0 ? i : (i < 8 ? 7 - i : NCH - 1 - (i - 8));
            const size_t bq = (size_t)b * NCH + q;
            CIN[(bq * 2 + dir) * DM + c] = carry;
            const float P = PS[((bq * 2 + dir) * 2) * DM + c], S = PS[((bq * 2 + dir) * 2 + 1) * DM + c];
            carry = P * carry + S;
        }
    }
}
__device__ __forceinline__ void ph_scan3(const Args& a, int gw, int NGW, int lane) {
    const float* CIN = (const float*)(a.ws + WS_LCIN); const bf16_t* GY = (const bf16_t*)(a.ws + WS_LGY); bf16_t* Gout = (bf16_t*)(a.ws + WS_LG);
    const bf16_t* AF = (const bf16_t*)(a.ws + WS_LAF); const bf16_t* GUF = (const bf16_t*)(a.ws + WS_LGUF); const bf16_t* AB = (const bf16_t*)(a.ws + WS_LAB); const bf16_t* GUB = (const bf16_t*)(a.ws + WS_LGUB);
    for (int item = gw; item < NB * NCH * 8; item += NGW) {
        const int cg = item & 7, bq = item >> 3, b = bq / NCH, q = bq % NCH;
        const size_t base = ((size_t)b * TB + q * 32) * DM + cg * 256 + lane * 4;
        f32x4 hf[32];
        f32x4 h = *(const f32x4*)(CIN + ((size_t)bq * 2 + 0) * DM + cg * 256 + lane * 4);
#pragma unroll
        for (int i = 0; i < 32; ++i) { scan_step(h, *(const u32x2*)(AF + base + (size_t)i * DM), *(const u32x2*)(GUF + base + (size_t)i * DM), nullptr); hf[i] = h; }
        h = *(const f32x4*)(CIN + ((size_t)bq * 2 + 1) * DM + cg * 256 + lane * 4);
#pragma unroll
        for (int i = 31; i >= 0; --i) {
            scan_step(h, *(const u32x2*)(AB + base + (size_t)i * DM), *(const u32x2*)(GUB + base + (size_t)i * DM), nullptr);
            const u32x2 gy = *(const u32x2*)(GY + base + (size_t)i * DM);
            const f32x4 o = (hf[i] + h) * (f32x4){bf_lo(gy.x), bf_hi(gy.x), bf_lo(gy.y), bf_hi(gy.y)};
            *(u32x2*)(Gout + base + (size_t)i * DM) = (u32x2){cvt_pk_bf16(o[0], o[1]), cvt_pk_bf16(o[2], o[3])}; }
    }
}
__device__ __forceinline__ void st_bf16x8(bf16_t* p, f32x4 v0, f32x4 v1) {
    u32x4 w = {cvt_pk_bf16(v0[0], v0[1]), cvt_pk_bf16(v0[2], v0[3]), cvt_pk_bf16(v1[0], v1[1]), cvt_pk_bf16(v1[2], v1[3])}; *(u32x4*)p = w; }
struct FStoreF32 { float* O; int ld;
    __device__ __forceinline__ void begin(const pg8::Unit&, int) {}
    __device__ __forceinline__ void row8(int row, int, int col, f32x4 v0, f32x4 v1) { float* p = O + (size_t)row * ld + col; *(f32x4*)p = v0; *(f32x4*)(p + 4) = v1; } };
struct FOut { bf16_t* O; float* PART; float* dst; int rowadj;
    __device__ __forceinline__ void begin(const pg8::Unit& u, int) {
        if (u.slice >= 0) { dst = PART + (size_t)u.slice * (NB * CTX) * DM; rowadj = (u.pm / 17) * CTX - u.pm * 256; } else { dst = nullptr; rowadj = 0; } }
    __device__ __forceinline__ void row8(int row, int, int col, f32x4 v0, f32x4 v1) {
        if (dst) { float* p = dst + (size_t)(row + rowadj) * DM + col; *(f32x4*)p = v0; *(f32x4*)(p + 4) = v1; }
        else st_bf16x8(O + (size_t)row * DM + col, v0, v1); } };
struct FBf16 { bf16_t* O; int ld;
    __device__ __forceinline__ void begin(const pg8::Unit&, int) {}
    __device__ __forceinline__ void row8(int row, int, int col, f32x4 v0, f32x4 v1) { st_bf16x8(O + (size_t)row * ld + col, v0, v1); } };
struct FQkv { bf16_t *Q, *K, *V; bf16_t* base; int ld, coff;
    __device__ __forceinline__ void begin(const pg8::Unit& u, int) { if (u.pn < 8) { base = Q; ld = 2048; coff = 0; } else if (u.pn < 10) { base = K; ld = 512; coff = 2048; } else { base = V; ld = 512; coff = 2560; } }
    __device__ __forceinline__ void row8(int row, int, int col, f32x4 v0, f32x4 v1) { st_bf16x8(base + (size_t)row * ld + (col - coff), v0, v1); } };
struct FRelu2 { bf16_t* O;
    __device__ __forceinline__ void begin(const pg8::Unit&, int) {}
    __device__ __forceinline__ void row8(int row, int, int col, f32x4 v0, f32x4 v1) {
#pragma unroll
        for (int i = 0; i < 4; ++i) { const float a = fmaxf(v0[i], 0.f), b = fmaxf(v1[i], 0.f); v0[i] = a * a; v1[i] = b * b; }
        st_bf16x8(O + (size_t)row * DFF + col, v0, v1); } };
__device__ __forceinline__ float gelu_tanh(float x) { const float z = 1.5957691216057308f * (x + 0.044715f * x * x * x); return x * __builtin_amdgcn_rcpf(1.0f + __builtin_amdgcn_exp2f(-1.4426950408889634f * z)); }
struct FLruXY { bf16_t *UP, *GY; bool gy;
    __device__ __forceinline__ void begin(const pg8::Unit& u, int) { gy = u.pn >= 8; }
    __device__ __forceinline__ void row8(int row, int, int col, f32x4 v0, f32x4 v1) {
        if (gy) {
#pragma unroll
            for (int i = 0; i < 4; ++i) { v0[i] = gelu_tanh(v0[i]); v1[i] = gelu_tanh(v1[i]); }
            st_bf16x8(GY + (size_t)row * DM + (col - 2048), v0, v1);
        } else st_bf16x8(UP + (size_t)row * DM + col, v0, v1); } };
struct EpiGates {
    static constexpr bool PERM = true;
    bf16_t* OUT4; const bf16_t* U; const float *ra_b, *ix_b, *lam;
    __device__ __forceinline__ void operator()(const f32x4 (&acc)[2][2][4][2], const pg8::Unit& u, int wr, int wc, int fr, int fq) const {
        const int which = u.pn >> 3, dir = which >> 1, ty = which & 1, ch0 = (u.pn & 7) * 256 + wc * 32 + 8 * fq, row0 = u.pm * 256 + wr * 64 + fr;
        bf16_t* dst = OUT4 + (size_t)which * ((size_t)R * DM);
        const float* bp = (ty == 0 ? ra_b : ix_b) + dir * DM;
#pragma unroll
        for (int bj = 0; bj < 2; ++bj) {
            const int ch = ch0 + bj * 128;
            const f32x4 b0 = *(const f32x4*)(bp + ch), b1 = *(const f32x4*)(bp + ch + 4);
            f32x4 l0 = {0.f, 0.f, 0.f, 0.f}, l1 = {0.f, 0.f, 0.f, 0.f};
            if (ty == 0) { l0 = *(const f32x4*)(lam + dir * DM + ch) * 1.4426950408889634f; l1 = *(const f32x4*)(lam + dir * DM + ch + 4) * 1.4426950408889634f; }
#pragma unroll
            for (int ai = 0; ai < 2; ++ai)
#pragma unroll
                for (int m = 0; m < 4; ++m) {
                    const int row = row0 + ai * 128 + m * 16;
                    const f32x4 x0 = acc[ai][bj][m][0] + b0, x1 = acc[ai][bj][m][1] + b1; f32x4 o0, o1;
                    if (ty == 0) {
#pragma unroll
                        for (int j = 0; j < 4; ++j) { o0[j] = l0[j] * sigmoidf_(x0[j]); o1[j] = l1[j] * sigmoidf_(x1[j]); }
                    } else {
                        const u32x4 uw = *(const u32x4*)(U + (size_t)row * DM + ch);
                        o0[0] = sigmoidf_(x0[0]) * bf_lo(uw.x); o0[1] = sigmoidf_(x0[1]) * bf_hi(uw.x); o0[2] = sigmoidf_(x0[2]) * bf_lo(uw.y); o0[3] = sigmoidf_(x0[3]) * bf_hi(uw.y);
                        o1[0] = sigmoidf_(x1[0]) * bf_lo(uw.z); o1[1] = sigmoidf_(x1[1]) * bf_hi(uw.z); o1[2] = sigmoidf_(x1[2]) * bf_lo(uw.w); o1[3] = sigmoidf_(x1[3]) * bf_hi(uw.w);
                    }
                    st_bf16x8(dst + (size_t)row * DM + ch, o0, o1);
                    __builtin_amdgcn_sched_barrier(0);
                }
        }
    } };
struct FKvb { bf16_t *K, *V;
    __device__ __forceinline__ void begin(const pg8::Unit&, int) {}
    __device__ __forceinline__ void row8(int row, int, int col, f32x4 v0, f32x4 v1) {
        bf16_t* p = col < 2048 ? K + (size_t)row * 3072 + (col >> 7) * 192 + (col & 127) : V + (size_t)row * DM + (col - 2048);
        st_bf16x8(p, v0, v1); } };

template <class F>
__device__ __forceinline__ void run_gemm(LAS unsigned char* lds, const bf16_t* A, int lda, const bf16_t* Bt, int ldb, int N, int K, int a_blk, F f, int G) {
    pg8::Gemm g{A, Bt, R, N, K, lda, ldb, a_blk}; pg8::StaticOrder S; S.init(R, N, K, G, (int)blockIdx.x);
    pg8::EpiRow8<F> E{f};
    PROBE_REPEAT_GEMM
    pg8::gemm_phase<pg8::EpiRow8<F>, pg8::StaticOrder, true, true>(lds, g, S, E);
}

__device__ __forceinline__ void run_gemm_out(LAS unsigned char* lds, const bf16_t* A, int lda, const bf16_t* Bt, int K, int SK, bf16_t* OUTF, float* PART, int G) {
    pg8::Gemm g{A, Bt, R, DM, K, lda, K, 0}; pg8::LatOrder S; S.init(DM, K, G, (int)blockIdx.x, SK);
    pg8::EpiRow8<FOut> E{FOut{OUTF, PART, nullptr, 0}};
    PROBE_REPEAT_GEMM
    pg8::gemm_phase<pg8::EpiRow8<FOut>, pg8::LatOrder, true, true>(lds, g, S, E);
}
template <class F>
__device__ __forceinline__ void run_gemm_lat(LAS unsigned char* lds, const bf16_t* A, int lda, const bf16_t* Bt, int ldb, int N, int K, F f, int G) {
    pg8::Gemm g{A, Bt, R, N, K, lda, ldb, 0}; pg8::LatOrder S; S.init(N, K, G, (int)blockIdx.x, 0);
    pg8::EpiRow8<F> E{f};
    PROBE_REPEAT_GEMM
    pg8::gemm_phase<pg8::EpiRow8<F>, pg8::LatOrder, true, true>(lds, g, S, E);
}

__device__ __forceinline__ void ph_attn_gqa(const Args& a, char* lds, const float* qg, bool ctx_units, int vcu, int G) {
    const bf16_t* Q = (const bf16_t*)(a.ws + WS_GQ); const bf16_t* K = (const bf16_t*)(a.ws + WS_GK); const bf16_t* V = (const bf16_t*)(a.ws + WS_GV); bf16_t* O = (bf16_t*)(a.ws + WS_GO);
    const f32x2* tab = (const f32x2*)(a.ws + WS_TAB);
    const int nun = ctx_units ? 1088 : 1024;
    PROBE_REPEAT_ATTN
    for (int id = vcu; id < nun; id += G) {
        int b, h, row0, seq, tok0; bool rope;
        if (id < 1024) { const int bk = id >> 6; b = bk >> 2; h = (bk & 3) * 4 + ((id & 63) >> 4); const int qb = id & 15; row0 = b * TB + CTX + qb * 256; seq = TB; tok0 = qb * 256; rope = true; }
        else { const int j = id - 1024; b = j >> 4; h = j & 15; row0 = b * TB; seq = CTX; tok0 = 0; rope = false; }
        const int kvh = h >> 2;
        att::attn_body<128, 2048, 512, 512, 2048>(Q + (size_t)row0 * 2048 + h * 128, K + (size_t)b * TB * 512 + kvh * 128, V + (size_t)b * TB * 512 + kvh * 128,
                                                  O + (size_t)row0 * 2048 + h * 128, seq, lds, qg, tab, rope, tok0);
    }
}
__device__ __forceinline__ void ph_attn_mla(const Args& a, char* lds, bool ctx_units, int vcu, int G) {
    const bf16_t* Q = (const bf16_t*)(a.ws + WS_MQ); const bf16_t* K = (const bf16_t*)(a.ws + WS_MK); const bf16_t* V = (const bf16_t*)(a.ws + WS_MV); bf16_t* O = (bf16_t*)(a.ws + WS_MO);
    const f32x2* tab = (const f32x2*)(a.ws + WS_TAB + 16384);
    const int nun = ctx_units ? 1088 : 1024;
    PROBE_REPEAT_ATTN
    for (int id = vcu; id < nun; id += G) {
        int b, h, row0, seq, tok0; bool rope;
        if (id < 1024) { const int bh = id >> 4; b = bh >> 4; h = bh & 15; const int qb = id & 15; row0 = b * TB + CTX + qb * 256; seq = TB; tok0 = qb * 256; rope = true; }
        else { const int j = id - 1024; b = j >> 4; h = j & 15; row0 = b * TB; seq = CTX; tok0 = 0; rope = false; }
        att::attn_body<192, 3072, 3072, 2048, 2048>(Q + (size_t)row0 * 3072 + h * 192, K + (size_t)b * TB * 3072 + h * 192, V + (size_t)b * TB * DM + h * 128,
                                                    O + (size_t)row0 * DM + h * 128, seq, lds, nullptr, tab, rope, tok0);
    }
}

constexpr int NPHASES = 39;
__global__ void __launch_bounds__(NWAVES * 64, 2) trunk_fwd(Args a) {
    extern __shared__ __attribute__((aligned(16))) unsigned char lds_raw[];
    LAS unsigned char* lds = (LAS unsigned char*)lds_raw;
    const int tid = threadIdx.x, lane = tid & 63, wave = __builtin_amdgcn_readfirstlane(tid >> 6);
    const int G = gridDim.x; const int bx = blockIdx.x; const int vcu = (G % 8 == 0) ? (bx % 8) * (G / 8) + bx / 8 : bx;
    const int gw = vcu * NWAVES + wave, NGW = G * NWAVES;
    unsigned char* ws = a.ws;
    for (int u = tid; u < (LDS_BYTES - LDSCTL_OFF) / 4; u += NWAVES * 64) ((LAS unsigned*)(lds + LDSCTL_OFF))[u] = 0u;
    __syncthreads();
    const int lo = a.ph_lo, hi = a.ph_hi;
    const bool use_bar = (hi - lo) > 1;
    XcdBarrier bar; bar.bar = (unsigned*)(ws + WS_CTL) + 1024; bar.x = 0; bar.st = nullptr;
    if (use_bar) bar = xcd_barrier_post((unsigned*)(ws + WS_CTL) + 1024, (volatile LAS unsigned*)(lds + LDSCTL_OFF + 64));
    int ph = 0;
#ifndef PH_FILTER
#define PH_FILTER(p) true
#endif
#define PH_BEGIN if (PH_FILTER(ph) && ph >= lo && ph < hi) {
#define PH_END   if (ph + 1 < hi) xcd_barrier(bar); } ++ph;

    PH_BEGIN ph_mods(a, lds, vcu, G); __syncthreads(); ph_transposes(a, lds, vcu, G); PH_END
    PH_BEGIN ph_init(a, gw, NGW, lane); PH_END

    bf16_t* const Hb = (bf16_t*)(ws + WS_H);
    bf16_t* const OUTF = (bf16_t*)(ws + WS_OUTF);
    bf16_t* const ACT = (bf16_t*)(ws + WS_ACT);

    float* const PARTB = (float*)(ws + WS_PART);
#define MLP_PHASES(L) \
    PH_BEGIN ph_ln<false, 1>(a, L, 0, gw, NGW, lane); PH_END \
    PH_BEGIN run_gemm(lds, Hb, DM, (const bf16_t*)(ws + WS_W1T) + (size_t)(L) * DFF * DM, DM, DFF, DM, 0, FRelu2{ACT}, G); PH_END \
    PH_BEGIN run_gemm_out(lds, ACT, DFF, (const bf16_t*)(ws + WS_W2T) + (size_t)(L) * DM * DFF, DFF, 8, OUTF, PARTB, G); PH_END \
    PH_BEGIN ph_ln<false, 1>(a, L, 1, gw, NGW, lane); PH_END
#define MLP_PHASES_LAST(L) \
    PH_BEGIN ph_ln<false, 2>(a, L, 0, gw, NGW, lane); PH_END \
    PH_BEGIN run_gemm_lat(lds, Hb, DM, (const bf16_t*)(ws + WS_W1T) + (size_t)(L) * DFF * DM, DM, DFF, DM, FRelu2{ACT}, G); PH_END \
    PH_BEGIN run_gemm_out(lds, ACT, DFF, (const bf16_t*)(ws + WS_W2T) + (size_t)(L) * DM * DFF, DFF, 0, OUTF, PARTB, G); PH_END \
    PH_BEGIN ph_ln<true, 2>(a, L, 1, gw, NGW, lane); PH_END

#define GQA_LAYER(L, SLOT, LASTL) \
    PH_BEGIN run_gemm(lds, Hb, DM, (const bf16_t*)(ws + WS_GQAW + (SLOT) * 20 * MiB), DM, 3072, DM, 0, FQkv{(bf16_t*)(ws + WS_GQ), (bf16_t*)(ws + WS_GK), (bf16_t*)(ws + WS_GV), nullptr, 0, 0}, G); PH_END \
    PH_BEGIN ph_knorm(a, a.gqa_k_g + (SLOT) * 128, gw, NGW, lane); PH_END \
    PH_BEGIN ph_attn_gqa(a, (char*)lds_raw, a.gqa_q_g + (SLOT) * 128, !(LASTL), vcu, G); PH_END \
    PH_BEGIN run_gemm_out(lds, (const bf16_t*)(ws + WS_GO), DM, (const bf16_t*)(ws + WS_GQAW + (SLOT) * 20 * MiB + 12 * MiB), DM, (LASTL) ? 0 : 8, OUTF, PARTB, G); PH_END

    GQA_LAYER(0, 0, false)
    MLP_PHASES(0)
    PH_BEGIN run_gemm(lds, Hb, DM, (const bf16_t*)(ws + WS_LRUW), DM, 4096, DM, 0, FLruXY{(bf16_t*)(ws + WS_LUP), (bf16_t*)(ws + WS_LGY), false}, G); PH_END
    PH_BEGIN ph_conv(a, gw, NGW, lane); PH_END
    PH_BEGIN { EpiGates eg{(bf16_t*)(ws + WS_LAF), (const bf16_t*)(ws + WS_LU), a.lru_ra_b, a.lru_ix_b, (const float*)(ws + WS_TAB + 32768)};
               pg8::Gemm g{(const bf16_t*)(ws + WS_LU), (const bf16_t*)(ws + WS_LRUW + 16 * MiB), R, 8192, 256, DM, 256, 1}; pg8::StaticOrder S; S.init(R, 8192, 256, G, (int)blockIdx.x);
               PROBE_REPEAT_GEMM
               pg8::gemm_phase<EpiGates, pg8::StaticOrder, true, true>(lds, g, S, eg); } PH_END
    PH_BEGIN ph_scan1(a, gw, NGW, lane); PH_END
    PH_BEGIN ph_scan2(a, vcu * 512 + tid, G * 512); PH_END
    PH_BEGIN ph_scan3(a, gw, NGW, lane); PH_END
    PH_BEGIN run_gemm_out(lds, (const bf16_t*)(ws + WS_LG), DM, (const bf16_t*)(ws + WS_LRUW + 20 * MiB), DM, 8, OUTF, PARTB, G); PH_END
    MLP_PHASES(1)
    PH_BEGIN run_gemm(lds, Hb, DM, (const bf16_t*)(ws + WS_MLAW), DM, 1280, DM, 0, FStoreF32{(float*)(ws + WS_MAP), 1280}, G); PH_END
    PH_BEGIN ph_mla_norm(a, gw, NGW, lane); PH_END
    PH_BEGIN run_gemm(lds, (const bf16_t*)(ws + WS_MQAN), 512, (const bf16_t*)(ws + WS_MLAW + 5 * MiB), 512, 3072, 512, 0, FBf16{(bf16_t*)(ws + WS_MQ), 3072}, G); PH_END
    PH_BEGIN run_gemm(lds, (const bf16_t*)(ws + WS_MCKVN), 512, (const bf16_t*)(ws + WS_MLAW + 8 * MiB), 512, 4096, 512, 0, FKvb{(bf16_t*)(ws + WS_MK), (bf16_t*)(ws + WS_MV)}, G); PH_END
    PH_BEGIN ph_attn_mla(a, (char*)lds_raw, true, vcu, G); PH_END
    PH_BEGIN run_gemm_out(lds, (const bf16_t*)(ws + WS_MO), DM, (const bf16_t*)(ws + WS_MLAW + 12 * MiB), DM, 8, OUTF, PARTB, G); PH_END
    MLP_PHASES(2)
    GQA_LAYER(3, 1, true)
    MLP_PHASES_LAST(3)
#undef PH_BEGIN
#undef PH_END
}

#ifndef MK_SPLIT
#define MK_SPLIT 0
#endif
extern "C" void kernel_launch(void* const* d_in, const int* in_sizes, int n_in, void* d_out, int out_size, void* d_ws, size_t ws_size, hipStream_t stream) {
    static int grid = 0;
    if (grid == 0) {
        if (n_in != 33 || in_sizes[0] != NB * SEQ * DM || out_size != NB * SEQ * DM || ws_size < WS_END) {
            fprintf(stderr, "kernel_launch: unexpected shapes: n_in %d in0 %d out %d ws %zu (need %zu)\n", n_in, n_in > 0 ? in_sizes[0] : -1, out_size, ws_size, (size_t)WS_END); grid = -1; return; }
        int dev = 0, cus = 0;
        if (hipGetDevice(&dev) != hipSuccess || hipDeviceGetAttribute(&cus, hipDeviceAttributeMultiprocessorCount, dev) != hipSuccess) { grid = -1; return; }
        if (hipFuncSetAttribute((const void*)trunk_fwd, hipFuncAttributeMaxDynamicSharedMemorySize, LDS_BYTES) != hipSuccess) { fprintf(stderr, "kernel_launch: hipFuncSetAttribute failed\n"); grid = -1; return; }
        int per_cu = 0;
        if (hipOccupancyMaxActiveBlocksPerMultiprocessor(&per_cu, (const void*)trunk_fwd, NWAVES * 64, LDS_BYTES) != hipSuccess || per_cu < 1)
            fprintf(stderr, "kernel_launch: occupancy query reports %d workgroups per CU\n", per_cu);
        (void)hipGetLastError();
        grid = cus;
    }
    if (grid < 0) return;
    if (hipMemsetAsync((char*)d_ws + WS_CTL, 0, CTL_ZERO_BYTES, stream) != hipSuccess) return;
    Args a{};
    const float** p = (const float**)&a;
    for (int i = 0; i < 33; ++i) p[i] = (const float*)d_in[i];
    a.out = (float*)d_out; a.ws = (unsigned char*)d_ws;
#if MK_SPLIT
    for (int k = 0; k < NPHASES; ++k) { a.ph_lo = k; a.ph_hi = k + 1; hipLaunchKernelGGL(trunk_fwd, dim3(grid), dim3(NWAVES * 64), LDS_BYTES, stream, a); }
#else
    a.ph_lo = 0; a.ph_hi = NPHASES; hipLaunchKernelGGL(trunk_fwd, dim3(grid), dim3(NWAVES * 64), LDS_BYTES, stream, a);
#endif
    const hipError_t le = hipPeekAtLastError();
    if (le != hipSuccess) fprintf(stderr, "kernel_launch: launch failed: %s\n", hipGetErrorName(le));
}
```

```cpp
#include <hip/hip_runtime.h>
#include <cstdio>
#include <cstdint>
#include <cmath>

#define LAS __attribute__((address_space(3)))
#define GAS __attribute__((address_space(1)))
typedef unsigned short bf16_t;
typedef short bf16x8 __attribute__((ext_vector_type(8)));
typedef short s16x4 __attribute__((ext_vector_type(4)));
typedef float f32x4 __attribute__((ext_vector_type(4)));
typedef float f32x2 __attribute__((ext_vector_type(2)));
typedef float f32x16 __attribute__((ext_vector_type(16)));
typedef unsigned u32x4 __attribute__((ext_vector_type(4)));
typedef unsigned u32x2 __attribute__((ext_vector_type(2)));

__device__ __forceinline__ unsigned cvt_pk_bf16(float lo, float hi) { unsigned r; asm volatile("v_cvt_pk_bf16_f32 %0, %1, %2" : "=v"(r) : "v"(lo), "v"(hi)); return r; }
__device__ __forceinline__ float bf_lo(unsigned w) { return __uint_as_float(w << 16); }
__device__ __forceinline__ float bf_hi(unsigned w) { return __uint_as_float(w & 0xffff0000u); }
__device__ __forceinline__ float bf2f(bf16_t h) { return __uint_as_float(((unsigned)h) << 16); }
__device__ __forceinline__ bf16_t f2bf(float f) { return (bf16_t)(cvt_pk_bf16(f, f) & 0xffffu); }

constexpr int DM = 2048, NB = 4, SEQ = 4096, CTX = 256, TB = SEQ + CTX  , R = NB * TB  , DFF = 8192, DEPTH = 4;
constexpr float LN_EPS = 1e-6f;
constexpr float DN_ALPHA = 1.6817928305074290861f;

namespace pg8 {
constexpr int BM = 256, BK = 64, HALF = 128, HTB = HALF * BK * 2, STAGE_BYTES = 8 * HTB, NXCD = 8, WGM = 4;
__host__ __device__ __forceinline__ int lds_byte(int r, int c) { const int st = (r >> 4) * 2 + (c >> 5), rr = r & 15, cc = c & 31, ob = rr * 64 + cc * 2; return st * 1024 + (ob ^ (((ob >> 9) & 1) << 5)); }
__host__ __device__ __forceinline__ void stage_rc(int b, int& Rr, int& C) { const int st = b / 1024, sb = b % 1024, swz = sb ^ (((sb >> 9) & 1) << 5); Rr = (st >> 1) * 16 + swz / 64; C = (st & 1) * 32 + (swz % 64) / 2; }
__host__ __device__ __forceinline__ int perm32(int rho) { const int n = rho >> 4, i = rho & 15; return 8 * (i >> 2) + 4 * n + (i & 3); }

struct Unit { int pm, pn, k0, nk, slice; };
struct Gemm { const bf16_t* A; const bf16_t* Bt; int M, N, K, lda, ldb, a_blk; };

struct StaticOrder {
    int nM, nN, nwg, G, c, nt;
    __device__ __forceinline__ void init(int M, int N, int K, int G_, int c_) { nM = M / BM; nN = N / BM; nwg = nM * nN; G = G_; c = c_; nt = K / BK; }
    __device__ __forceinline__ Unit next(int i) const {
        const long L = (long)i * G + c; if (L >= nwg) return Unit{-1, 0, 0, 0, -1};
        int wgid = (int)L; { const int q = nwg / NXCD, r = nwg % NXCD, xcd = wgid % NXCD, off = wgid / NXCD; wgid = (xcd < r ? xcd * (q + 1) : r * (q + 1) + (xcd - r) * q) + off; }
        const int nig = WGM * nN, gid = wgid / nig, fm = gid * WGM, gsz = (nM - fm) < WGM ? (nM - fm) : WGM;
        return Unit{fm + ((wgid % nig) % gsz), (wgid % nig) / gsz, 0, nt, -1};
    }
};
struct LatOrder {
    int nN, nwg, G, c, nt, SK, rev;
    __device__ __forceinline__ void init(int N, int K, int G_, int c_, int SK_, int rev_ = 0) { nN = N / BM; nwg = 64 * nN; G = G_; c = c_; nt = K / BK; SK = SK_; rev = rev_; }
    __device__ __forceinline__ Unit next(int i) const {
        const int nlat = c < nwg ? (nwg - c + G - 1) / G : 0;
        if (i < nlat) {
            int wgid = i * G + c; { const int q = nwg / NXCD, r = nwg % NXCD, xcd = wgid % NXCD, off = wgid / NXCD; wgid = (xcd < r ? xcd * (q + 1) : r * (q + 1) + (xcd - r) * q) + off; }
            const int nig = WGM * nN, gid = wgid / nig, fm = gid * WGM;
            int lp = fm + ((wgid % nig) % WGM); if (rev) lp = 63 - lp;
            return Unit{(lp >> 4) * 17 + 1 + (lp & 15), (wgid % nig) / WGM, 0, nt, -1};
        }
        if (SK > 0 && i >= nlat) { const int su = c + (i - nlat) * G;
            if (su < 4 * nN * SK) { const int t = su / SK, sl = su % SK, nks = nt / SK; return Unit{17 * (t / nN), t % nN, sl * nks, nks, sl}; } }
        return Unit{-1, 0, 0, 0, -1};
    }
};

template <class F> struct EpiRow8 {
    static constexpr bool PERM = true;
    F f;
    __device__ __forceinline__ void operator()(const f32x4 (&acc)[2][2][4][2], const Unit& u, int wr, int wc, int fr, int fq) {
        const int row0 = u.pm * BM + wr * 64 + fr, colb = u.pn * BM + wc * 32 + 8 * fq;
        f.begin(u, colb);
#pragma unroll
        for (int ai = 0; ai < 2; ++ai)
#pragma unroll
            for (int m = 0; m < 4; ++m) {
                const int row = row0 + ai * HALF + m * 16;
#pragma unroll
                for (int bj = 0; bj < 2; ++bj) f.row8(row, bj, colb + bj * HALF, acc[ai][bj][m][0], acc[ai][bj][m][1]);
            }
    }
};

template <class Epi, class Sched, bool ALIGN_EPI = true, bool SP2 = true>
__device__ __forceinline__ void gemm_phase(LAS unsigned char* lds, const Gemm g, const Sched& S, Epi& E) {
    int tid = threadIdx.x; asm volatile("" : "+v"(tid));
    const int wid = __builtin_amdgcn_readfirstlane(tid >> 6), lane = tid & 63, wr = wid >> 2, wc = wid & 3, fr = lane & 15, fq = lane >> 4;
    unsigned voffA[2], voffB[2];
#pragma unroll
    for (int i = 0; i < 2; ++i) { int Rr, C; stage_rc(tid * 16 + i * 8192, Rr, C); const int Rb = Epi::PERM ? ((Rr & ~31) + perm32(Rr & 31)) : Rr;
        voffA[i] = (unsigned)(Rr * g.lda + C) * 2u; voffB[i] = (unsigned)(Rb * g.ldb + C) * 2u; }
    const size_t kstep = (size_t)(BK * 2);
    const size_t hstepA = (size_t)HALF * g.lda * 2, hstepB = (size_t)HALF * g.ldb * 2;
    const size_t tstepA = 2 * hstepA, tstepB = 2 * hstepB;
    const unsigned ldsw = (unsigned)wid * 1024u;
    const int aoff = lds_byte(wr * 64 + fr, fq * 8), boff = lds_byte(wc * 32 + fr, fq * 8);
#define PG8_SA(b, h) (((b) * 2 + (h)) * HTB)
#define PG8_SB(b, h) ((4 + (b) * 2 + (h)) * HTB)
#define PG8_STAGE(bufoff, gbase, voff) do { _Pragma("unroll") for (int _i = 0; _i < 2; ++_i) \
        __builtin_amdgcn_global_load_lds((const unsigned*)((const char*)(gbase) + (voff)[_i]), (LAS unsigned*)(lds + (bufoff) + ldsw + _i * 8192), 16, 0, 0); } while (0)
#define PG8_LDA(dst, b, h) do { _Pragma("unroll") for (int m = 0; m < 4; ++m) _Pragma("unroll") for (int k = 0; k < 2; ++k) dst[m][k] = *(const LAS bf16x8*)(lds + PG8_SA(b, h) + aoff + m * 2048 + k * 1024); } while (0)
#define PG8_LDB(dst, b, h) do { _Pragma("unroll") for (int n = 0; n < 2; ++n) _Pragma("unroll") for (int k = 0; k < 2; ++k) dst[n][k] = *(const LAS bf16x8*)(lds + PG8_SB(b, h) + boff + n * 2048 + k * 1024); } while (0)
#define PG8_MMA(ai, bj, At, Bt) do { __builtin_amdgcn_s_setprio(1); _Pragma("unroll") for (int m = 0; m < 4; ++m) _Pragma("unroll") for (int n = 0; n < 2; ++n) _Pragma("unroll") for (int k = 0; k < 2; ++k) \
        acc[ai][bj][m][n] = __builtin_amdgcn_mfma_f32_16x16x32_bf16(Bt[n][k], At[m][k], acc[ai][bj][m][n], 0, 0, 0); __builtin_amdgcn_s_setprio(0); } while (0)
#define PG8_WAIT_V(n) asm volatile("s_waitcnt vmcnt(" #n ")" ::: "memory")
#define PG8_WAIT_L(n) asm volatile("s_waitcnt lgkmcnt(" #n ")" ::: "memory")
#define PG8_BAR __builtin_amdgcn_s_barrier()
#define PG8_SCHED __builtin_amdgcn_sched_barrier(0)
    Unit cur = S.next(0), nxt = cur; int ui = 0;
    if (cur.pm < 0) return;
    f32x4 acc[2][2][4][2];
#pragma unroll
    for (int a = 0; a < 2; ++a)
#pragma unroll
        for (int b = 0; b < 2; ++b)
#pragma unroll
            for (int m = 0; m < 4; ++m)
#pragma unroll
                for (int n = 0; n < 2; ++n) acc[a][b][m][n] = (f32x4){0.f, 0.f, 0.f, 0.f};
    bf16x8 At[4][2], B0[2][2], B1[2][2];
    const char* cA = (const char*)g.A + (size_t)cur.pm * tstepA + (size_t)(g.a_blk ? (cur.pn & 7) * 512 : 0) + (size_t)cur.k0 * kstep; const char* cB = (const char*)g.Bt + (size_t)cur.pn * tstepB + (size_t)cur.k0 * kstep;
    if constexpr (SP2) {
        PG8_STAGE(PG8_SB(0, 0), cB, voffB); PG8_STAGE(PG8_SB(0, 1), cB + hstepB, voffB); PG8_STAGE(PG8_SA(0, 0), cA, voffA); PG8_STAGE(PG8_SA(0, 1), cA + hstepA, voffA);
        if (wr == 1) PG8_BAR;
        PG8_WAIT_V(2); PG8_BAR;
        PG8_STAGE(PG8_SB(1, 0), cB + kstep, voffB); PG8_STAGE(PG8_SA(1, 0), cA + kstep, voffA); PG8_STAGE(PG8_SB(1, 1), cB + hstepB + kstep, voffB);
        PG8_WAIT_V(6); PG8_BAR;
    } else {
        PG8_STAGE(PG8_SB(0, 0), cB, voffB); PG8_STAGE(PG8_SA(0, 0), cA, voffA); PG8_STAGE(PG8_SB(0, 1), cB + hstepB, voffB); PG8_STAGE(PG8_SA(0, 1), cA + hstepA, voffA);
        if (wr == 1) PG8_BAR;
        PG8_WAIT_V(4); PG8_BAR;
        PG8_STAGE(PG8_SB(1, 0), cB + kstep, voffB); PG8_STAGE(PG8_SA(1, 0), cA + kstep, voffA); PG8_STAGE(PG8_SB(1, 1), cB + hstepB + kstep, voffB);
        PG8_WAIT_V(6); PG8_BAR;
    }
    for (;;) {
        nxt = S.next(ui + 1); const bool has_next = nxt.pm >= 0;
        const char* nA = has_next ? (const char*)g.A + (size_t)nxt.pm * tstepA + (size_t)(g.a_blk ? (nxt.pn & 7) * 512 : 0) + (size_t)nxt.k0 * kstep : cA; const char* nB = has_next ? (const char*)g.Bt + (size_t)nxt.pn * tstepB + (size_t)nxt.k0 * kstep : cB;
        const int nt = cur.nk;
#pragma unroll 1
        for (int t = 0; t < nt; t += 2) {
            const bool last = (t == nt - 2);
            const char* a1 = cA + (size_t)(t + 1) * kstep;
            const char* a2 = last ? nA : cA + (size_t)(t + 2) * kstep; const char* b2 = last ? nB : cB + (size_t)(t + 2) * kstep;
            const char* a3 = a2 + kstep; const char* b3 = b2 + kstep;
            if constexpr (SP2) {
            PG8_LDB(B0, 0, 0); PG8_LDB(B1, 0, 1); PG8_SCHED; PG8_LDA(At, 0, 0); PG8_STAGE(PG8_SA(1, 1), a1 + hstepA, voffA);
            PG8_WAIT_V(8); PG8_WAIT_L(0); PG8_BAR; PG8_MMA(0, 0, At, B0); PG8_MMA(0, 1, At, B1); PG8_BAR; PG8_SCHED;
            PG8_LDA(At, 0, 1); PG8_STAGE(PG8_SB(0, 0), b2, voffB); PG8_STAGE(PG8_SB(0, 1), b2 + hstepB, voffB); PG8_STAGE(PG8_SA(0, 0), a2, voffA);
            PG8_WAIT_V(8); PG8_WAIT_L(0); PG8_BAR; PG8_MMA(1, 0, At, B0); PG8_MMA(1, 1, At, B1); PG8_BAR; PG8_SCHED;
            PG8_LDB(B0, 1, 0); PG8_LDB(B1, 1, 1); PG8_SCHED; PG8_LDA(At, 1, 0); PG8_STAGE(PG8_SA(0, 1), a2 + hstepA, voffA);
            PG8_WAIT_V(8); PG8_WAIT_L(0); PG8_BAR; PG8_MMA(0, 0, At, B0); PG8_MMA(0, 1, At, B1); PG8_BAR; PG8_SCHED;
            PG8_LDA(At, 1, 1); PG8_STAGE(PG8_SB(1, 0), b3, voffB); PG8_STAGE(PG8_SB(1, 1), b3 + hstepB, voffB); PG8_STAGE(PG8_SA(1, 0), a3, voffA);
            PG8_WAIT_V(8); PG8_WAIT_L(0); PG8_BAR; PG8_MMA(1, 0, At, B0); PG8_MMA(1, 1, At, B1); PG8_BAR; PG8_SCHED;
            } else {
            PG8_LDB(B0, 0, 0); PG8_SCHED; PG8_LDA(At, 0, 0); PG8_STAGE(PG8_SA(1, 1), a1 + hstepA, voffA);
            PG8_WAIT_L(8); PG8_BAR; PG8_WAIT_L(0); PG8_MMA(0, 0, At, B0); PG8_BAR; PG8_SCHED;
            PG8_LDB(B1, 0, 1); PG8_STAGE(PG8_SB(0, 0), b2, voffB);
            PG8_BAR; PG8_WAIT_L(0); PG8_MMA(0, 1, At, B1); PG8_BAR;
            PG8_LDA(At, 0, 1); PG8_STAGE(PG8_SA(0, 0), a2, voffA);
            PG8_BAR; PG8_WAIT_L(0); PG8_MMA(1, 0, At, B0); PG8_BAR; PG8_SCHED;
            PG8_STAGE(PG8_SB(0, 1), b2 + hstepB, voffB);
            PG8_WAIT_V(6); PG8_BAR; PG8_MMA(1, 1, At, B1); PG8_BAR;
            PG8_LDB(B0, 1, 0); PG8_SCHED; PG8_LDA(At, 1, 0); PG8_STAGE(PG8_SA(0, 1), a2 + hstepA, voffA);
            PG8_WAIT_L(8); PG8_BAR; PG8_WAIT_L(0); PG8_MMA(0, 0, At, B0); PG8_BAR; PG8_SCHED;
            PG8_LDB(B1, 1, 1); PG8_STAGE(PG8_SB(1, 0), b3, voffB);
            PG8_BAR; PG8_WAIT_L(0); PG8_MMA(0, 1, At, B1); PG8_BAR;
            PG8_LDA(At, 1, 1); PG8_STAGE(PG8_SA(1, 0), a3, voffA);
            PG8_BAR; PG8_WAIT_L(0); PG8_MMA(1, 0, At, B0); PG8_BAR; PG8_SCHED;
            PG8_STAGE(PG8_SB(1, 1), b3 + hstepB, voffB);
            PG8_WAIT_V(6); PG8_BAR; PG8_MMA(1, 1, At, B1); PG8_BAR;
            }
        }
        if constexpr (ALIGN_EPI) { if (wr == 0) PG8_BAR; }
        E(acc, cur, wr, wc, fr, fq);
        if (!has_next) break;
#pragma unroll
        for (int a = 0; a < 2; ++a)
#pragma unroll
            for (int b = 0; b < 2; ++b)
#pragma unroll
                for (int m = 0; m < 4; ++m)
#pragma unroll
                    for (int n = 0; n < 2; ++n) acc[a][b][m][n] = (f32x4){0.f, 0.f, 0.f, 0.f};
        cur = nxt; cA = nA; cB = nB; ++ui;
        if constexpr (ALIGN_EPI) { if (wr == 1) PG8_BAR; }
    }
    PG8_WAIT_V(0);
    if constexpr (!ALIGN_EPI) { if (wr == 0) PG8_BAR; }
    PG8_BAR;
#undef PG8_SA
#undef PG8_SB
#undef PG8_STAGE
#undef PG8_LDA
#undef PG8_LDB
#undef PG8_MMA
#undef PG8_WAIT_V
#undef PG8_WAIT_L
#undef PG8_BAR
#undef PG8_SCHED
}
}

namespace att {
constexpr int NW = 8, QBLK = 32, KVBLK = 64, DV = 128;
constexpr float THR = 8.f;
#define SBAR() __builtin_amdgcn_sched_barrier(0)
__device__ __forceinline__ int crow(int r, int hi) { return (r & 3) + 8 * (r >> 2) + 4 * hi; }
template <int DQK> struct Cfg {
    static constexpr int KROW = DQK * 2;
    static constexpr int SHM_K = KVBLK * KROW, SHM_V = KVBLK * DV * 2;
    static constexpr int QPE_OFF = 2 * SHM_V + 2 * SHM_K + NW * 64 * 4;
    static constexpr int NPARK = DQK == 192 ? 4 : 0;
    static constexpr int QR0 = DQK / 16 - NPARK;
    static constexpr int LDS_BYTES = QPE_OFF + NW * NPARK * 1024;
    static constexpr int NQ = DQK / 16;
    static constexpr int NKC = DQK / 64;
};
template <int DQK> __device__ __forceinline__ int kswz(int row, int colB) { return row * (DQK * 2) + (colB ^ (DQK == 128 ? ((row & 15) << 4) : (((row >> 1) & 7) << 4))); }

template <int DQK>
__device__ __forceinline__ void partialSM(f32x16& p0, f32x16& p1, float& m_reg, float& mn, float& alpha) {
    constexpr float SCALE = DQK == 128 ? 0.08838834764831845f : 0.07216878364870322f;
    constexpr float C = SCALE * 1.4426950408889634f;
    float pmax = p0[0];
#pragma unroll
    for (int r = 1; r < 16; ++r) pmax = fmaxf(pmax, p0[r]);
#pragma unroll
    for (int r = 0; r < 16; ++r) pmax = fmaxf(pmax, p1[r]);
    { auto rr = __builtin_amdgcn_permlane32_swap(__float_as_uint(pmax), __float_as_uint(pmax), false, false);
      pmax = fmaxf(__uint_as_float(rr[0]), __uint_as_float(rr[1])); }
    if (__builtin_expect(__all(pmax - m_reg <= THR / SCALE), 1)) { mn = m_reg; alpha = 1.f; }
    else { mn = fmaxf(m_reg, pmax); alpha = __builtin_amdgcn_exp2f((m_reg - mn) * C); m_reg = mn; }
    const float mnC = -mn * C;
#pragma unroll
    for (int r = 0; r < 16; ++r) p0[r] = fmaf(p0[r], C, mnC);
#pragma unroll
    for (int r = 0; r < 16; ++r) p1[r] = fmaf(p1[r], C, mnC);
#pragma unroll
    for (int r = 0; r < 16; ++r) p0[r] = __builtin_amdgcn_exp2f(p0[r]);
}
__device__ __forceinline__ void finishSM(f32x16& p0, f32x16& p1, float alpha, float& l_reg, bf16x8& pa0, bf16x8& pa1, bf16x8& pa2, bf16x8& pa3) {
#pragma unroll
    for (int r = 0; r < 16; ++r) p1[r] = __builtin_amdgcn_exp2f(p1[r]);
    float ps = 0;
#pragma unroll
    for (int r = 0; r < 16; ++r) ps += p0[r];
#pragma unroll
    for (int r = 0; r < 16; ++r) ps += p1[r];
    { auto rr = __builtin_amdgcn_permlane32_swap(__float_as_uint(ps), __float_as_uint(ps), false, false);
      ps = __uint_as_float(rr[0]) + __uint_as_float(rr[1]); }
    l_reg = l_reg * alpha + ps;
#define PK4(P, BASE, OUT) do { unsigned a0 = cvt_pk_bf16(P[BASE + 0], P[BASE + 1]), a1 = cvt_pk_bf16(P[BASE + 2], P[BASE + 3]);   \
    unsigned b0 = cvt_pk_bf16(P[BASE + 4], P[BASE + 5]), b1 = cvt_pk_bf16(P[BASE + 6], P[BASE + 7]);                              \
    auto r0 = __builtin_amdgcn_permlane32_swap(a0, b0, false, false); auto r1 = __builtin_amdgcn_permlane32_swap(a1, b1, false, false); \
    u32x4 w = {r0[0], r1[0], r0[1], r1[1]}; OUT = *reinterpret_cast<bf16x8*>(&w); } while (0)
    PK4(p0, 0, pa0); PK4(p0, 8, pa1); PK4(p1, 0, pa2); PK4(p1, 8, pa3);
#undef PK4
}
__device__ __forceinline__ void partialSM_nomax(f32x16& p0, f32x16& p1) {
    SBAR();
#pragma unroll
    for (int r = 0; r < 16; ++r) p0[r] = __builtin_amdgcn_exp2f(p0[r]);
    SBAR();
}
template <int DQK, bool PARK = (DQK == 192)>
__device__ __forceinline__ void qkt(f32x16& p0, f32x16& p1, const char* Ks, const bf16x8* qr, const char* qpe, int r32, int hi) {
    p0 = f32x16{}; p1 = f32x16{};
#pragma unroll
    for (int d0 = 0; d0 < DQK / 16; ++d0) { const int cb = (d0 * 16 + hi * 8) * 2;
        bf16x8 b0 = *reinterpret_cast<const bf16x8*>(Ks + kswz<DQK>(r32, cb));
        bf16x8 b1 = *reinterpret_cast<const bf16x8*>(Ks + kswz<DQK>(32 + r32, cb));
        bf16x8 q; if (!PARK || d0 < Cfg<DQK>::QR0) q = qr[(!PARK || d0 < Cfg<DQK>::QR0) ? d0 : 0]; else q = *reinterpret_cast<const bf16x8*>(qpe + (d0 - Cfg<DQK>::QR0) * 1024);
        p0 = __builtin_amdgcn_mfma_f32_32x32x16_bf16(b0, q, p0, 0, 0, 0);
        p1 = __builtin_amdgcn_mfma_f32_32x32x16_bf16(b1, q, p1, 0, 0, 0);
        if (DQK == 192 && (d0 & 3) == 3 && d0 != 11) SBAR(); }
}
__device__ __forceinline__ int v_st(int k, int c) { const int kk = (k & ~0xC) | ((k & 4) << 1) | ((k & 8) >> 1); return ((kk >> 3) * 4 + (c >> 5)) * 512 + ((kk & 7) * 32 + (c & 31)) * 2; }
__device__ __forceinline__ int v_rd_base(int lane) { return ((lane & 3) << 3) | (((lane >> 2) & 3) << 6) | (((lane >> 4) & 1) << 5) | (((lane >> 5) & 1) << 8); }
constexpr int v_rd_off(int d0, int ks, int half) { return d0 * 512 + ks * 4096 + half * 2048; }
template <int OFF> __device__ __forceinline__ s16x4 tr_read(int vb) {
    s16x4 r; asm volatile("ds_read_b64_tr_b16 %0, %1 offset:%2" : "=&v"(r) : "v"(vb), "i"(OFF) : "memory"); return r;
}
template <int D0> __device__ __forceinline__ void pv_one(f32x16& od, int vb, bf16x8 pa0, bf16x8 pa1, bf16x8 pa2, bf16x8 pa3) {
    const s16x4 l0 = tr_read<v_rd_off(D0, 0, 0)>(vb), h0 = tr_read<v_rd_off(D0, 0, 1)>(vb), l1 = tr_read<v_rd_off(D0, 1, 0)>(vb), h1 = tr_read<v_rd_off(D0, 1, 1)>(vb);
    const s16x4 l2 = tr_read<v_rd_off(D0, 2, 0)>(vb), h2 = tr_read<v_rd_off(D0, 2, 1)>(vb), l3 = tr_read<v_rd_off(D0, 3, 0)>(vb), h3 = tr_read<v_rd_off(D0, 3, 1)>(vb);
    asm volatile("s_waitcnt lgkmcnt(0)" ::: "memory"); SBAR();
#define PK(L, H) (bf16x8){L[0], L[1], L[2], L[3], H[0], H[1], H[2], H[3]}
    od = __builtin_amdgcn_mfma_f32_32x32x16_bf16(pa0, PK(l0, h0), od, 0, 0, 0);
    od = __builtin_amdgcn_mfma_f32_32x32x16_bf16(pa1, PK(l1, h1), od, 0, 0, 0);
    od = __builtin_amdgcn_mfma_f32_32x32x16_bf16(pa2, PK(l2, h2), od, 0, 0, 0);
    od = __builtin_amdgcn_mfma_f32_32x32x16_bf16(pa3, PK(l3, h3), od, 0, 0, 0);
#undef PK
}
__device__ __forceinline__ void pv_d0(f32x16* o, int vb, bf16x8 pa0, bf16x8 pa1, bf16x8 pa2, bf16x8 pa3) {
    pv_one<0>(o[0], vb, pa0, pa1, pa2, pa3); pv_one<1>(o[1], vb, pa0, pa1, pa2, pa3); pv_one<2>(o[2], vb, pa0, pa1, pa2, pa3); pv_one<3>(o[3], vb, pa0, pa1, pa2, pa3);
}
struct VFrag { s16x4 l0, h0, l1, h1, l2, h2, l3, h3; };
template <int D0> __device__ __forceinline__ void pv_reads(VFrag& f, int vb) {
    f.l0 = tr_read<v_rd_off(D0, 0, 0)>(vb); f.h0 = tr_read<v_rd_off(D0, 0, 1)>(vb); f.l1 = tr_read<v_rd_off(D0, 1, 0)>(vb); f.h1 = tr_read<v_rd_off(D0, 1, 1)>(vb);
    f.l2 = tr_read<v_rd_off(D0, 2, 0)>(vb); f.h2 = tr_read<v_rd_off(D0, 2, 1)>(vb); f.l3 = tr_read<v_rd_off(D0, 3, 0)>(vb); f.h3 = tr_read<v_rd_off(D0, 3, 1)>(vb);
}
__device__ __forceinline__ void pv_mma(f32x16& od, const VFrag& f, bf16x8 pa0, bf16x8 pa1, bf16x8 pa2, bf16x8 pa3) {
#define PK(L, H) (bf16x8){L[0], L[1], L[2], L[3], H[0], H[1], H[2], H[3]}
    od = __builtin_amdgcn_mfma_f32_32x32x16_bf16(pa0, PK(f.l0, f.h0), od, 0, 0, 0);
    od = __builtin_amdgcn_mfma_f32_32x32x16_bf16(pa1, PK(f.l1, f.h1), od, 0, 0, 0);
    od = __builtin_amdgcn_mfma_f32_32x32x16_bf16(pa2, PK(f.l2, f.h2), od, 0, 0, 0);
    od = __builtin_amdgcn_mfma_f32_32x32x16_bf16(pa3, PK(f.l3, f.h3), od, 0, 0, 0);
#undef PK
}
__device__ __forceinline__ void pv_pipe(f32x16* o, int vb, bf16x8 pa0, bf16x8 pa1, bf16x8 pa2, bf16x8 pa3) {
    VFrag fa, fb;
    pv_reads<0>(fa, vb); pv_reads<1>(fb, vb);
    asm volatile("s_waitcnt lgkmcnt(8)" ::: "memory"); SBAR();
    pv_mma(o[0], fa, pa0, pa1, pa2, pa3); SBAR();
    pv_reads<2>(fa, vb);
    asm volatile("s_waitcnt lgkmcnt(8)" ::: "memory"); SBAR();
    pv_mma(o[1], fb, pa0, pa1, pa2, pa3); SBAR();
    pv_reads<3>(fb, vb);
    asm volatile("s_waitcnt lgkmcnt(8)" ::: "memory"); SBAR();
    pv_mma(o[2], fa, pa0, pa1, pa2, pa3); SBAR();
    asm volatile("s_waitcnt lgkmcnt(0)" ::: "memory"); SBAR();
    pv_mma(o[3], fb, pa0, pa1, pa2, pa3);
}
__device__ __forceinline__ void unpack8(bf16x8 v, float* f) {
    const u32x4 w = *reinterpret_cast<const u32x4*>(&v);
    f[0] = bf_lo(w.x); f[1] = bf_hi(w.x); f[2] = bf_lo(w.y); f[3] = bf_hi(w.y); f[4] = bf_lo(w.z); f[5] = bf_hi(w.z); f[6] = bf_lo(w.w); f[7] = bf_hi(w.w);
}
__device__ __forceinline__ bf16x8 pack8(const float* f) {
    u32x4 w = {cvt_pk_bf16(f[0], f[1]), cvt_pk_bf16(f[2], f[3]), cvt_pk_bf16(f[4], f[5]), cvt_pk_bf16(f[6], f[7])}; return *reinterpret_cast<bf16x8*>(&w);
}
__device__ __forceinline__ void rope_pair(bf16x8& A, bf16x8& B, const f32x2* __restrict__ tab) {
    float a[8], b[8], ra[8], rb[8]; unpack8(A, a); unpack8(B, b);
#pragma unroll
    for (int j = 0; j < 8; ++j) { const f32x2 cs = tab[j]; ra[j] = a[j] * cs.x - b[j] * cs.y; rb[j] = b[j] * cs.x + a[j] * cs.y; }
    A = pack8(ra); B = pack8(rb);
}

template <int DQK, int LDQ, int LDK, int LDV, int LDO>
__device__ __forceinline__ void attn_body(const bf16_t* __restrict__ Qb, const bf16_t* __restrict__ Kh, const bf16_t* __restrict__ Vh, bf16_t* __restrict__ Ob, int seq, char* lds,
                                          const float* __restrict__ qg, const f32x2* __restrict__ tab, bool rope, int tok0) {
    using C = Cfg<DQK>;
    int tid_ = threadIdx.x; asm volatile("" : "+v"(tid_));
    const int tid = tid_, wid = tid >> 6, lane = tid & 63, r32 = lane & 31, hi = lane >> 5;
    char* V_lds = lds; char* K_lds = lds + 2 * C::SHM_V;
    float* wsf = (float*)(lds + 2 * C::SHM_V + 2 * C::SHM_K) + wid * 64; float* li_l = wsf; float* al_l = wsf + 32;
    char* qpe = lds + C::QPE_OFF + wid * (C::NPARK * 1024) + lane * 16;
    float m_reg = -1e30f, l_reg = 0; f32x16 o[4] = {}; bf16x8 qr[C::NQ];
    const bf16_t* Qw = Qb + (long)(wid * QBLK + r32) * LDQ + hi * 8;
#pragma unroll
    for (int d0 = 0; d0 < C::NQ; ++d0) qr[d0] = *reinterpret_cast<const bf16x8*>(Qw + d0 * 16);
    {
        const int t = tok0 + wid * QBLK + r32, prow = t >> 6, pcol = t & 63;
        if constexpr (DQK == 128) {
            float ss = 0.f;
#pragma unroll
            for (int d0 = 0; d0 < 8; ++d0) { float f[8]; unpack8(qr[d0], f);
#pragma unroll
                for (int j = 0; j < 8; ++j) ss += f[j] * f[j]; }
            ss += __shfl_xor(ss, 32);
            const float rstd = 1.0f / sqrtf(ss * (1.0f / 128.0f) + 1e-6f);
#pragma unroll
            for (int d0 = 0; d0 < 8; ++d0) { float f[8]; unpack8(qr[d0], f);
#pragma unroll
                for (int j = 0; j < 8; ++j) f[j] = f[j] * rstd * qg[d0 * 16 + hi * 8 + j];
                qr[d0] = pack8(f); }
            if (rope) {
                const f32x2* tr = tab + prow * 32 + hi * 8; const f32x2* tc = tab + pcol * 32 + hi * 8;
                rope_pair(qr[0], qr[2], tr); rope_pair(qr[1], qr[3], tr + 16);
                rope_pair(qr[4], qr[6], tc); rope_pair(qr[5], qr[7], tc + 16);
            }
        } else {
            if (rope) {
                const f32x2* tr = tab + prow * 16 + hi * 8; const f32x2* tc = tab + pcol * 16 + hi * 8;
                rope_pair(qr[8], qr[9], tr); rope_pair(qr[10], qr[11], tc);
            }
        }
    }
    if constexpr (DQK == 192) {
#pragma unroll
        for (int d0 = C::QR0; d0 < 12; ++d0) *reinterpret_cast<bf16x8*>(qpe + (d0 - C::QR0) * 1024) = qr[d0];
        asm volatile("s_waitcnt lgkmcnt(0)" ::: "memory");
    }
    const int sr = tid >> 4, sc = (tid & 15) * 8, vst0 = v_st(sr, sc), vst1 = v_st(32 + sr, sc);
    const int vb0 = (int)(uintptr_t)V_lds + v_rd_base(lane);
    const int sr2 = tid >> 3, sc2 = 128 + (tid & 7) * 8;
    struct Slot { bf16x8 vs0, vs1, ks0, ks1, ks2; };
    Slot sA, sBs;
#define sB (*(DQK == 192 ? &sA : &sBs))
#define SLOAD(S, k0) do { S.vs0 = *reinterpret_cast<const bf16x8*>(&Vh[(long)((k0) + sr) * LDV + sc]); S.vs1 = *reinterpret_cast<const bf16x8*>(&Vh[(long)((k0) + 32 + sr) * LDV + sc]); \
    S.ks0 = *reinterpret_cast<const bf16x8*>(&Kh[(long)((k0) + sr) * LDK + sc]); S.ks1 = *reinterpret_cast<const bf16x8*>(&Kh[(long)((k0) + 32 + sr) * LDK + sc]); \
    if constexpr (DQK == 192) S.ks2 = *reinterpret_cast<const bf16x8*>(&Kh[(long)((k0) + sr2) * LDK + sc2]); } while (0)
#define SWRITE(b, S) do { *(bf16x8*)(V_lds + (b) * C::SHM_V + vst0) = S.vs0; *(bf16x8*)(V_lds + (b) * C::SHM_V + vst1) = S.vs1; \
    *(bf16x8*)(K_lds + (b) * C::SHM_K + kswz<DQK>(sr, sc * 2)) = S.ks0; *(bf16x8*)(K_lds + (b) * C::SHM_K + kswz<DQK>(32 + sr, sc * 2)) = S.ks1; \
    if constexpr (DQK == 192) *(bf16x8*)(K_lds + (b) * C::SHM_K + kswz<DQK>(sr2, sc2 * 2)) = S.ks2; } while (0)
#define SWAIT() do { if constexpr (DQK == 192) asm volatile("s_waitcnt vmcnt(0)" ::: "memory"); else asm volatile("s_waitcnt vmcnt(4)" ::: "memory"); } while (0)
#define RESC(a) do { if (__any((a) < 1.f)) { if (hi == 0) al_l[r32] = (a); asm volatile("s_waitcnt lgkmcnt(0)" ::: "memory"); \
    _Pragma("unroll") for (int d = 0; d < 4; ++d) _Pragma("unroll") for (int r = 0; r < 16; ++r) o[d][r] *= al_l[crow(r, hi)]; } } while (0)
    f32x16 pA0, pA1, pB0, pB1; float mnA, mnB, alA, alB; bf16x8 pa0, pa1, pa2, pa3; const int NT = seq / KVBLK;
    SLOAD(sA, 0); asm volatile("s_waitcnt vmcnt(0)" ::: "memory"); SWRITE(0, sA); __syncthreads();
    qkt<DQK>(pA0, pA1, K_lds, qr, qpe, r32, hi); partialSM<DQK>(pA0, pA1, m_reg, mnA, alA);
    SLOAD(sB, KVBLK); if constexpr (DQK != 192) { if (2 < NT) SLOAD(sA, 2 * KVBLK); }
    SWAIT(); SWRITE(1, sB); __syncthreads();
    for (int j = 1; j + 1 < NT; j += 2) {
        SBAR(); qkt<DQK>(pB0, pB1, K_lds + C::SHM_K, qr, qpe, r32, hi);
        finishSM(pA0, pA1, alA, l_reg, pa0, pa1, pa2, pa3); SBAR();
        SLOAD(sB, (j + (DQK == 192 ? 1 : 2)) * KVBLK); SBAR();
        pv_d0(o, vb0, pa0, pa1, pa2, pa3); partialSM<DQK>(pB0, pB1, m_reg, mnB, alB);
        __syncthreads(); SWAIT(); SWRITE(0, sA);
        RESC(alB); __syncthreads();
        SBAR(); qkt<DQK>(pA0, pA1, K_lds, qr, qpe, r32, hi);
        finishSM(pB0, pB1, alB, l_reg, pa0, pa1, pa2, pa3); SBAR();
        if (DQK == 192 || j + 3 < NT) SLOAD(sA, (j + (DQK == 192 ? 2 : 3)) * KVBLK); SBAR();
        pv_d0(o, vb0 + C::SHM_V, pa0, pa1, pa2, pa3); partialSM<DQK>(pA0, pA1, m_reg, mnA, alA);
        __syncthreads(); SWAIT(); SWRITE(1, sB);
        RESC(alA); __syncthreads();
    }
    SBAR(); qkt<DQK>(pB0, pB1, K_lds + C::SHM_K, qr, qpe, r32, hi);
    finishSM(pA0, pA1, alA, l_reg, pa0, pa1, pa2, pa3); SBAR();
    pv_d0(o, vb0, pa0, pa1, pa2, pa3); partialSM<DQK>(pB0, pB1, m_reg, mnB, alB);
    __syncthreads(); RESC(alB);
    finishSM(pB0, pB1, alB, l_reg, pa0, pa1, pa2, pa3); SBAR();
    pv_d0(o, vb0 + C::SHM_V, pa0, pa1, pa2, pa3);
    if (hi == 0) li_l[r32] = l_reg; asm volatile("s_waitcnt lgkmcnt(0)" ::: "memory");
    float rli[16];
#pragma unroll
    for (int r = 0; r < 16; ++r) rli[r] = __builtin_amdgcn_rcpf(li_l[crow(r, hi)]);
    bf16_t* Ow = Ob + (long)(wid * QBLK) * LDO;
#pragma unroll
    for (int r = 0; r < 16; ++r) { const int orow = crow(r, hi);
#pragma unroll
        for (int d0 = 0; d0 < 4; ++d0) Ow[(long)orow * LDO + d0 * 32 + r32] = f2bf(o[d0][r] * rli[r]); }
    __syncthreads();
#undef sB
#undef SLOAD
#undef SWRITE
#undef SWAIT
#undef RESC
}

__device__ __forceinline__ void glds16(const void* g, unsigned lds_base) {
    unsigned sv; asm volatile("s_mov_b32 %0, m0\n\ts_mov_b32 m0, %2\n\ts_nop 0\n\tglobal_load_lds_dwordx4 %1, off\n\ts_mov_b32 m0, %0" : "=&s"(sv) : "v"(g), "s"(lds_base) : "memory"); }
template <int DQK> struct CfgD {
    static constexpr int SHM_K = KVBLK * DQK * 2, SHM_V = KVBLK * DV * 2;
    static constexpr int KR = 0, VR = 3 * SHM_K, SCR = VR + 3 * SHM_V, LDS_BYTES = SCR + NW * 64 * 4;
    static constexpr int NPK = DQK / 64, NPV = 2;
};
template <int DQK, int LDQ, int LDK, int LDV, int LDO, bool NOMAX = false>
__device__ __forceinline__ void attn_body_dma(const bf16_t* __restrict__ Qb, const bf16_t* __restrict__ Kh, const bf16_t* __restrict__ Vh, bf16_t* __restrict__ Ob, int seq, char* lds,
                                              const float* __restrict__ qg, const f32x2* __restrict__ tab, bool rope, int tok0) {
    using C = CfgD<DQK>;
    int tid_ = threadIdx.x; asm volatile("" : "+v"(tid_));
    const int tid = tid_, wid = __builtin_amdgcn_readfirstlane(tid >> 6), lane = tid & 63, r32 = lane & 31, hi = lane >> 5;
    const unsigned lds0 = (unsigned)__builtin_amdgcn_readfirstlane((int)(uintptr_t)lds);
    char* K_lds = lds + C::KR;
    float* wsf = (float*)(lds + C::SCR) + wid * 64; float* li_l = wsf; float* al_l = wsf + 32;
    unsigned kvoff[C::NPK], vvoff[C::NPV];
#pragma unroll
    for (int i = 0; i < C::NPK; ++i) { const int b = (wid + 8 * i) * 1024 + lane * 16, row = b / (DQK * 2), pos = b % (DQK * 2);
        const int colB = pos ^ (DQK == 128 ? ((row & 15) << 4) : (((row >> 1) & 7) << 4)); kvoff[i] = (unsigned)(row * LDK * 2 + colB); }
#pragma unroll
    for (int i = 0; i < C::NPV; ++i) { const int sbt = (wid + 8 * i) * 2 + (lane >> 5), rowin = (lane & 31) >> 2, cch = lane & 3, kk = (sbt >> 2) * 8 + rowin;
        const int k = (kk & ~0xC) | ((kk & 4) << 1) | ((kk & 8) >> 1), c = (sbt & 3) * 32 + cch * 8; vvoff[i] = (unsigned)(k * LDV * 2 + c * 2); }
#define ISSUE_K(J, SL) do { const char* g_ = (const char*)Kh + (size_t)(J) * (KVBLK * LDK * 2); _Pragma("unroll") for (int i_ = 0; i_ < C::NPK; ++i_) \
        glds16(g_ + kvoff[i_], lds0 + C::KR + (SL) * C::SHM_K + (wid + 8 * i_) * 1024); } while (0)
#define ISSUE_V(J, SL) do { const char* g_ = (const char*)Vh + (size_t)(J) * (KVBLK * LDV * 2); _Pragma("unroll") for (int i_ = 0; i_ < C::NPV; ++i_) \
        glds16(g_ + vvoff[i_], lds0 + C::VR + (SL) * C::SHM_V + (wid + 8 * i_) * 1024); } while (0)
#define WAIT_BAR(N) asm volatile("s_waitcnt vmcnt(" #N ") lgkmcnt(0)\n\ts_barrier" ::: "memory")
    const int NT = seq / KVBLK;
    ISSUE_K(0, 0); ISSUE_V(0, 0); ISSUE_K(1, 1);
    float m_reg = -1e30f, l_reg = 0; f32x16 o[4] = {}; bf16x8 qr[DQK / 16];
    const bf16_t* Qw = Qb + (long)(wid * QBLK + r32) * LDQ + hi * 8;
#pragma unroll
    for (int d0 = 0; d0 < DQK / 16; ++d0) qr[d0] = *reinterpret_cast<const bf16x8*>(Qw + d0 * 16);
    {
        const int t = tok0 + wid * QBLK + r32, prow = t >> 6, pcol = t & 63;
        if constexpr (DQK == 128) {
            float ss = 0.f;
#pragma unroll
            for (int d0 = 0; d0 < 8; ++d0) { float f[8]; unpack8(qr[d0], f);
#pragma unroll
                for (int j = 0; j < 8; ++j) ss += f[j] * f[j]; }
            ss += __shfl_xor(ss, 32);
            const float rstd = 1.0f / sqrtf(ss * (1.0f / 128.0f) + 1e-6f);
#pragma unroll
            for (int d0 = 0; d0 < 8; ++d0) { float f[8]; unpack8(qr[d0], f);
#pragma unroll
                for (int j = 0; j < 8; ++j) f[j] = f[j] * rstd * qg[d0 * 16 + hi * 8 + j] * (NOMAX ? 0.08838834764831845f * 1.4426950408889634f : 1.0f);
                qr[d0] = pack8(f); }
            if (rope) {
                const f32x2* tr = tab + prow * 32 + hi * 8; const f32x2* tc = tab + pcol * 32 + hi * 8;
                rope_pair(qr[0], qr[2], tr); rope_pair(qr[1], qr[3], tr + 16);
                rope_pair(qr[4], qr[6], tc); rope_pair(qr[5], qr[7], tc + 16);
            }
        } else {
            if (rope) {
                const f32x2* tr = tab + prow * 16 + hi * 8; const f32x2* tc = tab + pcol * 16 + hi * 8;
                rope_pair(qr[8], qr[9], tr); rope_pair(qr[10], qr[11], tc);
            }
        }
    }
    SBAR();
    const int vb0 = (int)lds0 + C::VR + v_rd_base(lane);
#define RESC(a) do { if (__any((a) < 1.f)) { if (hi == 0) al_l[r32] = (a); asm volatile("s_waitcnt lgkmcnt(0)" ::: "memory"); \
    _Pragma("unroll") for (int d = 0; d < 4; ++d) _Pragma("unroll") for (int r = 0; r < 16; ++r) o[d][r] *= al_l[crow(r, hi)]; } } while (0)
    f32x16 pA0, pA1, pB0, pB1; float mnA = 0.f, mnB = 0.f, alA = 1.f, alB = 1.f; bf16x8 pa0, pa1, pa2, pa3;
#define PSM(P0, P1, MN, AL) do { if constexpr (NOMAX) partialSM_nomax(P0, P1); else partialSM<DQK>(P0, P1, m_reg, MN, AL); } while (0)
#define RESCX(a) do { if constexpr (!NOMAX) RESC(a); else SBAR(); } while (0)
    WAIT_BAR(0);
    qkt<DQK, false>(pA0, pA1, K_lds, qr, nullptr, r32, hi); PSM(pA0, pA1, mnA, alA);
    ISSUE_K(2, 2); ISSUE_V(1, 1);
    if constexpr (C::NPK + C::NPV == 4) WAIT_BAR(4); else WAIT_BAR(5);
    int sa = 1, sb = 2, sc = 0;
#define STEP(PX0, PX1, PY0, PY1, MNX, ALX, ALY, J) do { \
    SBAR(); qkt<DQK, false>(PX0, PX1, K_lds + sa * C::SHM_K, qr, nullptr, r32, hi); \
    finishSM(PY0, PY1, ALY, l_reg, pa0, pa1, pa2, pa3); SBAR(); \
    const bool gk_ = (J) + 2 < NT, gv_ = (J) + 1 < NT; \
    if (gk_) ISSUE_K((J) + 2, sc); if (gv_) ISSUE_V((J) + 1, sb); SBAR(); \
    pv_pipe(o, vb0 + sc * C::SHM_V, pa0, pa1, pa2, pa3); PSM(PX0, PX1, MNX, ALX); \
    RESCX(ALX); \
    if (gk_) { if constexpr (C::NPK + C::NPV == 4) WAIT_BAR(4); else WAIT_BAR(5); } else if (gv_) WAIT_BAR(2); else WAIT_BAR(0); \
    { const int t_ = sa; sa = sb; sb = sc; sc = t_; } } while (0)
    int j = 1;
    for (; j + 1 < NT; j += 2) {
        STEP(pB0, pB1, pA0, pA1, mnB, alB, alA, j);
        STEP(pA0, pA1, pB0, pB1, mnA, alA, alB, j + 1);
    }
    STEP(pB0, pB1, pA0, pA1, mnB, alB, alA, j);
    finishSM(pB0, pB1, alB, l_reg, pa0, pa1, pa2, pa3); SBAR();
    pv_d0(o, vb0 + sc * C::SHM_V, pa0, pa1, pa2, pa3);
    if (hi == 0) li_l[r32] = l_reg; asm volatile("s_waitcnt lgkmcnt(0)" ::: "memory");
    float rli[16];
#pragma unroll
    for (int r = 0; r < 16; ++r) rli[r] = __builtin_amdgcn_rcpf(li_l[crow(r, hi)]);
    bf16_t* Ow = Ob + (long)(wid * QBLK) * LDO;
#pragma unroll
    for (int r = 0; r < 16; ++r) { const int orow = crow(r, hi);
#pragma unroll
        for (int d0 = 0; d0 < 4; ++d0) Ow[(long)orow * LDO + d0 * 32 + r32] = f2bf(o[d0][r] * rli[r]); }
    WAIT_BAR(0);
#undef ISSUE_K
#undef ISSUE_V
#undef WAIT_BAR
#undef RESC
#undef STEP
#undef PSM
#undef RESCX
}
}

constexpr size_t MiB = 1u << 20;
constexpr size_t WS_CTL = 0, CTL_ZERO_BYTES = 1 * MiB;
constexpr size_t WS_MODS = 1 * MiB;
constexpr size_t WS_TAB = 2 * MiB;
constexpr size_t WS_X = 4 * MiB;
constexpr size_t WS_H = 140 * MiB;
constexpr size_t WS_OUTF = 208 * MiB;
constexpr size_t WS_W1T = 344 * MiB, WS_W2T = 472 * MiB;
constexpr size_t WS_GQAW = 600 * MiB;
constexpr size_t WS_LRUW = 640 * MiB;
constexpr size_t WS_MLAW = 668 * MiB;
constexpr size_t WS_BIG = 688 * MiB;
constexpr size_t WS_ACT = WS_BIG;
constexpr size_t WS_GQ = WS_BIG, WS_GK = WS_BIG + 68 * MiB, WS_GV = WS_BIG + 85 * MiB, WS_GO = WS_BIG + 102 * MiB;
constexpr size_t WS_MAP = WS_BIG, WS_MQAN = WS_BIG + 85 * MiB, WS_MCKVN = WS_BIG + 102 * MiB, WS_MQ = WS_BIG + 119 * MiB, WS_MK = WS_BIG + 221 * MiB, WS_MV = WS_BIG + 323 * MiB, WS_MO = WS_BIG + 391 * MiB;
constexpr size_t WS_LUP = WS_BIG, WS_LG = WS_BIG  , WS_LGY = WS_BIG + 68 * MiB, WS_LU = WS_BIG + 136 * MiB, WS_LAF = WS_BIG + 204 * MiB, WS_LGUF = WS_BIG + 272 * MiB,
                 WS_LAB = WS_BIG + 340 * MiB, WS_LGUB = WS_BIG + 408 * MiB, WS_LPS = WS_BIG + 476 * MiB, WS_LCIN = WS_BIG + 494 * MiB;
static_assert(WS_LGUF == WS_LAF + (size_t)R * DM * 2 && WS_LAB == WS_LGUF + (size_t)R * DM * 2 && WS_LGUB == WS_LAB + (size_t)R * DM * 2, "gate outputs are consecutive");
constexpr size_t WS_PART = WS_BIG + 776 * MiB;
constexpr size_t WS_END = WS_PART + 64 * MiB;
constexpr int NCH = 136;

#define XB_TMO      128
#define XB_XCNT(j)  (256  + 64 * (j))
#define XB_XSUB(j)  (1280 + 64 * (j))
#define XB_XGEN(j)  (2304 + 64 * (j))
#define XB_TOP      3328
#define XB_TOPGEN   3392
#define XCD_BAR_WORDS 3456
#define XB_SPIN_CAP (1u << 22)
__device__ __forceinline__ unsigned xb_ld(unsigned* p)              { return __hip_atomic_load(p, __ATOMIC_RELAXED, __HIP_MEMORY_SCOPE_AGENT); }
__device__ __forceinline__ unsigned xb_add(unsigned* p, unsigned v) { return __hip_atomic_fetch_add(p, v, __ATOMIC_RELAXED, __HIP_MEMORY_SCOPE_AGENT); }
__device__ __forceinline__ unsigned xb_xcc_id() { return (unsigned)__builtin_amdgcn_s_getreg((3 << 11) | 20) & 0xFu; }
#define XB_SPIN(cond, bar) do { unsigned _sp = 0; while (cond) { __builtin_amdgcn_s_sleep(1); \
    if ((++_sp & 255u) == 0u) { if (xb_ld(&(bar)[XB_TMO])) break; if (_sp > XB_SPIN_CAP) { atomicAdd(&(bar)[XB_TMO], 1u); break; } } } } while (0)
struct XcdBarrier { unsigned* bar; unsigned x; volatile LAS unsigned* st; };
__device__ __forceinline__ XcdBarrier xcd_barrier_post(unsigned* bar, volatile LAS unsigned* st) {
    XcdBarrier b; b.bar = bar; b.x = xb_xcc_id(); b.st = st;
    if (threadIdx.x == 0) (void)xb_add(&bar[XB_XCNT(b.x)], 1u);
    return b;
}
__device__ __forceinline__ void xcd_barrier_complete(unsigned* bar, unsigned x, unsigned& nloc, unsigned& nx) {
    const unsigned G = gridDim.x * gridDim.y * gridDim.z;
    unsigned sum, cnt, mine, sp = 0u;
    for (;;) {
        sum = 0u; cnt = 0u; mine = 0u;
#pragma unroll
        for (unsigned j = 0; j < 16; ++j) { const unsigned c = xb_ld(&bar[XB_XCNT(j)]); sum += c; cnt += (c > 0u) ? 1u : 0u; mine = (j == x) ? c : mine; }
        if (sum == G) break;
        __builtin_amdgcn_s_sleep(1);
        if ((++sp & 255u) == 0u) { if (xb_ld(&bar[XB_TMO])) break; if (sp > XB_SPIN_CAP) { atomicAdd(&bar[XB_TMO], 1u); break; } }
    }
    nloc = mine > 0u ? mine : 1u; nx = cnt > 0u ? cnt : 1u;
}
__device__ __forceinline__ void xcd_barrier(const XcdBarrier& b) {
    asm volatile("s_waitcnt vmcnt(0)" ::: "memory");
    __syncthreads();
    if (threadIdx.x == 0) {
        unsigned* bar = b.bar;
        __builtin_amdgcn_s_waitcnt(0);
        unsigned nloc = b.st[0], nx = b.st[1];
        if (nloc == 0u) { xcd_barrier_complete(bar, b.x, nloc, nx); b.st[0] = nloc; b.st[1] = nx; }
        const unsigned old = xb_add(&bar[XB_XSUB(b.x)], 1u);
        const unsigned gen = old / nloc;
        if (old + 1u == (gen + 1u) * nloc) {
            __builtin_amdgcn_fence(__ATOMIC_RELEASE, "agent");
            asm volatile("s_waitcnt vmcnt(0)" ::: "memory");
            const unsigned og = xb_add(&bar[XB_TOP], 1u);
            const unsigned tg = og / nx;
            if (og + 1u == (tg + 1u) * nx) xb_add(&bar[XB_TOPGEN], 1u);
            else XB_SPIN(xb_ld(&bar[XB_TOPGEN]) == tg, bar);
            __builtin_amdgcn_fence(__ATOMIC_ACQUIRE, "agent");
            xb_add(&bar[XB_XGEN(b.x)], 1u);
            asm volatile("s_waitcnt vmcnt(0)" ::: "memory");
        } else {
            XB_SPIN(xb_ld(&bar[XB_XGEN(b.x)]) == gen, bar);
            __builtin_amdgcn_fence(__ATOMIC_ACQUIRE, "agent");
            asm volatile("s_waitcnt vmcnt(0)" ::: "memory");
        }
    }
    __syncthreads();
}

#ifndef PROBE_N
#define PROBE_N 2
#endif
__device__ __forceinline__ int probe_count() { int n = PROBE_N; asm volatile("" : "+s"(n)); return n; }
#ifdef PROBE_GEMM
#define PROBE_REPEAT_GEMM for (int rep_ = 0, nrep_ = probe_count(); rep_ < nrep_; ++rep_)
#else
#define PROBE_REPEAT_GEMM
#endif
#ifdef PROBE_ATTN
#define PROBE_REPEAT_ATTN for (int rep_ = 0, nrep_ = probe_count(); rep_ < nrep_; ++rep_)
#else
#define PROBE_REPEAT_ATTN
#endif
struct Args {
    const float *x, *c, *ctx, *c_ctx, *ada_w, *ada_b, *ln_g, *ln_b, *mlp_w1, *mlp_w2;
    const float *gqa_wq, *gqa_wk, *gqa_wv, *gqa_wo, *gqa_q_g, *gqa_k_g;
    const float *lru_wx, *lru_wy, *lru_conv_w, *lru_conv_b, *lru_ra_w, *lru_ra_b, *lru_ix_w, *lru_ix_b, *lru_lam, *lru_wo;
    const float *mla_wq_a, *mla_q_a_g, *mla_wq_b, *mla_wkv_a, *mla_kv_a_g, *mla_wkv_b, *mla_wo;
    float* out; unsigned char* ws; int ph_lo, ph_hi;
};

typedef const __attribute__((address_space(4))) Args CArgs;
__device__ __forceinline__ CArgs* kargs() { CArgs* p = (CArgs*)__builtin_amdgcn_kernarg_segment_ptr(); asm volatile("" : "+s"(p)); return p; }
constexpr int NWAVES = 8;
constexpr int RING_BYTES = 131072, LDSCTL_OFF = RING_BYTES, LDS_BYTES = 147456;

__device__ __forceinline__ float wave_sum(float v) {
#pragma unroll
    for (int o = 1; o < 64; o <<= 1) v += __shfl_xor(v, o);
    return v;
}
__device__ __forceinline__ float sigmoidf_(float v) { return __builtin_amdgcn_rcpf(1.0f + __builtin_amdgcn_exp2f(-1.4426950408889634f * v)); }

__device__ __forceinline__ int tid_opaque() { int t = threadIdx.x; asm volatile("" : "+v"(t)); return t; }
__device__ __forceinline__ void ph_mods(CArgs& a, LAS unsigned char* lds, int vcu, int G) {
    LAS float* S = (LAS float*)lds; LAS float* red = (LAS float*)(lds + 40960);
    const int tid = tid_opaque(), wave = tid >> 6, lane = tid & 63;
    for (int i = tid; i < 5 * DM; i += 512) { const int bi = i / DM, k = i % DM; const float v = bi < 4 ? a.c[bi * DM + k] : a.c_ctx[k]; S[i] = v / (1.0f + expf(-v)); }
    __syncthreads();
    float* mods = (float*)(a.ws + WS_MODS);
    for (int item = vcu; item < 768; item += G) {
        const int l = item / 192, n0 = (item % 192) * 64, ksub = wave * 4 + (lane >> 4), cl = lane & 15;
        const float* wp = a.ada_w + ((size_t)l * DM + ksub) * 12288 + n0 + cl * 4;
        float acc[5][4];
#pragma unroll
        for (int i = 0; i < 5; ++i)
#pragma unroll
            for (int j = 0; j < 4; ++j) acc[i][j] = 0.f;
#pragma unroll 8
        for (int it = 0; it < 64; ++it) {
            const f32x4 w = *(const f32x4*)(wp + (size_t)it * 32 * 12288); const int k = ksub + 32 * it;
#pragma unroll
            for (int i = 0; i < 5; ++i) { const float s = S[i * DM + k];
#pragma unroll
                for (int j = 0; j < 4; ++j) acc[i][j] += s * w[j]; }
        }
#pragma unroll
        for (int i = 0; i < 5; ++i)
#pragma unroll
            for (int j = 0; j < 4; ++j) red[(ksub * 5 + i) * 64 + cl * 4 + j] = acc[i][j];
        __syncthreads();
        if (tid < 320) { const int i = tid / 64, cc = tid % 64; float s = 0.f;
            for (int ks = 0; ks < 32; ++ks) s += red[(ks * 5 + i) * 64 + cc];
            mods[(size_t)(l * 5 + i) * 12288 + n0 + cc] = s + a.ada_b[l * 12288 + n0 + cc]; }
        __syncthreads();
    }
}
__device__ __forceinline__ void tr_item(const float* __restrict__ W, int ldw, int k0, int n0, bf16_t* __restrict__ WT, int ldt, int drow0, LAS float* scr, int lane) {
#pragma unroll 8
    for (int i = 0; i < 32; ++i) { const int kk = 2 * i + (lane >> 5); scr[kk * 33 + (lane & 31)] = W[(size_t)(k0 + kk) * ldw + n0 + (lane & 31)]; }
    asm volatile("s_waitcnt lgkmcnt(0)" ::: "memory");
    const int c = lane & 7;
#pragma unroll
    for (int j = 0; j < 4; ++j) { const int n = (lane >> 3) + 8 * j; const LAS float* s = scr + (8 * c) * 33 + n;
        u32x4 o; o.x = cvt_pk_bf16(s[0 * 33], s[1 * 33]); o.y = cvt_pk_bf16(s[2 * 33], s[3 * 33]); o.z = cvt_pk_bf16(s[4 * 33], s[5 * 33]); o.w = cvt_pk_bf16(s[6 * 33], s[7 * 33]);
        *(u32x4*)(WT + (size_t)(drow0 + n) * ldt + k0 + 8 * c) = o; }
    asm volatile("s_waitcnt lgkmcnt(0)" ::: "memory");
}
__device__ __forceinline__ void ph_transposes(CArgs& a, LAS unsigned char* lds, int vcu, int G) {
    const int tid = tid_opaque(), wave = tid >> 6, lane = tid & 63;
    LAS float* scr = (LAS float*)(lds + wave * 8704);
    const int gw = vcu * NWAVES + wave, NGW = G * NWAVES;
    unsigned char* ws = a.ws;
    constexpr int NITEMS = 87872;
    for (int it = gw; it < NITEMS; it += NGW) {
        int r = it;
#define TR_DO(src, K_, N_, dst, drow) do { const int nblk = (N_) / 32, kb = ri / nblk, nb = ri % nblk; tr_item((src), (N_), 64 * kb, 32 * nb, (dst), (K_), (drow) + 32 * nb, scr, lane); } while (0)
        if (r < 32768) { const int l = r / 8192, ri = r % 8192; TR_DO(a.mlp_w1 + (size_t)l * DM * DFF, DM, DFF, (bf16_t*)(ws + WS_W1T) + (size_t)l * DFF * DM, 0); continue; } r -= 32768;
        if (r < 32768) { const int l = r / 8192, ri = r % 8192; TR_DO(a.mlp_w2 + (size_t)l * DFF * DM, DFF, DM, (bf16_t*)(ws + WS_W2T) + (size_t)l * DM * DFF, 0); continue; } r -= 32768;
        if (r < 4096) { const int s = r / 2048, ri = r % 2048; TR_DO(a.gqa_wq + (size_t)s * DM * DM, DM, DM, (bf16_t*)(ws + WS_GQAW + s * 20 * MiB), 0); continue; } r -= 4096;
        if (r < 1024) { const int s = r / 512, ri = r % 512; TR_DO(a.gqa_wk + (size_t)s * DM * 512, DM, 512, (bf16_t*)(ws + WS_GQAW + s * 20 * MiB), 2048); continue; } r -= 1024;
        if (r < 1024) { const int s = r / 512, ri = r % 512; TR_DO(a.gqa_wv + (size_t)s * DM * 512, DM, 512, (bf16_t*)(ws + WS_GQAW + s * 20 * MiB), 2560); continue; } r -= 1024;
        if (r < 4096) { const int s = r / 2048, ri = r % 2048; TR_DO(a.gqa_wo + (size_t)s * DM * DM, DM, DM, (bf16_t*)(ws + WS_GQAW + s * 20 * MiB + 12 * MiB), 0); continue; } r -= 4096;
        if (r < 2048) { const int ri = r; TR_DO(a.lru_wx, DM, DM, (bf16_t*)(ws + WS_LRUW), 0); continue; } r -= 2048;
        if (r < 2048) { const int ri = r; TR_DO(a.lru_wy, DM, DM, (bf16_t*)(ws + WS_LRUW), 2048); continue; } r -= 2048;
        if (r < 1024) { const int blk = r / 32, ri = r % 32, ty = blk / 16, d = (blk % 16) / 8, n = blk % 8, which = d * 2 + ty;
            const float* src = (ty == 0 ? a.lru_ra_w : a.lru_ix_w) + (size_t)(d * 8 + n) * 65536;
            TR_DO(src, 256, 256, (bf16_t*)(ws + WS_LRUW + 16 * MiB), (which * 8 + n) * 256); continue; } r -= 1024;
        if (r < 2048) { const int ri = r; TR_DO(a.lru_wo, DM, DM, (bf16_t*)(ws + WS_LRUW + 20 * MiB), 0); continue; } r -= 2048;
        if (r < 512) { const int ri = r; TR_DO(a.mla_wq_a, DM, 512, (bf16_t*)(ws + WS_MLAW), 0); continue; } r -= 512;
        if (r < 576) { const int ri = r; TR_DO(a.mla_wkv_a, DM, 576, (bf16_t*)(ws + WS_MLAW), 512); continue; } r -= 576;
        if (r < 768) { const int ri = r; TR_DO(a.mla_wq_b, 512, 3072, (bf16_t*)(ws + WS_MLAW + 5 * MiB), 0); continue; } r -= 768;
        if (r < 1024) { const int ri = r, nb = ri % 128, kb = ri / 128, n0 = 32 * nb, h = n0 >> 8, j0 = n0 & 255;
            const int drow = j0 < 128 ? h * 128 + j0 : 2048 + h * 128 + (j0 - 128);
            tr_item(a.mla_wkv_b, 4096, 64 * kb, n0, (bf16_t*)(ws + WS_MLAW + 8 * MiB), 512, drow, scr, lane); continue; } r -= 1024;
        { const int ri = r; TR_DO(a.mla_wo, DM, DM, (bf16_t*)(ws + WS_MLAW + 12 * MiB), 0); }
#undef TR_DO
    }
    { u32x4* z = (u32x4*)(ws + WS_MLAW + (size_t)1088 * DM * 2); const int gt = vcu * 512 + tid;
      for (int i = gt; i < 49152; i += G * 512) z[i] = (u32x4){0u, 0u, 0u, 0u}; }
    if (vcu == 1 % G) { float* ll = (float*)(ws + WS_TAB + 32768); for (int i = tid; i < 2 * DM; i += 512) ll[i] = -8.0f * log1pf(expf(-a.lru_lam[i])); }
    if (vcu == 0) {
        f32x2* tg = (f32x2*)(ws + WS_TAB); f32x2* tm = (f32x2*)(ws + WS_TAB + 16384);
        for (int i = tid; i < 64 * 32; i += 512) { const int pos = i / 32, f = i % 32; const float inv = powf(10000.0f, -((float)f * 2.0f) / 64.0f); const float ang = (float)pos * inv; tg[i] = (f32x2){cosf(ang), sinf(ang)}; }
        for (int i = tid; i < 64 * 16; i += 512) { const int pos = i / 16, f = i % 16; const float inv = powf(10000.0f, -((float)f * 2.0f) / 32.0f); const float ang = (float)pos * inv; tm[i] = (f32x2){cosf(ang), sinf(ang)}; }
    }
}

#define ROW_DECODE(r) const int b_ = (r) / TB, p_ = (r) % TB; const bool isctx_ = p_ < CTX; const int mi_ = isctx_ ? 4 : b_; (void)b_; (void)mi_
__device__ __forceinline__ const float* mods_ptr(CArgs& a, int l, int mi) { return (const float*)(a.ws + WS_MODS) + (size_t)(l * 5 + mi) * 12288; }

__device__ __forceinline__ void init_row(CArgs& a, const LAS float* vec, int r, int lane) {
    bf16_t* X = (bf16_t*)(a.ws + WS_X); bf16_t* H = (bf16_t*)(a.ws + WS_H);
    ROW_DECODE(r);
    const float* src = isctx_ ? a.ctx + ((size_t)b_ * CTX + p_) * DM : a.x + ((size_t)b_ * SEQ + (p_ - CTX)) * DM;
#pragma unroll
    for (int it = 0; it < 8; ++it) { const int idx = it * 256 + lane * 4;
        const f32x4 v = *(const f32x4*)(src + idx), m0 = *(const LAS f32x4*)(vec + idx), m1 = *(const LAS f32x4*)(vec + DM + idx);
        *(u32x2*)(X + (size_t)r * DM + idx) = (u32x2){cvt_pk_bf16(v[0], v[1]), cvt_pk_bf16(v[2], v[3])};
        const f32x4 h = v * m1 + m0;
        *(u32x2*)(H + (size_t)r * DM + idx) = (u32x2){cvt_pk_bf16(h[0], h[1]), cvt_pk_bf16(h[2], h[3])}; }
}
__device__ __forceinline__ void ph_init(CArgs& a, LAS unsigned char* lds, int vcu, int G) {
    const int tid = tid_opaque(), lane = tid & 63, wave = tid >> 6;
    LAS float* vec = (LAS float*)lds;
    const int b = (int)(((long)vcu * NB) / G), vlo = (b * G + NB - 1) / NB, vhi = ((b + 1) * G + NB - 1) / NB, wpb = vhi - vlo, w = vcu - vlo;
    { const float* m = mods_ptr(a, 0, b); const int i = tid * 4; *(LAS f32x4*)(vec + i) = *(const f32x4*)(m + i); *(LAS f32x4*)(vec + DM + i) = 1.0f + *(const f32x4*)(m + DM + i); }
    __syncthreads();
    for (int k = w * NWAVES + wave; k < SEQ; k += wpb * NWAVES) init_row(a, vec, b * TB + CTX + k, lane);
    __syncthreads();
    { const float* m = mods_ptr(a, 0, 4); const int i = tid * 4; *(LAS f32x4*)(vec + i) = *(const f32x4*)(m + i); *(LAS f32x4*)(vec + DM + i) = 1.0f + *(const f32x4*)(m + DM + i); }
    __syncthreads();
    for (int k = vcu * NWAVES + wave; k < NB * CTX; k += G * NWAVES) init_row(a, vec, (k / CTX) * TB + (k % CTX), lane);
    __syncthreads();
}
__device__ __forceinline__ void ln_stage_vecs(CArgs& a, LAS float* vec, int l, int which, int mi, bool last, int tid) {
    const float* lg = a.ln_g + (size_t)(l * 2 + which) * DM; const float* lb = a.ln_b + (size_t)(l * 2 + which) * DM;
    const float* m = mods_ptr(a, l, mi);
    const float* gate = m + (which == 0 ? 2 : 5) * DM;
    const float* sc = which == 0 ? m + 4 * DM : mods_ptr(a, last ? l : l + 1, mi) + 1 * DM;
    const float* sh = which == 0 ? m + 3 * DM : mods_ptr(a, last ? l : l + 1, mi);
    { const int i = tid * 4; const f32x4 g = *(const f32x4*)(gate + i), s4 = *(const f32x4*)(sc + i);
      *(LAS f32x4*)(vec + i) = 1.0f + g; *(LAS f32x4*)(vec + DM + i) = *(const f32x4*)(lg + i); *(LAS f32x4*)(vec + 2 * DM + i) = *(const f32x4*)(lb + i);
      *(LAS f32x4*)(vec + 3 * DM + i) = 1.0f + s4; *(LAS f32x4*)(vec + 4 * DM + i) = *(const f32x4*)(sh + i); }
}
template <bool LAST, int NR, bool FROM_PART>
__device__ __forceinline__ void ln_rows(CArgs& a, const LAS float* vec, int r, int lane) {
    bf16_t* X = (bf16_t*)(a.ws + WS_X); bf16_t* H = (bf16_t*)(a.ws + WS_H); const bf16_t* O = (const bf16_t*)(a.ws + WS_OUTF); const float* PART = (const float*)(a.ws + WS_PART);
    ROW_DECODE(r);
    float v[NR][4][8]; float s[NR];
#pragma unroll
    for (int rr = 0; rr < NR; ++rr) s[rr] = 0.f;
#pragma unroll
    for (int it = 0; it < 4; ++it) { const int idx = it * 512 + lane * 8;
        const f32x4 g0 = *(const LAS f32x4*)(vec + idx), g1 = *(const LAS f32x4*)(vec + idx + 4);
#pragma unroll
        for (int rr = 0; rr < NR; ++rr) {
            float xv[8], ov[8]; att::unpack8(*(const bf16x8*)(X + (size_t)(r + rr) * DM + idx), xv);
            if (FROM_PART) { const float* pp = PART + ((size_t)b_ * CTX + p_ + rr) * DM + idx;
                f32x4 o0 = *(const f32x4*)pp, o1 = *(const f32x4*)(pp + 4);
#pragma unroll
                for (int sl = 1; sl < 8; ++sl) { o0 += *(const f32x4*)(pp + (size_t)sl * (NB * CTX) * DM); o1 += *(const f32x4*)(pp + (size_t)sl * (NB * CTX) * DM + 4); }
                ov[0] = o0[0]; ov[1] = o0[1]; ov[2] = o0[2]; ov[3] = o0[3]; ov[4] = o1[0]; ov[5] = o1[1]; ov[6] = o1[2]; ov[7] = o1[3]; }
            else att::unpack8(*(const bf16x8*)(O + (size_t)(r + rr) * DM + idx), ov);
#pragma unroll
            for (int j = 0; j < 8; ++j) { v[rr][it][j] = DN_ALPHA * xv[j] + (j < 4 ? g0[j] : g1[j - 4]) * ov[j]; s[rr] += v[rr][it][j]; } }
        __builtin_amdgcn_sched_barrier(0);
    }
    float rstd[NR];
#pragma unroll
    for (int rr = 0; rr < NR; ++rr) { const float mean = wave_sum(s[rr]) * (1.0f / DM); float q = 0.f;
#pragma unroll
        for (int it = 0; it < 4; ++it)
#pragma unroll
            for (int j = 0; j < 8; ++j) { v[rr][it][j] -= mean; q += v[rr][it][j] * v[rr][it][j]; }
        rstd[rr] = 1.0f / sqrtf(wave_sum(q) * (1.0f / DM) + LN_EPS); }
#pragma unroll
    for (int it = 0; it < 4; ++it) { const int idx = it * 512 + lane * 8;
        const f32x4 lg0 = *(const LAS f32x4*)(vec + DM + idx), lg1 = *(const LAS f32x4*)(vec + DM + idx + 4), lb0 = *(const LAS f32x4*)(vec + 2 * DM + idx), lb1 = *(const LAS f32x4*)(vec + 2 * DM + idx + 4);
        f32x4 sc0 = {0.f, 0.f, 0.f, 0.f}, sc1 = sc0, sh0 = sc0, sh1 = sc0;
        if (!LAST) { sc0 = *(const LAS f32x4*)(vec + 3 * DM + idx); sc1 = *(const LAS f32x4*)(vec + 3 * DM + idx + 4); sh0 = *(const LAS f32x4*)(vec + 4 * DM + idx); sh1 = *(const LAS f32x4*)(vec + 4 * DM + idx + 4); }
#pragma unroll
        for (int rr = 0; rr < NR; ++rr) {
            float xn[8];
#pragma unroll
            for (int j = 0; j < 8; ++j) xn[j] = v[rr][it][j] * rstd[rr] * (j < 4 ? lg0[j] : lg1[j - 4]) + (j < 4 ? lb0[j] : lb1[j - 4]);
            if (LAST) { float* op = a.out + ((size_t)b_ * SEQ + (p_ + rr - CTX)) * DM + idx; *(f32x4*)op = (f32x4){xn[0], xn[1], xn[2], xn[3]}; *(f32x4*)(op + 4) = (f32x4){xn[4], xn[5], xn[6], xn[7]}; }
            else { *(bf16x8*)(X + (size_t)(r + rr) * DM + idx) = att::pack8(xn);
                float hh[8];
#pragma unroll
                for (int j = 0; j < 8; ++j) hh[j] = xn[j] * (j < 4 ? sc0[j] : sc1[j - 4]) + (j < 4 ? sh0[j] : sh1[j - 4]);
                *(bf16x8*)(H + (size_t)(r + rr) * DM + idx) = att::pack8(hh); } }
        __builtin_amdgcn_sched_barrier(0); }
}
template <bool LAST, int CTXMODE>
__device__ __forceinline__ void ph_ln(CArgs& a, LAS unsigned char* lds, int l, int which, int vcu, int G) {
    const int tid = tid_opaque(), lane = tid & 63, wave = tid >> 6;
    LAS float* vec = (LAS float*)lds;
    constexpr int NR = 4;
    const int b = (int)(((long)vcu * NB) / G), vlo = (b * G + NB - 1) / NB, vhi = ((b + 1) * G + NB - 1) / NB, wpb = vhi - vlo, w = vcu - vlo;
    ln_stage_vecs(a, vec, l, which, b, LAST, tid);
    __syncthreads();
    for (int k = w * NWAVES + wave; k < SEQ / NR; k += wpb * NWAVES) ln_rows<LAST, NR, false>(a, vec, b * TB + CTX + k * NR, lane);
    if (CTXMODE == 1 && !LAST) {
        __syncthreads();
        ln_stage_vecs(a, vec, l, which, 4, LAST, tid);
        __syncthreads();
        for (int k = vcu * NWAVES + wave; k < NB * CTX; k += G * NWAVES) ln_rows<false, 1, true>(a, vec, (k / CTX) * TB + (k % CTX), lane);
    }
    __syncthreads();
}
__device__ __forceinline__ void ph_knorm(CArgs& a, const float* kg, int vcu, int G) {
    const int tid_ = tid_opaque(), lane = tid_ & 63, gw = vcu * NWAVES + (tid_ >> 6), NGW = G * NWAVES; (void)lane;
    bf16_t* K = (bf16_t*)(a.ws + WS_GK); const f32x2* tab = (const f32x2*)(a.ws + WS_TAB);
    const int li = lane & 15;
    float g[8];
#pragma unroll
    for (int j = 0; j < 8; ++j) g[j] = kg[li * 8 + j];
    for (int r = gw; r < R; r += NGW) {
        ROW_DECODE(r);
        bf16x8 raw = *(const bf16x8*)(K + (size_t)r * 512 + lane * 8);
        float f[8]; att::unpack8(raw, f);
        float ss = 0.f;
#pragma unroll
        for (int j = 0; j < 8; ++j) ss += f[j] * f[j];
        ss += __shfl_xor(ss, 1); ss += __shfl_xor(ss, 2); ss += __shfl_xor(ss, 4); ss += __shfl_xor(ss, 8);
        const float rstd = 1.0f / sqrtf(ss * (1.0f / 128.0f) + 1e-6f);
#pragma unroll
        for (int j = 0; j < 8; ++j) f[j] = f[j] * rstd * g[j];
        if (!isctx_) {
            const int t = p_ - CTX, pos = (li & 8) ? (t & 63) : (t >> 6);
            const f32x2* tp = tab + pos * 32 + (li & 3) * 8;
            const bool second = (li & 4) != 0;
#pragma unroll
            for (int j = 0; j < 8; ++j) { const float other = __shfl_xor(f[j], 4); const f32x2 cs = tp[j];
                f[j] = second ? f[j] * cs.x + other * cs.y : f[j] * cs.x - other * cs.y; }
        }
        *(bf16x8*)(K + (size_t)r * 512 + lane * 8) = att::pack8(f);
    }
}
__device__ __forceinline__ void ph_mla_norm(CArgs& a, int vcu, int G) {
    const int tid_ = tid_opaque(), lane = tid_ & 63, gw = vcu * NWAVES + (tid_ >> 6), NGW = G * NWAVES; (void)lane;
    const float* AP = (const float*)(a.ws + WS_MAP); bf16_t* QAN = (bf16_t*)(a.ws + WS_MQAN); bf16_t* CKVN = (bf16_t*)(a.ws + WS_MCKVN); bf16_t* K = (bf16_t*)(a.ws + WS_MK);
    const f32x2* tab = (const f32x2*)(a.ws + WS_TAB + 16384);
    const f32x4 gq0 = *(const f32x4*)(a.mla_q_a_g + lane * 8), gq1 = *(const f32x4*)(a.mla_q_a_g + lane * 8 + 4), gk0 = *(const f32x4*)(a.mla_kv_a_g + lane * 8), gk1 = *(const f32x4*)(a.mla_kv_a_g + lane * 8 + 4);
    for (int r = gw; r < R; r += NGW) {
        ROW_DECODE(r);
        const float* ap = AP + (size_t)r * 1280;
#pragma unroll
        for (int part = 0; part < 2; ++part) {
            const f32x4 v0 = *(const f32x4*)(ap + part * 512 + lane * 8), v1 = *(const f32x4*)(ap + part * 512 + lane * 8 + 4);
            float ss = (v0[0] * v0[0] + v0[1] * v0[1]) + (v0[2] * v0[2] + v0[3] * v0[3]) + (v1[0] * v1[0] + v1[1] * v1[1]) + (v1[2] * v1[2] + v1[3] * v1[3]);
            const float rstd = 1.0f / sqrtf(wave_sum(ss) * (1.0f / 512.0f) + 1e-6f);
            const f32x4 g0 = part == 0 ? gq0 : gk0, g1 = part == 0 ? gq1 : gk1;
            const f32x4 o0 = v0 * rstd * g0, o1 = v1 * rstd * g1;
            u32x4 w = {cvt_pk_bf16(o0[0], o0[1]), cvt_pk_bf16(o0[2], o0[3]), cvt_pk_bf16(o1[0], o1[1]), cvt_pk_bf16(o1[2], o1[3])};
            *(u32x4*)((part == 0 ? QAN : CKVN) + (size_t)r * 512 + lane * 8) = w;
        }
        float v = ap[1024 + lane];
        if (!isctx_) {
            const int t = p_ - CTX, pos = (lane & 32) ? (t & 63) : (t >> 6);
            const f32x2 cs = tab[pos * 16 + (lane & 15)];
            const float other = __shfl_xor(v, 16);
            v = (lane & 16) ? v * cs.x + other * cs.y : v * cs.x - other * cs.y;
        }
        const bf16_t kb = f2bf(v);
#pragma unroll
        for (int h = 0; h < 16; ++h) K[(size_t)r * 3072 + h * 192 + 128 + lane] = kb;
    }
}
__device__ __forceinline__ void ph_conv(CArgs& a, LAS unsigned char* lds, int vcu, int G) {
    const int tid = tid_opaque(), lane = tid & 63, gw = vcu * NWAVES + (tid >> 6), NGW = G * NWAVES;
    LAS float* cw = (LAS float*)lds;
    { const int i = tid * 4;
#pragma unroll
      for (int j = 0; j < 4; ++j) *(LAS f32x4*)(cw + j * DM + i) = *(const f32x4*)(a.lru_conv_w + j * DM + i);
      *(LAS f32x4*)(cw + 4 * DM + i) = *(const f32x4*)(a.lru_conv_b + i); }
    __syncthreads();
    const bf16_t* UP = (const bf16_t*)(a.ws + WS_LUP); bf16_t* U = (bf16_t*)(a.ws + WS_LU);
    for (int r = gw; r < R; r += NGW) {
        ROW_DECODE(r);
        const int lo = isctx_ ? 0 : CTX, hi = isctx_ ? CTX : TB;
#pragma unroll
        for (int it = 0; it < 4; ++it) { const int idx = it * 512 + lane * 8;
            float acc[8];
            { const f32x4 b0 = *(const LAS f32x4*)(cw + 4 * DM + idx), b1 = *(const LAS f32x4*)(cw + 4 * DM + idx + 4);
              acc[0] = b0[0]; acc[1] = b0[1]; acc[2] = b0[2]; acc[3] = b0[3]; acc[4] = b1[0]; acc[5] = b1[1]; acc[6] = b1[2]; acc[7] = b1[3]; }
#pragma unroll
            for (int j = 0; j < 4; ++j) { const int pp = p_ + j - 2;
                if (pp >= lo && pp < hi) {
                    float f[8]; att::unpack8(*(const bf16x8*)(UP + (size_t)(r + j - 2) * DM + idx), f);
                    const f32x4 w0 = *(const LAS f32x4*)(cw + j * DM + idx), w1 = *(const LAS f32x4*)(cw + j * DM + idx + 4);
                    acc[0] += f[0] * w0[0]; acc[1] += f[1] * w0[1]; acc[2] += f[2] * w0[2]; acc[3] += f[3] * w0[3];
                    acc[4] += f[4] * w1[0]; acc[5] += f[5] * w1[1]; acc[6] += f[6] * w1[2]; acc[7] += f[7] * w1[3]; } }
            *(bf16x8*)(U + (size_t)r * DM + idx) = att::pack8(acc); }
    }
    __syncthreads();
}
__device__ __forceinline__ void scan_step(f32x4& h, u32x2 la, u32x2 gu, f32x4* Pacc) {
    f32x4 av = {__builtin_amdgcn_exp2f(bf_lo(la.x)), __builtin_amdgcn_exp2f(bf_hi(la.x)), __builtin_amdgcn_exp2f(bf_lo(la.y)), __builtin_amdgcn_exp2f(bf_hi(la.y))};
    const f32x4 gv = {bf_lo(gu.x), bf_hi(gu.x), bf_lo(gu.y), bf_hi(gu.y)};
    f32x4 s; s[0] = sqrtf(fmaxf(1.0f - av[0] * av[0], 0.f)); s[1] = sqrtf(fmaxf(1.0f - av[1] * av[1], 0.f)); s[2] = sqrtf(fmaxf(1.0f - av[2] * av[2], 0.f)); s[3] = sqrtf(fmaxf(1.0f - av[3] * av[3], 0.f));
    h = av * h + s * gv; if (Pacc) *Pacc = *Pacc * av;
}
__device__ __forceinline__ void ph_scan1(CArgs& a, int vcu, int G) {
    const int tid_ = tid_opaque(), lane = tid_ & 63, gw = vcu * NWAVES + (tid_ >> 6), NGW = G * NWAVES; (void)lane;
    float* PS = (float*)(a.ws + WS_LPS);
    for (int item = gw; item < NB * NCH * 2 * 8; item += NGW) {
        const int cg = item & 7, dir = (item >> 3) & 1, bq = item >> 4, b = bq / NCH, q = bq % NCH;
        const bf16_t* A = (const bf16_t*)(a.ws + (dir ? WS_LAB : WS_LAF)); const bf16_t* GU = (const bf16_t*)(a.ws + (dir ? WS_LGUB : WS_LGUF));
        const size_t base = ((size_t)b * TB + q * 32) * DM + cg * 256 + lane * 4;
        f32x4 h = {0.f, 0.f, 0.f, 0.f}, P = {1.f, 1.f, 1.f, 1.f};
#pragma unroll 8
        for (int i = 0; i < 32; ++i) { const int rr = dir ? 31 - i : i;
            scan_step(h, *(const u32x2*)(A + base + (size_t)rr * DM), *(const u32x2*)(GU + base + (size_t)rr * DM), &P); }
        float* o = PS + ((size_t)(bq * 2 + dir) * 2) * DM + cg * 256 + lane * 4;
        *(f32x4*)o = P; *(f32x4*)(o + DM) = h;
    }
}
__device__ __forceinline__ void ph_scan2(CArgs& a, int vcu, int G) {
    const float* PS = (const float*)(a.ws + WS_LPS); float* CIN = (float*)(a.ws + WS_LCIN);
    for (int v = vcu; v < 32; v += G) {
        const int b = v >> 3, dir = (v >> 2) & 1, c = (v & 3) * 512 + (int)threadIdx.x;
        float carry = 0.f;
#pragma unroll 1
        for (int i0 = 0; i0 < NCH; i0 += 8) {
            float P[8], S[8];
#pragma unroll
            for (int k = 0; k < 8; ++k) { const int i = i0 + k, q = dir == 0 ? i : (i < 8 ? 7 - i : NCH - 1 - (i - 8)); const size_t bq = (size_t)b * NCH + q;
                P[k] = PS[((bq * 2 + dir) * 2) * DM + c]; S[k] = PS[((bq * 2 + dir) * 2 + 1) * DM + c]; }
#pragma unroll
            for (int k = 0; k < 8; ++k) { const int i = i0 + k, q = dir == 0 ? i : (i < 8 ? 7 - i : NCH - 1 - (i - 8)); const size_t bq = (size_t)b * NCH + q;
                CIN[(bq * 2 + dir) * DM + c] = carry; carry = P[k] * carry + S[k]; }
        }
    }
}
__device__ __forceinline__ void ph_scan3(CArgs& a, int vcu, int G) {
    const int tid_ = tid_opaque(), lane = tid_ & 63, gw = vcu * NWAVES + (tid_ >> 6), NGW = G * NWAVES; (void)lane;
    const float* CIN = (const float*)(a.ws + WS_LCIN); const bf16_t* GY = (const bf16_t*)(a.ws + WS_LGY); bf16_t* Gout = (bf16_t*)(a.ws + WS_LG);
    const bf16_t* AF = (const bf16_t*)(a.ws + WS_LAF); const bf16_t* GUF = (const bf16_t*)(a.ws + WS_LGUF); const bf16_t* AB = (const bf16_t*)(a.ws + WS_LAB); const bf16_t* GUB = (const bf16_t*)(a.ws + WS_LGUB);
    for (int item = gw; item < NB * NCH * 8; item += NGW) {
        const int cg = item & 7, bq = item >> 3, b = bq / NCH, q = bq % NCH;
        const size_t base = ((size_t)b * TB + q * 32) * DM + cg * 256 + lane * 4;
        f32x4 hf[32];
        f32x4 h = *(const f32x4*)(CIN + ((size_t)bq * 2 + 0) * DM + cg * 256 + lane * 4);
#pragma unroll
        for (int i = 0; i < 32; ++i) { scan_step(h, *(const u32x2*)(AF + base + (size_t)i * DM), *(const u32x2*)(GUF + base + (size_t)i * DM), nullptr); hf[i] = h;
            if ((i & 7) == 7) __builtin_amdgcn_sched_barrier(0); }
        h = *(const f32x4*)(CIN + ((size_t)bq * 2 + 1) * DM + cg * 256 + lane * 4);
#pragma unroll
        for (int i = 31; i >= 0; --i) {
            scan_step(h, *(const u32x2*)(AB + base + (size_t)i * DM), *(const u32x2*)(GUB + base + (size_t)i * DM), nullptr);
            const u32x2 gy = *(const u32x2*)(GY + base + (size_t)i * DM);
            const f32x4 o = (hf[i] + h) * (f32x4){bf_lo(gy.x), bf_hi(gy.x), bf_lo(gy.y), bf_hi(gy.y)};
            *(u32x2*)(Gout + base + (size_t)i * DM) = (u32x2){cvt_pk_bf16(o[0], o[1]), cvt_pk_bf16(o[2], o[3])};
            if ((i & 7) == 0) __builtin_amdgcn_sched_barrier(0); }
    }
}
__device__ __forceinline__ void st_bf16x8(bf16_t* p, f32x4 v0, f32x4 v1) {
    u32x4 w = {cvt_pk_bf16(v0[0], v0[1]), cvt_pk_bf16(v0[2], v0[3]), cvt_pk_bf16(v1[0], v1[1]), cvt_pk_bf16(v1[2], v1[3])}; *(u32x4*)p = w; }
struct FStoreF32 { float* O; int ld;
    __device__ __forceinline__ void begin(const pg8::Unit&, int) {}
    __device__ __forceinline__ void row8(int row, int, int col, f32x4 v0, f32x4 v1) { float* p = O + (size_t)row * ld + col; *(f32x4*)p = v0; *(f32x4*)(p + 4) = v1; } };
struct FOut { bf16_t* O; float* PART; float* dst; int rowadj;
    __device__ __forceinline__ void begin(const pg8::Unit& u, int) {
        if (u.slice >= 0) { dst = PART + (size_t)u.slice * (NB * CTX) * DM; rowadj = (u.pm / 17) * CTX - u.pm * 256; } else { dst = nullptr; rowadj = 0; } }
    __device__ __forceinline__ void row8(int row, int, int col, f32x4 v0, f32x4 v1) {
        if (dst) { float* p = dst + (size_t)(row + rowadj) * DM + col; *(f32x4*)p = v0; *(f32x4*)(p + 4) = v1; }
        else st_bf16x8(O + (size_t)row * DM + col, v0, v1); } };
struct FBf16 { bf16_t* O; int ld;
    __device__ __forceinline__ void begin(const pg8::Unit&, int) {}
    __device__ __forceinline__ void row8(int row, int, int col, f32x4 v0, f32x4 v1) { st_bf16x8(O + (size_t)row * ld + col, v0, v1); } };
struct FQkv { bf16_t *Q, *K, *V; bf16_t* base; int ld, coff;
    __device__ __forceinline__ void begin(const pg8::Unit& u, int) { if (u.pn < 8) { base = Q; ld = 2048; coff = 0; } else if (u.pn < 10) { base = K; ld = 512; coff = 2048; } else { base = V; ld = 512; coff = 2560; } }
    __device__ __forceinline__ void row8(int row, int, int col, f32x4 v0, f32x4 v1) { st_bf16x8(base + (size_t)row * ld + (col - coff), v0, v1); } };
struct FRelu2 { bf16_t* O;
    __device__ __forceinline__ void begin(const pg8::Unit&, int) {}
    __device__ __forceinline__ void row8(int row, int, int col, f32x4 v0, f32x4 v1) {
#pragma unroll
        for (int i = 0; i < 4; ++i) { const float a = fmaxf(v0[i], 0.f), b = fmaxf(v1[i], 0.f); v0[i] = a * a; v1[i] = b * b; }
        st_bf16x8(O + (size_t)row * DFF + col, v0, v1); } };
__device__ __forceinline__ float gelu_tanh(float x) { const float z = 1.5957691216057308f * (x + 0.044715f * x * x * x); return x * __builtin_amdgcn_rcpf(1.0f + __builtin_amdgcn_exp2f(-1.4426950408889634f * z)); }
struct FLruXY { bf16_t *UP, *GY; bool gy;
    __device__ __forceinline__ void begin(const pg8::Unit& u, int) { gy = u.pn >= 8; }
    __device__ __forceinline__ void row8(int row, int, int col, f32x4 v0, f32x4 v1) {
        if (gy) {
#pragma unroll
            for (int i = 0; i < 4; ++i) { v0[i] = gelu_tanh(v0[i]); v1[i] = gelu_tanh(v1[i]); }
            st_bf16x8(GY + (size_t)row * DM + (col - 2048), v0, v1);
        } else st_bf16x8(UP + (size_t)row * DM + col, v0, v1); } };
struct EpiGates {
    static constexpr bool PERM = true;
    bf16_t* OUT4; const bf16_t* U; const float *ra_b, *ix_b, *lam;
    __device__ __forceinline__ void operator()(const f32x4 (&acc)[2][2][4][2], const pg8::Unit& u, int wr, int wc, int fr, int fq) const {
        const int which = u.pn >> 3, dir = which >> 1, ty = which & 1, ch0 = (u.pn & 7) * 256 + wc * 32 + 8 * fq, row0 = u.pm * 256 + wr * 64 + fr;
        bf16_t* dst = OUT4 + (size_t)which * ((size_t)R * DM);
        const float* bp = (ty == 0 ? ra_b : ix_b) + dir * DM;
#pragma unroll
        for (int bj = 0; bj < 2; ++bj) {
            const int ch = ch0 + bj * 128;
            const f32x4 b0 = *(const f32x4*)(bp + ch), b1 = *(const f32x4*)(bp + ch + 4);
            f32x4 l0 = {0.f, 0.f, 0.f, 0.f}, l1 = {0.f, 0.f, 0.f, 0.f};
            if (ty == 0) { l0 = *(const f32x4*)(lam + dir * DM + ch) * 1.4426950408889634f; l1 = *(const f32x4*)(lam + dir * DM + ch + 4) * 1.4426950408889634f; }
#pragma unroll
            for (int ai = 0; ai < 2; ++ai)
#pragma unroll
                for (int m = 0; m < 4; ++m) {
                    const int row = row0 + ai * 128 + m * 16;
                    const f32x4 x0 = acc[ai][bj][m][0] + b0, x1 = acc[ai][bj][m][1] + b1; f32x4 o0, o1;
                    if (ty == 0) {
#pragma unroll
                        for (int j = 0; j < 4; ++j) { o0[j] = l0[j] * sigmoidf_(x0[j]); o1[j] = l1[j] * sigmoidf_(x1[j]); }
                    } else {
                        const u32x4 uw = *(const u32x4*)(U + (size_t)row * DM + ch);
                        o0[0] = sigmoidf_(x0[0]) * bf_lo(uw.x); o0[1] = sigmoidf_(x0[1]) * bf_hi(uw.x); o0[2] = sigmoidf_(x0[2]) * bf_lo(uw.y); o0[3] = sigmoidf_(x0[3]) * bf_hi(uw.y);
                        o1[0] = sigmoidf_(x1[0]) * bf_lo(uw.z); o1[1] = sigmoidf_(x1[1]) * bf_hi(uw.z); o1[2] = sigmoidf_(x1[2]) * bf_lo(uw.w); o1[3] = sigmoidf_(x1[3]) * bf_hi(uw.w);
                    }
                    st_bf16x8(dst + (size_t)row * DM + ch, o0, o1);
                    __builtin_amdgcn_sched_barrier(0);
                }
        }
    } };
struct FKvb { bf16_t *K, *V;
    __device__ __forceinline__ void begin(const pg8::Unit&, int) {}
    __device__ __forceinline__ void row8(int row, int, int col, f32x4 v0, f32x4 v1) {
        bf16_t* p = col < 2048 ? K + (size_t)row * 3072 + (col >> 7) * 192 + (col & 127) : V + (size_t)row * DM + (col - 2048);
        st_bf16x8(p, v0, v1); } };

template <class F>
__device__ __forceinline__ void run_gemm(LAS unsigned char* lds, const bf16_t* A, int lda, const bf16_t* Bt, int ldb, int N, int K, int a_blk, F f, int G, int rot = 0) {
    pg8::Gemm g{A, Bt, R, N, K, lda, ldb, a_blk}; pg8::StaticOrder S; S.init(R, N, K, G, ((int)blockIdx.x + rot) % G);
    pg8::EpiRow8<F> E{f};
    PROBE_REPEAT_GEMM
    pg8::gemm_phase<pg8::EpiRow8<F>, pg8::StaticOrder, true, true>(lds, g, S, E);
}

__device__ __forceinline__ void run_gemm_out(LAS unsigned char* lds, const bf16_t* A, int lda, const bf16_t* Bt, int K, int SK, bf16_t* OUTF, float* PART, int G) {
    pg8::Gemm g{A, Bt, R, DM, K, lda, K, 0}; pg8::LatOrder S; S.init(DM, K, G, (int)blockIdx.x, SK, K == DFF ? 1 : 0);
    pg8::EpiRow8<FOut> E{FOut{OUTF, PART, nullptr, 0}};
    PROBE_REPEAT_GEMM
    pg8::gemm_phase<pg8::EpiRow8<FOut>, pg8::LatOrder, true, true>(lds, g, S, E);
}
template <class F>
__device__ __forceinline__ void run_gemm_lat(LAS unsigned char* lds, const bf16_t* A, int lda, const bf16_t* Bt, int ldb, int N, int K, F f, int G) {
    pg8::Gemm g{A, Bt, R, N, K, lda, ldb, 0}; pg8::LatOrder S; S.init(N, K, G, (int)blockIdx.x, 0);
    pg8::EpiRow8<F> E{f};
    PROBE_REPEAT_GEMM
    pg8::gemm_phase<pg8::EpiRow8<F>, pg8::LatOrder, true, true>(lds, g, S, E);
}

__device__ __forceinline__ void ph_attn_gqa(CArgs& a, char* lds, const float* qg, const float* kg, bool ctx_units, int vcu, int G) {
    const bf16_t* Q = (const bf16_t*)(a.ws + WS_GQ); const bf16_t* K = (const bf16_t*)(a.ws + WS_GK); const bf16_t* V = (const bf16_t*)(a.ws + WS_GV); bf16_t* O = (bf16_t*)(a.ws + WS_GO);
    const f32x2* tab = (const f32x2*)(a.ws + WS_TAB);
    const int nun = ctx_units ? 1088 : 1024;
    bool fast;
    { const int lane = tid_opaque() & 63; float gq = fmaxf(fabsf(qg[lane]), fabsf(qg[lane + 64])), gk = fmaxf(fabsf(kg[lane]), fabsf(kg[lane + 64]));
#pragma unroll
      for (int o = 1; o < 64; o <<= 1) { gq = fmaxf(gq, __shfl_xor(gq, o)); gk = fmaxf(gk, __shfl_xor(gk, o)); }
      fast = __builtin_amdgcn_readfirstlane((16.3224f * gq * gk <= 40.0f) ? 1 : 0) != 0; }
#define GQA_UNITS(NM) \
    for (int id = vcu; id < nun; id += G) { \
        int b, h, row0, seq, tok0; bool rope; \
        if (id < 1024) { const int bk = id >> 6; b = bk >> 2; h = (bk & 3) * 4 + ((id & 63) >> 4); const int qb = id & 15; row0 = b * TB + CTX + qb * 256; seq = TB; tok0 = qb * 256; rope = true; } \
        else { const int j = id - 1024; b = j >> 4; h = j & 15; row0 = b * TB; seq = CTX; tok0 = 0; rope = false; } \
        const int kvh = h >> 2; \
        att::attn_body_dma<128, 2048, 512, 512, 2048, NM>(Q + (size_t)row0 * 2048 + h * 128, K + (size_t)b * TB * 512 + kvh * 128, V + (size_t)b * TB * 512 + kvh * 128, \
                                                  O + (size_t)row0 * 2048 + h * 128, seq, lds, qg, tab, rope, tok0); }
    PROBE_REPEAT_ATTN
    { if (fast) { GQA_UNITS(true) } else { GQA_UNITS(false) } }
#undef GQA_UNITS
}
__device__ __forceinline__ void ph_attn_mla(CArgs& a, char* lds, bool ctx_units, int vcu, int G) {
    const bf16_t* Q = (const bf16_t*)(a.ws + WS_MQ); const bf16_t* K = (const bf16_t*)(a.ws + WS_MK); const bf16_t* V = (const bf16_t*)(a.ws + WS_MV); bf16_t* O = (bf16_t*)(a.ws + WS_MO);
    const f32x2* tab = (const f32x2*)(a.ws + WS_TAB + 16384);
    const int nun = ctx_units ? 1088 : 1024;
    PROBE_REPEAT_ATTN
    for (int id = vcu; id < nun; id += G) {
        int b, h, row0, seq, tok0; bool rope;
        if (id < 1024) { const int bh = id >> 4; b = bh >> 4; h = bh & 15; const int qb = id & 15; row0 = b * TB + CTX + qb * 256; seq = TB; tok0 = qb * 256; rope = true; }
        else { const int j = id - 1024; b = j >> 4; h = j & 15; row0 = b * TB; seq = CTX; tok0 = 0; rope = false; }
        att::attn_body_dma<192, 3072, 3072, 2048, 2048>(Q + (size_t)row0 * 3072 + h * 192, K + (size_t)b * TB * 3072 + h * 192, V + (size_t)b * TB * DM + h * 128,
                                                    O + (size_t)row0 * DM + h * 128, seq, lds, nullptr, tab, rope, tok0);
    }
}

constexpr int NPHASES = 38;
__global__ void __launch_bounds__(NWAVES * 64, 2) trunk_fwd(Args a_unused) {
#define a (*kargs())
    extern __shared__ __attribute__((aligned(16))) unsigned char lds_raw[];
    LAS unsigned char* lds = (LAS unsigned char*)lds_raw;
    const int tid = threadIdx.x;
    const int G = gridDim.x; const int bx = blockIdx.x; const int vcu = (G % 8 == 0) ? (bx % 8) * (G / 8) + bx / 8 : bx;
#define ws (a.ws)
    for (int u = tid; u < (LDS_BYTES - LDSCTL_OFF) / 4; u += NWAVES * 64) ((LAS unsigned*)(lds + LDSCTL_OFF))[u] = 0u;
    __syncthreads();
    if (a.ph_hi - a.ph_lo > 1) (void)xcd_barrier_post((unsigned*)(ws + WS_CTL) + 1024, (volatile LAS unsigned*)(lds + LDSCTL_OFF + 64));
    int ph = 0;
#ifndef PH_FILTER
#define PH_FILTER(p) true
#endif
#ifdef PROBE_STAMP_A
    unsigned long long st_prev = __builtin_amdgcn_s_memrealtime(), st_a = 0, st_b = 0; int st_cls = 0;
#define ST_CLS(c) st_cls = (c);
#define ST_ACC { const unsigned long long now_ = __builtin_amdgcn_s_memrealtime(); if (st_cls == PROBE_STAMP_A) st_a += now_ - st_prev; if (st_cls == PROBE_STAMP_B) st_b += now_ - st_prev; st_prev = now_; }
#else
#define ST_CLS(c)
#define ST_ACC
#endif
#define PH_BEGIN if (PH_FILTER(ph) && ph >= a.ph_lo && ph < a.ph_hi) {
#define MKBAR() XcdBarrier{(unsigned*)(ws + WS_CTL) + 1024, xb_xcc_id(), (volatile LAS unsigned*)(lds + LDSCTL_OFF + 64)}
#define PH_END   if (ph + 1 < a.ph_hi) xcd_barrier(MKBAR()); ST_ACC } ++ph;

    ST_CLS(0) PH_BEGIN ph_mods(a, lds, vcu, G); __syncthreads(); ph_transposes(a, lds, vcu, G); PH_END
    ST_CLS(1) PH_BEGIN ph_init(a, lds, vcu, G); PH_END

#define Hb ((bf16_t*)(ws + WS_H))
#define OUTF ((bf16_t*)(ws + WS_OUTF))
#define ACT ((bf16_t*)(ws + WS_ACT))

#define PARTB ((float*)(ws + WS_PART))
#define MLP_PHASES(L) \
    ST_CLS(4) PH_BEGIN ph_ln<false, 1>(a, lds, L, 0, vcu, G); PH_END \
    ST_CLS(5) PH_BEGIN run_gemm(lds, Hb, DM, (const bf16_t*)(ws + WS_W1T) + (size_t)(L) * DFF * DM, DM, DFF, DM, 0, FRelu2{ACT}, G); PH_END \
    ST_CLS(6) PH_BEGIN run_gemm_out(lds, ACT, DFF, (const bf16_t*)(ws + WS_W2T) + (size_t)(L) * DM * DFF, DFF, 8, OUTF, PARTB, G); PH_END \
    ST_CLS(4) PH_BEGIN ph_ln<false, 1>(a, lds, L, 1, vcu, G); PH_END
#define MLP_PHASES_LAST(L) \
    ST_CLS(4) PH_BEGIN ph_ln<false, 2>(a, lds, L, 0, vcu, G); PH_END \
    ST_CLS(5) PH_BEGIN run_gemm_lat(lds, Hb, DM, (const bf16_t*)(ws + WS_W1T) + (size_t)(L) * DFF * DM, DM, DFF, DM, FRelu2{ACT}, G); PH_END \
    ST_CLS(6) PH_BEGIN run_gemm_out(lds, ACT, DFF, (const bf16_t*)(ws + WS_W2T) + (size_t)(L) * DM * DFF, DFF, 0, OUTF, PARTB, G); PH_END \
    ST_CLS(4) PH_BEGIN ph_ln<true, 2>(a, lds, L, 1, vcu, G); PH_END

#define GQA_LAYER(L, SLOT, LASTL) \
    ST_CLS(2) PH_BEGIN run_gemm(lds, Hb, DM, (const bf16_t*)(ws + WS_GQAW + (SLOT) * 20 * MiB), DM, 3072, DM, 0, FQkv{(bf16_t*)(ws + WS_GQ), (bf16_t*)(ws + WS_GK), (bf16_t*)(ws + WS_GV), nullptr, 0, 0}, G); PH_END \
    ST_CLS(1) PH_BEGIN ph_knorm(a, a.gqa_k_g + (SLOT) * 128, vcu, G); PH_END \
    ST_CLS(3) PH_BEGIN ph_attn_gqa(a, (char*)lds_raw, a.gqa_q_g + (SLOT) * 128, a.gqa_k_g + (SLOT) * 128, !(LASTL), vcu, G); PH_END \
    ST_CLS(2) PH_BEGIN run_gemm_out(lds, (const bf16_t*)(ws + WS_GO), DM, (const bf16_t*)(ws + WS_GQAW + (SLOT) * 20 * MiB + 12 * MiB), DM, (LASTL) ? 0 : 8, OUTF, PARTB, G); PH_END

    GQA_LAYER(0, 0, false)
    MLP_PHASES(0)
    ST_CLS(2) PH_BEGIN run_gemm(lds, Hb, DM, (const bf16_t*)(ws + WS_LRUW), DM, 4096, DM, 0, FLruXY{(bf16_t*)(ws + WS_LUP), (bf16_t*)(ws + WS_LGY), false}, G); PH_END
    ST_CLS(1) PH_BEGIN ph_conv(a, lds, vcu, G); PH_END
    ST_CLS(2) PH_BEGIN { EpiGates eg{(bf16_t*)(ws + WS_LAF), (const bf16_t*)(ws + WS_LU), a.lru_ra_b, a.lru_ix_b, (const float*)(ws + WS_TAB + 32768)};
               pg8::Gemm g{(const bf16_t*)(ws + WS_LU), (const bf16_t*)(ws + WS_LRUW + 16 * MiB), R, 8192, 256, DM, 256, 1}; pg8::StaticOrder S; S.init(R, 8192, 256, G, (int)blockIdx.x);
               PROBE_REPEAT_GEMM
               pg8::gemm_phase<EpiGates, pg8::StaticOrder, true, true>(lds, g, S, eg); } PH_END
    ST_CLS(7) PH_BEGIN ph_scan1(a, vcu, G); PH_END
    PH_BEGIN ph_scan2(a, vcu, G); PH_END
    PH_BEGIN ph_scan3(a, vcu, G); PH_END
    ST_CLS(2) PH_BEGIN run_gemm_out(lds, (const bf16_t*)(ws + WS_LG), DM, (const bf16_t*)(ws + WS_LRUW + 20 * MiB), DM, 8, OUTF, PARTB, G); PH_END
    MLP_PHASES(1)
    ST_CLS(2) PH_BEGIN run_gemm(lds, Hb, DM, (const bf16_t*)(ws + WS_MLAW), DM, 1280, DM, 0, FStoreF32{(float*)(ws + WS_MAP), 1280}, G); PH_END
    ST_CLS(1) PH_BEGIN ph_mla_norm(a, vcu, G); PH_END
    ST_CLS(2) PH_BEGIN run_gemm(lds, (const bf16_t*)(ws + WS_MQAN), 512, (const bf16_t*)(ws + WS_MLAW + 5 * MiB), 512, 3072, 512, 0, FBf16{(bf16_t*)(ws + WS_MQ), 3072}, G);
             run_gemm(lds, (const bf16_t*)(ws + WS_MCKVN), 512, (const bf16_t*)(ws + WS_MLAW + 8 * MiB), 512, 4096, 512, 0, FKvb{(bf16_t*)(ws + WS_MK), (bf16_t*)(ws + WS_MV)}, G, G / 2); PH_END
    ST_CLS(3) PH_BEGIN ph_attn_mla(a, (char*)lds_raw, true, vcu, G); PH_END
    ST_CLS(2) PH_BEGIN run_gemm_out(lds, (const bf16_t*)(ws + WS_MO), DM, (const bf16_t*)(ws + WS_MLAW + 12 * MiB), DM, 8, OUTF, PARTB, G); PH_END
    MLP_PHASES(2)
    GQA_LAYER(3, 1, true)
    MLP_PHASES_LAST(3)
#ifdef PROBE_STAMP_A
    xcd_barrier(MKBAR());
    if (blockIdx.x == 0) {
        LAS float* sh = (LAS float*)(lds + LDSCTL_OFF + 256);
        if (tid == 0) { float va = (float)st_a * 0.01f, vb = (float)st_b * 0.01f;
            { float pw = 1.f; while (pw * 100.f <= va) pw *= 10.f; va = rintf(va / pw) * pw; }
            { float pw = 1.f; while (pw * 100.f <= vb) pw *= 10.f; vb = rintf(vb / pw) * pw; }
            sh[0] = va; sh[1] = vb; }
        __syncthreads();
        const float ta = sh[0], tb = sh[1];
        for (int i = 1 + tid; i <= (1 << 20); i += 512) a.out[i] = tb;
        if (tid == 0) a.out[0] = ta;
    }
#endif
#undef PH_BEGIN
#undef PH_END
#undef ws
#undef a
#undef Hb
#undef OUTF
#undef ACT
#undef PARTB
}

#ifndef MK_SPLIT
#define MK_SPLIT 0
#endif
extern "C" void kernel_launch(void* const* d_in, const int* in_sizes, int n_in, void* d_out, int out_size, void* d_ws, size_t ws_size, hipStream_t stream) {
    static int grid = 0;
    if (grid == 0) {
        if (n_in != 33 || in_sizes[0] != NB * SEQ * DM || out_size != NB * SEQ * DM || ws_size < WS_END) {
            fprintf(stderr, "kernel_launch: unexpected shapes: n_in %d in0 %d out %d ws %zu (need %zu)\n", n_in, n_in > 0 ? in_sizes[0] : -1, out_size, ws_size, (size_t)WS_END); grid = -1; return; }
        int dev = 0, cus = 0;
        if (hipGetDevice(&dev) != hipSuccess || hipDeviceGetAttribute(&cus, hipDeviceAttributeMultiprocessorCount, dev) != hipSuccess) { grid = -1; return; }
        if (hipFuncSetAttribute((const void*)trunk_fwd, hipFuncAttributeMaxDynamicSharedMemorySize, LDS_BYTES) != hipSuccess) { fprintf(stderr, "kernel_launch: hipFuncSetAttribute failed\n"); grid = -1; return; }
        int per_cu = 0;
        if (hipOccupancyMaxActiveBlocksPerMultiprocessor(&per_cu, (const void*)trunk_fwd, NWAVES * 64, LDS_BYTES) != hipSuccess || per_cu < 1)
            fprintf(stderr, "kernel_launch: occupancy query reports %d workgroups per CU\n", per_cu);
        (void)hipGetLastError();
        grid = cus;
    }
    if (grid < 0) return;
    if (hipMemsetAsync((char*)d_ws + WS_CTL, 0, CTL_ZERO_BYTES, stream) != hipSuccess) return;
    Args a{};
    const float** p = (const float**)&a;
    for (int i = 0; i < 33; ++i) p[i] = (const float*)d_in[i];
    a.out = (float*)d_out; a.ws = (unsigned char*)d_ws;
#ifdef PROBE_PREFIX
    a.ph_lo = 0; a.ph_hi = PROBE_PREFIX; hipLaunchKernelGGL(trunk_fwd, dim3(grid), dim3(NWAVES * 64), LDS_BYTES, stream, a);
    (void)hipMemsetAsync((char*)d_ws + WS_CTL, 0, CTL_ZERO_BYTES, stream);
    a.ph_lo = 0; a.ph_hi = NPHASES; hipLaunchKernelGGL(trunk_fwd, dim3(grid), dim3(NWAVES * 64), LDS_BYTES, stream, a);
#elif MK_SPLIT
    for (int k = 0; k < NPHASES; ++k) { a.ph_lo = k; a.ph_hi = k + 1; hipLaunchKernelGGL(trunk_fwd, dim3(grid), dim3(NWAVES * 64), LDS_BYTES, stream, a); }
#else
    a.ph_lo = 0; a.ph_hi = NPHASES; hipLaunchKernelGGL(trunk_fwd, dim3(grid), dim3(NWAVES * 64), LDS_BYTES, stream, a);
#endif
    const hipError_t le = hipPeekAtLastError();
    if (le != hipSuccess) fprintf(stderr, "kernel_launch: launch failed: %s\n", hipGetErrorName(le));
}
```

```cpp
#include <hip/hip_runtime.h>
#include <cstdio>
#include <cstdint>
#include <cmath>

#define LAS __attribute__((address_space(3)))
#define GAS __attribute__((address_space(1)))
typedef unsigned short bf16_t;
typedef short bf16x8 __attribute__((ext_vector_type(8)));
typedef short s16x4 __attribute__((ext_vector_type(4)));
typedef float f32x4 __attribute__((ext_vector_type(4)));
typedef float f32x2 __attribute__((ext_vector_type(2)));
typedef float f32x16 __attribute__((ext_vector_type(16)));
typedef unsigned u32x4 __attribute__((ext_vector_type(4)));
typedef unsigned u32x2 __attribute__((ext_vector_type(2)));

__device__ __forceinline__ unsigned cvt_pk_bf16(float lo, float hi) { unsigned r; asm volatile("v_cvt_pk_bf16_f32 %0, %1, %2" : "=v"(r) : "v"(lo), "v"(hi)); return r; }
__device__ __forceinline__ float bf_lo(unsigned w) { return __uint_as_float(w << 16); }
__device__ __forceinline__ float bf_hi(unsigned w) { return __uint_as_float(w & 0xffff0000u); }
__device__ __forceinline__ float bf2f(bf16_t h) { return __uint_as_float(((unsigned)h) << 16); }
__device__ __forceinline__ bf16_t f2bf(float f) { return (bf16_t)(cvt_pk_bf16(f, f) & 0xffffu); }

constexpr int DM = 2048, NB = 4, SEQ = 4096, CTX = 256, TB = SEQ + CTX  , R = NB * TB  , DFF = 8192, DEPTH = 4;
constexpr float LN_EPS = 1e-6f;
constexpr float DN_ALPHA = 1.6817928305074290861f;

namespace pg8 {
constexpr int BM = 256, BK = 64, HALF = 128, HTB = HALF * BK * 2, STAGE_BYTES = 8 * HTB, NXCD = 8, WGM = 4;
__host__ __device__ __forceinline__ int lds_byte(int r, int c) { const int st = (r >> 4) * 2 + (c >> 5), rr = r & 15, cc = c & 31, ob = rr * 64 + cc * 2; return st * 1024 + (ob ^ (((ob >> 9) & 1) << 5)); }
__host__ __device__ __forceinline__ void stage_rc(int b, int& Rr, int& C) { const int st = b / 1024, sb = b % 1024, swz = sb ^ (((sb >> 9) & 1) << 5); Rr = (st >> 1) * 16 + swz / 64; C = (st & 1) * 32 + (swz % 64) / 2; }
__host__ __device__ __forceinline__ int perm32(int rho) { const int n = rho >> 4, i = rho & 15; return 8 * (i >> 2) + 4 * n + (i & 3); }

struct Unit { int pm, pn, k0, nk, slice; };
struct Gemm { const bf16_t* A; const bf16_t* Bt; int M, N, K, lda, ldb, a_blk; };

struct StaticOrder {
    int nM, nN, nwg, G, c, nt;
    __device__ __forceinline__ void init(int M, int N, int K, int G_, int c_) { nM = M / BM; nN = N / BM; nwg = nM * nN; G = G_; c = c_; nt = K / BK; }
    __device__ __forceinline__ Unit next(int i) const {
        const long L = (long)i * G + c; if (L >= nwg) return Unit{-1, 0, 0, 0, -1};
        int wgid = (int)L; { const int q = nwg / NXCD, r = nwg % NXCD, xcd = wgid % NXCD, off = wgid / NXCD; wgid = (xcd < r ? xcd * (q + 1) : r * (q + 1) + (xcd - r) * q) + off; }
        const int nig = WGM * nN, gid = wgid / nig, fm = gid * WGM, gsz = (nM - fm) < WGM ? (nM - fm) : WGM;
        return Unit{fm + ((wgid % nig) % gsz), (wgid % nig) / gsz, 0, nt, -1};
    }
};
struct LatOrder {
    int nN, nwg, G, c, nt, SK, rev;
    __device__ __forceinline__ void init(int N, int K, int G_, int c_, int SK_, int rev_ = 0) { nN = N / BM; nwg = 64 * nN; G = G_; c = c_; nt = K / BK; SK = SK_; rev = rev_; }
    __device__ __forceinline__ Unit next(int i) const {
        const int nlat = c < nwg ? (nwg - c + G - 1) / G : 0;
        if (i < nlat) {
            int wgid = i * G + c; { const int q = nwg / NXCD, r = nwg % NXCD, xcd = wgid % NXCD, off = wgid / NXCD; wgid = (xcd < r ? xcd * (q + 1) : r * (q + 1) + (xcd - r) * q) + off; }
            const int nig = WGM * nN, gid = wgid / nig, fm = gid * WGM;
            int lp = fm + ((wgid % nig) % WGM); if (rev) lp = 63 - lp;
            return Unit{(lp >> 4) * 17 + 1 + (lp & 15), (wgid % nig) / WGM, 0, nt, -1};
        }
        if (SK > 0 && i >= nlat) { const int su = c + (i - nlat) * G;
            if (su < 4 * nN * SK) { const int t = su / SK, sl = su % SK, nks = nt / SK; return Unit{17 * (t / nN), t % nN, sl * nks, nks, sl}; } }
        return Unit{-1, 0, 0, 0, -1};
    }
};

template <class F> struct EpiRow8 {
    static constexpr bool PERM = true;
    F f;
    __device__ __forceinline__ void operator()(const f32x4 (&acc)[2][2][4][2], const Unit& u, int wr, int wc, int fr, int fq) {
        const int row0 = u.pm * BM + wr * 64 + fr, colb = u.pn * BM + wc * 32 + 8 * fq;
        f.begin(u, colb);
#pragma unroll
        for (int ai = 0; ai < 2; ++ai)
#pragma unroll
            for (int m = 0; m < 4; ++m) {
                const int row = row0 + ai * HALF + m * 16;
#pragma unroll
                for (int bj = 0; bj < 2; ++bj) f.row8(row, bj, colb + bj * HALF, acc[ai][bj][m][0], acc[ai][bj][m][1]);
            }
    }
};

template <class Epi, class Sched, bool ALIGN_EPI = true, bool SP2 = true>
__device__ __forceinline__ void gemm_phase(LAS unsigned char* lds, const Gemm g, const Sched& S, Epi& E) {
    int tid = threadIdx.x; asm volatile("" : "+v"(tid));
    const int wid = __builtin_amdgcn_readfirstlane(tid >> 6), lane = tid & 63, wr = wid >> 2, wc = wid & 3, fr = lane & 15, fq = lane >> 4;
    unsigned voffA[2], voffB[2];
#pragma unroll
    for (int i = 0; i < 2; ++i) { int Rr, C; stage_rc(tid * 16 + i * 8192, Rr, C); const int Rb = Epi::PERM ? ((Rr & ~31) + perm32(Rr & 31)) : Rr;
        voffA[i] = (unsigned)(Rr * g.lda + C) * 2u; voffB[i] = (unsigned)(Rb * g.ldb + C) * 2u; }
    const size_t kstep = (size_t)(BK * 2);
    const size_t hstepA = (size_t)HALF * g.lda * 2, hstepB = (size_t)HALF * g.ldb * 2;
    const size_t tstepA = 2 * hstepA, tstepB = 2 * hstepB;
    const unsigned ldsw = (unsigned)wid * 1024u;
    const int aoff = lds_byte(wr * 64 + fr, fq * 8), boff = lds_byte(wc * 32 + fr, fq * 8);
#define PG8_SA(b, h) (((b) * 2 + (h)) * HTB)
#define PG8_SB(b, h) ((4 + (b) * 2 + (h)) * HTB)
#define PG8_STAGE(bufoff, gbase, voff) do { _Pragma("unroll") for (int _i = 0; _i < 2; ++_i) \
        __builtin_amdgcn_global_load_lds((const unsigned*)((const char*)(gbase) + (voff)[_i]), (LAS unsigned*)(lds + (bufoff) + ldsw + _i * 8192), 16, 0, 0); } while (0)
#define PG8_LDA(dst, b, h) do { _Pragma("unroll") for (int m = 0; m < 4; ++m) _Pragma("unroll") for (int k = 0; k < 2; ++k) dst[m][k] = *(const LAS bf16x8*)(lds + PG8_SA(b, h) + aoff + m * 2048 + k * 1024); } while (0)
#define PG8_LDB(dst, b, h) do { _Pragma("unroll") for (int n = 0; n < 2; ++n) _Pragma("unroll") for (int k = 0; k < 2; ++k) dst[n][k] = *(const LAS bf16x8*)(lds + PG8_SB(b, h) + boff + n * 2048 + k * 1024); } while (0)
#define PG8_MMA(ai, bj, At, Bt) do { __builtin_amdgcn_s_setprio(1); _Pragma("unroll") for (int m = 0; m < 4; ++m) _Pragma("unroll") for (int n = 0; n < 2; ++n) _Pragma("unroll") for (int k = 0; k < 2; ++k) \
        acc[ai][bj][m][n] = __builtin_amdgcn_mfma_f32_16x16x32_bf16(Bt[n][k], At[m][k], acc[ai][bj][m][n], 0, 0, 0); __builtin_amdgcn_s_setprio(0); } while (0)
#define PG8_WAIT_V(n) asm volatile("s_waitcnt vmcnt(" #n ")" ::: "memory")
#define PG8_WAIT_L(n) asm volatile("s_waitcnt lgkmcnt(" #n ")" ::: "memory")
#define PG8_BAR __builtin_amdgcn_s_barrier()
#define PG8_SCHED __builtin_amdgcn_sched_barrier(0)
    Unit cur = S.next(0), nxt = cur; int ui = 0;
    if (cur.pm < 0) return;
    f32x4 acc[2][2][4][2];
#pragma unroll
    for (int a = 0; a < 2; ++a)
#pragma unroll
        for (int b = 0; b < 2; ++b)
#pragma unroll
            for (int m = 0; m < 4; ++m)
#pragma unroll
                for (int n = 0; n < 2; ++n) acc[a][b][m][n] = (f32x4){0.f, 0.f, 0.f, 0.f};
    bf16x8 At[4][2], B0[2][2], B1[2][2];
    const char* cA = (const char*)g.A + (size_t)cur.pm * tstepA + (size_t)(g.a_blk ? (cur.pn & 7) * 512 : 0) + (size_t)cur.k0 * kstep; const char* cB = (const char*)g.Bt + (size_t)cur.pn * tstepB + (size_t)cur.k0 * kstep;
    if constexpr (SP2) {
        PG8_STAGE(PG8_SB(0, 0), cB, voffB); PG8_STAGE(PG8_SB(0, 1), cB + hstepB, voffB); PG8_STAGE(PG8_SA(0, 0), cA, voffA); PG8_STAGE(PG8_SA(0, 1), cA + hstepA, voffA);
        if (wr == 1) PG8_BAR;
        PG8_WAIT_V(2); PG8_BAR;
        PG8_STAGE(PG8_SB(1, 0), cB + kstep, voffB); PG8_STAGE(PG8_SA(1, 0), cA + kstep, voffA); PG8_STAGE(PG8_SB(1, 1), cB + hstepB + kstep, voffB);
        PG8_WAIT_V(6); PG8_BAR;
    } else {
        PG8_STAGE(PG8_SB(0, 0), cB, voffB); PG8_STAGE(PG8_SA(0, 0), cA, voffA); PG8_STAGE(PG8_SB(0, 1), cB + hstepB, voffB); PG8_STAGE(PG8_SA(0, 1), cA + hstepA, voffA);
        if (wr == 1) PG8_BAR;
        PG8_WAIT_V(4); PG8_BAR;
        PG8_STAGE(PG8_SB(1, 0), cB + kstep, voffB); PG8_STAGE(PG8_SA(1, 0), cA + kstep, voffA); PG8_STAGE(PG8_SB(1, 1), cB + hstepB + kstep, voffB);
        PG8_WAIT_V(6); PG8_BAR;
    }
    for (;;) {
        nxt = S.next(ui + 1); const bool has_next = nxt.pm >= 0;
        const char* nA = has_next ? (const char*)g.A + (size_t)nxt.pm * tstepA + (size_t)(g.a_blk ? (nxt.pn & 7) * 512 : 0) + (size_t)nxt.k0 * kstep : cA; const char* nB = has_next ? (const char*)g.Bt + (size_t)nxt.pn * tstepB + (size_t)nxt.k0 * kstep : cB;
        const int nt = cur.nk;
#pragma unroll 1
        for (int t = 0; t < nt; t += 2) {
            const bool last = (t == nt - 2);
            const char* a1 = cA + (size_t)(t + 1) * kstep;
            const char* a2 = last ? nA : cA + (size_t)(t + 2) * kstep; const char* b2 = last ? nB : cB + (size_t)(t + 2) * kstep;
            const char* a3 = a2 + kstep; const char* b3 = b2 + kstep;
            if constexpr (SP2) {
            PG8_LDB(B0, 0, 0); PG8_LDB(B1, 0, 1); PG8_SCHED; PG8_LDA(At, 0, 0); PG8_STAGE(PG8_SA(1, 1), a1 + hstepA, voffA);
            PG8_WAIT_V(8); PG8_WAIT_L(0); PG8_BAR; PG8_MMA(0, 0, At, B0); PG8_MMA(0, 1, At, B1); PG8_BAR; PG8_SCHED;
            PG8_LDA(At, 0, 1); PG8_STAGE(PG8_SB(0, 0), b2, voffB); PG8_STAGE(PG8_SB(0, 1), b2 + hstepB, voffB); PG8_STAGE(PG8_SA(0, 0), a2, voffA);
            PG8_WAIT_V(8); PG8_WAIT_L(0); PG8_BAR; PG8_MMA(1, 0, At, B0); PG8_MMA(1, 1, At, B1); PG8_BAR; PG8_SCHED;
            PG8_LDB(B0, 1, 0); PG8_LDB(B1, 1, 1); PG8_SCHED; PG8_LDA(At, 1, 0); PG8_STAGE(PG8_SA(0, 1), a2 + hstepA, voffA);
            PG8_WAIT_V(8); PG8_WAIT_L(0); PG8_BAR; PG8_MMA(0, 0, At, B0); PG8_MMA(0, 1, At, B1); PG8_BAR; PG8_SCHED;
            PG8_LDA(At, 1, 1); PG8_STAGE(PG8_SB(1, 0), b3, voffB); PG8_STAGE(PG8_SB(1, 1), b3 + hstepB, voffB); PG8_STAGE(PG8_SA(1, 0), a3, voffA);
            PG8_WAIT_V(8); PG8_WAIT_L(0); PG8_BAR; PG8_MMA(1, 0, At, B0); PG8_MMA(1, 1, At, B1); PG8_BAR; PG8_SCHED;
            } else {
            PG8_LDB(B0, 0, 0); PG8_SCHED; PG8_LDA(At, 0, 0); PG8_STAGE(PG8_SA(1, 1), a1 + hstepA, voffA);
            PG8_WAIT_L(8); PG8_BAR; PG8_WAIT_L(0); PG8_MMA(0, 0, At, B0); PG8_BAR; PG8_SCHED;
            PG8_LDB(B1, 0, 1); PG8_STAGE(PG8_SB(0, 0), b2, voffB);
            PG8_BAR; PG8_WAIT_L(0); PG8_MMA(0, 1, At, B1); PG8_BAR;
            PG8_LDA(At, 0, 1); PG8_STAGE(PG8_SA(0, 0), a2, voffA);
            PG8_BAR; PG8_WAIT_L(0); PG8_MMA(1, 0, At, B0); PG8_BAR; PG8_SCHED;
            PG8_STAGE(PG8_SB(0, 1), b2 + hstepB, voffB);
            PG8_WAIT_V(6); PG8_BAR; PG8_MMA(1, 1, At, B1); PG8_BAR;
            PG8_LDB(B0, 1, 0); PG8_SCHED; PG8_LDA(At, 1, 0); PG8_STAGE(PG8_SA(0, 1), a2 + hstepA, voffA);
            PG8_WAIT_L(8); PG8_BAR; PG8_WAIT_L(0); PG8_MMA(0, 0, At, B0); PG8_BAR; PG8_SCHED;
            PG8_LDB(B1, 1, 1); PG8_STAGE(PG8_SB(1, 0), b3, voffB);
            PG8_BAR; PG8_WAIT_L(0); PG8_MMA(0, 1, At, B1); PG8_BAR;
            PG8_LDA(At, 1, 1); PG8_STAGE(PG8_SA(1, 0), a3, voffA);
            PG8_BAR; PG8_WAIT_L(0); PG8_MMA(1, 0, At, B0); PG8_BAR; PG8_SCHED;
            PG8_STAGE(PG8_SB(1, 1), b3 + hstepB, voffB);
            PG8_WAIT_V(6); PG8_BAR; PG8_MMA(1, 1, At, B1); PG8_BAR;
            }
        }
        if constexpr (ALIGN_EPI) { if (wr == 0) PG8_BAR; }
        E(acc, cur, wr, wc, fr, fq);
        if (!has_next) break;
#pragma unroll
        for (int a = 0; a < 2; ++a)
#pragma unroll
            for (int b = 0; b < 2; ++b)
#pragma unroll
                for (int m = 0; m < 4; ++m)
#pragma unroll
                    for (int n = 0; n < 2; ++n) acc[a][b][m][n] = (f32x4){0.f, 0.f, 0.f, 0.f};
        cur = nxt; cA = nA; cB = nB; ++ui;
        if constexpr (ALIGN_EPI) { if (wr == 1) PG8_BAR; }
    }
    PG8_WAIT_V(0);
    if constexpr (!ALIGN_EPI) { if (wr == 0) PG8_BAR; }
    PG8_BAR;
#undef PG8_SA
#undef PG8_SB
#undef PG8_STAGE
#undef PG8_LDA
#undef PG8_LDB
#undef PG8_MMA
#undef PG8_WAIT_V
#undef PG8_WAIT_L
#undef PG8_BAR
#undef PG8_SCHED
}
}

namespace att {
constexpr int NW = 8, QBLK = 32, KVBLK = 64, DV = 128;
constexpr float THR = 8.f;
#define SBAR() __builtin_amdgcn_sched_barrier(0)
__device__ __forceinline__ int crow(int r, int hi) { return (r & 3) + 8 * (r >> 2) + 4 * hi; }
template <int DQK> struct Cfg {
    static constexpr int KROW = DQK * 2;
    static constexpr int SHM_K = KVBLK * KROW, SHM_V = KVBLK * DV * 2;
    static constexpr int QPE_OFF = 2 * SHM_V + 2 * SHM_K + NW * 64 * 4;
    static constexpr int NPARK = DQK == 192 ? 4 : 0;
    static constexpr int QR0 = DQK / 16 - NPARK;
    static constexpr int LDS_BYTES = QPE_OFF + NW * NPARK * 1024;
    static constexpr int NQ = DQK / 16;
    static constexpr int NKC = DQK / 64;
};
template <int DQK> __device__ __forceinline__ int kswz(int row, int colB) { return row * (DQK * 2) + (colB ^ (DQK == 128 ? ((row & 15) << 4) : (((row >> 1) & 7) << 4))); }

template <int DQK>
__device__ __forceinline__ void partialSM(f32x16& p0, f32x16& p1, float& m_reg, float& mn, float& alpha) {
    constexpr float SCALE = DQK == 128 ? 0.08838834764831845f : 0.07216878364870322f;
    constexpr float C = SCALE * 1.4426950408889634f;
    float pmax = p0[0];
#pragma unroll
    for (int r = 1; r < 16; ++r) pmax = fmaxf(pmax, p0[r]);
#pragma unroll
    for (int r = 0; r < 16; ++r) pmax = fmaxf(pmax, p1[r]);
    { auto rr = __builtin_amdgcn_permlane32_swap(__float_as_uint(pmax), __float_as_uint(pmax), false, false);
      pmax = fmaxf(__uint_as_float(rr[0]), __uint_as_float(rr[1])); }
    if (__builtin_expect(__all(pmax - m_reg <= THR / SCALE), 1)) { mn = m_reg; alpha = 1.f; }
    else { mn = fmaxf(m_reg, pmax); alpha = __builtin_amdgcn_exp2f((m_reg - mn) * C); m_reg = mn; }
    const float mnC = -mn * C;
#pragma unroll
    for (int r = 0; r < 16; ++r) p0[r] = fmaf(p0[r], C, mnC);
#pragma unroll
    for (int r = 0; r < 16; ++r) p1[r] = fmaf(p1[r], C, mnC);
#pragma unroll
    for (int r = 0; r < 16; ++r) p0[r] = __builtin_amdgcn_exp2f(p0[r]);
}
__device__ __forceinline__ void finishSM(f32x16& p0, f32x16& p1, float alpha, float& l_reg, bf16x8& pa0, bf16x8& pa1, bf16x8& pa2, bf16x8& pa3) {
#pragma unroll
    for (int r = 0; r < 16; ++r) p1[r] = __builtin_amdgcn_exp2f(p1[r]);
    float ps = 0;
#pragma unroll
    for (int r = 0; r < 16; ++r) ps += p0[r];
#pragma unroll
    for (int r = 0; r < 16; ++r) ps += p1[r];
    { auto rr = __builtin_amdgcn_permlane32_swap(__float_as_uint(ps), __float_as_uint(ps), false, false);
      ps = __uint_as_float(rr[0]) + __uint_as_float(rr[1]); }
    l_reg = l_reg * alpha + ps;
#define PK4(P, BASE, OUT) do { unsigned a0 = cvt_pk_bf16(P[BASE + 0], P[BASE + 1]), a1 = cvt_pk_bf16(P[BASE + 2], P[BASE + 3]);   \
    unsigned b0 = cvt_pk_bf16(P[BASE + 4], P[BASE + 5]), b1 = cvt_pk_bf16(P[BASE + 6], P[BASE + 7]);                              \
    auto r0 = __builtin_amdgcn_permlane32_swap(a0, b0, false, false); auto r1 = __builtin_amdgcn_permlane32_swap(a1, b1, false, false); \
    u32x4 w = {r0[0], r1[0], r0[1], r1[1]}; OUT = *reinterpret_cast<bf16x8*>(&w); } while (0)
    PK4(p0, 0, pa0); PK4(p0, 8, pa1); PK4(p1, 0, pa2); PK4(p1, 8, pa3);
#undef PK4
}
__device__ __forceinline__ void partialSM_nomax(f32x16& p0, f32x16& p1) {
    SBAR();
#pragma unroll
    for (int r = 0; r < 16; ++r) p0[r] = __builtin_amdgcn_exp2f(p0[r]);
    SBAR();
}
template <int DQK, bool PARK = (DQK == 192)>
__device__ __forceinline__ void qkt(f32x16& p0, f32x16& p1, const char* Ks, const bf16x8* qr, const char* qpe, int r32, int hi) {
    p0 = f32x16{}; p1 = f32x16{};
#pragma unroll
    for (int d0 = 0; d0 < DQK / 16; ++d0) { const int cb = (d0 * 16 + hi * 8) * 2;
        bf16x8 b0 = *reinterpret_cast<const bf16x8*>(Ks + kswz<DQK>(r32, cb));
        bf16x8 b1 = *reinterpret_cast<const bf16x8*>(Ks + kswz<DQK>(32 + r32, cb));
        bf16x8 q; if (!PARK || d0 < Cfg<DQK>::QR0) q = qr[(!PARK || d0 < Cfg<DQK>::QR0) ? d0 : 0]; else q = *reinterpret_cast<const bf16x8*>(qpe + (d0 - Cfg<DQK>::QR0) * 1024);
        p0 = __builtin_amdgcn_mfma_f32_32x32x16_bf16(b0, q, p0, 0, 0, 0);
        p1 = __builtin_amdgcn_mfma_f32_32x32x16_bf16(b1, q, p1, 0, 0, 0);
        if (DQK == 192 && (d0 & 3) == 3 && d0 != 11) SBAR(); }
}
__device__ __forceinline__ int v_st(int k, int c) { const int kk = (k & ~0xC) | ((k & 4) << 1) | ((k & 8) >> 1); return ((kk >> 3) * 4 + (c >> 5)) * 512 + ((kk & 7) * 32 + (c & 31)) * 2; }
__device__ __forceinline__ int v_rd_base(int lane) { return ((lane & 3) << 3) | (((lane >> 2) & 3) << 6) | (((lane >> 4) & 1) << 5) | (((lane >> 5) & 1) << 8); }
constexpr int v_rd_off(int d0, int ks, int half) { return d0 * 512 + ks * 4096 + half * 2048; }
template <int OFF> __device__ __forceinline__ s16x4 tr_read(int vb) {
    s16x4 r; asm volatile("ds_read_b64_tr_b16 %0, %1 offset:%2" : "=&v"(r) : "v"(vb), "i"(OFF) : "memory"); return r;
}
template <int D0> __device__ __forceinline__ void pv_one(f32x16& od, int vb, bf16x8 pa0, bf16x8 pa1, bf16x8 pa2, bf16x8 pa3) {
    const s16x4 l0 = tr_read<v_rd_off(D0, 0, 0)>(vb), h0 = tr_read<v_rd_off(D0, 0, 1)>(vb), l1 = tr_read<v_rd_off(D0, 1, 0)>(vb), h1 = tr_read<v_rd_off(D0, 1, 1)>(vb);
    const s16x4 l2 = tr_read<v_rd_off(D0, 2, 0)>(vb), h2 = tr_read<v_rd_off(D0, 2, 1)>(vb), l3 = tr_read<v_rd_off(D0, 3, 0)>(vb), h3 = tr_read<v_rd_off(D0, 3, 1)>(vb);
    asm volatile("s_waitcnt lgkmcnt(0)" ::: "memory"); SBAR();
#define PK(L, H) (bf16x8){L[0], L[1], L[2], L[3], H[0], H[1], H[2], H[3]}
    od = __builtin_amdgcn_mfma_f32_32x32x16_bf16(pa0, PK(l0, h0), od, 0, 0, 0);
    od = __builtin_amdgcn_mfma_f32_32x32x16_bf16(pa1, PK(l1, h1), od, 0, 0, 0);
    od = __builtin_amdgcn_mfma_f32_32x32x16_bf16(pa2, PK(l2, h2), od, 0, 0, 0);
    od = __builtin_amdgcn_mfma_f32_32x32x16_bf16(pa3, PK(l3, h3), od, 0, 0, 0);
#undef PK
}
__device__ __forceinline__ void pv_d0(f32x16* o, int vb, bf16x8 pa0, bf16x8 pa1, bf16x8 pa2, bf16x8 pa3) {
    pv_one<0>(o[0], vb, pa0, pa1, pa2, pa3); pv_one<1>(o[1], vb, pa0, pa1, pa2, pa3); pv_one<2>(o[2], vb, pa0, pa1, pa2, pa3); pv_one<3>(o[3], vb, pa0, pa1, pa2, pa3);
}
struct VFrag { s16x4 l0, h0, l1, h1, l2, h2, l3, h3; };
template <int D0> __device__ __forceinline__ void pv_reads(VFrag& f, int vb) {
    f.l0 = tr_read<v_rd_off(D0, 0, 0)>(vb); f.h0 = tr_read<v_rd_off(D0, 0, 1)>(vb); f.l1 = tr_read<v_rd_off(D0, 1, 0)>(vb); f.h1 = tr_read<v_rd_off(D0, 1, 1)>(vb);
    f.l2 = tr_read<v_rd_off(D0, 2, 0)>(vb); f.h2 = tr_read<v_rd_off(D0, 2, 1)>(vb); f.l3 = tr_read<v_rd_off(D0, 3, 0)>(vb); f.h3 = tr_read<v_rd_off(D0, 3, 1)>(vb);
}
__device__ __forceinline__ void pv_mma(f32x16& od, const VFrag& f, bf16x8 pa0, bf16x8 pa1, bf16x8 pa2, bf16x8 pa3) {
#define PK(L, H) (bf16x8){L[0], L[1], L[2], L[3], H[0], H[1], H[2], H[3]}
    od = __builtin_amdgcn_mfma_f32_32x32x16_bf16(pa0, PK(f.l0, f.h0), od, 0, 0, 0);
    od = __builtin_amdgcn_mfma_f32_32x32x16_bf16(pa1, PK(f.l1, f.h1), od, 0, 0, 0);
    od = __builtin_amdgcn_mfma_f32_32x32x16_bf16(pa2, PK(f.l2, f.h2), od, 0, 0, 0);
    od = __builtin_amdgcn_mfma_f32_32x32x16_bf16(pa3, PK(f.l3, f.h3), od, 0, 0, 0);
#undef PK
}
__device__ __forceinline__ void pv_pipe(f32x16* o, int vb, bf16x8 pa0, bf16x8 pa1, bf16x8 pa2, bf16x8 pa3) {
    VFrag fa, fb;
    pv_reads<0>(fa, vb); pv_reads<1>(fb, vb);
    asm volatile("s_waitcnt lgkmcnt(8)" ::: "memory"); SBAR();
    pv_mma(o[0], fa, pa0, pa1, pa2, pa3); SBAR();
    pv_reads<2>(fa, vb);
    asm volatile("s_waitcnt lgkmcnt(8)" ::: "memory"); SBAR();
    pv_mma(o[1], fb, pa0, pa1, pa2, pa3); SBAR();
    pv_reads<3>(fb, vb);
    asm volatile("s_waitcnt lgkmcnt(8)" ::: "memory"); SBAR();
    pv_mma(o[2], fa, pa0, pa1, pa2, pa3); SBAR();
    asm volatile("s_waitcnt lgkmcnt(0)" ::: "memory"); SBAR();
    pv_mma(o[3], fb, pa0, pa1, pa2, pa3);
}
__device__ __forceinline__ void unpack8(bf16x8 v, float* f) {
    const u32x4 w = *reinterpret_cast<const u32x4*>(&v);
    f[0] = bf_lo(w.x); f[1] = bf_hi(w.x); f[2] = bf_lo(w.y); f[3] = bf_hi(w.y); f[4] = bf_lo(w.z); f[5] = bf_hi(w.z); f[6] = bf_lo(w.w); f[7] = bf_hi(w.w);
}
__device__ __forceinline__ bf16x8 pack8(const float* f) {
    u32x4 w = {cvt_pk_bf16(f[0], f[1]), cvt_pk_bf16(f[2], f[3]), cvt_pk_bf16(f[4], f[5]), cvt_pk_bf16(f[6], f[7])}; return *reinterpret_cast<bf16x8*>(&w);
}
__device__ __forceinline__ void rope_pair(bf16x8& A, bf16x8& B, const f32x2* __restrict__ tab) {
    float a[8], b[8], ra[8], rb[8]; unpack8(A, a); unpack8(B, b);
#pragma unroll
    for (int j = 0; j < 8; ++j) { const f32x2 cs = tab[j]; ra[j] = a[j] * cs.x - b[j] * cs.y; rb[j] = b[j] * cs.x + a[j] * cs.y; }
    A = pack8(ra); B = pack8(rb);
}

template <int DQK, int LDQ, int LDK, int LDV, int LDO>
__device__ __forceinline__ void attn_body(const bf16_t* __restrict__ Qb, const bf16_t* __restrict__ Kh, const bf16_t* __restrict__ Vh, bf16_t* __restrict__ Ob, int seq, char* lds,
                                          const float* __restrict__ qg, const f32x2* __restrict__ tab, bool rope, int tok0) {
    using C = Cfg<DQK>;
    int tid_ = threadIdx.x; asm volatile("" : "+v"(tid_));
    const int tid = tid_, wid = tid >> 6, lane = tid & 63, r32 = lane & 31, hi = lane >> 5;
    char* V_lds = lds; char* K_lds = lds + 2 * C::SHM_V;
    float* wsf = (float*)(lds + 2 * C::SHM_V + 2 * C::SHM_K) + wid * 64; float* li_l = wsf; float* al_l = wsf + 32;
    char* qpe = lds + C::QPE_OFF + wid * (C::NPARK * 1024) + lane * 16;
    float m_reg = -1e30f, l_reg = 0; f32x16 o[4] = {}; bf16x8 qr[C::NQ];
    const bf16_t* Qw = Qb + (long)(wid * QBLK + r32) * LDQ + hi * 8;
#pragma unroll
    for (int d0 = 0; d0 < C::NQ; ++d0) qr[d0] = *reinterpret_cast<const bf16x8*>(Qw + d0 * 16);
    {
        const int t = tok0 + wid * QBLK + r32, prow = t >> 6, pcol = t & 63;
        if constexpr (DQK == 128) {
            float ss = 0.f;
#pragma unroll
            for (int d0 = 0; d0 < 8; ++d0) { float f[8]; unpack8(qr[d0], f);
#pragma unroll
                for (int j = 0; j < 8; ++j) ss += f[j] * f[j]; }
            ss += __shfl_xor(ss, 32);
            const float rstd = 1.0f / sqrtf(ss * (1.0f / 128.0f) + 1e-6f);
#pragma unroll
            for (int d0 = 0; d0 < 8; ++d0) { float f[8]; unpack8(qr[d0], f);
#pragma unroll
                for (int j = 0; j < 8; ++j) f[j] = f[j] * rstd * qg[d0 * 16 + hi * 8 + j];
                qr[d0] = pack8(f); }
            if (rope) {
                const f32x2* tr = tab + prow * 32 + hi * 8; const f32x2* tc = tab + pcol * 32 + hi * 8;
                rope_pair(qr[0], qr[2], tr); rope_pair(qr[1], qr[3], tr + 16);
                rope_pair(qr[4], qr[6], tc); rope_pair(qr[5], qr[7], tc + 16);
            }
        } else {
            if (rope) {
                const f32x2* tr = tab + prow * 16 + hi * 8; const f32x2* tc = tab + pcol * 16 + hi * 8;
                rope_pair(qr[8], qr[9], tr); rope_pair(qr[10], qr[11], tc);
            }
        }
    }
    if constexpr (DQK == 192) {
#pragma unroll
        for (int d0 = C::QR0; d0 < 12; ++d0) *reinterpret_cast<bf16x8*>(qpe + (d0 - C::QR0) * 1024) = qr[d0];
        asm volatile("s_waitcnt lgkmcnt(0)" ::: "memory");
    }
    const int sr = tid >> 4, sc = (tid & 15) * 8, vst0 = v_st(sr, sc), vst1 = v_st(32 + sr, sc);
    const int vb0 = (int)(uintptr_t)V_lds + v_rd_base(lane);
    const int sr2 = tid >> 3, sc2 = 128 + (tid & 7) * 8;
    struct Slot { bf16x8 vs0, vs1, ks0, ks1, ks2; };
    Slot sA, sBs;
#define sB (*(DQK == 192 ? &sA : &sBs))
#define SLOAD(S, k0) do { S.vs0 = *reinterpret_cast<const bf16x8*>(&Vh[(long)((k0) + sr) * LDV + sc]); S.vs1 = *reinterpret_cast<const bf16x8*>(&Vh[(long)((k0) + 32 + sr) * LDV + sc]); \
    S.ks0 = *reinterpret_cast<const bf16x8*>(&Kh[(long)((k0) + sr) * LDK + sc]); S.ks1 = *reinterpret_cast<const bf16x8*>(&Kh[(long)((k0) + 32 + sr) * LDK + sc]); \
    if constexpr (DQK == 192) S.ks2 = *reinterpret_cast<const bf16x8*>(&Kh[(long)((k0) + sr2) * LDK + sc2]); } while (0)
#define SWRITE(b, S) do { *(bf16x8*)(V_lds + (b) * C::SHM_V + vst0) = S.vs0; *(bf16x8*)(V_lds + (b) * C::SHM_V + vst1) = S.vs1; \
    *(bf16x8*)(K_lds + (b) * C::SHM_K + kswz<DQK>(sr, sc * 2)) = S.ks0; *(bf16x8*)(K_lds + (b) * C::SHM_K + kswz<DQK>(32 + sr, sc * 2)) = S.ks1; \
    if constexpr (DQK == 192) *(bf16x8*)(K_lds + (b) * C::SHM_K + kswz<DQK>(sr2, sc2 * 2)) = S.ks2; } while (0)
#define SWAIT() do { if constexpr (DQK == 192) asm volatile("s_waitcnt vmcnt(0)" ::: "memory"); else asm volatile("s_waitcnt vmcnt(4)" ::: "memory"); } while (0)
#define RESC(a) do { if (__any((a) < 1.f)) { if (hi == 0) al_l[r32] = (a); asm volatile("s_waitcnt lgkmcnt(0)" ::: "memory"); \
    _Pragma("unroll") for (int d = 0; d < 4; ++d) _Pragma("unroll") for (int r = 0; r < 16; ++r) o[d][r] *= al_l[crow(r, hi)]; } } while (0)
    f32x16 pA0, pA1, pB0, pB1; float mnA, mnB, alA, alB; bf16x8 pa0, pa1, pa2, pa3; const int NT = seq / KVBLK;
    SLOAD(sA, 0); asm volatile("s_waitcnt vmcnt(0)" ::: "memory"); SWRITE(0, sA); __syncthreads();
    qkt<DQK>(pA0, pA1, K_lds, qr, qpe, r32, hi); partialSM<DQK>(pA0, pA1, m_reg, mnA, alA);
    SLOAD(sB, KVBLK); if constexpr (DQK != 192) { if (2 < NT) SLOAD(sA, 2 * KVBLK); }
    SWAIT(); SWRITE(1, sB); __syncthreads();
    for (int j = 1; j + 1 < NT; j += 2) {
        SBAR(); qkt<DQK>(pB0, pB1, K_lds + C::SHM_K, qr, qpe, r32, hi);
        finishSM(pA0, pA1, alA, l_reg, pa0, pa1, pa2, pa3); SBAR();
        SLOAD(sB, (j + (DQK == 192 ? 1 : 2)) * KVBLK); SBAR();
        pv_d0(o, vb0, pa0, pa1, pa2, pa3); partialSM<DQK>(pB0, pB1, m_reg, mnB, alB);
        __syncthreads(); SWAIT(); SWRITE(0, sA);
        RESC(alB); __syncthreads();
        SBAR(); qkt<DQK>(pA0, pA1, K_lds, qr, qpe, r32, hi);
        finishSM(pB0, pB1, alB, l_reg, pa0, pa1, pa2, pa3); SBAR();
        if (DQK == 192 || j + 3 < NT) SLOAD(sA, (j + (DQK == 192 ? 2 : 3)) * KVBLK); SBAR();
        pv_d0(o, vb0 + C::SHM_V, pa0, pa1, pa2, pa3); partialSM<DQK>(pA0, pA1, m_reg, mnA, alA);
        __syncthreads(); SWAIT(); SWRITE(1, sB);
        RESC(alA); __syncthreads();
    }
    SBAR(); qkt<DQK>(pB0, pB1, K_lds + C::SHM_K, qr, qpe, r32, hi);
    finishSM(pA0, pA1, alA, l_reg, pa0, pa1, pa2, pa3); SBAR();
    pv_d0(o, vb0, pa0, pa1, pa2, pa3); partialSM<DQK>(pB0, pB1, m_reg, mnB, alB);
    __syncthreads(); RESC(alB);
    finishSM(pB0, pB1, alB, l_reg, pa0, pa1, pa2, pa3); SBAR();
    pv_d0(o, vb0 + C::SHM_V, pa0, pa1, pa2, pa3);
    if (hi == 0) li_l[r32] = l_reg; asm volatile("s_waitcnt lgkmcnt(0)" ::: "memory");
    float rli[16];
#pragma unroll
    for (int r = 0; r < 16; ++r) rli[r] = __builtin_amdgcn_rcpf(li_l[crow(r, hi)]);
    bf16_t* Ow = Ob + (long)(wid * QBLK) * LDO;
#pragma unroll
    for (int r = 0; r < 16; ++r) { const int orow = crow(r, hi);
#pragma unroll
        for (int d0 = 0; d0 < 4; ++d0) Ow[(long)orow * LDO + d0 * 32 + r32] = f2bf(o[d0][r] * rli[r]); }
    __syncthreads();
#undef sB
#undef SLOAD
#undef SWRITE
#undef SWAIT
#undef RESC
}

__device__ __forceinline__ void glds16(const void* g, unsigned lds_base) {
    unsigned sv; asm volatile("s_mov_b32 %0, m0\n\ts_mov_b32 m0, %2\n\ts_nop 0\n\tglobal_load_lds_dwordx4 %1, off\n\ts_mov_b32 m0, %0" : "=&s"(sv) : "v"(g), "s"(lds_base) : "memory"); }
template <int DQK> struct CfgD {
    static constexpr int SHM_K = KVBLK * DQK * 2, SHM_V = KVBLK * DV * 2;
    static constexpr int KR = 0, VR = 3 * SHM_K, SCR = VR + 3 * SHM_V, LDS_BYTES = SCR + NW * 64 * 4;
    static constexpr int NPK = DQK / 64, NPV = 2;
};
template <int DQK, int LDQ, int LDK, int LDV, int LDO, bool NOMAX = false>
__device__ __forceinline__ void attn_body_dma(const bf16_t* __restrict__ Qb, const bf16_t* __restrict__ Kh, const bf16_t* __restrict__ Vh, bf16_t* __restrict__ Ob, int seq, char* lds,
                                              const float* __restrict__ qg, const f32x2* __restrict__ tab, bool rope, int tok0) {
    using C = CfgD<DQK>;
    int tid_ = threadIdx.x; asm volatile("" : "+v"(tid_));
    const int tid = tid_, wid = __builtin_amdgcn_readfirstlane(tid >> 6), lane = tid & 63, r32 = lane & 31, hi = lane >> 5;
    const unsigned lds0 = (unsigned)__builtin_amdgcn_readfirstlane((int)(uintptr_t)lds);
    char* K_lds = lds + C::KR;
    float* wsf = (float*)(lds + C::SCR) + wid * 64; float* li_l = wsf; float* al_l = wsf + 32;
    unsigned kvoff[C::NPK], vvoff[C::NPV];
#pragma unroll
    for (int i = 0; i < C::NPK; ++i) { const int b = (wid + 8 * i) * 1024 + lane * 16, row = b / (DQK * 2), pos = b % (DQK * 2);
        const int colB = pos ^ (DQK == 128 ? ((row & 15) << 4) : (((row >> 1) & 7) << 4)); kvoff[i] = (unsigned)(row * LDK * 2 + colB); }
#pragma unroll
    for (int i = 0; i < C::NPV; ++i) { const int sbt = (wid + 8 * i) * 2 + (lane >> 5), rowin = (lane & 31) >> 2, cch = lane & 3, kk = (sbt >> 2) * 8 + rowin;
        const int k = (kk & ~0xC) | ((kk & 4) << 1) | ((kk & 8) >> 1), c = (sbt & 3) * 32 + cch * 8; vvoff[i] = (unsigned)(k * LDV * 2 + c * 2); }
#define ISSUE_K(J, SL) do { const char* g_ = (const char*)Kh + (size_t)(J) * (KVBLK * LDK * 2); _Pragma("unroll") for (int i_ = 0; i_ < C::NPK; ++i_) \
        glds16(g_ + kvoff[i_], lds0 + C::KR + (SL) * C::SHM_K + (wid + 8 * i_) * 1024); } while (0)
#define ISSUE_V(J, SL) do { const char* g_ = (const char*)Vh + (size_t)(J) * (KVBLK * LDV * 2); _Pragma("unroll") for (int i_ = 0; i_ < C::NPV; ++i_) \
        glds16(g_ + vvoff[i_], lds0 + C::VR + (SL) * C::SHM_V + (wid + 8 * i_) * 1024); } while (0)
#define WAIT_BAR(N) asm volatile("s_waitcnt vmcnt(" #N ") lgkmcnt(0)\n\ts_barrier" ::: "memory")
    const int NT = seq / KVBLK;
    ISSUE_K(0, 0); ISSUE_V(0, 0); ISSUE_K(1, 1);
    float m_reg = -1e30f, l_reg = 0; f32x16 o[4] = {}; bf16x8 qr[DQK / 16];
    const bf16_t* Qw = Qb + (long)(wid * QBLK + r32) * LDQ + hi * 8;
#pragma unroll
    for (int d0 = 0; d0 < DQK / 16; ++d0) qr[d0] = *reinterpret_cast<const bf16x8*>(Qw + d0 * 16);
    {
        const int t = tok0 + wid * QBLK + r32, prow = t >> 6, pcol = t & 63;
        if constexpr (DQK == 128) {
            float ss = 0.f;
#pragma unroll
            for (int d0 = 0; d0 < 8; ++d0) { float f[8]; unpack8(qr[d0], f);
#pragma unroll
                for (int j = 0; j < 8; ++j) ss += f[j] * f[j]; }
            ss += __shfl_xor(ss, 32);
            const float rstd = 1.0f / sqrtf(ss * (1.0f / 128.0f) + 1e-6f);
#pragma unroll
            for (int d0 = 0; d0 < 8; ++d0) { float f[8]; unpack8(qr[d0], f);
#pragma unroll
                for (int j = 0; j < 8; ++j) f[j] = f[j] * rstd * qg[d0 * 16 + hi * 8 + j] * (NOMAX ? 0.08838834764831845f * 1.4426950408889634f : 1.0f);
                qr[d0] = pack8(f); }
            if (rope) {
                const f32x2* tr = tab + prow * 32 + hi * 8; const f32x2* tc = tab + pcol * 32 + hi * 8;
                rope_pair(qr[0], qr[2], tr); rope_pair(qr[1], qr[3], tr + 16);
                rope_pair(qr[4], qr[6], tc); rope_pair(qr[5], qr[7], tc + 16);
            }
        } else {
            if (rope) {
                const f32x2* tr = tab + prow * 16 + hi * 8; const f32x2* tc = tab + pcol * 16 + hi * 8;
                rope_pair(qr[8], qr[9], tr); rope_pair(qr[10], qr[11], tc);
            }
        }
    }
    SBAR();
    const int vb0 = (int)lds0 + C::VR + v_rd_base(lane);
#define RESC(a) do { if (__any((a) < 1.f)) { if (hi == 0) al_l[r32] = (a); asm volatile("s_waitcnt lgkmcnt(0)" ::: "memory"); \
    _Pragma("unroll") for (int d = 0; d < 4; ++d) _Pragma("unroll") for (int r = 0; r < 16; ++r) o[d][r] *= al_l[crow(r, hi)]; } } while (0)
    f32x16 pA0, pA1, pB0, pB1; float mnA = 0.f, mnB = 0.f, alA = 1.f, alB = 1.f; bf16x8 pa0, pa1, pa2, pa3;
#define PSM(P0, P1, MN, AL) do { if constexpr (NOMAX) partialSM_nomax(P0, P1); else partialSM<DQK>(P0, P1, m_reg, MN, AL); } while (0)
#define RESCX(a) do { if constexpr (!NOMAX) RESC(a); else SBAR(); } while (0)
    WAIT_BAR(0);
    qkt<DQK, false>(pA0, pA1, K_lds, qr, nullptr, r32, hi); PSM(pA0, pA1, mnA, alA);
    ISSUE_K(2, 2); ISSUE_V(1, 1);
    if constexpr (C::NPK + C::NPV == 4) WAIT_BAR(4); else WAIT_BAR(5);
    int sa = 1, sb = 2, sc = 0;
#define STEP(PX0, PX1, PY0, PY1, MNX, ALX, ALY, J) do { \
    SBAR(); qkt<DQK, false>(PX0, PX1, K_lds + sa * C::SHM_K, qr, nullptr, r32, hi); \
    finishSM(PY0, PY1, ALY, l_reg, pa0, pa1, pa2, pa3); SBAR(); \
    const bool gk_ = (J) + 2 < NT, gv_ = (J) + 1 < NT; \
    if (gk_) ISSUE_K((J) + 2, sc); if (gv_) ISSUE_V((J) + 1, sb); SBAR(); \
    pv_pipe(o, vb0 + sc * C::SHM_V, pa0, pa1, pa2, pa3); PSM(PX0, PX1, MNX, ALX); \
    RESCX(ALX); \
    if (gk_) { if constexpr (C::NPK + C::NPV == 4) WAIT_BAR(4); else WAIT_BAR(5); } else if (gv_) WAIT_BAR(2); else WAIT_BAR(0); \
    { const int t_ = sa; sa = sb; sb = sc; sc = t_; } } while (0)
    int j = 1;
    for (; j + 1 < NT; j += 2) {
        STEP(pB0, pB1, pA0, pA1, mnB, alB, alA, j);
        STEP(pA0, pA1, pB0, pB1, mnA, alA, alB, j + 1);
    }
    STEP(pB0, pB1, pA0, pA1, mnB, alB, alA, j);
    finishSM(pB0, pB1, alB, l_reg, pa0, pa1, pa2, pa3); SBAR();
    pv_d0(o, vb0 + sc * C::SHM_V, pa0, pa1, pa2, pa3);
    if (hi == 0) li_l[r32] = l_reg; asm volatile("s_waitcnt lgkmcnt(0)" ::: "memory");
    float rli[16];
#pragma unroll
    for (int r = 0; r < 16; ++r) rli[r] = __builtin_amdgcn_rcpf(li_l[crow(r, hi)]);
    bf16_t* Ow = Ob + (long)(wid * QBLK) * LDO;
#pragma unroll
    for (int r = 0; r < 16; ++r) { const int orow = crow(r, hi);
#pragma unroll
        for (int d0 = 0; d0 < 4; ++d0) Ow[(long)orow * LDO + d0 * 32 + r32] = f2bf(o[d0][r] * rli[r]); }
    WAIT_BAR(0);
#undef ISSUE_K
#undef ISSUE_V
#undef WAIT_BAR
#undef RESC
#undef STEP
#undef PSM
#undef RESCX
}
}

constexpr size_t MiB = 1u << 20;
constexpr size_t WS_CTL = 0, CTL_ZERO_BYTES = 1 * MiB;
constexpr size_t WS_MODS = 1 * MiB;
constexpr size_t WS_TAB = 2 * MiB;
constexpr size_t WS_X = 4 * MiB;
constexpr size_t WS_H = 140 * MiB;
constexpr size_t WS_OUTF = 208 * MiB;
constexpr size_t WS_W1T = 344 * MiB, WS_W2T = 472 * MiB;
constexpr size_t WS_GQAW = 600 * MiB;
constexpr size_t WS_LRUW = 640 * MiB;
constexpr size_t WS_MLAW = 668 * MiB;
constexpr size_t WS_BIG = 688 * MiB;
constexpr size_t WS_ACT = WS_BIG;
constexpr size_t WS_GQ = WS_BIG, WS_GK = WS_BIG + 68 * MiB, WS_GV = WS_BIG + 85 * MiB, WS_GO = WS_BIG + 102 * MiB;
constexpr size_t WS_MAP = WS_BIG, WS_MQAN = WS_BIG + 85 * MiB, WS_MCKVN = WS_BIG + 102 * MiB, WS_MQ = WS_BIG + 119 * MiB, WS_MK = WS_BIG + 221 * MiB, WS_MV = WS_BIG + 323 * MiB, WS_MO = WS_BIG + 391 * MiB;
constexpr size_t WS_LUP = WS_BIG, WS_LG = WS_BIG  , WS_LGY = WS_BIG + 68 * MiB, WS_LU = WS_BIG + 136 * MiB, WS_LAF = WS_BIG + 204 * MiB, WS_LGUF = WS_BIG + 272 * MiB,
                 WS_LAB = WS_BIG + 340 * MiB, WS_LGUB = WS_BIG + 408 * MiB, WS_LPS = WS_BIG + 476 * MiB, WS_LCIN = WS_BIG + 494 * MiB;
static_assert(WS_LGUF == WS_LAF + (size_t)R * DM * 2 && WS_LAB == WS_LGUF + (size_t)R * DM * 2 && WS_LGUB == WS_LAB + (size_t)R * DM * 2, "gate outputs are consecutive");
constexpr size_t WS_PART = WS_BIG + 776 * MiB;
constexpr size_t WS_END = WS_PART + 64 * MiB;
constexpr int NCH = 136;

#define XB_TMO      128
#define XB_XCNT(j)  (256  + 64 * (j))
#define XB_XSUB(j)  (1280 + 64 * (j))
#define XB_XGEN(j)  (2304 + 64 * (j))
#define XB_TOP      3328
#define XB_TOPGEN   3392
#define XCD_BAR_WORDS 3456
#define XB_SPIN_CAP (1u << 22)
__device__ __forceinline__ unsigned xb_ld(unsigned* p)              { return __hip_atomic_load(p, __ATOMIC_RELAXED, __HIP_MEMORY_SCOPE_AGENT); }
__device__ __forceinline__ unsigned xb_add(unsigned* p, unsigned v) { return __hip_atomic_fetch_add(p, v, __ATOMIC_RELAXED, __HIP_MEMORY_SCOPE_AGENT); }
__device__ __forceinline__ unsigned xb_xcc_id() { return (unsigned)__builtin_amdgcn_s_getreg((3 << 11) | 20) & 0xFu; }
#define XB_SPIN(cond, bar) do { unsigned _sp = 0; while (cond) { __builtin_amdgcn_s_sleep(1); \
    if ((++_sp & 255u) == 0u) { if (xb_ld(&(bar)[XB_TMO])) break; if (_sp > XB_SPIN_CAP) { atomicAdd(&(bar)[XB_TMO], 1u); break; } } } } while (0)
struct XcdBarrier { unsigned* bar; unsigned x; volatile LAS unsigned* st; };
__device__ __forceinline__ XcdBarrier xcd_barrier_post(unsigned* bar, volatile LAS unsigned* st) {
    XcdBarrier b; b.bar = bar; b.x = xb_xcc_id(); b.st = st;
    if (threadIdx.x == 0) (void)xb_add(&bar[XB_XCNT(b.x)], 1u);
    return b;
}
__device__ __forceinline__ void xcd_barrier_complete(unsigned* bar, unsigned x, unsigned& nloc, unsigned& nx) {
    const unsigned G = gridDim.x * gridDim.y * gridDim.z;
    unsigned sum, cnt, mine, sp = 0u;
    for (;;) {
        sum = 0u; cnt = 0u; mine = 0u;
#pragma unroll
        for (unsigned j = 0; j < 16; ++j) { const unsigned c = xb_ld(&bar[XB_XCNT(j)]); sum += c; cnt += (c > 0u) ? 1u : 0u; mine = (j == x) ? c : mine; }
        if (sum == G) break;
        __builtin_amdgcn_s_sleep(1);
        if ((++sp & 255u) == 0u) { if (xb_ld(&bar[XB_TMO])) break; if (sp > XB_SPIN_CAP) { atomicAdd(&bar[XB_TMO], 1u); break; } }
    }
    nloc = mine > 0u ? mine : 1u; nx = cnt > 0u ? cnt : 1u;
}
__device__ __forceinline__ void xcd_barrier(const XcdBarrier& b) {
    asm volatile("s_waitcnt vmcnt(0)" ::: "memory");
    __syncthreads();
    if (threadIdx.x == 0) {
        unsigned* bar = b.bar;
        __builtin_amdgcn_s_waitcnt(0);
        unsigned nloc = b.st[0], nx = b.st[1];
        if (nloc == 0u) { xcd_barrier_complete(bar, b.x, nloc, nx); b.st[0] = nloc; b.st[1] = nx; }
        const unsigned old = xb_add(&bar[XB_XSUB(b.x)], 1u);
        const unsigned gen = old / nloc;
        if (old + 1u == (gen + 1u) * nloc) {
            __builtin_amdgcn_fence(__ATOMIC_RELEASE, "agent");
            asm volatile("s_waitcnt vmcnt(0)" ::: "memory");
            const unsigned og = xb_add(&bar[XB_TOP], 1u);
            const unsigned tg = og / nx;
            if (og + 1u == (tg + 1u) * nx) xb_add(&bar[XB_TOPGEN], 1u);
            else XB_SPIN(xb_ld(&bar[XB_TOPGEN]) == tg, bar);
            __builtin_amdgcn_fence(__ATOMIC_ACQUIRE, "agent");
            xb_add(&bar[XB_XGEN(b.x)], 1u);
            asm volatile("s_waitcnt vmcnt(0)" ::: "memory");
        } else {
            XB_SPIN(xb_ld(&bar[XB_XGEN(b.x)]) == gen, bar);
            __builtin_amdgcn_fence(__ATOMIC_ACQUIRE, "agent");
            asm volatile("s_waitcnt vmcnt(0)" ::: "memory");
        }
    }
    __syncthreads();
}

#ifndef PROBE_N
#define PROBE_N 2
#endif
__device__ __forceinline__ int probe_count() { int n = PROBE_N; asm volatile("" : "+s"(n)); return n; }
#ifdef PROBE_GEMM
#define PROBE_REPEAT_GEMM for (int rep_ = 0, nrep_ = probe_count(); rep_ < nrep_; ++rep_)
#else
#define PROBE_REPEAT_GEMM
#endif
#ifdef PROBE_ATTN
#define PROBE_REPEAT_ATTN for (int rep_ = 0, nrep_ = probe_count(); rep_ < nrep_; ++rep_)
#else
#define PROBE_REPEAT_ATTN
#endif
struct Args {
    const float *x, *c, *ctx, *c_ctx, *ada_w, *ada_b, *ln_g, *ln_b, *mlp_w1, *mlp_w2;
    const float *gqa_wq, *gqa_wk, *gqa_wv, *gqa_wo, *gqa_q_g, *gqa_k_g;
    const float *lru_wx, *lru_wy, *lru_conv_w, *lru_conv_b, *lru_ra_w, *lru_ra_b, *lru_ix_w, *lru_ix_b, *lru_lam, *lru_wo;
    const float *mla_wq_a, *mla_q_a_g, *mla_wq_b, *mla_wkv_a, *mla_kv_a_g, *mla_wkv_b, *mla_wo;
    float* out; unsigned char* ws; int ph_lo, ph_hi;
};

typedef const __attribute__((address_space(4))) Args CArgs;
__device__ __forceinline__ CArgs* kargs() { CArgs* p = (CArgs*)__builtin_amdgcn_kernarg_segment_ptr(); asm volatile("" : "+s"(p)); return p; }
constexpr int NWAVES = 8;
constexpr int RING_BYTES = 131072, LDSCTL_OFF = RING_BYTES, LDS_BYTES = 147456;

__device__ __forceinline__ float wave_sum(float v) {
#pragma unroll
    for (int o = 1; o < 64; o <<= 1) v += __shfl_xor(v, o);
    return v;
}
__device__ __forceinline__ float sigmoidf_(float v) { return __builtin_amdgcn_rcpf(1.0f + __builtin_amdgcn_exp2f(-1.4426950408889634f * v)); }

__device__ __forceinline__ int tid_opaque() { int t = threadIdx.x; asm volatile("" : "+v"(t)); return t; }
__device__ __forceinline__ void ph_mods(CArgs& a, LAS unsigned char* lds, int vcu, int G) {
    LAS float* S = (LAS float*)lds; LAS float* red = (LAS float*)(lds + 40960);
    const int tid = tid_opaque(), wave = tid >> 6, lane = tid & 63;
    for (int i = tid; i < 5 * DM; i += 512) { const int bi = i / DM, k = i % DM; const float v = bi < 4 ? a.c[bi * DM + k] : a.c_ctx[k]; S[i] = v / (1.0f + expf(-v)); }
    __syncthreads();
    float* mods = (float*)(a.ws + WS_MODS);
    for (int item = vcu; item < 768; item += G) {
        const int l = item / 192, n0 = (item % 192) * 64, ksub = wave * 4 + (lane >> 4), cl = lane & 15;
        const float* wp = a.ada_w + ((size_t)l * DM + ksub) * 12288 + n0 + cl * 4;
        float acc[5][4];
#pragma unroll
        for (int i = 0; i < 5; ++i)
#pragma unroll
            for (int j = 0; j < 4; ++j) acc[i][j] = 0.f;
#pragma unroll 8
        for (int it = 0; it < 64; ++it) {
            const f32x4 w = *(const f32x4*)(wp + (size_t)it * 32 * 12288); const int k = ksub + 32 * it;
#pragma unroll
            for (int i = 0; i < 5; ++i) { const float s = S[i * DM + k];
#pragma unroll
                for (int j = 0; j < 4; ++j) acc[i][j] += s * w[j]; }
        }
#pragma unroll
        for (int i = 0; i < 5; ++i)
#pragma unroll
            for (int j = 0; j < 4; ++j) red[(ksub * 5 + i) * 64 + cl * 4 + j] = acc[i][j];
        __syncthreads();
        if (tid < 320) { const int i = tid / 64, cc = tid % 64; float s = 0.f;
            for (int ks = 0; ks < 32; ++ks) s += red[(ks * 5 + i) * 64 + cc];
            mods[(size_t)(l * 5 + i) * 12288 + n0 + cc] = s + a.ada_b[l * 12288 + n0 + cc]; }
        __syncthreads();
    }
}
__device__ __forceinline__ void tr_item(const float* __restrict__ W, int ldw, int k0, int n0, bf16_t* __restrict__ WT, int ldt, int drow0, LAS float* scr, int lane) {
#pragma unroll 8
    for (int i = 0; i < 32; ++i) { const int kk = 2 * i + (lane >> 5); scr[kk * 33 + (lane & 31)] = W[(size_t)(k0 + kk) * ldw + n0 + (lane & 31)]; }
    asm volatile("s_waitcnt lgkmcnt(0)" ::: "memory");
    const int c = lane & 7;
#pragma unroll
    for (int j = 0; j < 4; ++j) { const int n = (lane >> 3) + 8 * j; const LAS float* s = scr + (8 * c) * 33 + n;
        u32x4 o; o.x = cvt_pk_bf16(s[0 * 33], s[1 * 33]); o.y = cvt_pk_bf16(s[2 * 33], s[3 * 33]); o.z = cvt_pk_bf16(s[4 * 33], s[5 * 33]); o.w = cvt_pk_bf16(s[6 * 33], s[7 * 33]);
        *(u32x4*)(WT + (size_t)(drow0 + n) * ldt + k0 + 8 * c) = o; }
    asm volatile("s_waitcnt lgkmcnt(0)" ::: "memory");
}
__device__ __forceinline__ void ph_transposes(CArgs& a, LAS unsigned char* lds, int vcu, int G) {
    const int tid = tid_opaque(), wave = tid >> 6, lane = tid & 63;
    LAS float* scr = (LAS float*)(lds + wave * 8704);
    const int gw = vcu * NWAVES + wave, NGW = G * NWAVES;
    unsigned char* ws = a.ws;
    constexpr int NITEMS = 87872;
    for (int it = gw; it < NITEMS; it += NGW) {
        int r = it;
#define TR_DO(src, K_, N_, dst, drow) do { const int nblk = (N_) / 32, kb = ri / nblk, nb = ri % nblk; tr_item((src), (N_), 64 * kb, 32 * nb, (dst), (K_), (drow) + 32 * nb, scr, lane); } while (0)
        if (r < 32768) { const int l = r / 8192, ri = r % 8192; TR_DO(a.mlp_w1 + (size_t)l * DM * DFF, DM, DFF, (bf16_t*)(ws + WS_W1T) + (size_t)l * DFF * DM, 0); continue; } r -= 32768;
        if (r < 32768) { const int l = r / 8192, ri = r % 8192; TR_DO(a.mlp_w2 + (size_t)l * DFF * DM, DFF, DM, (bf16_t*)(ws + WS_W2T) + (size_t)l * DM * DFF, 0); continue; } r -= 32768;
        if (r < 4096) { const int s = r / 2048, ri = r % 2048; TR_DO(a.gqa_wq + (size_t)s * DM * DM, DM, DM, (bf16_t*)(ws + WS_GQAW + s * 20 * MiB), 0); continue; } r -= 4096;
        if (r < 1024) { const int s = r / 512, ri = r % 512; TR_DO(a.gqa_wk + (size_t)s * DM * 512, DM, 512, (bf16_t*)(ws + WS_GQAW + s * 20 * MiB), 2048); continue; } r -= 1024;
        if (r < 1024) { const int s = r / 512, ri = r % 512; TR_DO(a.gqa_wv + (size_t)s * DM * 512, DM, 512, (bf16_t*)(ws + WS_GQAW + s * 20 * MiB), 2560); continue; } r -= 1024;
        if (r < 4096) { const int s = r / 2048, ri = r % 2048; TR_DO(a.gqa_wo + (size_t)s * DM * DM, DM, DM, (bf16_t*)(ws + WS_GQAW + s * 20 * MiB + 12 * MiB), 0); continue; } r -= 4096;
        if (r < 2048) { const int ri = r; TR_DO(a.lru_wx, DM, DM, (bf16_t*)(ws + WS_LRUW), 0); continue; } r -= 2048;
        if (r < 2048) { const int ri = r; TR_DO(a.lru_wy, DM, DM, (bf16_t*)(ws + WS_LRUW), 2048); continue; } r -= 2048;
        if (r < 1024) { const int blk = r / 32, ri = r % 32, ty = blk / 16, d = (blk % 16) / 8, n = blk % 8, which = d * 2 + ty;
            const float* src = (ty == 0 ? a.lru_ra_w : a.lru_ix_w) + (size_t)(d * 8 + n) * 65536;
            TR_DO(src, 256, 256, (bf16_t*)(ws + WS_LRUW + 16 * MiB), (which * 8 + n) * 256); continue; } r -= 1024;
        if (r < 2048) { const int ri = r; TR_DO(a.lru_wo, DM, DM, (bf16_t*)(ws + WS_LRUW + 20 * MiB), 0); continue; } r -= 2048;
        if (r < 512) { const int ri = r; TR_DO(a.mla_wq_a, DM, 512, (bf16_t*)(ws + WS_MLAW), 0); continue; } r -= 512;
        if (r < 576) { const int ri = r; TR_DO(a.mla_wkv_a, DM, 576, (bf16_t*)(ws + WS_MLAW), 512); continue; } r -= 576;
        if (r < 768) { const int ri = r; TR_DO(a.mla_wq_b, 512, 3072, (bf16_t*)(ws + WS_MLAW + 5 * MiB), 0); continue; } r -= 768;
        if (r < 1024) { const int ri = r, nb = ri % 128, kb = ri / 128, n0 = 32 * nb, h = n0 >> 8, j0 = n0 & 255;
            const int drow = j0 < 128 ? h * 128 + j0 : 2048 + h * 128 + (j0 - 128);
            tr_item(a.mla_wkv_b, 4096, 64 * kb, n0, (bf16_t*)(ws + WS_MLAW + 8 * MiB), 512, drow, scr, lane); continue; } r -= 1024;
        { const int ri = r; TR_DO(a.mla_wo, DM, DM, (bf16_t*)(ws + WS_MLAW + 12 * MiB), 0); }
#undef TR_DO
    }
    { u32x4* z = (u32x4*)(ws + WS_MLAW + (size_t)1088 * DM * 2); const int gt = vcu * 512 + tid;
      for (int i = gt; i < 49152; i += G * 512) z[i] = (u32x4){0u, 0u, 0u, 0u}; }
    if (vcu == 1 % G) { float* ll = (float*)(ws + WS_TAB + 32768); for (int i = tid; i < 2 * DM; i += 512) ll[i] = -8.0f * log1pf(expf(-a.lru_lam[i])); }
    if (vcu == 0) {
        f32x2* tg = (f32x2*)(ws + WS_TAB); f32x2* tm = (f32x2*)(ws + WS_TAB + 16384);
        for (int i = tid; i < 64 * 32; i += 512) { const int pos = i / 32, f = i % 32; const float inv = powf(10000.0f, -((float)f * 2.0f) / 64.0f); const float ang = (float)pos * inv; tg[i] = (f32x2){cosf(ang), sinf(ang)}; }
        for (int i = tid; i < 64 * 16; i += 512) { const int pos = i / 16, f = i % 16; const float inv = powf(10000.0f, -((float)f * 2.0f) / 32.0f); const float ang = (float)pos * inv; tm[i] = (f32x2){cosf(ang), sinf(ang)}; }
    }
}

#define ROW_DECODE(r) const int b_ = (r) / TB, p_ = (r) % TB; const bool isctx_ = p_ < CTX; const int mi_ = isctx_ ? 4 : b_; (void)b_; (void)mi_
__device__ __forceinline__ const float* mods_ptr(CArgs& a, int l, int mi) { return (const float*)(a.ws + WS_MODS) + (size_t)(l * 5 + mi) * 12288; }

__device__ __forceinline__ void ph_init(CArgs& a, int vcu, int G) {
    const int tid_ = tid_opaque(), lane = tid_ & 63, gw = vcu * NWAVES + (tid_ >> 6), NGW = G * NWAVES; (void)lane;
    bf16_t* X = (bf16_t*)(a.ws + WS_X); bf16_t* H = (bf16_t*)(a.ws + WS_H);
    for (int r = gw; r < R; r += NGW) {
        ROW_DECODE(r);
        const float* src = isctx_ ? a.ctx + ((size_t)b_ * CTX + p_) * DM : a.x + ((size_t)b_ * SEQ + (p_ - CTX)) * DM;
        const float* m = mods_ptr(a, 0, mi_);
#pragma unroll
        for (int it = 0; it < 8; ++it) { const int idx = it * 256 + lane * 4;
            const f32x4 v = *(const f32x4*)(src + idx), m0 = *(const f32x4*)(m + idx), m1 = *(const f32x4*)(m + DM + idx);
            *(u32x2*)(X + (size_t)r * DM + idx) = (u32x2){cvt_pk_bf16(v[0], v[1]), cvt_pk_bf16(v[2], v[3])};
            const f32x4 h = v * (1.0f + m1) + m0;
            *(u32x2*)(H + (size_t)r * DM + idx) = (u32x2){cvt_pk_bf16(h[0], h[1]), cvt_pk_bf16(h[2], h[3])}; }
    }
}
__device__ __forceinline__ void ln_stage_vecs(CArgs& a, LAS float* vec, int l, int which, int mi, bool last, int tid) {
    const float* lg = a.ln_g + (size_t)(l * 2 + which) * DM; const float* lb = a.ln_b + (size_t)(l * 2 + which) * DM;
    const float* m = mods_ptr(a, l, mi);
    const float* gate = m + (which == 0 ? 2 : 5) * DM;
    const float* sc = which == 0 ? m + 4 * DM : mods_ptr(a, last ? l : l + 1, mi) + 1 * DM;
    const float* sh = which == 0 ? m + 3 * DM : mods_ptr(a, last ? l : l + 1, mi);
    { const int i = tid * 4; const f32x4 g = *(const f32x4*)(gate + i), s4 = *(const f32x4*)(sc + i);
      *(LAS f32x4*)(vec + i) = 1.0f + g; *(LAS f32x4*)(vec + DM + i) = *(const f32x4*)(lg + i); *(LAS f32x4*)(vec + 2 * DM + i) = *(const f32x4*)(lb + i);
      *(LAS f32x4*)(vec + 3 * DM + i) = 1.0f + s4; *(LAS f32x4*)(vec + 4 * DM + i) = *(const f32x4*)(sh + i); }
}
template <bool LAST, int NR, bool FROM_PART>
__device__ __forceinline__ void ln_rows(CArgs& a, const LAS float* vec, int r, int lane) {
    bf16_t* X = (bf16_t*)(a.ws + WS_X); bf16_t* H = (bf16_t*)(a.ws + WS_H); const bf16_t* O = (const bf16_t*)(a.ws + WS_OUTF); const bf16_t* PART = (const bf16_t*)(a.ws + WS_PART);
    ROW_DECODE(r);
    float v[NR][4][8]; float s[NR];
#pragma unroll
    for (int rr = 0; rr < NR; ++rr) s[rr] = 0.f;
#pragma unroll
    for (int it = 0; it < 4; ++it) { const int idx = it * 512 + lane * 8;
        const f32x4 g0 = *(const LAS f32x4*)(vec + idx), g1 = *(const LAS f32x4*)(vec + idx + 4);
#pragma unroll
        for (int rr = 0; rr < NR; ++rr) {
            float xv[8], ov[8]; att::unpack8(*(const bf16x8*)(X + (size_t)(r + rr) * DM + idx), xv);
            if (FROM_PART) { const bf16_t* pp = PART + ((size_t)b_ * CTX + p_ + rr) * DM + idx;
                att::unpack8(*(const bf16x8*)pp, ov);
#pragma unroll
                for (int sl = 1; sl < 8; ++sl) { float t8[8]; att::unpack8(*(const bf16x8*)(pp + (size_t)sl * (NB * CTX) * DM), t8);
#pragma unroll
                    for (int j = 0; j < 8; ++j) ov[j] += t8[j]; } }
            else att::unpack8(*(const bf16x8*)(O + (size_t)(r + rr) * DM + idx), ov);
#pragma unroll
            for (int j = 0; j < 8; ++j) { v[rr][it][j] = DN_ALPHA * xv[j] + (j < 4 ? g0[j] : g1[j - 4]) * ov[j]; s[rr] += v[rr][it][j]; } }
        __builtin_amdgcn_sched_barrier(0);
    }
    float rstd[NR];
#pragma unroll
    for (int rr = 0; rr < NR; ++rr) { const float mean = wave_sum(s[rr]) * (1.0f / DM); float q = 0.f;
#pragma unroll
        for (int it = 0; it < 4; ++it)
#pragma unroll
            for (int j = 0; j < 8; ++j) { v[rr][it][j] -= mean; q += v[rr][it][j] * v[rr][it][j]; }
        rstd[rr] = 1.0f / sqrtf(wave_sum(q) * (1.0f / DM) + LN_EPS); }
#pragma unroll
    for (int it = 0; it < 4; ++it) { const int idx = it * 512 + lane * 8;
        const f32x4 lg0 = *(const LAS f32x4*)(vec + DM + idx), lg1 = *(const LAS f32x4*)(vec + DM + idx + 4), lb0 = *(const LAS f32x4*)(vec + 2 * DM + idx), lb1 = *(const LAS f32x4*)(vec + 2 * DM + idx + 4);
        f32x4 sc0 = {0.f, 0.f, 0.f, 0.f}, sc1 = sc0, sh0 = sc0, sh1 = sc0;
        if (!LAST) { sc0 = *(const LAS f32x4*)(vec + 3 * DM + idx); sc1 = *(const LAS f32x4*)(vec + 3 * DM + idx + 4); sh0 = *(const LAS f32x4*)(vec + 4 * DM + idx); sh1 = *(const LAS f32x4*)(vec + 4 * DM + idx + 4); }
#pragma unroll
        for (int rr = 0; rr < NR; ++rr) {
            float xn[8];
#pragma unroll
            for (int j = 0; j < 8; ++j) xn[j] = v[rr][it][j] * rstd[rr] * (j < 4 ? lg0[j] : lg1[j - 4]) + (j < 4 ? lb0[j] : lb1[j - 4]);
            if (LAST) { float* op = a.out + ((size_t)b_ * SEQ + (p_ + rr - CTX)) * DM + idx; *(f32x4*)op = (f32x4){xn[0], xn[1], xn[2], xn[3]}; *(f32x4*)(op + 4) = (f32x4){xn[4], xn[5], xn[6], xn[7]}; }
            else { *(bf16x8*)(X + (size_t)(r + rr) * DM + idx) = att::pack8(xn);
                float hh[8];
#pragma unroll
                for (int j = 0; j < 8; ++j) hh[j] = xn[j] * (j < 4 ? sc0[j] : sc1[j - 4]) + (j < 4 ? sh0[j] : sh1[j - 4]);
                *(bf16x8*)(H + (size_t)(r + rr) * DM + idx) = att::pack8(hh); } }
        __builtin_amdgcn_sched_barrier(0); }
}
template <bool LAST, int CTXMODE>
__device__ __forceinline__ void ph_ln(CArgs& a, LAS unsigned char* lds, int l, int which, int vcu, int G) {
    const int tid = tid_opaque(), lane = tid & 63, wave = tid >> 6;
    LAS float* vec = (LAS float*)lds;
    constexpr int NR = 2;
    const int b = (int)(((long)vcu * NB) / G), vlo = (b * G + NB - 1) / NB, vhi = ((b + 1) * G + NB - 1) / NB, wpb = vhi - vlo, w = vcu - vlo;
    ln_stage_vecs(a, vec, l, which, b, LAST, tid);
    __syncthreads();
    for (int k = w * NWAVES + wave; k < SEQ / NR; k += wpb * NWAVES) ln_rows<LAST, NR, false>(a, vec, b * TB + CTX + k * NR, lane);
    if (CTXMODE == 1 && !LAST) {
        __syncthreads();
        ln_stage_vecs(a, vec, l, which, 4, LAST, tid);
        __syncthreads();
        for (int k = vcu * NWAVES + wave; k < NB * CTX; k += G * NWAVES) ln_rows<false, 1, true>(a, vec, (k / CTX) * TB + (k % CTX), lane);
    }
    __syncthreads();
}
__device__ __forceinline__ void ph_knorm(CArgs& a, const float* kg, int vcu, int G) {
    const int tid_ = tid_opaque(), lane = tid_ & 63, gw = vcu * NWAVES + (tid_ >> 6), NGW = G * NWAVES; (void)lane;
    bf16_t* K = (bf16_t*)(a.ws + WS_GK); const f32x2* tab = (const f32x2*)(a.ws + WS_TAB);
    const int li = lane & 15;
    float g[8];
#pragma unroll
    for (int j = 0; j < 8; ++j) g[j] = kg[li * 8 + j];
    for (int r = gw; r < R; r += NGW) {
        ROW_DECODE(r);
        bf16x8 raw = *(const bf16x8*)(K + (size_t)r * 512 + lane * 8);
        float f[8]; att::unpack8(raw, f);
        float ss = 0.f;
#pragma unroll
        for (int j = 0; j < 8; ++j) ss += f[j] * f[j];
        ss += __shfl_xor(ss, 1); ss += __shfl_xor(ss, 2); ss += __shfl_xor(ss, 4); ss += __shfl_xor(ss, 8);
        const float rstd = 1.0f / sqrtf(ss * (1.0f / 128.0f) + 1e-6f);
#pragma unroll
        for (int j = 0; j < 8; ++j) f[j] = f[j] * rstd * g[j];
        if (!isctx_) {
            const int t = p_ - CTX, pos = (li & 8) ? (t & 63) : (t >> 6);
            const f32x2* tp = tab + pos * 32 + (li & 3) * 8;
            const bool second = (li & 4) != 0;
#pragma unroll
            for (int j = 0; j < 8; ++j) { const float other = __shfl_xor(f[j], 4); const f32x2 cs = tp[j];
                f[j] = second ? f[j] * cs.x + other * cs.y : f[j] * cs.x - other * cs.y; }
        }
        *(bf16x8*)(K + (size_t)r * 512 + lane * 8) = att::pack8(f);
    }
}
__device__ __forceinline__ void ph_mla_norm(CArgs& a, int vcu, int G) {
    const int tid_ = tid_opaque(), lane = tid_ & 63, gw = vcu * NWAVES + (tid_ >> 6), NGW = G * NWAVES; (void)lane;
    const float* AP = (const float*)(a.ws + WS_MAP); bf16_t* QAN = (bf16_t*)(a.ws + WS_MQAN); bf16_t* CKVN = (bf16_t*)(a.ws + WS_MCKVN); bf16_t* K = (bf16_t*)(a.ws + WS_MK);
    const f32x2* tab = (const f32x2*)(a.ws + WS_TAB + 16384);
    for (int r = gw; r < R; r += NGW) {
        ROW_DECODE(r);
        const float* ap = AP + (size_t)r * 1280;
#pragma unroll
        for (int part = 0; part < 2; ++part) {
            const f32x4 v0 = *(const f32x4*)(ap + part * 512 + lane * 8), v1 = *(const f32x4*)(ap + part * 512 + lane * 8 + 4);
            float ss = (v0[0] * v0[0] + v0[1] * v0[1]) + (v0[2] * v0[2] + v0[3] * v0[3]) + (v1[0] * v1[0] + v1[1] * v1[1]) + (v1[2] * v1[2] + v1[3] * v1[3]);
            const float rstd = 1.0f / sqrtf(wave_sum(ss) * (1.0f / 512.0f) + 1e-6f);
            const float* gp = (part == 0 ? a.mla_q_a_g : a.mla_kv_a_g) + lane * 8;
            const f32x4 g0 = *(const f32x4*)gp, g1 = *(const f32x4*)(gp + 4);
            const f32x4 o0 = v0 * rstd * g0, o1 = v1 * rstd * g1;
            u32x4 w = {cvt_pk_bf16(o0[0], o0[1]), cvt_pk_bf16(o0[2], o0[3]), cvt_pk_bf16(o1[0], o1[1]), cvt_pk_bf16(o1[2], o1[3])};
            *(u32x4*)((part == 0 ? QAN : CKVN) + (size_t)r * 512 + lane * 8) = w;
        }
        float v = ap[1024 + lane];
        if (!isctx_) {
            const int t = p_ - CTX, pos = (lane & 32) ? (t & 63) : (t >> 6);
            const f32x2 cs = tab[pos * 16 + (lane & 15)];
            const float other = __shfl_xor(v, 16);
            v = (lane & 16) ? v * cs.x + other * cs.y : v * cs.x - other * cs.y;
        }
        const bf16_t kb = f2bf(v);
#pragma unroll
        for (int h = 0; h < 16; ++h) K[(size_t)r * 3072 + h * 192 + 128 + lane] = kb;
    }
}
__device__ __forceinline__ void ph_conv(CArgs& a, int vcu, int G) {
    const int tid_ = tid_opaque(), lane = tid_ & 63, gw = vcu * NWAVES + (tid_ >> 6), NGW = G * NWAVES; (void)lane;
    const bf16_t* UP = (const bf16_t*)(a.ws + WS_LUP); bf16_t* U = (bf16_t*)(a.ws + WS_LU);
    for (int r = gw; r < R; r += NGW) {
        ROW_DECODE(r);
        const int lo = isctx_ ? 0 : CTX, hi = isctx_ ? CTX : TB;
#pragma unroll
        for (int it = 0; it < 4; ++it) { const int idx = it * 512 + lane * 8;
            float acc[8];
            { const f32x4 b0 = *(const f32x4*)(a.lru_conv_b + idx), b1 = *(const f32x4*)(a.lru_conv_b + idx + 4);
              acc[0] = b0[0]; acc[1] = b0[1]; acc[2] = b0[2]; acc[3] = b0[3]; acc[4] = b1[0]; acc[5] = b1[1]; acc[6] = b1[2]; acc[7] = b1[3]; }
#pragma unroll
            for (int j = 0; j < 4; ++j) { const int pp = p_ + j - 2;
                if (pp >= lo && pp < hi) {
                    float f[8]; att::unpack8(*(const bf16x8*)(UP + (size_t)(r + j - 2) * DM + idx), f);
                    const f32x4 w0 = *(const f32x4*)(a.lru_conv_w + j * DM + idx), w1 = *(const f32x4*)(a.lru_conv_w + j * DM + idx + 4);
                    acc[0] += f[0] * w0[0]; acc[1] += f[1] * w0[1]; acc[2] += f[2] * w0[2]; acc[3] += f[3] * w0[3];
                    acc[4] += f[4] * w1[0]; acc[5] += f[5] * w1[1]; acc[6] += f[6] * w1[2]; acc[7] += f[7] * w1[3]; } }
            *(bf16x8*)(U + (size_t)r * DM + idx) = att::pack8(acc); }
    }
}
__device__ __forceinline__ void scan_step(f32x4& h, u32x2 la, u32x2 gu, f32x4* Pacc) {
    f32x4 av = {__builtin_amdgcn_exp2f(bf_lo(la.x)), __builtin_amdgcn_exp2f(bf_hi(la.x)), __builtin_amdgcn_exp2f(bf_lo(la.y)), __builtin_amdgcn_exp2f(bf_hi(la.y))};
    const f32x4 gv = {bf_lo(gu.x), bf_hi(gu.x), bf_lo(gu.y), bf_hi(gu.y)};
    f32x4 s; s[0] = sqrtf(fmaxf(1.0f - av[0] * av[0], 0.f)); s[1] = sqrtf(fmaxf(1.0f - av[1] * av[1], 0.f)); s[2] = sqrtf(fmaxf(1.0f - av[2] * av[2], 0.f)); s[3] = sqrtf(fmaxf(1.0f - av[3] * av[3], 0.f));
    h = av * h + s * gv; if (Pacc) *Pacc = *Pacc * av;
}
__device__ __forceinline__ void ph_scan1(CArgs& a, int vcu, int G) {
    const int tid_ = tid_opaque(), lane = tid_ & 63, gw = vcu * NWAVES + (tid_ >> 6), NGW = G * NWAVES; (void)lane;
    float* PS = (float*)(a.ws + WS_LPS);
    for (int item = gw; item < NB * NCH * 2 * 8; item += NGW) {
        const int cg = item & 7, dir = (item >> 3) & 1, bq = item >> 4, b = bq / NCH, q = bq % NCH;
        const bf16_t* A = (const bf16_t*)(a.ws + (dir ? WS_LAB : WS_LAF)); const bf16_t* GU = (const bf16_t*)(a.ws + (dir ? WS_LGUB : WS_LGUF));
        const size_t base = ((size_t)b * TB + q * 32) * DM + cg * 256 + lane * 4;
        f32x4 h = {0.f, 0.f, 0.f, 0.f}, P = {1.f, 1.f, 1.f, 1.f};
#pragma unroll 8
        for (int i = 0; i < 32; ++i) { const int rr = dir ? 31 - i : i;
            scan_step(h, *(const u32x2*)(A + base + (size_t)rr * DM), *(const u32x2*)(GU + base + (size_t)rr * DM), &P); }
        float* o = PS + ((size_t)(bq * 2 + dir) * 2) * DM + cg * 256 + lane * 4;
        *(f32x4*)o = P; *(f32x4*)(o + DM) = h;
    }
}
__device__ __forceinline__ void ph_scan2(CArgs& a, int vcu, int G) {
    const float* PS = (const float*)(a.ws + WS_LPS); float* CIN = (float*)(a.ws + WS_LCIN);
    for (int v = vcu; v < 32; v += G) {
        const int b = v >> 3, dir = (v >> 2) & 1, c = (v & 3) * 512 + (int)threadIdx.x;
        float carry = 0.f;
#pragma unroll 1
        for (int i0 = 0; i0 < NCH; i0 += 8) {
            float P[8], S[8];
#pragma unroll
            for (int k = 0; k < 8; ++k) { const int i = i0 + k, q = dir == 0 ? i : (i < 8 ? 7 - i : NCH - 1 - (i - 8)); const size_t bq = (size_t)b * NCH + q;
                P[k] = PS[((bq * 2 + dir) * 2) * DM + c]; S[k] = PS[((bq * 2 + dir) * 2 + 1) * DM + c]; }
#pragma unroll
            for (int k = 0; k < 8; ++k) { const int i = i0 + k, q = dir == 0 ? i : (i < 8 ? 7 - i : NCH - 1 - (i - 8)); const size_t bq = (size_t)b * NCH + q;
                CIN[(bq * 2 + dir) * DM + c] = carry; carry = P[k] * carry + S[k]; }
        }
    }
}
__device__ __forceinline__ void ph_scan3(CArgs& a, int vcu, int G) {
    const int tid_ = tid_opaque(), lane = tid_ & 63, gw = vcu * NWAVES + (tid_ >> 6), NGW = G * NWAVES; (void)lane;
    const float* CIN = (const float*)(a.ws + WS_LCIN); const bf16_t* GY = (const bf16_t*)(a.ws + WS_LGY); bf16_t* Gout = (bf16_t*)(a.ws + WS_LG);
    const bf16_t* AF = (const bf16_t*)(a.ws + WS_LAF); const bf16_t* GUF = (const bf16_t*)(a.ws + WS_LGUF); const bf16_t* AB = (const bf16_t*)(a.ws + WS_LAB); const bf16_t* GUB = (const bf16_t*)(a.ws + WS_LGUB);
    for (int item = gw; item < NB * NCH * 8; item += NGW) {
        const int cg = item & 7, bq = item >> 3, b = bq / NCH, q = bq % NCH;
        const size_t base = ((size_t)b * TB + q * 32) * DM + cg * 256 + lane * 4;
        f32x4 hf[32];
        f32x4 h = *(const f32x4*)(CIN + ((size_t)bq * 2 + 0) * DM + cg * 256 + lane * 4);
#pragma unroll
        for (int i = 0; i < 32; ++i) { scan_step(h, *(const u32x2*)(AF + base + (size_t)i * DM), *(const u32x2*)(GUF + base + (size_t)i * DM), nullptr); hf[i] = h;
            if ((i & 7) == 7) __builtin_amdgcn_sched_barrier(0); }
        h = *(const f32x4*)(CIN + ((size_t)bq * 2 + 1) * DM + cg * 256 + lane * 4);
#pragma unroll
        for (int i = 31; i >= 0; --i) {
            scan_step(h, *(const u32x2*)(AB + base + (size_t)i * DM), *(const u32x2*)(GUB + base + (size_t)i * DM), nullptr);
            const u32x2 gy = *(const u32x2*)(GY + base + (size_t)i * DM);
            const f32x4 o = (hf[i] + h) * (f32x4){bf_lo(gy.x), bf_hi(gy.x), bf_lo(gy.y), bf_hi(gy.y)};
            *(u32x2*)(Gout + base + (size_t)i * DM) = (u32x2){cvt_pk_bf16(o[0], o[1]), cvt_pk_bf16(o[2], o[3])};
            if ((i & 7) == 0) __builtin_amdgcn_sched_barrier(0); }
    }
}
__device__ __forceinline__ void st_bf16x8(bf16_t* p, f32x4 v0, f32x4 v1) {
    u32x4 w = {cvt_pk_bf16(v0[0], v0[1]), cvt_pk_bf16(v0[2], v0[3]), cvt_pk_bf16(v1[0], v1[1]), cvt_pk_bf16(v1[2], v1[3])}; *(u32x4*)p = w; }
struct FStoreF32 { float* O; int ld;
    __device__ __forceinline__ void begin(const pg8::Unit&, int) {}
    __device__ __forceinline__ void row8(int row, int, int col, f32x4 v0, f32x4 v1) { float* p = O + (size_t)row * ld + col; *(f32x4*)p = v0; *(f32x4*)(p + 4) = v1; } };
struct FOut { bf16_t* O; bf16_t* PART; bf16_t* dst; int rowadj;
    __device__ __forceinline__ void begin(const pg8::Unit& u, int) {
        if (u.slice >= 0) { dst = PART + (size_t)u.slice * (NB * CTX) * DM; rowadj = (u.pm / 17) * CTX - u.pm * 256; } else { dst = O; rowadj = 0; } }
    __device__ __forceinline__ void row8(int row, int, int col, f32x4 v0, f32x4 v1) { st_bf16x8(dst + (size_t)(row + rowadj) * DM + col, v0, v1); } };
struct FBf16 { bf16_t* O; int ld;
    __device__ __forceinline__ void begin(const pg8::Unit&, int) {}
    __device__ __forceinline__ void row8(int row, int, int col, f32x4 v0, f32x4 v1) { st_bf16x8(O + (size_t)row * ld + col, v0, v1); } };
struct FQkv { bf16_t *Q, *K, *V; bf16_t* base; int ld, coff;
    __device__ __forceinline__ void begin(const pg8::Unit& u, int) { if (u.pn < 8) { base = Q; ld = 2048; coff = 0; } else if (u.pn < 10) { base = K; ld = 512; coff = 2048; } else { base = V; ld = 512; coff = 2560; } }
    __device__ __forceinline__ void row8(int row, int, int col, f32x4 v0, f32x4 v1) { st_bf16x8(base + (size_t)row * ld + (col - coff), v0, v1); } };
struct FRelu2 { bf16_t* O;
    __device__ __forceinline__ void begin(const pg8::Unit&, int) {}
    __device__ __forceinline__ void row8(int row, int, int col, f32x4 v0, f32x4 v1) {
#pragma unroll
        for (int i = 0; i < 4; ++i) { const float a = fmaxf(v0[i], 0.f), b = fmaxf(v1[i], 0.f); v0[i] = a * a; v1[i] = b * b; }
        st_bf16x8(O + (size_t)row * DFF + col, v0, v1); } };
__device__ __forceinline__ float gelu_tanh(float x) { const float z = 1.5957691216057308f * (x + 0.044715f * x * x * x); return x * __builtin_amdgcn_rcpf(1.0f + __builtin_amdgcn_exp2f(-1.4426950408889634f * z)); }
struct FLruXY { bf16_t *UP, *GY; bool gy;
    __device__ __forceinline__ void begin(const pg8::Unit& u, int) { gy = u.pn >= 8; }
    __device__ __forceinline__ void row8(int row, int, int col, f32x4 v0, f32x4 v1) {
        if (gy) {
#pragma unroll
            for (int i = 0; i < 4; ++i) { v0[i] = gelu_tanh(v0[i]); v1[i] = gelu_tanh(v1[i]); }
            st_bf16x8(GY + (size_t)row * DM + (col - 2048), v0, v1);
        } else st_bf16x8(UP + (size_t)row * DM + col, v0, v1); } };
struct EpiGates {
    static constexpr bool PERM = true;
    bf16_t* OUT4; const bf16_t* U; const float *ra_b, *ix_b, *lam;
    __device__ __forceinline__ void operator()(const f32x4 (&acc)[2][2][4][2], const pg8::Unit& u, int wr, int wc, int fr, int fq) const {
        const int which = u.pn >> 3, dir = which >> 1, ty = which & 1, ch0 = (u.pn & 7) * 256 + wc * 32 + 8 * fq, row0 = u.pm * 256 + wr * 64 + fr;
        bf16_t* dst = OUT4 + (size_t)which * ((size_t)R * DM);
        const float* bp = (ty == 0 ? ra_b : ix_b) + dir * DM;
#pragma unroll
        for (int bj = 0; bj < 2; ++bj) {
            const int ch = ch0 + bj * 128;
            const f32x4 b0 = *(const f32x4*)(bp + ch), b1 = *(const f32x4*)(bp + ch + 4);
            f32x4 l0 = {0.f, 0.f, 0.f, 0.f}, l1 = {0.f, 0.f, 0.f, 0.f};
            if (ty == 0) { l0 = *(const f32x4*)(lam + dir * DM + ch) * 1.4426950408889634f; l1 = *(const f32x4*)(lam + dir * DM + ch + 4) * 1.4426950408889634f; }
#pragma unroll
            for (int ai = 0; ai < 2; ++ai)
#pragma unroll
                for (int m = 0; m < 4; ++m) {
                    const int row = row0 + ai * 128 + m * 16;
                    const f32x4 x0 = acc[ai][bj][m][0] + b0, x1 = acc[ai][bj][m][1] + b1; f32x4 o0, o1;
                    if (ty == 0) {
#pragma unroll
                        for (int j = 0; j < 4; ++j) { o0[j] = l0[j] * sigmoidf_(x0[j]); o1[j] = l1[j] * sigmoidf_(x1[j]); }
                    } else {
                        const u32x4 uw = *(const u32x4*)(U + (size_t)row * DM + ch);
                        o0[0] = sigmoidf_(x0[0]) * bf_lo(uw.x); o0[1] = sigmoidf_(x0[1]) * bf_hi(uw.x); o0[2] = sigmoidf_(x0[2]) * bf_lo(uw.y); o0[3] = sigmoidf_(x0[3]) * bf_hi(uw.y);
                        o1[0] = sigmoidf_(x1[0]) * bf_lo(uw.z); o1[1] = sigmoidf_(x1[1]) * bf_hi(uw.z); o1[2] = sigmoidf_(x1[2]) * bf_lo(uw.w); o1[3] = sigmoidf_(x1[3]) * bf_hi(uw.w);
                    }
                    st_bf16x8(dst + (size_t)row * DM + ch, o0, o1);
                    __builtin_amdgcn_sched_barrier(0);
                }
        }
    } };
struct FKvb { bf16_t *K, *V;
    __device__ __forceinline__ void begin(const pg8::Unit&, int) {}
    __device__ __forceinline__ void row8(int row, int, int col, f32x4 v0, f32x4 v1) {
        bf16_t* p = col < 2048 ? K + (size_t)row * 3072 + (col >> 7) * 192 + (col & 127) : V + (size_t)row * DM + (col - 2048);
        st_bf16x8(p, v0, v1); } };

template <class F>
__device__ __forceinline__ void run_gemm(LAS unsigned char* lds, const bf16_t* A, int lda, const bf16_t* Bt, int ldb, int N, int K, int a_blk, F f, int G, int rot = 0) {
    pg8::Gemm g{A, Bt, R, N, K, lda, ldb, a_blk}; pg8::StaticOrder S; S.init(R, N, K, G, ((int)blockIdx.x + rot) % G);
    pg8::EpiRow8<F> E{f};
    PROBE_REPEAT_GEMM
    pg8::gemm_phase<pg8::EpiRow8<F>, pg8::StaticOrder, true, true>(lds, g, S, E);
}

__device__ __forceinline__ void run_gemm_out(LAS unsigned char* lds, const bf16_t* A, int lda, const bf16_t* Bt, int K, int SK, bf16_t* OUTF, bf16_t* PART, int G) {
    pg8::Gemm g{A, Bt, R, DM, K, lda, K, 0}; pg8::LatOrder S; S.init(DM, K, G, (int)blockIdx.x, SK, K == DFF ? 1 : 0);
    pg8::EpiRow8<FOut> E{FOut{OUTF, PART, nullptr, 0}};
    PROBE_REPEAT_GEMM
    pg8::gemm_phase<pg8::EpiRow8<FOut>, pg8::LatOrder, true, true>(lds, g, S, E);
}
template <class F>
__device__ __forceinline__ void run_gemm_lat(LAS unsigned char* lds, const bf16_t* A, int lda, const bf16_t* Bt, int ldb, int N, int K, F f, int G) {
    pg8::Gemm g{A, Bt, R, N, K, lda, ldb, 0}; pg8::LatOrder S; S.init(N, K, G, (int)blockIdx.x, 0);
    pg8::EpiRow8<F> E{f};
    PROBE_REPEAT_GEMM
    pg8::gemm_phase<pg8::EpiRow8<F>, pg8::LatOrder, true, true>(lds, g, S, E);
}

__device__ __forceinline__ void ph_attn_gqa(CArgs& a, char* lds, const float* qg, const float* kg, bool ctx_units, int vcu, int G) {
    const bf16_t* Q = (const bf16_t*)(a.ws + WS_GQ); const bf16_t* K = (const bf16_t*)(a.ws + WS_GK); const bf16_t* V = (const bf16_t*)(a.ws + WS_GV); bf16_t* O = (bf16_t*)(a.ws + WS_GO);
    const f32x2* tab = (const f32x2*)(a.ws + WS_TAB);
    const int nun = ctx_units ? 1088 : 1024;
    bool fast;
    { const int lane = tid_opaque() & 63; float gq = fmaxf(fabsf(qg[lane]), fabsf(qg[lane + 64])), gk = fmaxf(fabsf(kg[lane]), fabsf(kg[lane + 64]));
#pragma unroll
      for (int o = 1; o < 64; o <<= 1) { gq = fmaxf(gq, __shfl_xor(gq, o)); gk = fmaxf(gk, __shfl_xor(gk, o)); }
      fast = __builtin_amdgcn_readfirstlane((16.3224f * gq * gk <= 40.0f) ? 1 : 0) != 0; }
#define GQA_UNITS(NM) \
    for (int id = vcu; id < nun; id += G) { \
        int b, h, row0, seq, tok0; bool rope; \
        if (id < 1024) { const int bk = id >> 6; b = bk >> 2; h = (bk & 3) * 4 + ((id & 63) >> 4); const int qb = id & 15; row0 = b * TB + CTX + qb * 256; seq = TB; tok0 = qb * 256; rope = true; } \
        else { const int j = id - 1024; b = j >> 4; h = j & 15; row0 = b * TB; seq = CTX; tok0 = 0; rope = false; } \
        const int kvh = h >> 2; \
        att::attn_body_dma<128, 2048, 512, 512, 2048, NM>(Q + (size_t)row0 * 2048 + h * 128, K + (size_t)b * TB * 512 + kvh * 128, V + (size_t)b * TB * 512 + kvh * 128, \
                                                  O + (size_t)row0 * 2048 + h * 128, seq, lds, qg, tab, rope, tok0); }
    PROBE_REPEAT_ATTN
    { if (fast) { GQA_UNITS(true) } else { GQA_UNITS(false) } }
#undef GQA_UNITS
}
__device__ __forceinline__ void ph_attn_mla(CArgs& a, char* lds, bool ctx_units, int vcu, int G) {
    const bf16_t* Q = (const bf16_t*)(a.ws + WS_MQ); const bf16_t* K = (const bf16_t*)(a.ws + WS_MK); const bf16_t* V = (const bf16_t*)(a.ws + WS_MV); bf16_t* O = (bf16_t*)(a.ws + WS_MO);
    const f32x2* tab = (const f32x2*)(a.ws + WS_TAB + 16384);
    const int nun = ctx_units ? 1088 : 1024;
    PROBE_REPEAT_ATTN
    for (int id = vcu; id < nun; id += G) {
        int b, h, row0, seq, tok0; bool rope;
        if (id < 1024) { const int bh = id >> 4; b = bh >> 4; h = bh & 15; const int qb = id & 15; row0 = b * TB + CTX + qb * 256; seq = TB; tok0 = qb * 256; rope = true; }
        else { const int j = id - 1024; b = j >> 4; h = j & 15; row0 = b * TB; seq = CTX; tok0 = 0; rope = false; }
        att::attn_body_dma<192, 3072, 3072, 2048, 2048>(Q + (size_t)row0 * 3072 + h * 192, K + (size_t)b * TB * 3072 + h * 192, V + (size_t)b * TB * DM + h * 128,
                                                    O + (size_t)row0 * DM + h * 128, seq, lds, nullptr, tab, rope, tok0);
    }
}

constexpr int NPHASES = 38;
__global__ void __launch_bounds__(NWAVES * 64, 2) trunk_fwd(Args a_unused) {
#define a (*kargs())
    extern __shared__ __attribute__((aligned(16))) unsigned char lds_raw[];
    LAS unsigned char* lds = (LAS unsigned char*)lds_raw;
    const int tid = threadIdx.x;
    const int G = gridDim.x; const int bx = blockIdx.x; const int vcu = (G % 8 == 0) ? (bx % 8) * (G / 8) + bx / 8 : bx;
#define ws (a.ws)
    for (int u = tid; u < (LDS_BYTES - LDSCTL_OFF) / 4; u += NWAVES * 64) ((LAS unsigned*)(lds + LDSCTL_OFF))[u] = 0u;
    __syncthreads();
    if (a.ph_hi - a.ph_lo > 1) (void)xcd_barrier_post((unsigned*)(ws + WS_CTL) + 1024, (volatile LAS unsigned*)(lds + LDSCTL_OFF + 64));
    int ph = 0;
#ifndef PH_FILTER
#define PH_FILTER(p) true
#endif
#ifdef PROBE_STAMP_A
    unsigned long long st_prev = __builtin_amdgcn_s_memrealtime(), st_a = 0, st_b = 0; int st_cls = 0;
#define ST_CLS(c) st_cls = (c);
#define ST_ACC { const unsigned long long now_ = __builtin_amdgcn_s_memrealtime(); if (st_cls == PROBE_STAMP_A) st_a += now_ - st_prev; if (st_cls == PROBE_STAMP_B) st_b += now_ - st_prev; st_prev = now_; }
#else
#define ST_CLS(c)
#define ST_ACC
#endif
#define PH_BEGIN if (PH_FILTER(ph) && ph >= a.ph_lo && ph < a.ph_hi) {
#define MKBAR() XcdBarrier{(unsigned*)(ws + WS_CTL) + 1024, xb_xcc_id(), (volatile LAS unsigned*)(lds + LDSCTL_OFF + 64)}
#define PH_END   if (ph + 1 < a.ph_hi) xcd_barrier(MKBAR()); ST_ACC } ++ph;

    ST_CLS(0) PH_BEGIN ph_mods(a, lds, vcu, G); __syncthreads(); ph_transposes(a, lds, vcu, G); PH_END
    ST_CLS(1) PH_BEGIN ph_init(a, vcu, G); PH_END

#define Hb ((bf16_t*)(ws + WS_H))
#define OUTF ((bf16_t*)(ws + WS_OUTF))
#define ACT ((bf16_t*)(ws + WS_ACT))

#define PARTB ((bf16_t*)(ws + WS_PART))
#define MLP_PHASES(L) \
    ST_CLS(4) PH_BEGIN ph_ln<false, 1>(a, lds, L, 0, vcu, G); PH_END \
    ST_CLS(5) PH_BEGIN run_gemm(lds, Hb, DM, (const bf16_t*)(ws + WS_W1T) + (size_t)(L) * DFF * DM, DM, DFF, DM, 0, FRelu2{ACT}, G); PH_END \
    ST_CLS(6) PH_BEGIN run_gemm_out(lds, ACT, DFF, (const bf16_t*)(ws + WS_W2T) + (size_t)(L) * DM * DFF, DFF, 8, OUTF, PARTB, G); PH_END \
    ST_CLS(4) PH_BEGIN ph_ln<false, 1>(a, lds, L, 1, vcu, G); PH_END
#define MLP_PHASES_LAST(L) \
    ST_CLS(4) PH_BEGIN ph_ln<false, 2>(a, lds, L, 0, vcu, G); PH_END \
    ST_CLS(5) PH_BEGIN run_gemm_lat(lds, Hb, DM, (const bf16_t*)(ws + WS_W1T) + (size_t)(L) * DFF * DM, DM, DFF, DM, FRelu2{ACT}, G); PH_END \
    ST_CLS(6) PH_BEGIN run_gemm_out(lds, ACT, DFF, (const bf16_t*)(ws + WS_W2T) + (size_t)(L) * DM * DFF, DFF, 0, OUTF, PARTB, G); PH_END \
    ST_CLS(4) PH_BEGIN ph_ln<true, 2>(a, lds, L, 1, vcu, G); PH_END

#define GQA_LAYER(L, SLOT, LASTL) \
    ST_CLS(2) PH_BEGIN run_gemm(lds, Hb, DM, (const bf16_t*)(ws + WS_GQAW + (SLOT) * 20 * MiB), DM, 3072, DM, 0, FQkv{(bf16_t*)(ws + WS_GQ), (bf16_t*)(ws + WS_GK), (bf16_t*)(ws + WS_GV), nullptr, 0, 0}, G); PH_END \
    ST_CLS(1) PH_BEGIN ph_knorm(a, a.gqa_k_g + (SLOT) * 128, vcu, G); PH_END \
    ST_CLS(3) PH_BEGIN ph_attn_gqa(a, (char*)lds_raw, a.gqa_q_g + (SLOT) * 128, a.gqa_k_g + (SLOT) * 128, !(LASTL), vcu, G); PH_END \
    ST_CLS(2) PH_BEGIN run_gemm_out(lds, (const bf16_t*)(ws + WS_GO), DM, (const bf16_t*)(ws + WS_GQAW + (SLOT) * 20 * MiB + 12 * MiB), DM, (LASTL) ? 0 : 8, OUTF, PARTB, G); PH_END

    GQA_LAYER(0, 0, false)
    MLP_PHASES(0)
    ST_CLS(2) PH_BEGIN run_gemm(lds, Hb, DM, (const bf16_t*)(ws + WS_LRUW), DM, 4096, DM, 0, FLruXY{(bf16_t*)(ws + WS_LUP), (bf16_t*)(ws + WS_LGY), false}, G); PH_END
    ST_CLS(1) PH_BEGIN ph_conv(a, vcu, G); PH_END
    ST_CLS(2) PH_BEGIN { EpiGates eg{(bf16_t*)(ws + WS_LAF), (const bf16_t*)(ws + WS_LU), a.lru_ra_b, a.lru_ix_b, (const float*)(ws + WS_TAB + 32768)};
               pg8::Gemm g{(const bf16_t*)(ws + WS_LU), (const bf16_t*)(ws + WS_LRUW + 16 * MiB), R, 8192, 256, DM, 256, 1}; pg8::StaticOrder S; S.init(R, 8192, 256, G, (int)blockIdx.x);
               PROBE_REPEAT_GEMM
               pg8::gemm_phase<EpiGates, pg8::StaticOrder, true, true>(lds, g, S, eg); } PH_END
    ST_CLS(7) PH_BEGIN ph_scan1(a, vcu, G); PH_END
    PH_BEGIN ph_scan2(a, vcu, G); PH_END
    PH_BEGIN ph_scan3(a, vcu, G); PH_END
    ST_CLS(2) PH_BEGIN run_gemm_out(lds, (const bf16_t*)(ws + WS_LG), DM, (const bf16_t*)(ws + WS_LRUW + 20 * MiB), DM, 8, OUTF, PARTB, G); PH_END
    MLP_PHASES(1)
    ST_CLS(2) PH_BEGIN run_gemm(lds, Hb, DM, (const bf16_t*)(ws + WS_MLAW), DM, 1280, DM, 0, FStoreF32{(float*)(ws + WS_MAP), 1280}, G); PH_END
    ST_CLS(1) PH_BEGIN ph_mla_norm(a, vcu, G); PH_END
    ST_CLS(2) PH_BEGIN run_gemm(lds, (const bf16_t*)(ws + WS_MQAN), 512, (const bf16_t*)(ws + WS_MLAW + 5 * MiB), 512, 3072, 512, 0, FBf16{(bf16_t*)(ws + WS_MQ), 3072}, G);
             run_gemm(lds, (const bf16_t*)(ws + WS_MCKVN), 512, (const bf16_t*)(ws + WS_MLAW + 8 * MiB), 512, 4096, 512, 0, FKvb{(bf16_t*)(ws + WS_MK), (bf16_t*)(ws + WS_MV)}, G, G / 2); PH_END
    ST_CLS(3) PH_BEGIN ph_attn_mla(a, (char*)lds_raw, true, vcu, G); PH_END
    ST_CLS(2) PH_BEGIN run_gemm_out(lds, (const bf16_t*)(ws + WS_MO), DM, (const bf16_t*)(ws + WS_MLAW + 12 * MiB), DM, 8, OUTF, PARTB, G); PH_END
    MLP_PHASES(2)
    GQA_LAYER(3, 1, true)
    MLP_PHASES_LAST(3)
#ifdef PROBE_STAMP_A
    xcd_barrier(MKBAR());
    if (blockIdx.x == 0) {
        LAS float* sh = (LAS float*)(lds + LDSCTL_OFF + 256);
        if (tid == 0) { float va = (float)st_a * 0.01f, vb = (float)st_b * 0.01f;
            { float pw = 1.f; while (pw * 100.f <= va) pw *= 10.f; va = rintf(va / pw) * pw; }
            { float pw = 1.f; while (pw * 100.f <= vb) pw *= 10.f; vb = rintf(vb / pw) * pw; }
            sh[0] = va; sh[1] = vb; }
        __syncthreads();
        const float ta = sh[0], tb = sh[1];
        for (int i = 1 + tid; i <= (1 << 20); i += 512) a.out[i] = tb;
        if (tid == 0) a.out[0] = ta;
    }
#endif
#undef PH_BEGIN
#undef PH_END
#undef ws
#undef a
#undef Hb
#undef OUTF
#undef ACT
#undef PARTB
}

#ifndef MK_SPLIT
#define MK_SPLIT 0
#endif
extern "C" void kernel_launch(void* const* d_in, const int* in_sizes, int n_in, void* d_out, int out_size, void* d_ws, size_t ws_size, hipStream_t stream) {
    static int grid = 0;
    if (grid == 0) {
        if (n_in != 33 || in_sizes[0] != NB * SEQ * DM || out_size != NB * SEQ * DM || ws_size < WS_END) {
            fprintf(stderr, "kernel_launch: unexpected shapes: n_in %d in0 %d out %d ws %zu (need %zu)\n", n_in, n_in > 0 ? in_sizes[0] : -1, out_size, ws_size, (size_t)WS_END); grid = -1; return; }
        int dev = 0, cus = 0;
        if (hipGetDevice(&dev) != hipSuccess || hipDeviceGetAttribute(&cus, hipDeviceAttributeMultiprocessorCount, dev) != hipSuccess) { grid = -1; return; }
        if (hipFuncSetAttribute((const void*)trunk_fwd, hipFuncAttributeMaxDynamicSharedMemorySize, LDS_BYTES) != hipSuccess) { fprintf(stderr, "kernel_launch: hipFuncSetAttribute failed\n"); grid = -1; return; }
        int per_cu = 0;
        if (hipOccupancyMaxActiveBlocksPerMultiprocessor(&per_cu, (const void*)trunk_fwd, NWAVES * 64, LDS_BYTES) != hipSuccess || per_cu < 1)
            fprintf(stderr, "kernel_launch: occupancy query reports %d workgroups per CU\n", per_cu);
        (void)hipGetLastError();
        grid = cus;
    }
    if (grid < 0) return;
    if (hipMemsetAsync((char*)d_ws + WS_CTL, 0, CTL_ZERO_BYTES, stream) != hipSuccess) return;
    Args a{};
    const float** p = (const float**)&a;
    for (int i = 0; i < 33; ++i) p[i] = (const float*)d_in[i];
    a.out = (float*)d_out; a.ws = (unsigned char*)d_ws;
#ifdef PROBE_PREFIX
    a.ph_lo = 0; a.ph_hi = PROBE_PREFIX; hipLaunchKernelGGL(trunk_fwd, dim3(grid), dim3(NWAVES * 64), LDS_BYTES, stream, a);
    (void)hipMemsetAsync((char*)d_ws + WS_CTL, 0, CTL_ZERO_BYTES, stream);
    a.ph_lo = 0; a.ph_hi = NPHASES; hipLaunchKernelGGL(trunk_fwd, dim3(grid), dim3(NWAVES * 64), LDS_BYTES, stream, a);
#elif MK_SPLIT
    for (int k = 0; k < NPHASES; ++k) { a.ph_lo = k; a.ph_hi = k + 1; hipLaunchKernelGGL(trunk_fwd, dim3(grid), dim3(NWAVES * 64), LDS_BYTES, stream, a); }
#else
    a.ph_lo = 0; a.ph_hi = NPHASES; hipLaunchKernelGGL(trunk_fwd, dim3(grid), dim3(NWAVES * 64), LDS_BYTES, stream, a);
#endif
    const hipError_t le = hipPeekAtLastError();
    if (le != hipSuccess) fprintf(stderr, "kernel_launch: launch failed: %s\n", hipGetErrorName(le));
}
```

```cpp
#include <hip/hip_runtime.h>
#include <cstdio>
#include <cstdint>
#include <cmath>

#define LAS __attribute__((address_space(3)))
#define GAS __attribute__((address_space(1)))
typedef unsigned short bf16_t;
typedef short bf16x8 __attribute__((ext_vector_type(8)));
typedef short s16x4 __attribute__((ext_vector_type(4)));
typedef float f32x4 __attribute__((ext_vector_type(4)));
typedef float f32x2 __attribute__((ext_vector_type(2)));
typedef float f32x16 __attribute__((ext_vector_type(16)));
typedef unsigned u32x4 __attribute__((ext_vector_type(4)));
typedef unsigned u32x2 __attribute__((ext_vector_type(2)));

__device__ __forceinline__ unsigned cvt_pk_bf16(float lo, float hi) { unsigned r; asm volatile("v_cvt_pk_bf16_f32 %0, %1, %2" : "=v"(r) : "v"(lo), "v"(hi)); return r; }
__device__ __forceinline__ float bf_lo(unsigned w) { return __uint_as_float(w << 16); }
__device__ __forceinline__ float bf_hi(unsigned w) { return __uint_as_float(w & 0xffff0000u); }
__device__ __forceinline__ float bf2f(bf16_t h) { return __uint_as_float(((unsigned)h) << 16); }
__device__ __forceinline__ bf16_t f2bf(float f) { return (bf16_t)(cvt_pk_bf16(f, f) & 0xffffu); }

constexpr int DM = 2048, NB = 4, SEQ = 4096, CTX = 256, TB = SEQ + CTX  , R = NB * TB  , DFF = 8192, DEPTH = 4;
constexpr float LN_EPS = 1e-6f;
constexpr float DN_ALPHA = 1.6817928305074290861f;

namespace pg8 {
constexpr int BM = 256, BK = 64, HALF = 128, HTB = HALF * BK * 2, STAGE_BYTES = 8 * HTB, NXCD = 8, WGM = 4;
__host__ __device__ __forceinline__ int lds_byte(int r, int c) { const int st = (r >> 4) * 2 + (c >> 5), rr = r & 15, cc = c & 31, ob = rr * 64 + cc * 2; return st * 1024 + (ob ^ (((ob >> 9) & 1) << 5)); }
__host__ __device__ __forceinline__ void stage_rc(int b, int& Rr, int& C) { const int st = b / 1024, sb = b % 1024, swz = sb ^ (((sb >> 9) & 1) << 5); Rr = (st >> 1) * 16 + swz / 64; C = (st & 1) * 32 + (swz % 64) / 2; }
__host__ __device__ __forceinline__ int perm32(int rho) { const int n = rho >> 4, i = rho & 15; return 8 * (i >> 2) + 4 * n + (i & 3); }

struct Unit { int pm, pn, k0, nk, slice; };
struct Gemm { const bf16_t* A; const bf16_t* Bt; int M, N, K, lda, ldb, a_blk; };

struct StaticOrder {
    int nM, nN, nwg, G, c, nt;
    __device__ __forceinline__ void init(int M, int N, int K, int G_, int c_) { nM = M / BM; nN = N / BM; nwg = nM * nN; G = G_; c = c_; nt = K / BK; }
    __device__ __forceinline__ Unit next(int i) const {
        const long L = (long)i * G + c; if (L >= nwg) return Unit{-1, 0, 0, 0, -1};
        int wgid = (int)L; { const int q = nwg / NXCD, r = nwg % NXCD, xcd = wgid % NXCD, off = wgid / NXCD; wgid = (xcd < r ? xcd * (q + 1) : r * (q + 1) + (xcd - r) * q) + off; }
        const int nig = WGM * nN, gid = wgid / nig, fm = gid * WGM, gsz = (nM - fm) < WGM ? (nM - fm) : WGM;
        return Unit{fm + ((wgid % nig) % gsz), (wgid % nig) / gsz, 0, nt, -1};
    }
};
struct LatOrder {
    int nN, nwg, G, c, nt, SK, rev;
    __device__ __forceinline__ void init(int N, int K, int G_, int c_, int SK_, int rev_ = 0) { nN = N / BM; nwg = 64 * nN; G = G_; c = c_; nt = K / BK; SK = SK_; rev = rev_; }
    __device__ __forceinline__ Unit next(int i) const {
        const int nlat = c < nwg ? (nwg - c + G - 1) / G : 0;
        if (i < nlat) {
            int wgid = i * G + c; { const int q = nwg / NXCD, r = nwg % NXCD, xcd = wgid % NXCD, off = wgid / NXCD; wgid = (xcd < r ? xcd * (q + 1) : r * (q + 1) + (xcd - r) * q) + off; }
            const int nig = WGM * nN, gid = wgid / nig, fm = gid * WGM;
            int lp = fm + ((wgid % nig) % WGM); if (rev) lp = 63 - lp;
            return Unit{(lp >> 4) * 17 + 1 + (lp & 15), (wgid % nig) / WGM, 0, nt, -1};
        }
        if (SK > 0 && i >= nlat) { const int su = c + (i - nlat) * G;
            if (su < 4 * nN * SK) { const int t = su / SK, sl = su % SK, nks = nt / SK; return Unit{17 * (t / nN), t % nN, sl * nks, nks, sl}; } }
        return Unit{-1, 0, 0, 0, -1};
    }
};

template <class F> struct EpiRow8 {
    static constexpr bool PERM = true;
    F f;
    __device__ __forceinline__ void operator()(const f32x4 (&acc)[2][2][4][2], const Unit& u, int wr, int wc, int fr, int fq) {
        const int row0 = u.pm * BM + wr * 64 + fr, colb = u.pn * BM + wc * 32 + 8 * fq;
        f.begin(u, colb);
#pragma unroll
        for (int ai = 0; ai < 2; ++ai)
#pragma unroll
            for (int m = 0; m < 4; ++m) {
                const int row = row0 + ai * HALF + m * 16;
#pragma unroll
                for (int bj = 0; bj < 2; ++bj) f.row8(row, bj, colb + bj * HALF, acc[ai][bj][m][0], acc[ai][bj][m][1]);
            }
    }
};

template <class Epi, class Sched, bool ALIGN_EPI = true, bool SP2 = true>
__device__ __forceinline__ void gemm_phase(LAS unsigned char* lds, const Gemm g, const Sched& S, Epi& E) {
    int tid = threadIdx.x; asm volatile("" : "+v"(tid));
    const int wid = __builtin_amdgcn_readfirstlane(tid >> 6), lane = tid & 63, wr = wid >> 2, wc = wid & 3, fr = lane & 15, fq = lane >> 4;
    unsigned voffA[2], voffB[2];
#pragma unroll
    for (int i = 0; i < 2; ++i) { int Rr, C; stage_rc(tid * 16 + i * 8192, Rr, C); const int Rb = Epi::PERM ? ((Rr & ~31) + perm32(Rr & 31)) : Rr;
        voffA[i] = (unsigned)(Rr * g.lda + C) * 2u; voffB[i] = (unsigned)(Rb * g.ldb + C) * 2u; }
    const size_t kstep = (size_t)(BK * 2);
    const size_t hstepA = (size_t)HALF * g.lda * 2, hstepB = (size_t)HALF * g.ldb * 2;
    const size_t tstepA = 2 * hstepA, tstepB = 2 * hstepB;
    const unsigned ldsw = (unsigned)wid * 1024u;
    const int aoff = lds_byte(wr * 64 + fr, fq * 8), boff = lds_byte(wc * 32 + fr, fq * 8);
#define PG8_SA(b, h) (((b) * 2 + (h)) * HTB)
#define PG8_SB(b, h) ((4 + (b) * 2 + (h)) * HTB)
#define PG8_STAGE(bufoff, gbase, voff) do { _Pragma("unroll") for (int _i = 0; _i < 2; ++_i) \
        __builtin_amdgcn_global_load_lds((const unsigned*)((const char*)(gbase) + (voff)[_i]), (LAS unsigned*)(lds + (bufoff) + ldsw + _i * 8192), 16, 0, 0); } while (0)
#define PG8_LDA(dst, b, h) do { _Pragma("unroll") for (int m = 0; m < 4; ++m) _Pragma("unroll") for (int k = 0; k < 2; ++k) dst[m][k] = *(const LAS bf16x8*)(lds + PG8_SA(b, h) + aoff + m * 2048 + k * 1024); } while (0)
#define PG8_LDB(dst, b, h) do { _Pragma("unroll") for (int n = 0; n < 2; ++n) _Pragma("unroll") for (int k = 0; k < 2; ++k) dst[n][k] = *(const LAS bf16x8*)(lds + PG8_SB(b, h) + boff + n * 2048 + k * 1024); } while (0)
#define PG8_MMA(ai, bj, At, Bt) do { __builtin_amdgcn_s_setprio(1); _Pragma("unroll") for (int m = 0; m < 4; ++m) _Pragma("unroll") for (int n = 0; n < 2; ++n) _Pragma("unroll") for (int k = 0; k < 2; ++k) \
        acc[ai][bj][m][n] = __builtin_amdgcn_mfma_f32_16x16x32_bf16(Bt[n][k], At[m][k], acc[ai][bj][m][n], 0, 0, 0); __builtin_amdgcn_s_setprio(0); } while (0)
#define PG8_WAIT_V(n) asm volatile("s_waitcnt vmcnt(" #n ")" ::: "memory")
#define PG8_WAIT_L(n) asm volatile("s_waitcnt lgkmcnt(" #n ")" ::: "memory")
#define PG8_BAR __builtin_amdgcn_s_barrier()
#define PG8_SCHED __builtin_amdgcn_sched_barrier(0)
    Unit cur = S.next(0), nxt = cur; int ui = 0;
    if (cur.pm < 0) return;
    f32x4 acc[2][2][4][2];
#pragma unroll
    for (int a = 0; a < 2; ++a)
#pragma unroll
        for (int b = 0; b < 2; ++b)
#pragma unroll
            for (int m = 0; m < 4; ++m)
#pragma unroll
                for (int n = 0; n < 2; ++n) acc[a][b][m][n] = (f32x4){0.f, 0.f, 0.f, 0.f};
    bf16x8 At[4][2], B0[2][2], B1[2][2];
    const char* cA = (const char*)g.A + (size_t)cur.pm * tstepA + (size_t)(g.a_blk ? (cur.pn & 7) * 512 : 0) + (size_t)cur.k0 * kstep; const char* cB = (const char*)g.Bt + (size_t)cur.pn * tstepB + (size_t)cur.k0 * kstep;
    if constexpr (SP2) {
        PG8_STAGE(PG8_SB(0, 0), cB, voffB); PG8_STAGE(PG8_SB(0, 1), cB + hstepB, voffB); PG8_STAGE(PG8_SA(0, 0), cA, voffA); PG8_STAGE(PG8_SA(0, 1), cA + hstepA, voffA);
        if (wr == 1) PG8_BAR;
        PG8_WAIT_V(2); PG8_BAR;
        PG8_STAGE(PG8_SB(1, 0), cB + kstep, voffB); PG8_STAGE(PG8_SA(1, 0), cA + kstep, voffA); PG8_STAGE(PG8_SB(1, 1), cB + hstepB + kstep, voffB);
        PG8_WAIT_V(6); PG8_BAR;
    } else {
        PG8_STAGE(PG8_SB(0, 0), cB, voffB); PG8_STAGE(PG8_SA(0, 0), cA, voffA); PG8_STAGE(PG8_SB(0, 1), cB + hstepB, voffB); PG8_STAGE(PG8_SA(0, 1), cA + hstepA, voffA);
        if (wr == 1) PG8_BAR;
        PG8_WAIT_V(4); PG8_BAR;
        PG8_STAGE(PG8_SB(1, 0), cB + kstep, voffB); PG8_STAGE(PG8_SA(1, 0), cA + kstep, voffA); PG8_STAGE(PG8_SB(1, 1), cB + hstepB + kstep, voffB);
        PG8_WAIT_V(6); PG8_BAR;
    }
    for (;;) {
        nxt = S.next(ui + 1); const bool has_next = nxt.pm >= 0;
        const char* nA = has_next ? (const char*)g.A + (size_t)nxt.pm * tstepA + (size_t)(g.a_blk ? (nxt.pn & 7) * 512 : 0) + (size_t)nxt.k0 * kstep : cA; const char* nB = has_next ? (const char*)g.Bt + (size_t)nxt.pn * tstepB + (size_t)nxt.k0 * kstep : cB;
        const int nt = cur.nk;
#pragma unroll 1
        for (int t = 0; t < nt; t += 2) {
            const bool last = (t == nt - 2);
            const char* a1 = cA + (size_t)(t + 1) * kstep;
            const char* a2 = last ? nA : cA + (size_t)(t + 2) * kstep; const char* b2 = last ? nB : cB + (size_t)(t + 2) * kstep;
            const char* a3 = a2 + kstep; const char* b3 = b2 + kstep;
            if constexpr (SP2) {
            PG8_LDB(B0, 0, 0); PG8_LDB(B1, 0, 1); PG8_SCHED; PG8_LDA(At, 0, 0); PG8_STAGE(PG8_SA(1, 1), a1 + hstepA, voffA);
            PG8_WAIT_V(8); PG8_WAIT_L(0); PG8_BAR; PG8_MMA(0, 0, At, B0); PG8_MMA(0, 1, At, B1); PG8_BAR; PG8_SCHED;
            PG8_LDA(At, 0, 1); PG8_STAGE(PG8_SB(0, 0), b2, voffB); PG8_STAGE(PG8_SB(0, 1), b2 + hstepB, voffB); PG8_STAGE(PG8_SA(0, 0), a2, voffA);
            PG8_WAIT_V(8); PG8_WAIT_L(0); PG8_BAR; PG8_MMA(1, 0, At, B0); PG8_MMA(1, 1, At, B1); PG8_BAR; PG8_SCHED;
            PG8_LDB(B0, 1, 0); PG8_LDB(B1, 1, 1); PG8_SCHED; PG8_LDA(At, 1, 0); PG8_STAGE(PG8_SA(0, 1), a2 + hstepA, voffA);
            PG8_WAIT_V(8); PG8_WAIT_L(0); PG8_BAR; PG8_MMA(0, 0, At, B0); PG8_MMA(0, 1, At, B1); PG8_BAR; PG8_SCHED;
            PG8_LDA(At, 1, 1); PG8_STAGE(PG8_SB(1, 0), b3, voffB); PG8_STAGE(PG8_SB(1, 1), b3 + hstepB, voffB); PG8_STAGE(PG8_SA(1, 0), a3, voffA);
            PG8_WAIT_V(8); PG8_WAIT_L(0); PG8_BAR; PG8_MMA(1, 0, At, B0); PG8_MMA(1, 1, At, B1); PG8_BAR; PG8_SCHED;
            } else {
            PG8_LDB(B0, 0, 0); PG8_SCHED; PG8_LDA(At, 0, 0); PG8_STAGE(PG8_SA(1, 1), a1 + hstepA, voffA);
            PG8_WAIT_L(8); PG8_BAR; PG8_WAIT_L(0); PG8_MMA(0, 0, At, B0); PG8_BAR; PG8_SCHED;
            PG8_LDB(B1, 0, 1); PG8_STAGE(PG8_SB(0, 0), b2, voffB);
            PG8_BAR; PG8_WAIT_L(0); PG8_MMA(0, 1, At, B1); PG8_BAR;
            PG8_LDA(At, 0, 1); PG8_STAGE(PG8_SA(0, 0), a2, voffA);
            PG8_BAR; PG8_WAIT_L(0); PG8_MMA(1, 0, At, B0); PG8_BAR; PG8_SCHED;
            PG8_STAGE(PG8_SB(0, 1), b2 + hstepB, voffB);
            PG8_WAIT_V(6); PG8_BAR; PG8_MMA(1, 1, At, B1); PG8_BAR;
            PG8_LDB(B0, 1, 0); PG8_SCHED; PG8_LDA(At, 1, 0); PG8_STAGE(PG8_SA(0, 1), a2 + hstepA, voffA);
            PG8_WAIT_L(8); PG8_BAR; PG8_WAIT_L(0); PG8_MMA(0, 0, At, B0); PG8_BAR; PG8_SCHED;
            PG8_LDB(B1, 1, 1); PG8_STAGE(PG8_SB(1, 0), b3, voffB);
            PG8_BAR; PG8_WAIT_L(0); PG8_MMA(0, 1, At, B1); PG8_BAR;
            PG8_LDA(At, 1, 1); PG8_STAGE(PG8_SA(1, 0), a3, voffA);
            PG8_BAR; PG8_WAIT_L(0); PG8_MMA(1, 0, At, B0); PG8_BAR; PG8_SCHED;
            PG8_STAGE(PG8_SB(1, 1), b3 + hstepB, voffB);
            PG8_WAIT_V(6); PG8_BAR; PG8_MMA(1, 1, At, B1); PG8_BAR;
            }
        }
        if constexpr (ALIGN_EPI) { if (wr == 0) PG8_BAR; }
        E(acc, cur, wr, wc, fr, fq);
        if (!has_next) break;
#pragma unroll
        for (int a = 0; a < 2; ++a)
#pragma unroll
            for (int b = 0; b < 2; ++b)
#pragma unroll
                for (int m = 0; m < 4; ++m)
#pragma unroll
                    for (int n = 0; n < 2; ++n) acc[a][b][m][n] = (f32x4){0.f, 0.f, 0.f, 0.f};
        cur = nxt; cA = nA; cB = nB; ++ui;
        if constexpr (ALIGN_EPI) { if (wr == 1) PG8_BAR; }
    }
    PG8_WAIT_V(0);
    if constexpr (!ALIGN_EPI) { if (wr == 0) PG8_BAR; }
    PG8_BAR;
#undef PG8_SA
#undef PG8_SB
#undef PG8_STAGE
#undef PG8_LDA
#undef PG8_LDB
#undef PG8_MMA
#undef PG8_WAIT_V
#undef PG8_WAIT_L
#undef PG8_BAR
#undef PG8_SCHED
}
}

namespace att {
constexpr int NW = 8, QBLK = 32, KVBLK = 64, DV = 128;
constexpr float THR = 8.f;
#define SBAR() __builtin_amdgcn_sched_barrier(0)
__device__ __forceinline__ int crow(int r, int hi) { return (r & 3) + 8 * (r >> 2) + 4 * hi; }
template <int DQK> struct Cfg {
    static constexpr int KROW = DQK * 2;
    static constexpr int SHM_K = KVBLK * KROW, SHM_V = KVBLK * DV * 2;
    static constexpr int QPE_OFF = 2 * SHM_V + 2 * SHM_K + NW * 64 * 4;
    static constexpr int NPARK = DQK == 192 ? 4 : 0;
    static constexpr int QR0 = DQK / 16 - NPARK;
    static constexpr int LDS_BYTES = QPE_OFF + NW * NPARK * 1024;
    static constexpr int NQ = DQK / 16;
    static constexpr int NKC = DQK / 64;
};
template <int DQK> __device__ __forceinline__ int kswz(int row, int colB) { return row * (DQK * 2) + (colB ^ (DQK == 128 ? ((row & 15) << 4) : (((row >> 1) & 7) << 4))); }

template <int DQK>
__device__ __forceinline__ void partialSM(f32x16& p0, f32x16& p1, float& m_reg, float& mn, float& alpha) {
    constexpr float SCALE = DQK == 128 ? 0.08838834764831845f : 0.07216878364870322f;
    constexpr float C = SCALE * 1.4426950408889634f;
    float pmax = p0[0];
#pragma unroll
    for (int r = 1; r < 16; ++r) pmax = fmaxf(pmax, p0[r]);
#pragma unroll
    for (int r = 0; r < 16; ++r) pmax = fmaxf(pmax, p1[r]);
    { auto rr = __builtin_amdgcn_permlane32_swap(__float_as_uint(pmax), __float_as_uint(pmax), false, false);
      pmax = fmaxf(__uint_as_float(rr[0]), __uint_as_float(rr[1])); }
    if (__builtin_expect(__all(pmax - m_reg <= THR / SCALE), 1)) { mn = m_reg; alpha = 1.f; }
    else { mn = fmaxf(m_reg, pmax); alpha = __builtin_amdgcn_exp2f((m_reg - mn) * C); m_reg = mn; }
    const float mnC = -mn * C;
#pragma unroll
    for (int r = 0; r < 16; ++r) p0[r] = fmaf(p0[r], C, mnC);
#pragma unroll
    for (int r = 0; r < 16; ++r) p1[r] = fmaf(p1[r], C, mnC);
#pragma unroll
    for (int r = 0; r < 16; ++r) p0[r] = __builtin_amdgcn_exp2f(p0[r]);
}
__device__ __forceinline__ void finishSM(f32x16& p0, f32x16& p1, float alpha, float& l_reg, bf16x8& pa0, bf16x8& pa1, bf16x8& pa2, bf16x8& pa3) {
#pragma unroll
    for (int r = 0; r < 16; ++r) p1[r] = __builtin_amdgcn_exp2f(p1[r]);
    float ps = 0;
#pragma unroll
    for (int r = 0; r < 16; ++r) ps += p0[r];
#pragma unroll
    for (int r = 0; r < 16; ++r) ps += p1[r];
    { auto rr = __builtin_amdgcn_permlane32_swap(__float_as_uint(ps), __float_as_uint(ps), false, false);
      ps = __uint_as_float(rr[0]) + __uint_as_float(rr[1]); }
    l_reg = l_reg * alpha + ps;
#define PK4(P, BASE, OUT) do { unsigned a0 = cvt_pk_bf16(P[BASE + 0], P[BASE + 1]), a1 = cvt_pk_bf16(P[BASE + 2], P[BASE + 3]);   \
    unsigned b0 = cvt_pk_bf16(P[BASE + 4], P[BASE + 5]), b1 = cvt_pk_bf16(P[BASE + 6], P[BASE + 7]);                              \
    auto r0 = __builtin_amdgcn_permlane32_swap(a0, b0, false, false); auto r1 = __builtin_amdgcn_permlane32_swap(a1, b1, false, false); \
    u32x4 w = {r0[0], r1[0], r0[1], r1[1]}; OUT = *reinterpret_cast<bf16x8*>(&w); } while (0)
    PK4(p0, 0, pa0); PK4(p0, 8, pa1); PK4(p1, 0, pa2); PK4(p1, 8, pa3);
#undef PK4
}
__device__ __forceinline__ void partialSM_nomax(f32x16& p0, f32x16& p1) {
    SBAR();
#pragma unroll
    for (int r = 0; r < 16; ++r) p0[r] = __builtin_amdgcn_exp2f(p0[r]);
    SBAR();
}
template <int DQK, bool PARK = (DQK == 192)>
__device__ __forceinline__ void qkt(f32x16& p0, f32x16& p1, const char* Ks, const bf16x8* qr, const char* qpe, int r32, int hi) {
    p0 = f32x16{}; p1 = f32x16{};
#pragma unroll
    for (int d0 = 0; d0 < DQK / 16; ++d0) { const int cb = (d0 * 16 + hi * 8) * 2;
        bf16x8 b0 = *reinterpret_cast<const bf16x8*>(Ks + kswz<DQK>(r32, cb));
        bf16x8 b1 = *reinterpret_cast<const bf16x8*>(Ks + kswz<DQK>(32 + r32, cb));
        bf16x8 q; if (!PARK || d0 < Cfg<DQK>::QR0) q = qr[(!PARK || d0 < Cfg<DQK>::QR0) ? d0 : 0]; else q = *reinterpret_cast<const bf16x8*>(qpe + (d0 - Cfg<DQK>::QR0) * 1024);
        p0 = __builtin_amdgcn_mfma_f32_32x32x16_bf16(b0, q, p0, 0, 0, 0);
        p1 = __builtin_amdgcn_mfma_f32_32x32x16_bf16(b1, q, p1, 0, 0, 0);
        if (DQK == 192 && (d0 & 3) == 3 && d0 != 11) SBAR(); }
}
__device__ __forceinline__ int v_st(int k, int c) { const int kk = (k & ~0xC) | ((k & 4) << 1) | ((k & 8) >> 1); return ((kk >> 3) * 4 + (c >> 5)) * 512 + ((kk & 7) * 32 + (c & 31)) * 2; }
__device__ __forceinline__ int v_rd_base(int lane) { return ((lane & 3) << 3) | (((lane >> 2) & 3) << 6) | (((lane >> 4) & 1) << 5) | (((lane >> 5) & 1) << 8); }
constexpr int v_rd_off(int d0, int ks, int half) { return d0 * 512 + ks * 4096 + half * 2048; }
template <int OFF> __device__ __forceinline__ s16x4 tr_read(int vb) {
    s16x4 r; asm volatile("ds_read_b64_tr_b16 %0, %1 offset:%2" : "=&v"(r) : "v"(vb), "i"(OFF) : "memory"); return r;
}
template <int D0> __device__ __forceinline__ void pv_one(f32x16& od, int vb, bf16x8 pa0, bf16x8 pa1, bf16x8 pa2, bf16x8 pa3) {
    const s16x4 l0 = tr_read<v_rd_off(D0, 0, 0)>(vb), h0 = tr_read<v_rd_off(D0, 0, 1)>(vb), l1 = tr_read<v_rd_off(D0, 1, 0)>(vb), h1 = tr_read<v_rd_off(D0, 1, 1)>(vb);
    const s16x4 l2 = tr_read<v_rd_off(D0, 2, 0)>(vb), h2 = tr_read<v_rd_off(D0, 2, 1)>(vb), l3 = tr_read<v_rd_off(D0, 3, 0)>(vb), h3 = tr_read<v_rd_off(D0, 3, 1)>(vb);
    asm volatile("s_waitcnt lgkmcnt(0)" ::: "memory"); SBAR();
#define PK(L, H) (bf16x8){L[0], L[1], L[2], L[3], H[0], H[1], H[2], H[3]}
    od = __builtin_amdgcn_mfma_f32_32x32x16_bf16(pa0, PK(l0, h0), od, 0, 0, 0);
    od = __builtin_amdgcn_mfma_f32_32x32x16_bf16(pa1, PK(l1, h1), od, 0, 0, 0);
    od = __builtin_amdgcn_mfma_f32_32x32x16_bf16(pa2, PK(l2, h2), od, 0, 0, 0);
    od = __builtin_amdgcn_mfma_f32_32x32x16_bf16(pa3, PK(l3, h3), od, 0, 0, 0);
#undef PK
}
__device__ __forceinline__ void pv_d0(f32x16* o, int vb, bf16x8 pa0, bf16x8 pa1, bf16x8 pa2, bf16x8 pa3) {
    pv_one<0>(o[0], vb, pa0, pa1, pa2, pa3); pv_one<1>(o[1], vb, pa0, pa1, pa2, pa3); pv_one<2>(o[2], vb, pa0, pa1, pa2, pa3); pv_one<3>(o[3], vb, pa0, pa1, pa2, pa3);
}
struct VFrag { s16x4 l0, h0, l1, h1, l2, h2, l3, h3; };
template <int D0> __device__ __forceinline__ void pv_reads(VFrag& f, int vb) {
    f.l0 = tr_read<v_rd_off(D0, 0, 0)>(vb); f.h0 = tr_read<v_rd_off(D0, 0, 1)>(vb); f.l1 = tr_read<v_rd_off(D0, 1, 0)>(vb); f.h1 = tr_read<v_rd_off(D0, 1, 1)>(vb);
    f.l2 = tr_read<v_rd_off(D0, 2, 0)>(vb); f.h2 = tr_read<v_rd_off(D0, 2, 1)>(vb); f.l3 = tr_read<v_rd_off(D0, 3, 0)>(vb); f.h3 = tr_read<v_rd_off(D0, 3, 1)>(vb);
}
__device__ __forceinline__ void pv_mma(f32x16& od, const VFrag& f, bf16x8 pa0, bf16x8 pa1, bf16x8 pa2, bf16x8 pa3) {
#define PK(L, H) (bf16x8){L[0], L[1], L[2], L[3], H[0], H[1], H[2], H[3]}
    od = __builtin_amdgcn_mfma_f32_32x32x16_bf16(pa0, PK(f.l0, f.h0), od, 0, 0, 0);
    od = __builtin_amdgcn_mfma_f32_32x32x16_bf16(pa1, PK(f.l1, f.h1), od, 0, 0, 0);
    od = __builtin_amdgcn_mfma_f32_32x32x16_bf16(pa2, PK(f.l2, f.h2), od, 0, 0, 0);
    od = __builtin_amdgcn_mfma_f32_32x32x16_bf16(pa3, PK(f.l3, f.h3), od, 0, 0, 0);
#undef PK
}
__device__ __forceinline__ void pv_pipe(f32x16* o, int vb, bf16x8 pa0, bf16x8 pa1, bf16x8 pa2, bf16x8 pa3) {
    VFrag fa, fb;
    pv_reads<0>(fa, vb); pv_reads<1>(fb, vb);
    asm volatile("s_waitcnt lgkmcnt(8)" ::: "memory"); SBAR();
    pv_mma(o[0], fa, pa0, pa1, pa2, pa3); SBAR();
    pv_reads<2>(fa, vb);
    asm volatile("s_waitcnt lgkmcnt(8)" ::: "memory"); SBAR();
    pv_mma(o[1], fb, pa0, pa1, pa2, pa3); SBAR();
    pv_reads<3>(fb, vb);
    asm volatile("s_waitcnt lgkmcnt(8)" ::: "memory"); SBAR();
    pv_mma(o[2], fa, pa0, pa1, pa2, pa3); SBAR();
    asm volatile("s_waitcnt lgkmcnt(0)" ::: "memory"); SBAR();
    pv_mma(o[3], fb, pa0, pa1, pa2, pa3);
}
__device__ __forceinline__ void unpack8(bf16x8 v, float* f) {
    const u32x4 w = *reinterpret_cast<const u32x4*>(&v);
    f[0] = bf_lo(w.x); f[1] = bf_hi(w.x); f[2] = bf_lo(w.y); f[3] = bf_hi(w.y); f[4] = bf_lo(w.z); f[5] = bf_hi(w.z); f[6] = bf_lo(w.w); f[7] = bf_hi(w.w);
}
__device__ __forceinline__ bf16x8 pack8(const float* f) {
    u32x4 w = {cvt_pk_bf16(f[0], f[1]), cvt_pk_bf16(f[2], f[3]), cvt_pk_bf16(f[4], f[5]), cvt_pk_bf16(f[6], f[7])}; return *reinterpret_cast<bf16x8*>(&w);
}
__device__ __forceinline__ void rope_pair(bf16x8& A, bf16x8& B, const f32x2* __restrict__ tab) {
    float a[8], b[8], ra[8], rb[8]; unpack8(A, a); unpack8(B, b);
#pragma unroll
    for (int j = 0; j < 8; ++j) { const f32x2 cs = tab[j]; ra[j] = a[j] * cs.x - b[j] * cs.y; rb[j] = b[j] * cs.x + a[j] * cs.y; }
    A = pack8(ra); B = pack8(rb);
}

template <int DQK, int LDQ, int LDK, int LDV, int LDO>
__device__ __forceinline__ void attn_body(const bf16_t* __restrict__ Qb, const bf16_t* __restrict__ Kh, const bf16_t* __restrict__ Vh, bf16_t* __restrict__ Ob, int seq, char* lds,
                                          const float* __restrict__ qg, const f32x2* __restrict__ tab, bool rope, int tok0) {
    using C = Cfg<DQK>;
    int tid_ = threadIdx.x; asm volatile("" : "+v"(tid_));
    const int tid = tid_, wid = tid >> 6, lane = tid & 63, r32 = lane & 31, hi = lane >> 5;
    char* V_lds = lds; char* K_lds = lds + 2 * C::SHM_V;
    float* wsf = (float*)(lds + 2 * C::SHM_V + 2 * C::SHM_K) + wid * 64; float* li_l = wsf; float* al_l = wsf + 32;
    char* qpe = lds + C::QPE_OFF + wid * (C::NPARK * 1024) + lane * 16;
    float m_reg = -1e30f, l_reg = 0; f32x16 o[4] = {}; bf16x8 qr[C::NQ];
    const bf16_t* Qw = Qb + (long)(wid * QBLK + r32) * LDQ + hi * 8;
#pragma unroll
    for (int d0 = 0; d0 < C::NQ; ++d0) qr[d0] = *reinterpret_cast<const bf16x8*>(Qw + d0 * 16);
    {
        const int t = tok0 + wid * QBLK + r32, prow = t >> 6, pcol = t & 63;
        if constexpr (DQK == 128) {
            float ss = 0.f;
#pragma unroll
            for (int d0 = 0; d0 < 8; ++d0) { float f[8]; unpack8(qr[d0], f);
#pragma unroll
                for (int j = 0; j < 8; ++j) ss += f[j] * f[j]; }
            ss += __shfl_xor(ss, 32);
            const float rstd = 1.0f / sqrtf(ss * (1.0f / 128.0f) + 1e-6f);
#pragma unroll
            for (int d0 = 0; d0 < 8; ++d0) { float f[8]; unpack8(qr[d0], f);
#pragma unroll
                for (int j = 0; j < 8; ++j) f[j] = f[j] * rstd * qg[d0 * 16 + hi * 8 + j];
                qr[d0] = pack8(f); }
            if (rope) {
                const f32x2* tr = tab + prow * 32 + hi * 8; const f32x2* tc = tab + pcol * 32 + hi * 8;
                rope_pair(qr[0], qr[2], tr); rope_pair(qr[1], qr[3], tr + 16);
                rope_pair(qr[4], qr[6], tc); rope_pair(qr[5], qr[7], tc + 16);
            }
        } else {
            if (rope) {
                const f32x2* tr = tab + prow * 16 + hi * 8; const f32x2* tc = tab + pcol * 16 + hi * 8;
                rope_pair(qr[8], qr[9], tr); rope_pair(qr[10], qr[11], tc);
            }
        }
    }
    if constexpr (DQK == 192) {
#pragma unroll
        for (int d0 = C::QR0; d0 < 12; ++d0) *reinterpret_cast<bf16x8*>(qpe + (d0 - C::QR0) * 1024) = qr[d0];
        asm volatile("s_waitcnt lgkmcnt(0)" ::: "memory");
    }
    const int sr = tid >> 4, sc = (tid & 15) * 8, vst0 = v_st(sr, sc), vst1 = v_st(32 + sr, sc);
    const int vb0 = (int)(uintptr_t)V_lds + v_rd_base(lane);
    const int sr2 = tid >> 3, sc2 = 128 + (tid & 7) * 8;
    struct Slot { bf16x8 vs0, vs1, ks0, ks1, ks2; };
    Slot sA, sBs;
#define sB (*(DQK == 192 ? &sA : &sBs))
#define SLOAD(S, k0) do { S.vs0 = *reinterpret_cast<const bf16x8*>(&Vh[(long)((k0) + sr) * LDV + sc]); S.vs1 = *reinterpret_cast<const bf16x8*>(&Vh[(long)((k0) + 32 + sr) * LDV + sc]); \
    S.ks0 = *reinterpret_cast<const bf16x8*>(&Kh[(long)((k0) + sr) * LDK + sc]); S.ks1 = *reinterpret_cast<const bf16x8*>(&Kh[(long)((k0) + 32 + sr) * LDK + sc]); \
    if constexpr (DQK == 192) S.ks2 = *reinterpret_cast<const bf16x8*>(&Kh[(long)((k0) + sr2) * LDK + sc2]); } while (0)
#define SWRITE(b, S) do { *(bf16x8*)(V_lds + (b) * C::SHM_V + vst0) = S.vs0; *(bf16x8*)(V_lds + (b) * C::SHM_V + vst1) = S.vs1; \
    *(bf16x8*)(K_lds + (b) * C::SHM_K + kswz<DQK>(sr, sc * 2)) = S.ks0; *(bf16x8*)(K_lds + (b) * C::SHM_K + kswz<DQK>(32 + sr, sc * 2)) = S.ks1; \
    if constexpr (DQK == 192) *(bf16x8*)(K_lds + (b) * C::SHM_K + kswz<DQK>(sr2, sc2 * 2)) = S.ks2; } while (0)
#define SWAIT() do { if constexpr (DQK == 192) asm volatile("s_waitcnt vmcnt(0)" ::: "memory"); else asm volatile("s_waitcnt vmcnt(4)" ::: "memory"); } while (0)
#define RESC(a) do { if (__any((a) < 1.f)) { if (hi == 0) al_l[r32] = (a); asm volatile("s_waitcnt lgkmcnt(0)" ::: "memory"); \
    _Pragma("unroll") for (int d = 0; d < 4; ++d) _Pragma("unroll") for (int r = 0; r < 16; ++r) o[d][r] *= al_l[crow(r, hi)]; } } while (0)
    f32x16 pA0, pA1, pB0, pB1; float mnA, mnB, alA, alB; bf16x8 pa0, pa1, pa2, pa3; const int NT = seq / KVBLK;
    SLOAD(sA, 0); asm volatile("s_waitcnt vmcnt(0)" ::: "memory"); SWRITE(0, sA); __syncthreads();
    qkt<DQK>(pA0, pA1, K_lds, qr, qpe, r32, hi); partialSM<DQK>(pA0, pA1, m_reg, mnA, alA);
    SLOAD(sB, KVBLK); if constexpr (DQK != 192) { if (2 < NT) SLOAD(sA, 2 * KVBLK); }
    SWAIT(); SWRITE(1, sB); __syncthreads();
    for (int j = 1; j + 1 < NT; j += 2) {
        SBAR(); qkt<DQK>(pB0, pB1, K_lds + C::SHM_K, qr, qpe, r32, hi);
        finishSM(pA0, pA1, alA, l_reg, pa0, pa1, pa2, pa3); SBAR();
        SLOAD(sB, (j + (DQK == 192 ? 1 : 2)) * KVBLK); SBAR();
        pv_d0(o, vb0, pa0, pa1, pa2, pa3); partialSM<DQK>(pB0, pB1, m_reg, mnB, alB);
        __syncthreads(); SWAIT(); SWRITE(0, sA);
        RESC(alB); __syncthreads();
        SBAR(); qkt<DQK>(pA0, pA1, K_lds, qr, qpe, r32, hi);
        finishSM(pB0, pB1, alB, l_reg, pa0, pa1, pa2, pa3); SBAR();
        if (DQK == 192 || j + 3 < NT) SLOAD(sA, (j + (DQK == 192 ? 2 : 3)) * KVBLK); SBAR();
        pv_d0(o, vb0 + C::SHM_V, pa0, pa1, pa2, pa3); partialSM<DQK>(pA0, pA1, m_reg, mnA, alA);
        __syncthreads(); SWAIT(); SWRITE(1, sB);
        RESC(alA); __syncthreads();
    }
    SBAR(); qkt<DQK>(pB0, pB1, K_lds + C::SHM_K, qr, qpe, r32, hi);
    finishSM(pA0, pA1, alA, l_reg, pa0, pa1, pa2, pa3); SBAR();
    pv_d0(o, vb0, pa0, pa1, pa2, pa3); partialSM<DQK>(pB0, pB1, m_reg, mnB, alB);
    __syncthreads(); RESC(alB);
    finishSM(pB0, pB1, alB, l_reg, pa0, pa1, pa2, pa3); SBAR();
    pv_d0(o, vb0 + C::SHM_V, pa0, pa1, pa2, pa3);
    if (hi == 0) li_l[r32] = l_reg; asm volatile("s_waitcnt lgkmcnt(0)" ::: "memory");
    float rli[16];
#pragma unroll
    for (int r = 0; r < 16; ++r) rli[r] = __builtin_amdgcn_rcpf(li_l[crow(r, hi)]);
    bf16_t* Ow = Ob + (long)(wid * QBLK) * LDO;
#pragma unroll
    for (int r = 0; r < 16; ++r) { const int orow = crow(r, hi);
#pragma unroll
        for (int d0 = 0; d0 < 4; ++d0) Ow[(long)orow * LDO + d0 * 32 + r32] = f2bf(o[d0][r] * rli[r]); }
    __syncthreads();
#undef sB
#undef SLOAD
#undef SWRITE
#undef SWAIT
#undef RESC
}

__device__ __forceinline__ void glds16(const void* g, unsigned lds_base) {
    unsigned sv; asm volatile("s_mov_b32 %0, m0\n\ts_mov_b32 m0, %2\n\ts_nop 0\n\tglobal_load_lds_dwordx4 %1, off\n\ts_mov_b32 m0, %0" : "=&s"(sv) : "v"(g), "s"(lds_base) : "memory"); }
template <int DQK> struct CfgD {
    static constexpr int SHM_K = KVBLK * DQK * 2, SHM_V = KVBLK * DV * 2;
    static constexpr int KR = 0, VR = 3 * SHM_K, SCR = VR + 3 * SHM_V, LDS_BYTES = SCR + NW * 64 * 4;
    static constexpr int NPK = DQK / 64, NPV = 2;
};
template <int DQK, int LDQ, int LDK, int LDV, int LDO, bool NOMAX = false>
__device__ __forceinline__ void attn_body_dma(const bf16_t* __restrict__ Qb, const bf16_t* __restrict__ Kh, const bf16_t* __restrict__ Vh, bf16_t* __restrict__ Ob, int seq, char* lds,
                                              const float* __restrict__ qg, const f32x2* __restrict__ tab, bool rope, int tok0) {
    using C = CfgD<DQK>;
    int tid_ = threadIdx.x; asm volatile("" : "+v"(tid_));
    const int tid = tid_, wid = __builtin_amdgcn_readfirstlane(tid >> 6), lane = tid & 63, r32 = lane & 31, hi = lane >> 5;
    const unsigned lds0 = (unsigned)__builtin_amdgcn_readfirstlane((int)(uintptr_t)lds);
    char* K_lds = lds + C::KR;
    float* wsf = (float*)(lds + C::SCR) + wid * 64; float* li_l = wsf; float* al_l = wsf + 32;
    unsigned kvoff[C::NPK], vvoff[C::NPV];
#pragma unroll
    for (int i = 0; i < C::NPK; ++i) { const int b = (wid + 8 * i) * 1024 + lane * 16, row = b / (DQK * 2), pos = b % (DQK * 2);
        const int colB = pos ^ (DQK == 128 ? ((row & 15) << 4) : (((row >> 1) & 7) << 4)); kvoff[i] = (unsigned)(row * LDK * 2 + colB); }
#pragma unroll
    for (int i = 0; i < C::NPV; ++i) { const int sbt = (wid + 8 * i) * 2 + (lane >> 5), rowin = (lane & 31) >> 2, cch = lane & 3, kk = (sbt >> 2) * 8 + rowin;
        const int k = (kk & ~0xC) | ((kk & 4) << 1) | ((kk & 8) >> 1), c = (sbt & 3) * 32 + cch * 8; vvoff[i] = (unsigned)(k * LDV * 2 + c * 2); }
#define ISSUE_K(J, SL) do { const char* g_ = (const char*)Kh + (size_t)(J) * (KVBLK * LDK * 2); _Pragma("unroll") for (int i_ = 0; i_ < C::NPK; ++i_) \
        glds16(g_ + kvoff[i_], lds0 + C::KR + (SL) * C::SHM_K + (wid + 8 * i_) * 1024); } while (0)
#define ISSUE_V(J, SL) do { const char* g_ = (const char*)Vh + (size_t)(J) * (KVBLK * LDV * 2); _Pragma("unroll") for (int i_ = 0; i_ < C::NPV; ++i_) \
        glds16(g_ + vvoff[i_], lds0 + C::VR + (SL) * C::SHM_V + (wid + 8 * i_) * 1024); } while (0)
#define WAIT_BAR(N) asm volatile("s_waitcnt vmcnt(" #N ") lgkmcnt(0)\n\ts_barrier" ::: "memory")
    const int NT = seq / KVBLK;
    ISSUE_K(0, 0); ISSUE_V(0, 0); ISSUE_K(1, 1);
    float m_reg = -1e30f, l_reg = 0; f32x16 o[4] = {}; bf16x8 qr[DQK / 16];
    const bf16_t* Qw = Qb + (long)(wid * QBLK + r32) * LDQ + hi * 8;
#pragma unroll
    for (int d0 = 0; d0 < DQK / 16; ++d0) qr[d0] = *reinterpret_cast<const bf16x8*>(Qw + d0 * 16);
    {
        const int t = tok0 + wid * QBLK + r32, prow = t >> 6, pcol = t & 63;
        if constexpr (DQK == 128) {
            float ss = 0.f;
#pragma unroll
            for (int d0 = 0; d0 < 8; ++d0) { float f[8]; unpack8(qr[d0], f);
#pragma unroll
                for (int j = 0; j < 8; ++j) ss += f[j] * f[j]; }
            ss += __shfl_xor(ss, 32);
            const float rstd = 1.0f / sqrtf(ss * (1.0f / 128.0f) + 1e-6f);
#pragma unroll
            for (int d0 = 0; d0 < 8; ++d0) { float f[8]; unpack8(qr[d0], f);
#pragma unroll
                for (int j = 0; j < 8; ++j) f[j] = f[j] * rstd * qg[d0 * 16 + hi * 8 + j] * (NOMAX ? 0.08838834764831845f * 1.4426950408889634f : 1.0f);
                qr[d0] = pack8(f); }
            if (rope) {
                const f32x2* tr = tab + prow * 32 + hi * 8; const f32x2* tc = tab + pcol * 32 + hi * 8;
                rope_pair(qr[0], qr[2], tr); rope_pair(qr[1], qr[3], tr + 16);
                rope_pair(qr[4], qr[6], tc); rope_pair(qr[5], qr[7], tc + 16);
            }
        } else {
            if (rope) {
                const f32x2* tr = tab + prow * 16 + hi * 8; const f32x2* tc = tab + pcol * 16 + hi * 8;
                rope_pair(qr[8], qr[9], tr); rope_pair(qr[10], qr[11], tc);
            }
        }
    }
    SBAR();
    const int vb0 = (int)lds0 + C::VR + v_rd_base(lane);
#define RESC(a) do { if (__any((a) < 1.f)) { if (hi == 0) al_l[r32] = (a); asm volatile("s_waitcnt lgkmcnt(0)" ::: "memory"); \
    _Pragma("unroll") for (int d = 0; d < 4; ++d) _Pragma("unroll") for (int r = 0; r < 16; ++r) o[d][r] *= al_l[crow(r, hi)]; } } while (0)
    f32x16 pA0, pA1, pB0, pB1; float mnA = 0.f, mnB = 0.f, alA = 1.f, alB = 1.f; bf16x8 pa0, pa1, pa2, pa3;
#define PSM(P0, P1, MN, AL) do { if constexpr (NOMAX) partialSM_nomax(P0, P1); else partialSM<DQK>(P0, P1, m_reg, MN, AL); } while (0)
#define RESCX(a) do { if constexpr (!NOMAX) RESC(a); else SBAR(); } while (0)
    WAIT_BAR(0);
    qkt<DQK, false>(pA0, pA1, K_lds, qr, nullptr, r32, hi); PSM(pA0, pA1, mnA, alA);
    ISSUE_K(2, 2); ISSUE_V(1, 1);
    if constexpr (C::NPK + C::NPV == 4) WAIT_BAR(4); else WAIT_BAR(5);
    int sa = 1, sb = 2, sc = 0;
#define STEP(PX0, PX1, PY0, PY1, MNX, ALX, ALY, J) do { \
    SBAR(); qkt<DQK, false>(PX0, PX1, K_lds + sa * C::SHM_K, qr, nullptr, r32, hi); \
    finishSM(PY0, PY1, ALY, l_reg, pa0, pa1, pa2, pa3); SBAR(); \
    const bool gk_ = (J) + 2 < NT, gv_ = (J) + 1 < NT; \
    if (gk_) ISSUE_K((J) + 2, sc); if (gv_) ISSUE_V((J) + 1, sb); SBAR(); \
    pv_pipe(o, vb0 + sc * C::SHM_V, pa0, pa1, pa2, pa3); PSM(PX0, PX1, MNX, ALX); \
    RESCX(ALX); \
    if (gk_) { if constexpr (C::NPK + C::NPV == 4) WAIT_BAR(4); else WAIT_BAR(5); } else if (gv_) WAIT_BAR(2); else WAIT_BAR(0); \
    { const int t_ = sa; sa = sb; sb = sc; sc = t_; } } while (0)
    int j = 1;
    for (; j + 1 < NT; j += 2) {
        STEP(pB0, pB1, pA0, pA1, mnB, alB, alA, j);
        STEP(pA0, pA1, pB0, pB1, mnA, alA, alB, j + 1);
    }
    STEP(pB0, pB1, pA0, pA1, mnB, alB, alA, j);
    finishSM(pB0, pB1, alB, l_reg, pa0, pa1, pa2, pa3); SBAR();
    pv_d0(o, vb0 + sc * C::SHM_V, pa0, pa1, pa2, pa3);
    if (hi == 0) li_l[r32] = l_reg; asm volatile("s_waitcnt lgkmcnt(0)" ::: "memory");
    float rli[16];
#pragma unroll
    for (int r = 0; r < 16; ++r) rli[r] = __builtin_amdgcn_rcpf(li_l[crow(r, hi)]);
    bf16_t* Ow = Ob + (long)(wid * QBLK) * LDO;
#pragma unroll
    for (int r = 0; r < 16; ++r) { const int orow = crow(r, hi);
#pragma unroll
        for (int d0 = 0; d0 < 4; ++d0) Ow[(long)orow * LDO + d0 * 32 + r32] = f2bf(o[d0][r] * rli[r]); }
    WAIT_BAR(0);
#undef ISSUE_K
#undef ISSUE_V
#undef WAIT_BAR
#undef RESC
#undef STEP
#undef PSM
#undef RESCX
}
}

constexpr size_t MiB = 1u << 20;
constexpr size_t WS_CTL = 0, CTL_ZERO_BYTES = 1 * MiB;
constexpr size_t WS_MODS = 1 * MiB;
constexpr size_t WS_TAB = 2 * MiB;
constexpr size_t WS_X = 4 * MiB;
constexpr size_t WS_H = 140 * MiB;
constexpr size_t WS_OUTF = 208 * MiB;
constexpr size_t WS_W1T = 344 * MiB, WS_W2T = 472 * MiB;
constexpr size_t WS_GQAW = 600 * MiB;
constexpr size_t WS_LRUW = 640 * MiB;
constexpr size_t WS_MLAW = 668 * MiB;
constexpr size_t WS_BIG = 688 * MiB;
constexpr size_t WS_ACT = WS_BIG;
constexpr size_t WS_GQ = WS_BIG, WS_GK = WS_BIG + 68 * MiB, WS_GV = WS_BIG + 85 * MiB, WS_GO = WS_BIG + 102 * MiB;
constexpr size_t WS_MAP = WS_BIG, WS_MQAN = WS_BIG + 85 * MiB, WS_MCKVN = WS_BIG + 102 * MiB, WS_MQ = WS_BIG + 119 * MiB, WS_MK = WS_BIG + 221 * MiB, WS_MV = WS_BIG + 323 * MiB, WS_MO = WS_BIG + 391 * MiB;
constexpr size_t WS_LUP = WS_BIG, WS_LG = WS_BIG  , WS_LGY = WS_BIG + 68 * MiB, WS_LU = WS_BIG + 136 * MiB, WS_LAF = WS_BIG + 204 * MiB, WS_LGUF = WS_BIG + 272 * MiB,
                 WS_LAB = WS_BIG + 340 * MiB, WS_LGUB = WS_BIG + 408 * MiB, WS_LPS = WS_BIG + 476 * MiB, WS_LCIN = WS_BIG + 494 * MiB;
static_assert(WS_LGUF == WS_LAF + (size_t)R * DM * 2 && WS_LAB == WS_LGUF + (size_t)R * DM * 2 && WS_LGUB == WS_LAB + (size_t)R * DM * 2, "gate outputs are consecutive");
constexpr size_t WS_PART = WS_BIG + 776 * MiB;
constexpr size_t WS_END = WS_PART + 64 * MiB;
constexpr int NCH = 136;

#define XB_TMO      128
#define XB_XCNT(j)  (256  + 64 * (j))
#define XB_XSUB(j)  (1280 + 64 * (j))
#define XB_XGEN(j)  (2304 + 64 * (j))
#define XB_TOP      3328
#define XB_TOPGEN   3392
#define XCD_BAR_WORDS 3456
#define XB_SPIN_CAP (1u << 22)
__device__ __forceinline__ unsigned xb_ld(unsigned* p)              { return __hip_atomic_load(p, __ATOMIC_RELAXED, __HIP_MEMORY_SCOPE_AGENT); }
__device__ __forceinline__ unsigned xb_add(unsigned* p, unsigned v) { return __hip_atomic_fetch_add(p, v, __ATOMIC_RELAXED, __HIP_MEMORY_SCOPE_AGENT); }
__device__ __forceinline__ unsigned xb_xcc_id() { return (unsigned)__builtin_amdgcn_s_getreg((3 << 11) | 20) & 0xFu; }
#define XB_SPIN(cond, bar) do { unsigned _sp = 0; while (cond) { __builtin_amdgcn_s_sleep(1); \
    if ((++_sp & 255u) == 0u) { if (xb_ld(&(bar)[XB_TMO])) break; if (_sp > XB_SPIN_CAP) { atomicAdd(&(bar)[XB_TMO], 1u); break; } } } } while (0)
struct XcdBarrier { unsigned* bar; unsigned x; volatile LAS unsigned* st; };
__device__ __forceinline__ XcdBarrier xcd_barrier_post(unsigned* bar, volatile LAS unsigned* st) {
    XcdBarrier b; b.bar = bar; b.x = xb_xcc_id(); b.st = st;
    if (threadIdx.x == 0) (void)xb_add(&bar[XB_XCNT(b.x)], 1u);
    return b;
}
__device__ __forceinline__ void xcd_barrier_complete(unsigned* bar, unsigned x, unsigned& nloc, unsigned& nx) {
    const unsigned G = gridDim.x * gridDim.y * gridDim.z;
    unsigned sum, cnt, mine, sp = 0u;
    for (;;) {
        sum = 0u; cnt = 0u; mine = 0u;
#pragma unroll
        for (unsigned j = 0; j < 16; ++j) { const unsigned c = xb_ld(&bar[XB_XCNT(j)]); sum += c; cnt += (c > 0u) ? 1u : 0u; mine = (j == x) ? c : mine; }
        if (sum == G) break;
        __builtin_amdgcn_s_sleep(1);
        if ((++sp & 255u) == 0u) { if (xb_ld(&bar[XB_TMO])) break; if (sp > XB_SPIN_CAP) { atomicAdd(&bar[XB_TMO], 1u); break; } }
    }
    nloc = mine > 0u ? mine : 1u; nx = cnt > 0u ? cnt : 1u;
}
__device__ __forceinline__ void xcd_barrier(const XcdBarrier& b) {
    asm volatile("s_waitcnt vmcnt(0)" ::: "memory");
    __syncthreads();
    if (threadIdx.x == 0) {
        unsigned* bar = b.bar;
        __builtin_amdgcn_s_waitcnt(0);
        unsigned nloc = b.st[0], nx = b.st[1];
        if (nloc == 0u) { xcd_barrier_complete(bar, b.x, nloc, nx); b.st[0] = nloc; b.st[1] = nx; }
        const unsigned old = xb_add(&bar[XB_XSUB(b.x)], 1u);
        const unsigned gen = old / nloc;
        if (old + 1u == (gen + 1u) * nloc) {
            __builtin_amdgcn_fence(__ATOMIC_RELEASE, "agent");
            asm volatile("s_waitcnt vmcnt(0)" ::: "memory");
            const unsigned og = xb_add(&bar[XB_TOP], 1u);
            const unsigned tg = og / nx;
            if (og + 1u == (tg + 1u) * nx) xb_add(&bar[XB_TOPGEN], 1u);
            else XB_SPIN(xb_ld(&bar[XB_TOPGEN]) == tg, bar);
            __builtin_amdgcn_fence(__ATOMIC_ACQUIRE, "agent");
            xb_add(&bar[XB_XGEN(b.x)], 1u);
            asm volatile("s_waitcnt vmcnt(0)" ::: "memory");
        } else {
            XB_SPIN(xb_ld(&bar[XB_XGEN(b.x)]) == gen, bar);
            __builtin_amdgcn_fence(__ATOMIC_ACQUIRE, "agent");
            asm volatile("s_waitcnt vmcnt(0)" ::: "memory");
        }
    }
    __syncthreads();
}

#ifndef PROBE_N
#define PROBE_N 2
#endif
__device__ __forceinline__ int probe_count() { int n = PROBE_N; asm volatile("" : "+s"(n)); return n; }
#ifdef PROBE_GEMM
#define PROBE_REPEAT_GEMM for (int rep_ = 0, nrep_ = probe_count(); rep_ < nrep_; ++rep_)
#else
#define PROBE_REPEAT_GEMM
#endif
#ifdef PROBE_ATTN
#define PROBE_REPEAT_ATTN for (int rep_ = 0, nrep_ = probe_count(); rep_ < nrep_; ++rep_)
#else
#define PROBE_REPEAT_ATTN
#endif
struct Args {
    const float *x, *c, *ctx, *c_ctx, *ada_w, *ada_b, *ln_g, *ln_b, *mlp_w1, *mlp_w2;
    const float *gqa_wq, *gqa_wk, *gqa_wv, *gqa_wo, *gqa_q_g, *gqa_k_g;
    const float *lru_wx, *lru_wy, *lru_conv_w, *lru_conv_b, *lru_ra_w, *lru_ra_b, *lru_ix_w, *lru_ix_b, *lru_lam, *lru_wo;
    const float *mla_wq_a, *mla_q_a_g, *mla_wq_b, *mla_wkv_a, *mla_kv_a_g, *mla_wkv_b, *mla_wo;
    float* out; unsigned char* ws; int ph_lo, ph_hi;
};

typedef const __attribute__((address_space(4))) Args CArgs;
__device__ __forceinline__ CArgs* kargs() { CArgs* p = (CArgs*)__builtin_amdgcn_kernarg_segment_ptr(); asm volatile("" : "+s"(p)); return p; }
constexpr int NWAVES = 8;
constexpr int RING_BYTES = 131072, LDSCTL_OFF = RING_BYTES, LDS_BYTES = 147456;

__device__ __forceinline__ float wave_sum(float v) {
#pragma unroll
    for (int o = 1; o < 64; o <<= 1) v += __shfl_xor(v, o);
    return v;
}
__device__ __forceinline__ float sigmoidf_(float v) { return __builtin_amdgcn_rcpf(1.0f + __builtin_amdgcn_exp2f(-1.4426950408889634f * v)); }

__device__ __forceinline__ int tid_opaque() { int t = threadIdx.x; asm volatile("" : "+v"(t)); return t; }
__device__ __forceinline__ void ph_mods(CArgs& a, LAS unsigned char* lds, int vcu, int G) {
    LAS float* S = (LAS float*)lds; LAS float* red = (LAS float*)(lds + 40960);
    const int tid = tid_opaque(), wave = tid >> 6, lane = tid & 63;
    for (int i = tid; i < 5 * DM; i += 512) { const int bi = i / DM, k = i % DM; const float v = bi < 4 ? a.c[bi * DM + k] : a.c_ctx[k]; S[i] = v / (1.0f + expf(-v)); }
    __syncthreads();
    float* mods = (float*)(a.ws + WS_MODS);
    for (int item = vcu; item < 768; item += G) {
        const int l = item / 192, n0 = (item % 192) * 64, ksub = wave * 4 + (lane >> 4), cl = lane & 15;
        const float* wp = a.ada_w + ((size_t)l * DM + ksub) * 12288 + n0 + cl * 4;
        float acc[5][4];
#pragma unroll
        for (int i = 0; i < 5; ++i)
#pragma unroll
            for (int j = 0; j < 4; ++j) acc[i][j] = 0.f;
#pragma unroll 8
        for (int it = 0; it < 64; ++it) {
            const f32x4 w = *(const f32x4*)(wp + (size_t)it * 32 * 12288); const int k = ksub + 32 * it;
#pragma unroll
            for (int i = 0; i < 5; ++i) { const float s = S[i * DM + k];
#pragma unroll
                for (int j = 0; j < 4; ++j) acc[i][j] += s * w[j]; }
        }
#pragma unroll
        for (int i = 0; i < 5; ++i)
#pragma unroll
            for (int j = 0; j < 4; ++j) red[(ksub * 5 + i) * 64 + cl * 4 + j] = acc[i][j];
        __syncthreads();
        if (tid < 320) { const int i = tid / 64, cc = tid % 64; float s = 0.f;
            for (int ks = 0; ks < 32; ++ks) s += red[(ks * 5 + i) * 64 + cc];
            mods[(size_t)(l * 5 + i) * 12288 + n0 + cc] = s + a.ada_b[l * 12288 + n0 + cc]; }
        __syncthreads();
    }
}
__device__ __forceinline__ void tr_item(const float* __restrict__ W, int ldw, int k0, int n0, bf16_t* __restrict__ WT, int ldt, int drow0, LAS float* scr, int lane) {
#pragma unroll 8
    for (int i = 0; i < 32; ++i) { const int kk = 2 * i + (lane >> 5); scr[kk * 33 + (lane & 31)] = W[(size_t)(k0 + kk) * ldw + n0 + (lane & 31)]; }
    asm volatile("s_waitcnt lgkmcnt(0)" ::: "memory");
    const int c = lane & 7;
#pragma unroll
    for (int j = 0; j < 4; ++j) { const int n = (lane >> 3) + 8 * j; const LAS float* s = scr + (8 * c) * 33 + n;
        u32x4 o; o.x = cvt_pk_bf16(s[0 * 33], s[1 * 33]); o.y = cvt_pk_bf16(s[2 * 33], s[3 * 33]); o.z = cvt_pk_bf16(s[4 * 33], s[5 * 33]); o.w = cvt_pk_bf16(s[6 * 33], s[7 * 33]);
        *(u32x4*)(WT + (size_t)(drow0 + n) * ldt + k0 + 8 * c) = o; }
    asm volatile("s_waitcnt lgkmcnt(0)" ::: "memory");
}
__device__ __forceinline__ void ph_transposes(CArgs& a, LAS unsigned char* lds, int vcu, int G) {
    const int tid = tid_opaque(), wave = tid >> 6, lane = tid & 63;
    LAS float* scr = (LAS float*)(lds + wave * 8704);
    const int gw = vcu * NWAVES + wave, NGW = G * NWAVES;
    unsigned char* ws = a.ws;
    constexpr int NITEMS = 87872;
    for (int it = gw; it < NITEMS; it += NGW) {
        int r = it;
#define TR_DO(src, K_, N_, dst, drow) do { const int nblk = (N_) / 32, kb = ri / nblk, nb = ri % nblk; tr_item((src), (N_), 64 * kb, 32 * nb, (dst), (K_), (drow) + 32 * nb, scr, lane); } while (0)
        if (r < 32768) { const int l = r / 8192, ri = r % 8192; TR_DO(a.mlp_w1 + (size_t)l * DM * DFF, DM, DFF, (bf16_t*)(ws + WS_W1T) + (size_t)l * DFF * DM, 0); continue; } r -= 32768;
        if (r < 32768) { const int l = r / 8192, ri = r % 8192; TR_DO(a.mlp_w2 + (size_t)l * DFF * DM, DFF, DM, (bf16_t*)(ws + WS_W2T) + (size_t)l * DM * DFF, 0); continue; } r -= 32768;
        if (r < 4096) { const int s = r / 2048, ri = r % 2048; TR_DO(a.gqa_wq + (size_t)s * DM * DM, DM, DM, (bf16_t*)(ws + WS_GQAW + s * 20 * MiB), 0); continue; } r -= 4096;
        if (r < 1024) { const int s = r / 512, ri = r % 512; TR_DO(a.gqa_wk + (size_t)s * DM * 512, DM, 512, (bf16_t*)(ws + WS_GQAW + s * 20 * MiB), 2048); continue; } r -= 1024;
        if (r < 1024) { const int s = r / 512, ri = r % 512; TR_DO(a.gqa_wv + (size_t)s * DM * 512, DM, 512, (bf16_t*)(ws + WS_GQAW + s * 20 * MiB), 2560); continue; } r -= 1024;
        if (r < 4096) { const int s = r / 2048, ri = r % 2048; TR_DO(a.gqa_wo + (size_t)s * DM * DM, DM, DM, (bf16_t*)(ws + WS_GQAW + s * 20 * MiB + 12 * MiB), 0); continue; } r -= 4096;
        if (r < 2048) { const int ri = r; TR_DO(a.lru_wx, DM, DM, (bf16_t*)(ws + WS_LRUW), 0); continue; } r -= 2048;
        if (r < 2048) { const int ri = r; TR_DO(a.lru_wy, DM, DM, (bf16_t*)(ws + WS_LRUW), 2048); continue; } r -= 2048;
        if (r < 1024) { const int blk = r / 32, ri = r % 32, ty = blk / 16, d = (blk % 16) / 8, n = blk % 8, which = d * 2 + ty;
            const float* src = (ty == 0 ? a.lru_ra_w : a.lru_ix_w) + (size_t)(d * 8 + n) * 65536;
            TR_DO(src, 256, 256, (bf16_t*)(ws + WS_LRUW + 16 * MiB), (which * 8 + n) * 256); continue; } r -= 1024;
        if (r < 2048) { const int ri = r; TR_DO(a.lru_wo, DM, DM, (bf16_t*)(ws + WS_LRUW + 20 * MiB), 0); continue; } r -= 2048;
        if (r < 512) { const int ri = r; TR_DO(a.mla_wq_a, DM, 512, (bf16_t*)(ws + WS_MLAW), 0); continue; } r -= 512;
        if (r < 576) { const int ri = r; TR_DO(a.mla_wkv_a, DM, 576, (bf16_t*)(ws + WS_MLAW), 512); continue; } r -= 576;
        if (r < 768) { const int ri = r; TR_DO(a.mla_wq_b, 512, 3072, (bf16_t*)(ws + WS_MLAW + 5 * MiB), 0); continue; } r -= 768;
        if (r < 1024) { const int ri = r, nb = ri % 128, kb = ri / 128, n0 = 32 * nb, h = n0 >> 8, j0 = n0 & 255;
            const int drow = j0 < 128 ? h * 128 + j0 : 2048 + h * 128 + (j0 - 128);
            tr_item(a.mla_wkv_b, 4096, 64 * kb, n0, (bf16_t*)(ws + WS_MLAW + 8 * MiB), 512, drow, scr, lane); continue; } r -= 1024;
        { const int ri = r; TR_DO(a.mla_wo, DM, DM, (bf16_t*)(ws + WS_MLAW + 12 * MiB), 0); }
#undef TR_DO
    }
    { u32x4* z = (u32x4*)(ws + WS_MLAW + (size_t)1088 * DM * 2); const int gt = vcu * 512 + tid;
      for (int i = gt; i < 49152; i += G * 512) z[i] = (u32x4){0u, 0u, 0u, 0u}; }
    if (vcu == 1 % G) { float* ll = (float*)(ws + WS_TAB + 32768); for (int i = tid; i < 2 * DM; i += 512) ll[i] = -8.0f * log1pf(expf(-a.lru_lam[i])); }
    if (vcu == 0) {
        f32x2* tg = (f32x2*)(ws + WS_TAB); f32x2* tm = (f32x2*)(ws + WS_TAB + 16384);
        for (int i = tid; i < 64 * 32; i += 512) { const int pos = i / 32, f = i % 32; const float inv = powf(10000.0f, -((float)f * 2.0f) / 64.0f); const float ang = (float)pos * inv; tg[i] = (f32x2){cosf(ang), sinf(ang)}; }
        for (int i = tid; i < 64 * 16; i += 512) { const int pos = i / 16, f = i % 16; const float inv = powf(10000.0f, -((float)f * 2.0f) / 32.0f); const float ang = (float)pos * inv; tm[i] = (f32x2){cosf(ang), sinf(ang)}; }
    }
}

#define ROW_DECODE(r) const int b_ = (r) / TB, p_ = (r) % TB; const bool isctx_ = p_ < CTX; const int mi_ = isctx_ ? 4 : b_; (void)b_; (void)mi_
__device__ __forceinline__ const float* mods_ptr(CArgs& a, int l, int mi) { return (const float*)(a.ws + WS_MODS) + (size_t)(l * 5 + mi) * 12288; }

__device__ __forceinline__ void ph_init(CArgs& a, int vcu, int G) {
    const int tid_ = tid_opaque(), lane = tid_ & 63, gw = vcu * NWAVES + (tid_ >> 6), NGW = G * NWAVES; (void)lane;
    bf16_t* X = (bf16_t*)(a.ws + WS_X); bf16_t* H = (bf16_t*)(a.ws + WS_H);
    for (int r = gw; r < R; r += NGW) {
        ROW_DECODE(r);
        const float* src = isctx_ ? a.ctx + ((size_t)b_ * CTX + p_) * DM : a.x + ((size_t)b_ * SEQ + (p_ - CTX)) * DM;
        const float* m = mods_ptr(a, 0, mi_);
#pragma unroll
        for (int it = 0; it < 8; ++it) { const int idx = it * 256 + lane * 4;
            const f32x4 v = *(const f32x4*)(src + idx), m0 = *(const f32x4*)(m + idx), m1 = *(const f32x4*)(m + DM + idx);
            *(u32x2*)(X + (size_t)r * DM + idx) = (u32x2){cvt_pk_bf16(v[0], v[1]), cvt_pk_bf16(v[2], v[3])};
            const f32x4 h = v * (1.0f + m1) + m0;
            *(u32x2*)(H + (size_t)r * DM + idx) = (u32x2){cvt_pk_bf16(h[0], h[1]), cvt_pk_bf16(h[2], h[3])}; }
    }
}
__device__ __forceinline__ void ln_stage_vecs(CArgs& a, LAS float* vec, int l, int which, int mi, bool last, int tid) {
    const float* lg = a.ln_g + (size_t)(l * 2 + which) * DM; const float* lb = a.ln_b + (size_t)(l * 2 + which) * DM;
    const float* m = mods_ptr(a, l, mi);
    const float* gate = m + (which == 0 ? 2 : 5) * DM;
    const float* sc = which == 0 ? m + 4 * DM : mods_ptr(a, last ? l : l + 1, mi) + 1 * DM;
    const float* sh = which == 0 ? m + 3 * DM : mods_ptr(a, last ? l : l + 1, mi);
    { const int i = tid * 4; const f32x4 g = *(const f32x4*)(gate + i), s4 = *(const f32x4*)(sc + i);
      *(LAS f32x4*)(vec + i) = 1.0f + g; *(LAS f32x4*)(vec + DM + i) = *(const f32x4*)(lg + i); *(LAS f32x4*)(vec + 2 * DM + i) = *(const f32x4*)(lb + i);
      *(LAS f32x4*)(vec + 3 * DM + i) = 1.0f + s4; *(LAS f32x4*)(vec + 4 * DM + i) = *(const f32x4*)(sh + i); }
}
template <bool LAST, int NR, bool FROM_PART>
__device__ __forceinline__ void ln_rows(CArgs& a, const LAS float* vec, int r, int lane) {
    bf16_t* X = (bf16_t*)(a.ws + WS_X); bf16_t* H = (bf16_t*)(a.ws + WS_H); const bf16_t* O = (const bf16_t*)(a.ws + WS_OUTF); const bf16_t* PART = (const bf16_t*)(a.ws + WS_PART);
    ROW_DECODE(r);
    float v[NR][4][8]; float s[NR];
#pragma unroll
    for (int rr = 0; rr < NR; ++rr) s[rr] = 0.f;
#pragma unroll
    for (int it = 0; it < 4; ++it) { const int idx = it * 512 + lane * 8;
        const f32x4 g0 = *(const LAS f32x4*)(vec + idx), g1 = *(const LAS f32x4*)(vec + idx + 4);
#pragma unroll
        for (int rr = 0; rr < NR; ++rr) {
            float xv[8], ov[8]; att::unpack8(*(const bf16x8*)(X + (size_t)(r + rr) * DM + idx), xv);
            if (FROM_PART) { const bf16_t* pp = PART + ((size_t)b_ * CTX + p_ + rr) * DM + idx;
                att::unpack8(*(const bf16x8*)pp, ov);
#pragma unroll
                for (int sl = 1; sl < 8; ++sl) { float t8[8]; att::unpack8(*(const bf16x8*)(pp + (size_t)sl * (NB * CTX) * DM), t8);
#pragma unroll
                    for (int j = 0; j < 8; ++j) ov[j] += t8[j]; } }
            else att::unpack8(*(const bf16x8*)(O + (size_t)(r + rr) * DM + idx), ov);
#pragma unroll
            for (int j = 0; j < 8; ++j) { v[rr][it][j] = DN_ALPHA * xv[j] + (j < 4 ? g0[j] : g1[j - 4]) * ov[j]; s[rr] += v[rr][it][j]; } }
        __builtin_amdgcn_sched_barrier(0);
    }
    float rstd[NR];
#pragma unroll
    for (int rr = 0; rr < NR; ++rr) { const float mean = wave_sum(s[rr]) * (1.0f / DM); float q = 0.f;
#pragma unroll
        for (int it = 0; it < 4; ++it)
#pragma unroll
            for (int j = 0; j < 8; ++j) { v[rr][it][j] -= mean; q += v[rr][it][j] * v[rr][it][j]; }
        rstd[rr] = 1.0f / sqrtf(wave_sum(q) * (1.0f / DM) + LN_EPS); }
#pragma unroll
    for (int it = 0; it < 4; ++it) { const int idx = it * 512 + lane * 8;
        const f32x4 lg0 = *(const LAS f32x4*)(vec + DM + idx), lg1 = *(const LAS f32x4*)(vec + DM + idx + 4), lb0 = *(const LAS f32x4*)(vec + 2 * DM + idx), lb1 = *(const LAS f32x4*)(vec + 2 * DM + idx + 4);
        f32x4 sc0 = {0.f, 0.f, 0.f, 0.f}, sc1 = sc0, sh0 = sc0, sh1 = sc0;
        if (!LAST) { sc0 = *(const LAS f32x4*)(vec + 3 * DM + idx); sc1 = *(const LAS f32x4*)(vec + 3 * DM + idx + 4); sh0 = *(const LAS f32x4*)(vec + 4 * DM + idx); sh1 = *(const LAS f32x4*)(vec + 4 * DM + idx + 4); }
#pragma unroll
        for (int rr = 0; rr < NR; ++rr) {
            float xn[8];
#pragma unroll
            for (int j = 0; j < 8; ++j) xn[j] = v[rr][it][j] * rstd[rr] * (j < 4 ? lg0[j] : lg1[j - 4]) + (j < 4 ? lb0[j] : lb1[j - 4]);
            if (LAST) { float* op = a.out + ((size_t)b_ * SEQ + (p_ + rr - CTX)) * DM + idx; *(f32x4*)op = (f32x4){xn[0], xn[1], xn[2], xn[3]}; *(f32x4*)(op + 4) = (f32x4){xn[4], xn[5], xn[6], xn[7]}; }
            else { *(bf16x8*)(X + (size_t)(r + rr) * DM + idx) = att::pack8(xn);
                float hh[8];
#pragma unroll
                for (int j = 0; j < 8; ++j) hh[j] = xn[j] * (j < 4 ? sc0[j] : sc1[j - 4]) + (j < 4 ? sh0[j] : sh1[j - 4]);
                *(bf16x8*)(H + (size_t)(r + rr) * DM + idx) = att::pack8(hh); } }
        __builtin_amdgcn_sched_barrier(0); }
}
template <bool LAST, int CTXMODE>
__device__ __forceinline__ void ph_ln(CArgs& a, LAS unsigned char* lds, int l, int which, int vcu, int G) {
    const int tid = tid_opaque(), lane = tid & 63, wave = tid >> 6;
    LAS float* vec = (LAS float*)lds;
    constexpr int NR = 2;
    const int b = (int)(((long)vcu * NB) / G), vlo = (b * G + NB - 1) / NB, vhi = ((b + 1) * G + NB - 1) / NB, wpb = vhi - vlo, w = vcu - vlo;
    ln_stage_vecs(a, vec, l, which, b, LAST, tid);
    __syncthreads();
    for (int k = w * NWAVES + wave; k < SEQ / NR; k += wpb * NWAVES) ln_rows<LAST, NR, false>(a, vec, b * TB + CTX + k * NR, lane);
    if (CTXMODE == 1 && !LAST) {
        __syncthreads();
        ln_stage_vecs(a, vec, l, which, 4, LAST, tid);
        __syncthreads();
        for (int k = wave * G + vcu; k < NB * CTX; k += G * NWAVES) ln_rows<false, 1, true>(a, vec, (k / CTX) * TB + (k % CTX), lane);
    }
    __syncthreads();
}
__device__ __forceinline__ void ph_knorm(CArgs& a, const float* kg, int vcu, int G) {
    const int tid_ = tid_opaque(), lane = tid_ & 63, gw = vcu * NWAVES + (tid_ >> 6), NGW = G * NWAVES; (void)lane;
    bf16_t* K = (bf16_t*)(a.ws + WS_GK); const f32x2* tab = (const f32x2*)(a.ws + WS_TAB);
    const int li = lane & 15;
    float g[8];
#pragma unroll
    for (int j = 0; j < 8; ++j) g[j] = kg[li * 8 + j];
    for (int r = gw; r < R; r += NGW) {
        ROW_DECODE(r);
        bf16x8 raw = *(const bf16x8*)(K + (size_t)r * 512 + lane * 8);
        float f[8]; att::unpack8(raw, f);
        float ss = 0.f;
#pragma unroll
        for (int j = 0; j < 8; ++j) ss += f[j] * f[j];
        ss += __shfl_xor(ss, 1); ss += __shfl_xor(ss, 2); ss += __shfl_xor(ss, 4); ss += __shfl_xor(ss, 8);
        const float rstd = 1.0f / sqrtf(ss * (1.0f / 128.0f) + 1e-6f);
#pragma unroll
        for (int j = 0; j < 8; ++j) f[j] = f[j] * rstd * g[j];
        if (!isctx_) {
            const int t = p_ - CTX, pos = (li & 8) ? (t & 63) : (t >> 6);
            const f32x2* tp = tab + pos * 32 + (li & 3) * 8;
            const bool second = (li & 4) != 0;
#pragma unroll
            for (int j = 0; j < 8; ++j) { const float other = __shfl_xor(f[j], 4); const f32x2 cs = tp[j];
                f[j] = second ? f[j] * cs.x + other * cs.y : f[j] * cs.x - other * cs.y; }
        }
        *(bf16x8*)(K + (size_t)r * 512 + lane * 8) = att::pack8(f);
    }
}
__device__ __forceinline__ void ph_mla_norm(CArgs& a, int vcu, int G) {
    const int tid_ = tid_opaque(), lane = tid_ & 63, gw = vcu * NWAVES + (tid_ >> 6), NGW = G * NWAVES; (void)lane;
    const bf16_t* AP = (const bf16_t*)(a.ws + WS_MAP); bf16_t* QAN = (bf16_t*)(a.ws + WS_MQAN); bf16_t* CKVN = (bf16_t*)(a.ws + WS_MCKVN); bf16_t* K = (bf16_t*)(a.ws + WS_MK);
    const f32x2* tab = (const f32x2*)(a.ws + WS_TAB + 16384);
    for (int r = gw; r < R; r += NGW) {
        ROW_DECODE(r);
        const bf16_t* ap = AP + (size_t)r * 1280;
#pragma unroll
        for (int part = 0; part < 2; ++part) {
            float f8_[8]; att::unpack8(*(const bf16x8*)(ap + part * 512 + lane * 8), f8_);
            const f32x4 v0 = {f8_[0], f8_[1], f8_[2], f8_[3]}, v1 = {f8_[4], f8_[5], f8_[6], f8_[7]};
            float ss = (v0[0] * v0[0] + v0[1] * v0[1]) + (v0[2] * v0[2] + v0[3] * v0[3]) + (v1[0] * v1[0] + v1[1] * v1[1]) + (v1[2] * v1[2] + v1[3] * v1[3]);
            const float rstd = 1.0f / sqrtf(wave_sum(ss) * (1.0f / 512.0f) + 1e-6f);
            const float* gp = (part == 0 ? a.mla_q_a_g : a.mla_kv_a_g) + lane * 8;
            const f32x4 g0 = *(const f32x4*)gp, g1 = *(const f32x4*)(gp + 4);
            const f32x4 o0 = v0 * rstd * g0, o1 = v1 * rstd * g1;
            u32x4 w = {cvt_pk_bf16(o0[0], o0[1]), cvt_pk_bf16(o0[2], o0[3]), cvt_pk_bf16(o1[0], o1[1]), cvt_pk_bf16(o1[2], o1[3])};
            *(u32x4*)((part == 0 ? QAN : CKVN) + (size_t)r * 512 + lane * 8) = w;
        }
        float v = bf2f(ap[1024 + lane]);
        if (!isctx_) {
            const int t = p_ - CTX, pos = (lane & 32) ? (t & 63) : (t >> 6);
            const f32x2 cs = tab[pos * 16 + (lane & 15)];
            const float other = __shfl_xor(v, 16);
            v = (lane & 16) ? v * cs.x + other * cs.y : v * cs.x - other * cs.y;
        }
        const bf16_t kb = f2bf(v);
#pragma unroll
        for (int h = 0; h < 16; ++h) K[(size_t)r * 3072 + h * 192 + 128 + lane] = kb;
    }
}
__device__ __forceinline__ void ph_conv(CArgs& a, int vcu, int G) {
    const int tid_ = tid_opaque(), lane = tid_ & 63, gw = vcu * NWAVES + (tid_ >> 6), NGW = G * NWAVES; (void)lane;
    const bf16_t* UP = (const bf16_t*)(a.ws + WS_LUP); bf16_t* U = (bf16_t*)(a.ws + WS_LU);
    for (int r = gw; r < R; r += NGW) {
        ROW_DECODE(r);
        const int lo = isctx_ ? 0 : CTX, hi = isctx_ ? CTX : TB;
#pragma unroll
        for (int it = 0; it < 4; ++it) { const int idx = it * 512 + lane * 8;
            float acc[8];
            { const f32x4 b0 = *(const f32x4*)(a.lru_conv_b + idx), b1 = *(const f32x4*)(a.lru_conv_b + idx + 4);
              acc[0] = b0[0]; acc[1] = b0[1]; acc[2] = b0[2]; acc[3] = b0[3]; acc[4] = b1[0]; acc[5] = b1[1]; acc[6] = b1[2]; acc[7] = b1[3]; }
#pragma unroll
            for (int j = 0; j < 4; ++j) { const int pp = p_ + j - 2;
                if (pp >= lo && pp < hi) {
                    float f[8]; att::unpack8(*(const bf16x8*)(UP + (size_t)(r + j - 2) * DM + idx), f);
                    const f32x4 w0 = *(const f32x4*)(a.lru_conv_w + j * DM + idx), w1 = *(const f32x4*)(a.lru_conv_w + j * DM + idx + 4);
                    acc[0] += f[0] * w0[0]; acc[1] += f[1] * w0[1]; acc[2] += f[2] * w0[2]; acc[3] += f[3] * w0[3];
                    acc[4] += f[4] * w1[0]; acc[5] += f[5] * w1[1]; acc[6] += f[6] * w1[2]; acc[7] += f[7] * w1[3]; } }
            *(bf16x8*)(U + (size_t)r * DM + idx) = att::pack8(acc); }
    }
}
__device__ __forceinline__ void scan_step(f32x4& h, u32x2 la, u32x2 gu, f32x4* Pacc) {
    f32x4 av = {__builtin_amdgcn_exp2f(bf_lo(la.x)), __builtin_amdgcn_exp2f(bf_hi(la.x)), __builtin_amdgcn_exp2f(bf_lo(la.y)), __builtin_amdgcn_exp2f(bf_hi(la.y))};
    const f32x4 gv = {bf_lo(gu.x), bf_hi(gu.x), bf_lo(gu.y), bf_hi(gu.y)};
    f32x4 s; s[0] = sqrtf(fmaxf(1.0f - av[0] * av[0], 0.f)); s[1] = sqrtf(fmaxf(1.0f - av[1] * av[1], 0.f)); s[2] = sqrtf(fmaxf(1.0f - av[2] * av[2], 0.f)); s[3] = sqrtf(fmaxf(1.0f - av[3] * av[3], 0.f));
    h = av * h + s * gv; if (Pacc) *Pacc = *Pacc * av;
}
__device__ __forceinline__ void ph_scan1(CArgs& a, int vcu, int G) {
    const int tid_ = tid_opaque(), lane = tid_ & 63, gw = vcu * NWAVES + (tid_ >> 6), NGW = G * NWAVES; (void)lane;
    float* PS = (float*)(a.ws + WS_LPS);
    for (int item = gw; item < NB * NCH * 2 * 8; item += NGW) {
        const int cg = item & 7, dir = (item >> 3) & 1, bq = item >> 4, b = bq / NCH, q = bq % NCH;
        const bf16_t* A = (const bf16_t*)(a.ws + (dir ? WS_LAB : WS_LAF)); const bf16_t* GU = (const bf16_t*)(a.ws + (dir ? WS_LGUB : WS_LGUF));
        const size_t base = ((size_t)b * TB + q * 32) * DM + cg * 256 + lane * 4;
        f32x4 h = {0.f, 0.f, 0.f, 0.f}, P = {1.f, 1.f, 1.f, 1.f};
#pragma unroll 8
        for (int i = 0; i < 32; ++i) { const int rr = dir ? 31 - i : i;
            scan_step(h, *(const u32x2*)(A + base + (size_t)rr * DM), *(const u32x2*)(GU + base + (size_t)rr * DM), &P); }
        float* o = PS + ((size_t)(bq * 2 + dir) * 2) * DM + cg * 256 + lane * 4;
        *(f32x4*)o = P; *(f32x4*)(o + DM) = h;
    }
}
__device__ __forceinline__ void ph_scan2(CArgs& a, LAS unsigned char* lds, int vcu, int G) {
    const float* PS = (const float*)(a.ws + WS_LPS); float* CIN = (float*)(a.ws + WS_LCIN);
    const int tid = tid_opaque(), lane = tid & 63, seg = tid >> 6;
    LAS float* sm = (LAS float*)lds;
    for (int v = vcu; v < NB * 2 * (DM / 64); v += G) {
        const int cb = v % (DM / 64), dir = (v / (DM / 64)) & 1, b = v / (2 * (DM / 64)), c = cb * 64 + lane;
        float P[17], S[17];
#pragma unroll
        for (int k = 0; k < 17; ++k) { const int i = seg * 17 + k, q = dir == 0 ? i : (i < 8 ? 7 - i : NCH - 1 - (i - 8)); const size_t bq = (size_t)b * NCH + q;
            P[k] = PS[((bq * 2 + dir) * 2) * DM + c]; S[k] = PS[((bq * 2 + dir) * 2 + 1) * DM + c]; }
        float pp = 1.f, ss = 0.f;
#pragma unroll
        for (int k = 0; k < 17; ++k) { ss = P[k] * ss + S[k]; pp *= P[k]; }
        sm[(seg * 2 + 0) * 64 + lane] = pp; sm[(seg * 2 + 1) * 64 + lane] = ss;
        __syncthreads();
        float carry = 0.f;
        for (int s2 = 0; s2 < seg; ++s2) carry = sm[(s2 * 2 + 0) * 64 + lane] * carry + sm[(s2 * 2 + 1) * 64 + lane];
#pragma unroll
        for (int k = 0; k < 17; ++k) { const int i = seg * 17 + k, q = dir == 0 ? i : (i < 8 ? 7 - i : NCH - 1 - (i - 8)); const size_t bq = (size_t)b * NCH + q;
            CIN[(bq * 2 + dir) * DM + c] = carry; carry = P[k] * carry + S[k]; }
        __syncthreads();
    }
}
__device__ __forceinline__ void ph_scan3(CArgs& a, int vcu, int G) {
    const int tid_ = tid_opaque(), lane = tid_ & 63, gw = vcu * NWAVES + (tid_ >> 6), NGW = G * NWAVES; (void)lane;
    const float* CIN = (const float*)(a.ws + WS_LCIN); const bf16_t* GY = (const bf16_t*)(a.ws + WS_LGY); bf16_t* Gout = (bf16_t*)(a.ws + WS_LG);
    const bf16_t* AF = (const bf16_t*)(a.ws + WS_LAF); const bf16_t* GUF = (const bf16_t*)(a.ws + WS_LGUF); const bf16_t* AB = (const bf16_t*)(a.ws + WS_LAB); const bf16_t* GUB = (const bf16_t*)(a.ws + WS_LGUB);
    for (int item = gw; item < NB * NCH * 8; item += NGW) {
        const int cg = item & 7, bq = item >> 3, b = bq / NCH, q = bq % NCH;
        const size_t base = ((size_t)b * TB + q * 32) * DM + cg * 256 + lane * 4;
        f32x4 hf[32];
        f32x4 h = *(const f32x4*)(CIN + ((size_t)bq * 2 + 0) * DM + cg * 256 + lane * 4);
#pragma unroll
        for (int i = 0; i < 32; ++i) { scan_step(h, *(const u32x2*)(AF + base + (size_t)i * DM), *(const u32x2*)(GUF + base + (size_t)i * DM), nullptr); hf[i] = h;
            if ((i & 7) == 7) __builtin_amdgcn_sched_barrier(0); }
        h = *(const f32x4*)(CIN + ((size_t)bq * 2 + 1) * DM + cg * 256 + lane * 4);
#pragma unroll
        for (int i = 31; i >= 0; --i) {
            scan_step(h, *(const u32x2*)(AB + base + (size_t)i * DM), *(const u32x2*)(GUB + base + (size_t)i * DM), nullptr);
            const u32x2 gy = *(const u32x2*)(GY + base + (size_t)i * DM);
            const f32x4 o = (hf[i] + h) * (f32x4){bf_lo(gy.x), bf_hi(gy.x), bf_lo(gy.y), bf_hi(gy.y)};
            *(u32x2*)(Gout + base + (size_t)i * DM) = (u32x2){cvt_pk_bf16(o[0], o[1]), cvt_pk_bf16(o[2], o[3])};
            if ((i & 7) == 0) __builtin_amdgcn_sched_barrier(0); }
    }
}
__device__ __forceinline__ void st_bf16x8(bf16_t* p, f32x4 v0, f32x4 v1) {
    u32x4 w = {cvt_pk_bf16(v0[0], v0[1]), cvt_pk_bf16(v0[2], v0[3]), cvt_pk_bf16(v1[0], v1[1]), cvt_pk_bf16(v1[2], v1[3])}; *(u32x4*)p = w; }
struct FStoreF32 { float* O; int ld;
    __device__ __forceinline__ void begin(const pg8::Unit&, int) {}
    __device__ __forceinline__ void row8(int row, int, int col, f32x4 v0, f32x4 v1) { float* p = O + (size_t)row * ld + col; *(f32x4*)p = v0; *(f32x4*)(p + 4) = v1; } };
struct FOut { bf16_t* O; bf16_t* PART; bf16_t* dst; int rowadj;
    __device__ __forceinline__ void begin(const pg8::Unit& u, int) {
        if (u.slice >= 0) { dst = PART + (size_t)u.slice * (NB * CTX) * DM; rowadj = (u.pm / 17) * CTX - u.pm * 256; } else { dst = O; rowadj = 0; } }
    __device__ __forceinline__ void row8(int row, int, int col, f32x4 v0, f32x4 v1) { st_bf16x8(dst + (size_t)(row + rowadj) * DM + col, v0, v1); } };
struct FBf16 { bf16_t* O; int ld;
    __device__ __forceinline__ void begin(const pg8::Unit&, int) {}
    __device__ __forceinline__ void row8(int row, int, int col, f32x4 v0, f32x4 v1) { st_bf16x8(O + (size_t)row * ld + col, v0, v1); } };
struct FQkv { bf16_t *Q, *K, *V; bf16_t* base; int ld, coff;
    __device__ __forceinline__ void begin(const pg8::Unit& u, int) { if (u.pn < 8) { base = Q; ld = 2048; coff = 0; } else if (u.pn < 10) { base = K; ld = 512; coff = 2048; } else { base = V; ld = 512; coff = 2560; } }
    __device__ __forceinline__ void row8(int row, int, int col, f32x4 v0, f32x4 v1) { st_bf16x8(base + (size_t)row * ld + (col - coff), v0, v1); } };
struct FRelu2 { bf16_t* O;
    __device__ __forceinline__ void begin(const pg8::Unit&, int) {}
    __device__ __forceinline__ void row8(int row, int, int col, f32x4 v0, f32x4 v1) {
#pragma unroll
        for (int i = 0; i < 4; ++i) { const float a = fmaxf(v0[i], 0.f), b = fmaxf(v1[i], 0.f); v0[i] = a * a; v1[i] = b * b; }
        st_bf16x8(O + (size_t)row * DFF + col, v0, v1); } };
__device__ __forceinline__ float gelu_tanh(float x) { const float z = 1.5957691216057308f * (x + 0.044715f * x * x * x); return x * __builtin_amdgcn_rcpf(1.0f + __builtin_amdgcn_exp2f(-1.4426950408889634f * z)); }
struct FLruXY { bf16_t *UP, *GY; bool gy;
    __device__ __forceinline__ void begin(const pg8::Unit& u, int) { gy = u.pn >= 8; }
    __device__ __forceinline__ void row8(int row, int, int col, f32x4 v0, f32x4 v1) {
        if (gy) {
#pragma unroll
            for (int i = 0; i < 4; ++i) { v0[i] = gelu_tanh(v0[i]); v1[i] = gelu_tanh(v1[i]); }
            st_bf16x8(GY + (size_t)row * DM + (col - 2048), v0, v1);
        } else st_bf16x8(UP + (size_t)row * DM + col, v0, v1); } };
struct EpiGates {
    static constexpr bool PERM = true;
    bf16_t* OUT4; const bf16_t* U; const float *ra_b, *ix_b, *lam;
    __device__ __forceinline__ void operator()(const f32x4 (&acc)[2][2][4][2], const pg8::Unit& u, int wr, int wc, int fr, int fq) const {
        const int which = u.pn >> 3, dir = which >> 1, ty = which & 1, ch0 = (u.pn & 7) * 256 + wc * 32 + 8 * fq, row0 = u.pm * 256 + wr * 64 + fr;
        bf16_t* dst = OUT4 + (size_t)which * ((size_t)R * DM);
        const float* bp = (ty == 0 ? ra_b : ix_b) + dir * DM;
#pragma unroll
        for (int bj = 0; bj < 2; ++bj) {
            const int ch = ch0 + bj * 128;
            const f32x4 b0 = *(const f32x4*)(bp + ch), b1 = *(const f32x4*)(bp + ch + 4);
            f32x4 l0 = {0.f, 0.f, 0.f, 0.f}, l1 = {0.f, 0.f, 0.f, 0.f};
            if (ty == 0) { l0 = *(const f32x4*)(lam + dir * DM + ch) * 1.4426950408889634f; l1 = *(const f32x4*)(lam + dir * DM + ch + 4) * 1.4426950408889634f; }
#pragma unroll
            for (int ai = 0; ai < 2; ++ai)
#pragma unroll
                for (int m = 0; m < 4; ++m) {
                    const int row = row0 + ai * 128 + m * 16;
                    const f32x4 x0 = acc[ai][bj][m][0] + b0, x1 = acc[ai][bj][m][1] + b1; f32x4 o0, o1;
                    if (ty == 0) {
#pragma unroll
                        for (int j = 0; j < 4; ++j) { o0[j] = l0[j] * sigmoidf_(x0[j]); o1[j] = l1[j] * sigmoidf_(x1[j]); }
                    } else {
                        const u32x4 uw = *(const u32x4*)(U + (size_t)row * DM + ch);
                        o0[0] = sigmoidf_(x0[0]) * bf_lo(uw.x); o0[1] = sigmoidf_(x0[1]) * bf_hi(uw.x); o0[2] = sigmoidf_(x0[2]) * bf_lo(uw.y); o0[3] = sigmoidf_(x0[3]) * bf_hi(uw.y);
                        o1[0] = sigmoidf_(x1[0]) * bf_lo(uw.z); o1[1] = sigmoidf_(x1[1]) * bf_hi(uw.z); o1[2] = sigmoidf_(x1[2]) * bf_lo(uw.w); o1[3] = sigmoidf_(x1[3]) * bf_hi(uw.w);
                    }
                    st_bf16x8(dst + (size_t)row * DM + ch, o0, o1);
                    __builtin_amdgcn_sched_barrier(0);
                }
        }
    } };
struct FKvb { bf16_t *K, *V;
    __device__ __forceinline__ void begin(const pg8::Unit&, int) {}
    __device__ __forceinline__ void row8(int row, int, int col, f32x4 v0, f32x4 v1) {
        bf16_t* p = col < 2048 ? K + (size_t)row * 3072 + (col >> 7) * 192 + (col & 127) : V + (size_t)row * DM + (col - 2048);
        st_bf16x8(p, v0, v1); } };

template <class F>
__device__ __forceinline__ void run_gemm(LAS unsigned char* lds, const bf16_t* A, int lda, const bf16_t* Bt, int ldb, int N, int K, int a_blk, F f, int G, int rot = 0) {
    pg8::Gemm g{A, Bt, R, N, K, lda, ldb, a_blk}; pg8::StaticOrder S; S.init(R, N, K, G, ((int)blockIdx.x + rot) % G);
    pg8::EpiRow8<F> E{f};
    PROBE_REPEAT_GEMM
    pg8::gemm_phase<pg8::EpiRow8<F>, pg8::StaticOrder, true, true>(lds, g, S, E);
}

__device__ __forceinline__ void run_gemm_out(LAS unsigned char* lds, const bf16_t* A, int lda, const bf16_t* Bt, int K, int SK, bf16_t* OUTF, bf16_t* PART, int G) {
    pg8::Gemm g{A, Bt, R, DM, K, lda, K, 0}; pg8::LatOrder S; S.init(DM, K, G, (int)blockIdx.x, SK, K == DFF ? 1 : 0);
    pg8::EpiRow8<FOut> E{FOut{OUTF, PART, nullptr, 0}};
    PROBE_REPEAT_GEMM
    pg8::gemm_phase<pg8::EpiRow8<FOut>, pg8::LatOrder, true, true>(lds, g, S, E);
}
template <class F>
__device__ __forceinline__ void run_gemm_lat(LAS unsigned char* lds, const bf16_t* A, int lda, const bf16_t* Bt, int ldb, int N, int K, F f, int G) {
    pg8::Gemm g{A, Bt, R, N, K, lda, ldb, 0}; pg8::LatOrder S; S.init(N, K, G, (int)blockIdx.x, 0);
    pg8::EpiRow8<F> E{f};
    PROBE_REPEAT_GEMM
    pg8::gemm_phase<pg8::EpiRow8<F>, pg8::LatOrder, true, true>(lds, g, S, E);
}

__device__ __forceinline__ void ph_attn_gqa(CArgs& a, char* lds, const float* qg, const float* kg, bool ctx_units, int vcu, int G) {
    const bf16_t* Q = (const bf16_t*)(a.ws + WS_GQ); const bf16_t* K = (const bf16_t*)(a.ws + WS_GK); const bf16_t* V = (const bf16_t*)(a.ws + WS_GV); bf16_t* O = (bf16_t*)(a.ws + WS_GO);
    const f32x2* tab = (const f32x2*)(a.ws + WS_TAB);
    const int nun = ctx_units ? 1088 : 1024;
    bool fast;
    { const int lane = tid_opaque() & 63; float gq = fmaxf(fabsf(qg[lane]), fabsf(qg[lane + 64])), gk = fmaxf(fabsf(kg[lane]), fabsf(kg[lane + 64]));
#pragma unroll
      for (int o = 1; o < 64; o <<= 1) { gq = fmaxf(gq, __shfl_xor(gq, o)); gk = fmaxf(gk, __shfl_xor(gk, o)); }
      fast = __builtin_amdgcn_readfirstlane((16.3224f * gq * gk <= 40.0f) ? 1 : 0) != 0; }
#define GQA_UNITS(NM) \
    for (int id = vcu; id < nun; id += G) { \
        int b, h, row0, seq, tok0; bool rope; \
        if (id < 1024) { const int bk = id >> 6; b = bk >> 2; h = (bk & 3) * 4 + ((id & 63) >> 4); const int qb = id & 15; row0 = b * TB + CTX + qb * 256; seq = TB; tok0 = qb * 256; rope = true; } \
        else { const int j = id - 1024; b = j >> 4; h = j & 15; row0 = b * TB; seq = CTX; tok0 = 0; rope = false; } \
        const int kvh = h >> 2; \
        att::attn_body_dma<128, 2048, 512, 512, 2048, NM>(Q + (size_t)row0 * 2048 + h * 128, K + (size_t)b * TB * 512 + kvh * 128, V + (size_t)b * TB * 512 + kvh * 128, \
                                                  O + (size_t)row0 * 2048 + h * 128, seq, lds, qg, tab, rope, tok0); }
    PROBE_REPEAT_ATTN
    { if (fast) { GQA_UNITS(true) } else { GQA_UNITS(false) } }
#undef GQA_UNITS
}
__device__ __forceinline__ void ph_attn_mla(CArgs& a, char* lds, bool ctx_units, int vcu, int G) {
    const bf16_t* Q = (const bf16_t*)(a.ws + WS_MQ); const bf16_t* K = (const bf16_t*)(a.ws + WS_MK); const bf16_t* V = (const bf16_t*)(a.ws + WS_MV); bf16_t* O = (bf16_t*)(a.ws + WS_MO);
    const f32x2* tab = (const f32x2*)(a.ws + WS_TAB + 16384);
    const int nun = ctx_units ? 1088 : 1024;
    PROBE_REPEAT_ATTN
    for (int id = vcu; id < nun; id += G) {
        int b, h, row0, seq, tok0; bool rope;
        if (id < 1024) { const int bh = id >> 4; b = bh >> 4; h = bh & 15; const int qb = id & 15; row0 = b * TB + CTX + qb * 256; seq = TB; tok0 = qb * 256; rope = true; }
        else { const int j = id - 1024; b = j >> 4; h = j & 15; row0 = b * TB; seq = CTX; tok0 = 0; rope = false; }
        att::attn_body_dma<192, 3072, 3072, 2048, 2048>(Q + (size_t)row0 * 3072 + h * 192, K + (size_t)b * TB * 3072 + h * 192, V + (size_t)b * TB * DM + h * 128,
                                                    O + (size_t)row0 * DM + h * 128, seq, lds, nullptr, tab, rope, tok0);
    }
}

constexpr int NPHASES = 38;
__global__ void __launch_bounds__(NWAVES * 64, 2) trunk_fwd(Args a_unused) {
#define a (*kargs())
    extern __shared__ __attribute__((aligned(16))) unsigned char lds_raw[];
    LAS unsigned char* lds = (LAS unsigned char*)lds_raw;
    const int tid = threadIdx.x;
    const int G = gridDim.x; const int bx = blockIdx.x; const int vcu = (G % 8 == 0) ? (bx % 8) * (G / 8) + bx / 8 : bx;
#define ws (a.ws)
    for (int u = tid; u < (LDS_BYTES - LDSCTL_OFF) / 4; u += NWAVES * 64) ((LAS unsigned*)(lds + LDSCTL_OFF))[u] = 0u;
    __syncthreads();
    if (a.ph_hi - a.ph_lo > 1) (void)xcd_barrier_post((unsigned*)(ws + WS_CTL) + 1024, (volatile LAS unsigned*)(lds + LDSCTL_OFF + 64));
    int ph = 0;
#ifndef PH_FILTER
#define PH_FILTER(p) true
#endif
#ifdef PROBE_STAMP_A
    unsigned long long st_prev = __builtin_amdgcn_s_memrealtime(), st_a = 0, st_b = 0; int st_cls = 0;
#define ST_CLS(c) st_cls = (c);
#define ST_ACC { const unsigned long long now_ = __builtin_amdgcn_s_memrealtime(); if (st_cls == PROBE_STAMP_A) st_a += now_ - st_prev; if (st_cls == PROBE_STAMP_B) st_b += now_ - st_prev; st_prev = now_; }
#else
#define ST_CLS(c)
#define ST_ACC
#endif
#define PH_BEGIN if (PH_FILTER(ph) && ph >= a.ph_lo && ph < a.ph_hi) {
#define MKBAR() XcdBarrier{(unsigned*)(ws + WS_CTL) + 1024, xb_xcc_id(), (volatile LAS unsigned*)(lds + LDSCTL_OFF + 64)}
#define PH_END   if (ph + 1 < a.ph_hi) xcd_barrier(MKBAR()); ST_ACC } ++ph;

    ST_CLS(0) PH_BEGIN ph_mods(a, lds, vcu, G); __syncthreads(); ph_transposes(a, lds, vcu, G); PH_END
    ST_CLS(1) PH_BEGIN ph_init(a, vcu, G); PH_END

#define Hb ((bf16_t*)(ws + WS_H))
#define OUTF ((bf16_t*)(ws + WS_OUTF))
#define ACT ((bf16_t*)(ws + WS_ACT))

#define PARTB ((bf16_t*)(ws + WS_PART))
#define MLP_PHASES(L) \
    ST_CLS(4) PH_BEGIN ph_ln<false, 1>(a, lds, L, 0, vcu, G); PH_END \
    ST_CLS(5) PH_BEGIN run_gemm(lds, Hb, DM, (const bf16_t*)(ws + WS_W1T) + (size_t)(L) * DFF * DM, DM, DFF, DM, 0, FRelu2{ACT}, G); PH_END \
    ST_CLS(6) PH_BEGIN run_gemm_out(lds, ACT, DFF, (const bf16_t*)(ws + WS_W2T) + (size_t)(L) * DM * DFF, DFF, 8, OUTF, PARTB, G); PH_END \
    ST_CLS(4) PH_BEGIN ph_ln<false, 1>(a, lds, L, 1, vcu, G); PH_END
#define MLP_PHASES_LAST(L) \
    ST_CLS(4) PH_BEGIN ph_ln<false, 2>(a, lds, L, 0, vcu, G); PH_END \
    ST_CLS(5) PH_BEGIN run_gemm_lat(lds, Hb, DM, (const bf16_t*)(ws + WS_W1T) + (size_t)(L) * DFF * DM, DM, DFF, DM, FRelu2{ACT}, G); PH_END \
    ST_CLS(6) PH_BEGIN run_gemm_out(lds, ACT, DFF, (const bf16_t*)(ws + WS_W2T) + (size_t)(L) * DM * DFF, DFF, 0, OUTF, PARTB, G); PH_END \
    ST_CLS(4) PH_BEGIN ph_ln<true, 2>(a, lds, L, 1, vcu, G); PH_END

#define GQA_LAYER(L, SLOT, LASTL) \
    ST_CLS(2) PH_BEGIN run_gemm(lds, Hb, DM, (const bf16_t*)(ws + WS_GQAW + (SLOT) * 20 * MiB), DM, 3072, DM, 0, FQkv{(bf16_t*)(ws + WS_GQ), (bf16_t*)(ws + WS_GK), (bf16_t*)(ws + WS_GV), nullptr, 0, 0}, G); PH_END \
    ST_CLS(1) PH_BEGIN ph_knorm(a, a.gqa_k_g + (SLOT) * 128, vcu, G); PH_END \
    ST_CLS(3) PH_BEGIN ph_attn_gqa(a, (char*)lds_raw, a.gqa_q_g + (SLOT) * 128, a.gqa_k_g + (SLOT) * 128, !(LASTL), vcu, G); PH_END \
    ST_CLS(2) PH_BEGIN run_gemm_out(lds, (const bf16_t*)(ws + WS_GO), DM, (const bf16_t*)(ws + WS_GQAW + (SLOT) * 20 * MiB + 12 * MiB), DM, (LASTL) ? 0 : 8, OUTF, PARTB, G); PH_END

    GQA_LAYER(0, 0, false)
    MLP_PHASES(0)
    ST_CLS(2) PH_BEGIN run_gemm(lds, Hb, DM, (const bf16_t*)(ws + WS_LRUW), DM, 4096, DM, 0, FLruXY{(bf16_t*)(ws + WS_LUP), (bf16_t*)(ws + WS_LGY), false}, G); PH_END
    ST_CLS(1) PH_BEGIN ph_conv(a, vcu, G); PH_END
    ST_CLS(2) PH_BEGIN { EpiGates eg{(bf16_t*)(ws + WS_LAF), (const bf16_t*)(ws + WS_LU), a.lru_ra_b, a.lru_ix_b, (const float*)(ws + WS_TAB + 32768)};
               pg8::Gemm g{(const bf16_t*)(ws + WS_LU), (const bf16_t*)(ws + WS_LRUW + 16 * MiB), R, 8192, 256, DM, 256, 1}; pg8::StaticOrder S; S.init(R, 8192, 256, G, (int)blockIdx.x);
               PROBE_REPEAT_GEMM
               pg8::gemm_phase<EpiGates, pg8::StaticOrder, true, true>(lds, g, S, eg); } PH_END
    ST_CLS(7) PH_BEGIN ph_scan1(a, vcu, G); PH_END
    PH_BEGIN ph_scan2(a, lds, vcu, G); PH_END
    PH_BEGIN ph_scan3(a, vcu, G); PH_END
    ST_CLS(2) PH_BEGIN run_gemm_out(lds, (const bf16_t*)(ws + WS_LG), DM, (const bf16_t*)(ws + WS_LRUW + 20 * MiB), DM, 8, OUTF, PARTB, G); PH_END
    MLP_PHASES(1)
    ST_CLS(2) PH_BEGIN run_gemm(lds, Hb, DM, (const bf16_t*)(ws + WS_MLAW), DM, 1280, DM, 0, FBf16{(bf16_t*)(ws + WS_MAP), 1280}, G); PH_END
    ST_CLS(1) PH_BEGIN ph_mla_norm(a, vcu, G); PH_END
    ST_CLS(2) PH_BEGIN run_gemm(lds, (const bf16_t*)(ws + WS_MQAN), 512, (const bf16_t*)(ws + WS_MLAW + 5 * MiB), 512, 3072, 512, 0, FBf16{(bf16_t*)(ws + WS_MQ), 3072}, G);
             run_gemm(lds, (const bf16_t*)(ws + WS_MCKVN), 512, (const bf16_t*)(ws + WS_MLAW + 8 * MiB), 512, 4096, 512, 0, FKvb{(bf16_t*)(ws + WS_MK), (bf16_t*)(ws + WS_MV)}, G, G / 2); PH_END
    ST_CLS(3) PH_BEGIN ph_attn_mla(a, (char*)lds_raw, true, vcu, G); PH_END
    ST_CLS(2) PH_BEGIN run_gemm_out(lds, (const bf16_t*)(ws + WS_MO), DM, (const bf16_t*)(ws + WS_MLAW + 12 * MiB), DM, 8, OUTF, PARTB, G); PH_END
    MLP_PHASES(2)
    GQA_LAYER(3, 1, true)
    MLP_PHASES_LAST(3)
#ifdef PROBE_STAMP_A
    xcd_barrier(MKBAR());
    if (blockIdx.x == 0) {
        LAS float* sh = (LAS float*)(lds + LDSCTL_OFF + 256);
        if (tid == 0) { float va = (float)st_a * 0.01f, vb = (float)st_b * 0.01f;
            { float pw = 1.f; while (pw * 100.f <= va) pw *= 10.f; va = rintf(va / pw) * pw; }
            { float pw = 1.f; while (pw * 100.f <= vb) pw *= 10.f; vb = rintf(vb / pw) * pw; }
            sh[0] = va; sh[1] = vb; }
        __syncthreads();
        const float ta = sh[0], tb = sh[1];
        for (int i = 1 + tid; i <= (1 << 20); i += 512) a.out[i] = tb;
        if (tid == 0) a.out[0] = ta;
    }
#endif
#undef PH_BEGIN
#undef PH_END
#undef ws
#undef a
#undef Hb
#undef OUTF
#undef ACT
#undef PARTB
}

#ifndef MK_SPLIT
#define MK_SPLIT 0
#endif
extern "C" void kernel_launch(void* const* d_in, const int* in_sizes, int n_in, void* d_out, int out_size, void* d_ws, size_t ws_size, hipStream_t stream) {
    static int grid = 0;
    if (grid == 0) {
        if (n_in != 33 || in_sizes[0] != NB * SEQ * DM || out_size != NB * SEQ * DM || ws_size < WS_END) {
            fprintf(stderr, "kernel_launch: unexpected shapes: n_in %d in0 %d out %d ws %zu (need %zu)\n", n_in, n_in > 0 ? in_sizes[0] : -1, out_size, ws_size, (size_t)WS_END); grid = -1; return; }
        int dev = 0, cus = 0;
        if (hipGetDevice(&dev) != hipSuccess || hipDeviceGetAttribute(&cus, hipDeviceAttributeMultiprocessorCount, dev) != hipSuccess) { grid = -1; return; }
        if (hipFuncSetAttribute((const void*)trunk_fwd, hipFuncAttributeMaxDynamicSharedMemorySize, LDS_BYTES) != hipSuccess) { fprintf(stderr, "kernel_launch: hipFuncSetAttribute failed\n"); grid = -1; return; }
        int per_cu = 0;
        if (hipOccupancyMaxActiveBlocksPerMultiprocessor(&per_cu, (const void*)trunk_fwd, NWAVES * 64, LDS_BYTES) != hipSuccess || per_cu < 1)
            fprintf(stderr, "kernel_launch: occupancy query reports %d workgroups per CU\n", per_cu);
        (void)hipGetLastError();
        grid = cus;
    }
    if (grid < 0) return;
    if (hipMemsetAsync((char*)d_ws + WS_CTL, 0, CTL_ZERO_BYTES, stream) != hipSuccess) return;
    Args a{};
    const float** p = (const float**)&a;
    for (int i = 0; i < 33; ++i) p[i] = (const float*)d_in[i];
    a.out = (float*)d_out; a.ws = (unsigned char*)d_ws;
#ifdef PROBE_PREFIX
    a.ph_lo = 0; a.ph_hi = PROBE_PREFIX; hipLaunchKernelGGL(trunk_fwd, dim3(grid), dim3(NWAVES * 64), LDS_BYTES, stream, a);
    (void)hipMemsetAsync((char*)d_ws + WS_CTL, 0, CTL_ZERO_BYTES, stream);
    a.ph_lo = 0; a.ph_hi = NPHASES; hipLaunchKernelGGL(trunk_fwd, dim3(grid), dim3(NWAVES * 64), LDS_BYTES, stream, a);
#elif MK_SPLIT
    for (int k = 0; k < NPHASES; ++k) { a.ph_lo = k; a.ph_hi = k + 1; hipLaunchKernelGGL(trunk_fwd, dim3(grid), dim3(NWAVES * 64), LDS_BYTES, stream, a); }
#else
    a.ph_lo = 0; a.ph_hi = NPHASES; hipLaunchKernelGGL(trunk_fwd, dim3(grid), dim3(NWAVES * 64), LDS_BYTES, stream, a);
#endif
    const hipError_t le = hipPeekAtLastError();
    if (le != hipSuccess) fprintf(stderr, "kernel_launch: launch failed: %s\n", hipGetErrorName(le));
}
```

```cpp
#include <hip/hip_runtime.h>
#include <cstdio>
#include <cstdint>
#include <cmath>

#define LAS __attribute__((address_space(3)))
#define GAS __attribute__((address_space(1)))
typedef unsigned short bf16_t;
typedef short bf16x8 __attribute__((ext_vector_type(8)));
typedef short s16x4 __attribute__((ext_vector_type(4)));
typedef float f32x4 __attribute__((ext_vector_type(4)));
typedef float f32x2 __attribute__((ext_vector_type(2)));
typedef float f32x16 __attribute__((ext_vector_type(16)));
typedef unsigned u32x4 __attribute__((ext_vector_type(4)));
typedef unsigned u32x2 __attribute__((ext_vector_type(2)));

__device__ __forceinline__ unsigned cvt_pk_bf16(float lo, float hi) { unsigned r; asm volatile("v_cvt_pk_bf16_f32 %0, %1, %2" : "=v"(r) : "v"(lo), "v"(hi)); return r; }
__device__ __forceinline__ float bf_lo(unsigned w) { return __uint_as_float(w << 16); }
__device__ __forceinline__ float bf_hi(unsigned w) { return __uint_as_float(w & 0xffff0000u); }
__device__ __forceinline__ float bf2f(bf16_t h) { return __uint_as_float(((unsigned)h) << 16); }
__device__ __forceinline__ bf16_t f2bf(float f) { return (bf16_t)(cvt_pk_bf16(f, f) & 0xffffu); }

constexpr int DM = 2048, NB = 4, SEQ = 4096, CTX = 256, TB = SEQ + CTX  , R = NB * TB  , DFF = 8192, DEPTH = 4;
constexpr float LN_EPS = 1e-6f;
constexpr float DN_ALPHA = 1.6817928305074290861f;

namespace pg8 {
constexpr int BM = 256, BK = 64, HALF = 128, HTB = HALF * BK * 2, STAGE_BYTES = 8 * HTB, NXCD = 8, WGM = 4;
__host__ __device__ __forceinline__ int lds_byte(int r, int c) { const int st = (r >> 4) * 2 + (c >> 5), rr = r & 15, cc = c & 31, ob = rr * 64 + cc * 2; return st * 1024 + (ob ^ (((ob >> 9) & 1) << 5)); }
__host__ __device__ __forceinline__ void stage_rc(int b, int& Rr, int& C) { const int st = b / 1024, sb = b % 1024, swz = sb ^ (((sb >> 9) & 1) << 5); Rr = (st >> 1) * 16 + swz / 64; C = (st & 1) * 32 + (swz % 64) / 2; }
__host__ __device__ __forceinline__ int perm32(int rho) { const int n = rho >> 4, i = rho & 15; return 8 * (i >> 2) + 4 * n + (i & 3); }

struct Unit { int pm, pn, k0, nk, slice; };
struct Gemm { const bf16_t* A; const bf16_t* Bt; int M, N, K, lda, ldb, a_blk; };

struct StaticOrder {
    int nM, nN, nwg, G, c, nt;
    __device__ __forceinline__ void init(int M, int N, int K, int G_, int c_) { nM = M / BM; nN = N / BM; nwg = nM * nN; G = G_; c = c_; nt = K / BK; }
    __device__ __forceinline__ Unit next(int i) const {
        const long L = (long)i * G + c; if (L >= nwg) return Unit{-1, 0, 0, 0, -1};
        int wgid = (int)L; { const int q = nwg / NXCD, r = nwg % NXCD, xcd = wgid % NXCD, off = wgid / NXCD; wgid = (xcd < r ? xcd * (q + 1) : r * (q + 1) + (xcd - r) * q) + off; }
        const int nig = WGM * nN, gid = wgid / nig, fm = gid * WGM, gsz = (nM - fm) < WGM ? (nM - fm) : WGM;
        return Unit{fm + ((wgid % nig) % gsz), (wgid % nig) / gsz, 0, nt, -1};
    }
};
struct LatOrder {
    int nN, nwg, G, c, nt, SK, rev;
    __device__ __forceinline__ void init(int N, int K, int G_, int c_, int SK_, int rev_ = 0) { nN = N / BM; nwg = 64 * nN; G = G_; c = c_; nt = K / BK; SK = SK_; rev = rev_; }
    __device__ __forceinline__ Unit next(int i) const {
        const int nlat = c < nwg ? (nwg - c + G - 1) / G : 0;
        if (i < nlat) {
            int wgid = i * G + c; { const int q = nwg / NXCD, r = nwg % NXCD, xcd = wgid % NXCD, off = wgid / NXCD; wgid = (xcd < r ? xcd * (q + 1) : r * (q + 1) + (xcd - r) * q) + off; }
            const int nig = WGM * nN, gid = wgid / nig, fm = gid * WGM;
            int lp = fm + ((wgid % nig) % WGM); if (rev) lp = 63 - lp;
            return Unit{(lp >> 4) * 17 + 1 + (lp & 15), (wgid % nig) / WGM, 0, nt, -1};
        }
        if (SK > 0 && i >= nlat) { const int su = c + (i - nlat) * G;
            if (su < 4 * nN * SK) { const int t = su / SK, sl = su % SK, nks = nt / SK; return Unit{17 * (t / nN), t % nN, sl * nks, nks, sl}; } }
        return Unit{-1, 0, 0, 0, -1};
    }
};

template <class F> struct EpiRow8 {
    static constexpr bool PERM = true;
    F f;
    __device__ __forceinline__ void operator()(const f32x4 (&acc)[2][2][4][2], const Unit& u, int wr, int wc, int fr, int fq) {
        const int row0 = u.pm * BM + wr * 64 + fr, colb = u.pn * BM + wc * 32 + 8 * fq;
        f.begin(u, colb);
#pragma unroll
        for (int ai = 0; ai < 2; ++ai)
#pragma unroll
            for (int m = 0; m < 4; ++m) {
                const int row = row0 + ai * HALF + m * 16;
#pragma unroll
                for (int bj = 0; bj < 2; ++bj) f.row8(row, bj, colb + bj * HALF, acc[ai][bj][m][0], acc[ai][bj][m][1]);
            }
    }
};

template <class Epi, class Sched, bool ALIGN_EPI = true, bool SP2 = true>
__device__ __forceinline__ void gemm_phase(LAS unsigned char* lds, const Gemm g, const Sched& S, Epi& E) {
    int tid = threadIdx.x; asm volatile("" : "+v"(tid));
    const int wid = __builtin_amdgcn_readfirstlane(tid >> 6), lane = tid & 63, wr = wid >> 2, wc = wid & 3, fr = lane & 15, fq = lane >> 4;
    unsigned voffA[2], voffB[2];
#pragma unroll
    for (int i = 0; i < 2; ++i) { int Rr, C; stage_rc(tid * 16 + i * 8192, Rr, C); const int Rb = Epi::PERM ? ((Rr & ~31) + perm32(Rr & 31)) : Rr;
        voffA[i] = (unsigned)(Rr * g.lda + C) * 2u; voffB[i] = (unsigned)(Rb * g.ldb + C) * 2u; }
    const size_t kstep = (size_t)(BK * 2);
    const size_t hstepA = (size_t)HALF * g.lda * 2, hstepB = (size_t)HALF * g.ldb * 2;
    const size_t tstepA = 2 * hstepA, tstepB = 2 * hstepB;
    const unsigned ldsw = (unsigned)wid * 1024u;
    const int aoff = lds_byte(wr * 64 + fr, fq * 8), boff = lds_byte(wc * 32 + fr, fq * 8);
#define PG8_SA(b, h) (((b) * 2 + (h)) * HTB)
#define PG8_SB(b, h) ((4 + (b) * 2 + (h)) * HTB)
#define PG8_STAGE(bufoff, gbase, voff) do { _Pragma("unroll") for (int _i = 0; _i < 2; ++_i) \
        __builtin_amdgcn_global_load_lds((const unsigned*)((const char*)(gbase) + (voff)[_i]), (LAS unsigned*)(lds + (bufoff) + ldsw + _i * 8192), 16, 0, 0); } while (0)
#define PG8_LDA(dst, b, h) do { _Pragma("unroll") for (int m = 0; m < 4; ++m) _Pragma("unroll") for (int k = 0; k < 2; ++k) dst[m][k] = *(const LAS bf16x8*)(lds + PG8_SA(b, h) + aoff + m * 2048 + k * 1024); } while (0)
#define PG8_LDB(dst, b, h) do { _Pragma("unroll") for (int n = 0; n < 2; ++n) _Pragma("unroll") for (int k = 0; k < 2; ++k) dst[n][k] = *(const LAS bf16x8*)(lds + PG8_SB(b, h) + boff + n * 2048 + k * 1024); } while (0)
#define PG8_MMA(ai, bj, At, Bt) do { __builtin_amdgcn_s_setprio(1); _Pragma("unroll") for (int m = 0; m < 4; ++m) _Pragma("unroll") for (int n = 0; n < 2; ++n) _Pragma("unroll") for (int k = 0; k < 2; ++k) \
        acc[ai][bj][m][n] = __builtin_amdgcn_mfma_f32_16x16x32_bf16(Bt[n][k], At[m][k], acc[ai][bj][m][n], 0, 0, 0); __builtin_amdgcn_s_setprio(0); } while (0)
#define PG8_WAIT_V(n) asm volatile("s_waitcnt vmcnt(" #n ")" ::: "memory")
#define PG8_WAIT_L(n) asm volatile("s_waitcnt lgkmcnt(" #n ")" ::: "memory")
#define PG8_BAR __builtin_amdgcn_s_barrier()
#define PG8_SCHED __builtin_amdgcn_sched_barrier(0)
    Unit cur = S.next(0), nxt = cur; int ui = 0;
    if (cur.pm < 0) return;
    f32x4 acc[2][2][4][2];
#pragma unroll
    for (int a = 0; a < 2; ++a)
#pragma unroll
        for (int b = 0; b < 2; ++b)
#pragma unroll
            for (int m = 0; m < 4; ++m)
#pragma unroll
                for (int n = 0; n < 2; ++n) acc[a][b][m][n] = (f32x4){0.f, 0.f, 0.f, 0.f};
    bf16x8 At[4][2], B0[2][2], B1[2][2];
    const char* cA = (const char*)g.A + (size_t)cur.pm * tstepA + (size_t)(g.a_blk ? (cur.pn & 7) * 512 : 0) + (size_t)cur.k0 * kstep; const char* cB = (const char*)g.Bt + (size_t)cur.pn * tstepB + (size_t)cur.k0 * kstep;
    if constexpr (SP2) {
        PG8_STAGE(PG8_SB(0, 0), cB, voffB); PG8_STAGE(PG8_SB(0, 1), cB + hstepB, voffB); PG8_STAGE(PG8_SA(0, 0), cA, voffA); PG8_STAGE(PG8_SA(0, 1), cA + hstepA, voffA);
        if (wr == 1) PG8_BAR;
        PG8_WAIT_V(2); PG8_BAR;
        PG8_STAGE(PG8_SB(1, 0), cB + kstep, voffB); PG8_STAGE(PG8_SA(1, 0), cA + kstep, voffA); PG8_STAGE(PG8_SB(1, 1), cB + hstepB + kstep, voffB);
        PG8_WAIT_V(6); PG8_BAR;
    } else {
        PG8_STAGE(PG8_SB(0, 0), cB, voffB); PG8_STAGE(PG8_SA(0, 0), cA, voffA); PG8_STAGE(PG8_SB(0, 1), cB + hstepB, voffB); PG8_STAGE(PG8_SA(0, 1), cA + hstepA, voffA);
        if (wr == 1) PG8_BAR;
        PG8_WAIT_V(4); PG8_BAR;
        PG8_STAGE(PG8_SB(1, 0), cB + kstep, voffB); PG8_STAGE(PG8_SA(1, 0), cA + kstep, voffA); PG8_STAGE(PG8_SB(1, 1), cB + hstepB + kstep, voffB);
        PG8_WAIT_V(6); PG8_BAR;
    }
    for (;;) {
        nxt = S.next(ui + 1); const bool has_next = nxt.pm >= 0;
        const char* nA = has_next ? (const char*)g.A + (size_t)nxt.pm * tstepA + (size_t)(g.a_blk ? (nxt.pn & 7) * 512 : 0) + (size_t)nxt.k0 * kstep : cA; const char* nB = has_next ? (const char*)g.Bt + (size_t)nxt.pn * tstepB + (size_t)nxt.k0 * kstep : cB;
        const int nt = cur.nk;
#pragma unroll 1
        for (int t = 0; t < nt; t += 2) {
            const bool last = (t == nt - 2);
            const char* a1 = cA + (size_t)(t + 1) * kstep;
            const char* a2 = last ? nA : cA + (size_t)(t + 2) * kstep; const char* b2 = last ? nB : cB + (size_t)(t + 2) * kstep;
            const char* a3 = a2 + kstep; const char* b3 = b2 + kstep;
            if constexpr (SP2) {
            PG8_LDB(B0, 0, 0); PG8_LDB(B1, 0, 1); PG8_SCHED; PG8_LDA(At, 0, 0); PG8_STAGE(PG8_SA(1, 1), a1 + hstepA, voffA);
            PG8_WAIT_V(8); PG8_WAIT_L(0); PG8_BAR; PG8_MMA(0, 0, At, B0); PG8_MMA(0, 1, At, B1); PG8_BAR; PG8_SCHED;
            PG8_LDA(At, 0, 1); PG8_STAGE(PG8_SB(0, 0), b2, voffB); PG8_STAGE(PG8_SB(0, 1), b2 + hstepB, voffB); PG8_STAGE(PG8_SA(0, 0), a2, voffA);
            PG8_WAIT_V(8); PG8_WAIT_L(0); PG8_BAR; PG8_MMA(1, 0, At, B0); PG8_MMA(1, 1, At, B1); PG8_BAR; PG8_SCHED;
            PG8_LDB(B0, 1, 0); PG8_LDB(B1, 1, 1); PG8_SCHED; PG8_LDA(At, 1, 0); PG8_STAGE(PG8_SA(0, 1), a2 + hstepA, voffA);
            PG8_WAIT_V(8); PG8_WAIT_L(0); PG8_BAR; PG8_MMA(0, 0, At, B0); PG8_MMA(0, 1, At, B1); PG8_BAR; PG8_SCHED;
            PG8_LDA(At, 1, 1); PG8_STAGE(PG8_SB(1, 0), b3, voffB); PG8_STAGE(PG8_SB(1, 1), b3 + hstepB, voffB); PG8_STAGE(PG8_SA(1, 0), a3, voffA);
            PG8_WAIT_V(8); PG8_WAIT_L(0); PG8_BAR; PG8_MMA(1, 0, At, B0); PG8_MMA(1, 1, At, B1); PG8_BAR; PG8_SCHED;
            } else {
            PG8_LDB(B0, 0, 0); PG8_SCHED; PG8_LDA(At, 0, 0); PG8_STAGE(PG8_SA(1, 1), a1 + hstepA, voffA);
            PG8_WAIT_L(8); PG8_BAR; PG8_WAIT_L(0); PG8_MMA(0, 0, At, B0); PG8_BAR; PG8_SCHED;
            PG8_LDB(B1, 0, 1); PG8_STAGE(PG8_SB(0, 0), b2, voffB);
            PG8_BAR; PG8_WAIT_L(0); PG8_MMA(0, 1, At, B1); PG8_BAR;
            PG8_LDA(At, 0, 1); PG8_STAGE(PG8_SA(0, 0), a2, voffA);
            PG8_BAR; PG8_WAIT_L(0); PG8_MMA(1, 0, At, B0); PG8_BAR; PG8_SCHED;
            PG8_STAGE(PG8_SB(0, 1), b2 + hstepB, voffB);
            PG8_WAIT_V(6); PG8_BAR; PG8_MMA(1, 1, At, B1); PG8_BAR;
            PG8_LDB(B0, 1, 0); PG8_SCHED; PG8_LDA(At, 1, 0); PG8_STAGE(PG8_SA(0, 1), a2 + hstepA, voffA);
            PG8_WAIT_L(8); PG8_BAR; PG8_WAIT_L(0); PG8_MMA(0, 0, At, B0); PG8_BAR; PG8_SCHED;
            PG8_LDB(B1, 1, 1); PG8_STAGE(PG8_SB(1, 0), b3, voffB);
            PG8_BAR; PG8_WAIT_L(0); PG8_MMA(0, 1, At, B1); PG8_BAR;
            PG8_LDA(At, 1, 1); PG8_STAGE(PG8_SA(1, 0), a3, voffA);
            PG8_BAR; PG8_WAIT_L(0); PG8_MMA(1, 0, At, B0); PG8_BAR; PG8_SCHED;
            PG8_STAGE(PG8_SB(1, 1), b3 + hstepB, voffB);
            PG8_WAIT_V(6); PG8_BAR; PG8_MMA(1, 1, At, B1); PG8_BAR;
            }
        }
        if constexpr (ALIGN_EPI) { if (wr == 0) PG8_BAR; }
        E(acc, cur, wr, wc, fr, fq);
        if (!has_next) break;
#pragma unroll
        for (int a = 0; a < 2; ++a)
#pragma unroll
            for (int b = 0; b < 2; ++b)
#pragma unroll
                for (int m = 0; m < 4; ++m)
#pragma unroll
                    for (int n = 0; n < 2; ++n) acc[a][b][m][n] = (f32x4){0.f, 0.f, 0.f, 0.f};
        cur = nxt; cA = nA; cB = nB; ++ui;
        if constexpr (ALIGN_EPI) { if (wr == 1) PG8_BAR; }
    }
    PG8_WAIT_V(0);
    if constexpr (!ALIGN_EPI) { if (wr == 0) PG8_BAR; }
    PG8_BAR;
#undef PG8_SA
#undef PG8_SB
#undef PG8_STAGE
#undef PG8_LDA
#undef PG8_LDB
#undef PG8_MMA
#undef PG8_WAIT_V
#undef PG8_WAIT_L
#undef PG8_BAR
#undef PG8_SCHED
}
}

namespace att {
constexpr int NW = 8, QBLK = 32, KVBLK = 64, DV = 128;
constexpr float THR = 8.f;
#define SBAR() __builtin_amdgcn_sched_barrier(0)
__device__ __forceinline__ int crow(int r, int hi) { return (r & 3) + 8 * (r >> 2) + 4 * hi; }
template <int DQK> struct Cfg {
    static constexpr int KROW = DQK * 2;
    static constexpr int SHM_K = KVBLK * KROW, SHM_V = KVBLK * DV * 2;
    static constexpr int QPE_OFF = 2 * SHM_V + 2 * SHM_K + NW * 64 * 4;
    static constexpr int NPARK = DQK == 192 ? 4 : 0;
    static constexpr int QR0 = DQK / 16 - NPARK;
    static constexpr int LDS_BYTES = QPE_OFF + NW * NPARK * 1024;
    static constexpr int NQ = DQK / 16;
    static constexpr int NKC = DQK / 64;
};
template <int DQK> __device__ __forceinline__ int kswz(int row, int colB) { return row * (DQK * 2) + (colB ^ (DQK == 128 ? ((row & 15) << 4) : (((row >> 1) & 7) << 4))); }

template <int DQK>
__device__ __forceinline__ void partialSM(f32x16& p0, f32x16& p1, float& m_reg, float& mn, float& alpha) {
    constexpr float SCALE = DQK == 128 ? 0.08838834764831845f : 0.07216878364870322f;
    constexpr float C = SCALE * 1.4426950408889634f;
    float pmax = p0[0];
#pragma unroll
    for (int r = 1; r < 16; ++r) pmax = fmaxf(pmax, p0[r]);
#pragma unroll
    for (int r = 0; r < 16; ++r) pmax = fmaxf(pmax, p1[r]);
    { auto rr = __builtin_amdgcn_permlane32_swap(__float_as_uint(pmax), __float_as_uint(pmax), false, false);
      pmax = fmaxf(__uint_as_float(rr[0]), __uint_as_float(rr[1])); }
    if (__builtin_expect(__all(pmax - m_reg <= THR / SCALE), 1)) { mn = m_reg; alpha = 1.f; }
    else { mn = fmaxf(m_reg, pmax); alpha = __builtin_amdgcn_exp2f((m_reg - mn) * C); m_reg = mn; }
    const float mnC = -mn * C;
#pragma unroll
    for (int r = 0; r < 16; ++r) p0[r] = fmaf(p0[r], C, mnC);
#pragma unroll
    for (int r = 0; r < 16; ++r) p1[r] = fmaf(p1[r], C, mnC);
#pragma unroll
    for (int r = 0; r < 16; ++r) p0[r] = __builtin_amdgcn_exp2f(p0[r]);
}
__device__ __forceinline__ void finishSM(f32x16& p0, f32x16& p1, float alpha, float& l_reg, bf16x8& pa0, bf16x8& pa1, bf16x8& pa2, bf16x8& pa3) {
#pragma unroll
    for (int r = 0; r < 16; ++r) p1[r] = __builtin_amdgcn_exp2f(p1[r]);
    float ps = 0;
#pragma unroll
    for (int r = 0; r < 16; ++r) ps += p0[r];
#pragma unroll
    for (int r = 0; r < 16; ++r) ps += p1[r];
    { auto rr = __builtin_amdgcn_permlane32_swap(__float_as_uint(ps), __float_as_uint(ps), false, false);
      ps = __uint_as_float(rr[0]) + __uint_as_float(rr[1]); }
    l_reg = l_reg * alpha + ps;
#define PK4(P, BASE, OUT) do { unsigned a0 = cvt_pk_bf16(P[BASE + 0], P[BASE + 1]), a1 = cvt_pk_bf16(P[BASE + 2], P[BASE + 3]);   \
    unsigned b0 = cvt_pk_bf16(P[BASE + 4], P[BASE + 5]), b1 = cvt_pk_bf16(P[BASE + 6], P[BASE + 7]);                              \
    auto r0 = __builtin_amdgcn_permlane32_swap(a0, b0, false, false); auto r1 = __builtin_amdgcn_permlane32_swap(a1, b1, false, false); \
    u32x4 w = {r0[0], r1[0], r0[1], r1[1]}; OUT = *reinterpret_cast<bf16x8*>(&w); } while (0)
    PK4(p0, 0, pa0); PK4(p0, 8, pa1); PK4(p1, 0, pa2); PK4(p1, 8, pa3);
#undef PK4
}
__device__ __forceinline__ void partialSM_nomax(f32x16& p0, f32x16& p1) {
    SBAR();
#pragma unroll
    for (int r = 0; r < 16; ++r) p0[r] = __builtin_amdgcn_exp2f(p0[r]);
    SBAR();
}
template <int DQK, bool PARK = (DQK == 192)>
__device__ __forceinline__ void qkt(f32x16& p0, f32x16& p1, const char* Ks, const bf16x8* qr, const char* qpe, int r32, int hi) {
    p0 = f32x16{}; p1 = f32x16{};
#pragma unroll
    for (int d0 = 0; d0 < DQK / 16; ++d0) { const int cb = (d0 * 16 + hi * 8) * 2;
        bf16x8 b0 = *reinterpret_cast<const bf16x8*>(Ks + kswz<DQK>(r32, cb));
        bf16x8 b1 = *reinterpret_cast<const bf16x8*>(Ks + kswz<DQK>(32 + r32, cb));
        bf16x8 q; if (!PARK || d0 < Cfg<DQK>::QR0) q = qr[(!PARK || d0 < Cfg<DQK>::QR0) ? d0 : 0]; else q = *reinterpret_cast<const bf16x8*>(qpe + (d0 - Cfg<DQK>::QR0) * 1024);
        p0 = __builtin_amdgcn_mfma_f32_32x32x16_bf16(b0, q, p0, 0, 0, 0);
        p1 = __builtin_amdgcn_mfma_f32_32x32x16_bf16(b1, q, p1, 0, 0, 0);
        if (DQK == 192 && (d0 & 3) == 3 && d0 != 11) SBAR(); }
}
__device__ __forceinline__ int v_st(int k, int c) { const int kk = (k & ~0xC) | ((k & 4) << 1) | ((k & 8) >> 1); return ((kk >> 3) * 4 + (c >> 5)) * 512 + ((kk & 7) * 32 + (c & 31)) * 2; }
__device__ __forceinline__ int v_rd_base(int lane) { return ((lane & 3) << 3) | (((lane >> 2) & 3) << 6) | (((lane >> 4) & 1) << 5) | (((lane >> 5) & 1) << 8); }
constexpr int v_rd_off(int d0, int ks, int half) { return d0 * 512 + ks * 4096 + half * 2048; }
template <int OFF> __device__ __forceinline__ s16x4 tr_read(int vb) {
    s16x4 r; asm volatile("ds_read_b64_tr_b16 %0, %1 offset:%2" : "=&v"(r) : "v"(vb), "i"(OFF) : "memory"); return r;
}
template <int D0> __device__ __forceinline__ void pv_one(f32x16& od, int vb, bf16x8 pa0, bf16x8 pa1, bf16x8 pa2, bf16x8 pa3) {
    const s16x4 l0 = tr_read<v_rd_off(D0, 0, 0)>(vb), h0 = tr_read<v_rd_off(D0, 0, 1)>(vb), l1 = tr_read<v_rd_off(D0, 1, 0)>(vb), h1 = tr_read<v_rd_off(D0, 1, 1)>(vb);
    const s16x4 l2 = tr_read<v_rd_off(D0, 2, 0)>(vb), h2 = tr_read<v_rd_off(D0, 2, 1)>(vb), l3 = tr_read<v_rd_off(D0, 3, 0)>(vb), h3 = tr_read<v_rd_off(D0, 3, 1)>(vb);
    asm volatile("s_waitcnt lgkmcnt(0)" ::: "memory"); SBAR();
#define PK(L, H) (bf16x8){L[0], L[1], L[2], L[3], H[0], H[1], H[2], H[3]}
    od = __builtin_amdgcn_mfma_f32_32x32x16_bf16(pa0, PK(l0, h0), od, 0, 0, 0);
    od = __builtin_amdgcn_mfma_f32_32x32x16_bf16(pa1, PK(l1, h1), od, 0, 0, 0);
    od = __builtin_amdgcn_mfma_f32_32x32x16_bf16(pa2, PK(l2, h2), od, 0, 0, 0);
    od = __builtin_amdgcn_mfma_f32_32x32x16_bf16(pa3, PK(l3, h3), od, 0, 0, 0);
#undef PK
}
__device__ __forceinline__ void pv_d0(f32x16* o, int vb, bf16x8 pa0, bf16x8 pa1, bf16x8 pa2, bf16x8 pa3) {
    pv_one<0>(o[0], vb, pa0, pa1, pa2, pa3); pv_one<1>(o[1], vb, pa0, pa1, pa2, pa3); pv_one<2>(o[2], vb, pa0, pa1, pa2, pa3); pv_one<3>(o[3], vb, pa0, pa1, pa2, pa3);
}
struct VFrag { s16x4 l0, h0, l1, h1, l2, h2, l3, h3; };
template <int D0> __device__ __forceinline__ void pv_reads(VFrag& f, int vb) {
    f.l0 = tr_read<v_rd_off(D0, 0, 0)>(vb); f.h0 = tr_read<v_rd_off(D0, 0, 1)>(vb); f.l1 = tr_read<v_rd_off(D0, 1, 0)>(vb); f.h1 = tr_read<v_rd_off(D0, 1, 1)>(vb);
    f.l2 = tr_read<v_rd_off(D0, 2, 0)>(vb); f.h2 = tr_read<v_rd_off(D0, 2, 1)>(vb); f.l3 = tr_read<v_rd_off(D0, 3, 0)>(vb); f.h3 = tr_read<v_rd_off(D0, 3, 1)>(vb);
}
__device__ __forceinline__ void pv_mma(f32x16& od, const VFrag& f, bf16x8 pa0, bf16x8 pa1, bf16x8 pa2, bf16x8 pa3) {
#define PK(L, H) (bf16x8){L[0], L[1], L[2], L[3], H[0], H[1], H[2], H[3]}
    od = __builtin_amdgcn_mfma_f32_32x32x16_bf16(pa0, PK(f.l0, f.h0), od, 0, 0, 0);
    od = __builtin_amdgcn_mfma_f32_32x32x16_bf16(pa1, PK(f.l1, f.h1), od, 0, 0, 0);
    od = __builtin_amdgcn_mfma_f32_32x32x16_bf16(pa2, PK(f.l2, f.h2), od, 0, 0, 0);
    od = __builtin_amdgcn_mfma_f32_32x32x16_bf16(pa3, PK(f.l3, f.h3), od, 0, 0, 0);
#undef PK
}
__device__ __forceinline__ void pv_pipe(f32x16* o, int vb, bf16x8 pa0, bf16x8 pa1, bf16x8 pa2, bf16x8 pa3) {
    VFrag fa, fb;
    pv_reads<0>(fa, vb); pv_reads<1>(fb, vb);
    asm volatile("s_waitcnt lgkmcnt(8)" ::: "memory"); SBAR();
    pv_mma(o[0], fa, pa0, pa1, pa2, pa3); SBAR();
    pv_reads<2>(fa, vb);
    asm volatile("s_waitcnt lgkmcnt(8)" ::: "memory"); SBAR();
    pv_mma(o[1], fb, pa0, pa1, pa2, pa3); SBAR();
    pv_reads<3>(fb, vb);
    asm volatile("s_waitcnt lgkmcnt(8)" ::: "memory"); SBAR();
    pv_mma(o[2], fa, pa0, pa1, pa2, pa3); SBAR();
    asm volatile("s_waitcnt lgkmcnt(0)" ::: "memory"); SBAR();
    pv_mma(o[3], fb, pa0, pa1, pa2, pa3);
}
__device__ __forceinline__ void unpack8(bf16x8 v, float* f) {
    const u32x4 w = *reinterpret_cast<const u32x4*>(&v);
    f[0] = bf_lo(w.x); f[1] = bf_hi(w.x); f[2] = bf_lo(w.y); f[3] = bf_hi(w.y); f[4] = bf_lo(w.z); f[5] = bf_hi(w.z); f[6] = bf_lo(w.w); f[7] = bf_hi(w.w);
}
__device__ __forceinline__ bf16x8 pack8(const float* f) {
    u32x4 w = {cvt_pk_bf16(f[0], f[1]), cvt_pk_bf16(f[2], f[3]), cvt_pk_bf16(f[4], f[5]), cvt_pk_bf16(f[6], f[7])}; return *reinterpret_cast<bf16x8*>(&w);
}
__device__ __forceinline__ void rope_pair(bf16x8& A, bf16x8& B, const f32x2* __restrict__ tab) {
    float a[8], b[8], ra[8], rb[8]; unpack8(A, a); unpack8(B, b);
#pragma unroll
    for (int j = 0; j < 8; ++j) { const f32x2 cs = tab[j]; ra[j] = a[j] * cs.x - b[j] * cs.y; rb[j] = b[j] * cs.x + a[j] * cs.y; }
    A = pack8(ra); B = pack8(rb);
}

template <int DQK, int LDQ, int LDK, int LDV, int LDO>
__device__ __forceinline__ void attn_body(const bf16_t* __restrict__ Qb, const bf16_t* __restrict__ Kh, const bf16_t* __restrict__ Vh, bf16_t* __restrict__ Ob, int seq, char* lds,
                                          const float* __restrict__ qg, const f32x2* __restrict__ tab, bool rope, int tok0) {
    using C = Cfg<DQK>;
    int tid_ = threadIdx.x; asm volatile("" : "+v"(tid_));
    const int tid = tid_, wid = tid >> 6, lane = tid & 63, r32 = lane & 31, hi = lane >> 5;
    char* V_lds = lds; char* K_lds = lds + 2 * C::SHM_V;
    float* wsf = (float*)(lds + 2 * C::SHM_V + 2 * C::SHM_K) + wid * 64; float* li_l = wsf; float* al_l = wsf + 32;
    char* qpe = lds + C::QPE_OFF + wid * (C::NPARK * 1024) + lane * 16;
    float m_reg = -1e30f, l_reg = 0; f32x16 o[4] = {}; bf16x8 qr[C::NQ];
    const bf16_t* Qw = Qb + (long)(wid * QBLK + r32) * LDQ + hi * 8;
#pragma unroll
    for (int d0 = 0; d0 < C::NQ; ++d0) qr[d0] = *reinterpret_cast<const bf16x8*>(Qw + d0 * 16);
    {
        const int t = tok0 + wid * QBLK + r32, prow = t >> 6, pcol = t & 63;
        if constexpr (DQK == 128) {
            float ss = 0.f;
#pragma unroll
            for (int d0 = 0; d0 < 8; ++d0) { float f[8]; unpack8(qr[d0], f);
#pragma unroll
                for (int j = 0; j < 8; ++j) ss += f[j] * f[j]; }
            ss += __shfl_xor(ss, 32);
            const float rstd = 1.0f / sqrtf(ss * (1.0f / 128.0f) + 1e-6f);
#pragma unroll
            for (int d0 = 0; d0 < 8; ++d0) { float f[8]; unpack8(qr[d0], f);
#pragma unroll
                for (int j = 0; j < 8; ++j) f[j] = f[j] * rstd * qg[d0 * 16 + hi * 8 + j];
                qr[d0] = pack8(f); }
            if (rope) {
                const f32x2* tr = tab + prow * 32 + hi * 8; const f32x2* tc = tab + pcol * 32 + hi * 8;
                rope_pair(qr[0], qr[2], tr); rope_pair(qr[1], qr[3], tr + 16);
                rope_pair(qr[4], qr[6], tc); rope_pair(qr[5], qr[7], tc + 16);
            }
        } else {
            if (rope) {
                const f32x2* tr = tab + prow * 16 + hi * 8; const f32x2* tc = tab + pcol * 16 + hi * 8;
                rope_pair(qr[8], qr[9], tr); rope_pair(qr[10], qr[11], tc);
            }
        }
    }
    if constexpr (DQK == 192) {
#pragma unroll
        for (int d0 = C::QR0; d0 < 12; ++d0) *reinterpret_cast<bf16x8*>(qpe + (d0 - C::QR0) * 1024) = qr[d0];
        asm volatile("s_waitcnt lgkmcnt(0)" ::: "memory");
    }
    const int sr = tid >> 4, sc = (tid & 15) * 8, vst0 = v_st(sr, sc), vst1 = v_st(32 + sr, sc);
    const int vb0 = (int)(uintptr_t)V_lds + v_rd_base(lane);
    const int sr2 = tid >> 3, sc2 = 128 + (tid & 7) * 8;
    struct Slot { bf16x8 vs0, vs1, ks0, ks1, ks2; };
    Slot sA, sBs;
#define sB (*(DQK == 192 ? &sA : &sBs))
#define SLOAD(S, k0) do { S.vs0 = *reinterpret_cast<const bf16x8*>(&Vh[(long)((k0) + sr) * LDV + sc]); S.vs1 = *reinterpret_cast<const bf16x8*>(&Vh[(long)((k0) + 32 + sr) * LDV + sc]); \
    S.ks0 = *reinterpret_cast<const bf16x8*>(&Kh[(long)((k0) + sr) * LDK + sc]); S.ks1 = *reinterpret_cast<const bf16x8*>(&Kh[(long)((k0) + 32 + sr) * LDK + sc]); \
    if constexpr (DQK == 192) S.ks2 = *reinterpret_cast<const bf16x8*>(&Kh[(long)((k0) + sr2) * LDK + sc2]); } while (0)
#define SWRITE(b, S) do { *(bf16x8*)(V_lds + (b) * C::SHM_V + vst0) = S.vs0; *(bf16x8*)(V_lds + (b) * C::SHM_V + vst1) = S.vs1; \
    *(bf16x8*)(K_lds + (b) * C::SHM_K + kswz<DQK>(sr, sc * 2)) = S.ks0; *(bf16x8*)(K_lds + (b) * C::SHM_K + kswz<DQK>(32 + sr, sc * 2)) = S.ks1; \
    if constexpr (DQK == 192) *(bf16x8*)(K_lds + (b) * C::SHM_K + kswz<DQK>(sr2, sc2 * 2)) = S.ks2; } while (0)
#define SWAIT() do { if constexpr (DQK == 192) asm volatile("s_waitcnt vmcnt(0)" ::: "memory"); else asm volatile("s_waitcnt vmcnt(4)" ::: "memory"); } while (0)
#define RESC(a) do { if (__any((a) < 1.f)) { if (hi == 0) al_l[r32] = (a); asm volatile("s_waitcnt lgkmcnt(0)" ::: "memory"); \
    _Pragma("unroll") for (int d = 0; d < 4; ++d) _Pragma("unroll") for (int r = 0; r < 16; ++r) o[d][r] *= al_l[crow(r, hi)]; } } while (0)
    f32x16 pA0, pA1, pB0, pB1; float mnA, mnB, alA, alB; bf16x8 pa0, pa1, pa2, pa3; const int NT = seq / KVBLK;
    SLOAD(sA, 0); asm volatile("s_waitcnt vmcnt(0)" ::: "memory"); SWRITE(0, sA); __syncthreads();
    qkt<DQK>(pA0, pA1, K_lds, qr, qpe, r32, hi); partialSM<DQK>(pA0, pA1, m_reg, mnA, alA);
    SLOAD(sB, KVBLK); if constexpr (DQK != 192) { if (2 < NT) SLOAD(sA, 2 * KVBLK); }
    SWAIT(); SWRITE(1, sB); __syncthreads();
    for (int j = 1; j + 1 < NT; j += 2) {
        SBAR(); qkt<DQK>(pB0, pB1, K_lds + C::SHM_K, qr, qpe, r32, hi);
        finishSM(pA0, pA1, alA, l_reg, pa0, pa1, pa2, pa3); SBAR();
        SLOAD(sB, (j + (DQK == 192 ? 1 : 2)) * KVBLK); SBAR();
        pv_d0(o, vb0, pa0, pa1, pa2, pa3); partialSM<DQK>(pB0, pB1, m_reg, mnB, alB);
        __syncthreads(); SWAIT(); SWRITE(0, sA);
        RESC(alB); __syncthreads();
        SBAR(); qkt<DQK>(pA0, pA1, K_lds, qr, qpe, r32, hi);
        finishSM(pB0, pB1, alB, l_reg, pa0, pa1, pa2, pa3); SBAR();
        if (DQK == 192 || j + 3 < NT) SLOAD(sA, (j + (DQK == 192 ? 2 : 3)) * KVBLK); SBAR();
        pv_d0(o, vb0 + C::SHM_V, pa0, pa1, pa2, pa3); partialSM<DQK>(pA0, pA1, m_reg, mnA, alA);
        __syncthreads(); SWAIT(); SWRITE(1, sB);
        RESC(alA); __syncthreads();
    }
    SBAR(); qkt<DQK>(pB0, pB1, K_lds + C::SHM_K, qr, qpe, r32, hi);
    finishSM(pA0, pA1, alA, l_reg, pa0, pa1, pa2, pa3); SBAR();
    pv_d0(o, vb0, pa0, pa1, pa2, pa3); partialSM<DQK>(pB0, pB1, m_reg, mnB, alB);
    __syncthreads(); RESC(alB);
    finishSM(pB0, pB1, alB, l_reg, pa0, pa1, pa2, pa3); SBAR();
    pv_d0(o, vb0 + C::SHM_V, pa0, pa1, pa2, pa3);
    if (hi == 0) li_l[r32] = l_reg; asm volatile("s_waitcnt lgkmcnt(0)" ::: "memory");
    float rli[16];
#pragma unroll
    for (int r = 0; r < 16; ++r) rli[r] = __builtin_amdgcn_rcpf(li_l[crow(r, hi)]);
    bf16_t* Ow = Ob + (long)(wid * QBLK) * LDO;
#pragma unroll
    for (int r = 0; r < 16; ++r) { const int orow = crow(r, hi);
#pragma unroll
        for (int d0 = 0; d0 < 4; ++d0) Ow[(long)orow * LDO + d0 * 32 + r32] = f2bf(o[d0][r] * rli[r]); }
    __syncthreads();
#undef sB
#undef SLOAD
#undef SWRITE
#undef SWAIT
#undef RESC
}

__device__ __forceinline__ void glds16(const void* g, unsigned lds_base) {
    unsigned sv; asm volatile("s_mov_b32 %0, m0\n\ts_mov_b32 m0, %2\n\ts_nop 0\n\tglobal_load_lds_dwordx4 %1, off\n\ts_mov_b32 m0, %0" : "=&s"(sv) : "v"(g), "s"(lds_base) : "memory"); }
template <int DQK> struct CfgD {
    static constexpr int SHM_K = KVBLK * DQK * 2, SHM_V = KVBLK * DV * 2;
    static constexpr int KR = 0, VR = 3 * SHM_K, SCR = VR + 3 * SHM_V, LDS_BYTES = SCR + NW * 64 * 4;
    static constexpr int NPK = DQK / 64, NPV = 2;
};
template <int DQK, int LDQ, int LDK, int LDV, int LDO, bool NOMAX = false>
__device__ __forceinline__ void attn_body_dma(const bf16_t* __restrict__ Qb, const bf16_t* __restrict__ Kh, const bf16_t* __restrict__ Vh, bf16_t* __restrict__ Ob, int seq, char* lds,
                                              const float* __restrict__ qg, const f32x2* __restrict__ tab, bool rope, int tok0) {
    using C = CfgD<DQK>;
    int tid_ = threadIdx.x; asm volatile("" : "+v"(tid_));
    const int tid = tid_, wid = __builtin_amdgcn_readfirstlane(tid >> 6), lane = tid & 63, r32 = lane & 31, hi = lane >> 5;
    const unsigned lds0 = (unsigned)__builtin_amdgcn_readfirstlane((int)(uintptr_t)lds);
    char* K_lds = lds + C::KR;
    float* wsf = (float*)(lds + C::SCR) + wid * 64; float* li_l = wsf; float* al_l = wsf + 32;
    unsigned kvoff[C::NPK], vvoff[C::NPV];
#pragma unroll
    for (int i = 0; i < C::NPK; ++i) { const int b = (wid + 8 * i) * 1024 + lane * 16, row = b / (DQK * 2), pos = b % (DQK * 2);
        const int colB = pos ^ (DQK == 128 ? ((row & 15) << 4) : (((row >> 1) & 7) << 4)); kvoff[i] = (unsigned)(row * LDK * 2 + colB); }
#pragma unroll
    for (int i = 0; i < C::NPV; ++i) { const int sbt = (wid + 8 * i) * 2 + (lane >> 5), rowin = (lane & 31) >> 2, cch = lane & 3, kk = (sbt >> 2) * 8 + rowin;
        const int k = (kk & ~0xC) | ((kk & 4) << 1) | ((kk & 8) >> 1), c = (sbt & 3) * 32 + cch * 8; vvoff[i] = (unsigned)(k * LDV * 2 + c * 2); }
#define ISSUE_K(J, SL) do { const char* g_ = (const char*)Kh + (size_t)(J) * (KVBLK * LDK * 2); _Pragma("unroll") for (int i_ = 0; i_ < C::NPK; ++i_) \
        glds16(g_ + kvoff[i_], lds0 + C::KR + (SL) * C::SHM_K + (wid + 8 * i_) * 1024); } while (0)
#define ISSUE_V(J, SL) do { const char* g_ = (const char*)Vh + (size_t)(J) * (KVBLK * LDV * 2); _Pragma("unroll") for (int i_ = 0; i_ < C::NPV; ++i_) \
        glds16(g_ + vvoff[i_], lds0 + C::VR + (SL) * C::SHM_V + (wid + 8 * i_) * 1024); } while (0)
#define WAIT_BAR(N) asm volatile("s_waitcnt vmcnt(" #N ") lgkmcnt(0)\n\ts_barrier" ::: "memory")
    const int NT = seq / KVBLK;
    ISSUE_K(0, 0); ISSUE_V(0, 0); ISSUE_K(1, 1);
    float m_reg = -1e30f, l_reg = 0; f32x16 o[4] = {}; bf16x8 qr[DQK / 16];
    const bf16_t* Qw = Qb + (long)(wid * QBLK + r32) * LDQ + hi * 8;
#pragma unroll
    for (int d0 = 0; d0 < DQK / 16; ++d0) qr[d0] = *reinterpret_cast<const bf16x8*>(Qw + d0 * 16);
    {
        const int t = tok0 + wid * QBLK + r32, prow = t >> 6, pcol = t & 63;
        if constexpr (DQK == 128) {
            float ss = 0.f;
#pragma unroll
            for (int d0 = 0; d0 < 8; ++d0) { float f[8]; unpack8(qr[d0], f);
#pragma unroll
                for (int j = 0; j < 8; ++j) ss += f[j] * f[j]; }
            ss += __shfl_xor(ss, 32);
            const float rstd = 1.0f / sqrtf(ss * (1.0f / 128.0f) + 1e-6f);
#pragma unroll
            for (int d0 = 0; d0 < 8; ++d0) { float f[8]; unpack8(qr[d0], f);
#pragma unroll
                for (int j = 0; j < 8; ++j) f[j] = f[j] * rstd * qg[d0 * 16 + hi * 8 + j] * (NOMAX ? 0.08838834764831845f * 1.4426950408889634f : 1.0f);
                qr[d0] = pack8(f); }
            if (rope) {
                const f32x2* tr = tab + prow * 32 + hi * 8; const f32x2* tc = tab + pcol * 32 + hi * 8;
                rope_pair(qr[0], qr[2], tr); rope_pair(qr[1], qr[3], tr + 16);
                rope_pair(qr[4], qr[6], tc); rope_pair(qr[5], qr[7], tc + 16);
            }
        } else {
            if (rope) {
                const f32x2* tr = tab + prow * 16 + hi * 8; const f32x2* tc = tab + pcol * 16 + hi * 8;
                rope_pair(qr[8], qr[9], tr); rope_pair(qr[10], qr[11], tc);
            }
        }
    }
    SBAR();
    const int vb0 = (int)lds0 + C::VR + v_rd_base(lane);
#define RESC(a) do { if (__any((a) < 1.f)) { if (hi == 0) al_l[r32] = (a); asm volatile("s_waitcnt lgkmcnt(0)" ::: "memory"); \
    _Pragma("unroll") for (int d = 0; d < 4; ++d) _Pragma("unroll") for (int r = 0; r < 16; ++r) o[d][r] *= al_l[crow(r, hi)]; } } while (0)
    f32x16 pA0, pA1, pB0, pB1; float mnA = 0.f, mnB = 0.f, alA = 1.f, alB = 1.f; bf16x8 pa0, pa1, pa2, pa3;
#define PSM(P0, P1, MN, AL) do { if constexpr (NOMAX) partialSM_nomax(P0, P1); else partialSM<DQK>(P0, P1, m_reg, MN, AL); } while (0)
#define RESCX(a) do { if constexpr (!NOMAX) RESC(a); else SBAR(); } while (0)
    WAIT_BAR(0);
    qkt<DQK, false>(pA0, pA1, K_lds, qr, nullptr, r32, hi); PSM(pA0, pA1, mnA, alA);
    ISSUE_K(2, 2); ISSUE_V(1, 1);
    if constexpr (C::NPK + C::NPV == 4) WAIT_BAR(4); else WAIT_BAR(5);
    int sa = 1, sb = 2, sc = 0;
#define STEP(PX0, PX1, PY0, PY1, MNX, ALX, ALY, J) do { \
    SBAR(); qkt<DQK, false>(PX0, PX1, K_lds + sa * C::SHM_K, qr, nullptr, r32, hi); \
    finishSM(PY0, PY1, ALY, l_reg, pa0, pa1, pa2, pa3); SBAR(); \
    const bool gk_ = (J) + 2 < NT, gv_ = (J) + 1 < NT; \
    if (gk_) ISSUE_K((J) + 2, sc); if (gv_) ISSUE_V((J) + 1, sb); SBAR(); \
    pv_pipe(o, vb0 + sc * C::SHM_V, pa0, pa1, pa2, pa3); PSM(PX0, PX1, MNX, ALX); \
    RESCX(ALX); \
    if (gk_) { if constexpr (C::NPK + C::NPV == 4) WAIT_BAR(4); else WAIT_BAR(5); } else if (gv_) WAIT_BAR(2); else WAIT_BAR(0); \
    { const int t_ = sa; sa = sb; sb = sc; sc = t_; } } while (0)
    int j = 1;
    for (; j + 1 < NT; j += 2) {
        STEP(pB0, pB1, pA0, pA1, mnB, alB, alA, j);
        STEP(pA0, pA1, pB0, pB1, mnA, alA, alB, j + 1);
    }
    STEP(pB0, pB1, pA0, pA1, mnB, alB, alA, j);
    finishSM(pB0, pB1, alB, l_reg, pa0, pa1, pa2, pa3); SBAR();
    pv_d0(o, vb0 + sc * C::SHM_V, pa0, pa1, pa2, pa3);
    if (hi == 0) li_l[r32] = l_reg; asm volatile("s_waitcnt lgkmcnt(0)" ::: "memory");
    float rli[16];
#pragma unroll
    for (int r = 0; r < 16; ++r) rli[r] = __builtin_amdgcn_rcpf(li_l[crow(r, hi)]);
    bf16_t* Ow = Ob + (long)(wid * QBLK) * LDO;
#pragma unroll
    for (int r = 0; r < 16; ++r) { const int orow = crow(r, hi);
#pragma unroll
        for (int d0 = 0; d0 < 4; ++d0) Ow[(long)orow * LDO + d0 * 32 + r32] = f2bf(o[d0][r] * rli[r]); }
    WAIT_BAR(0);
#undef ISSUE_K
#undef ISSUE_V
#undef WAIT_BAR
#undef RESC
#undef STEP
#undef PSM
#undef RESCX
}
}

constexpr size_t MiB = 1u << 20;
constexpr size_t WS_CTL = 0, CTL_ZERO_BYTES = 1 * MiB;
constexpr size_t WS_MODS = 1 * MiB;
constexpr size_t WS_TAB = 2 * MiB;
constexpr size_t WS_X = 4 * MiB;
constexpr size_t WS_H = 140 * MiB;
constexpr size_t WS_OUTF = 208 * MiB;
constexpr size_t WS_W1T = 344 * MiB, WS_W2T = 472 * MiB;
constexpr size_t WS_GQAW = 600 * MiB;
constexpr size_t WS_LRUW = 640 * MiB;
constexpr size_t WS_MLAW = 668 * MiB;
constexpr size_t WS_BIG = 688 * MiB;
constexpr size_t WS_ACT = WS_BIG;
constexpr size_t WS_GQ = WS_BIG, WS_GK = WS_BIG + 68 * MiB, WS_GV = WS_BIG + 85 * MiB, WS_GO = WS_BIG + 102 * MiB;
constexpr size_t WS_MAP = WS_BIG, WS_MQAN = WS_BIG + 85 * MiB, WS_MCKVN = WS_BIG + 102 * MiB, WS_MQ = WS_BIG + 119 * MiB, WS_MK = WS_BIG + 221 * MiB, WS_MV = WS_BIG + 323 * MiB, WS_MO = WS_BIG + 391 * MiB;
constexpr size_t WS_LUP = WS_BIG, WS_LG = WS_BIG  , WS_LGY = WS_BIG + 68 * MiB, WS_LU = WS_BIG + 136 * MiB, WS_LAF = WS_BIG + 204 * MiB, WS_LGUF = WS_BIG + 272 * MiB,
                 WS_LAB = WS_BIG + 340 * MiB, WS_LGUB = WS_BIG + 408 * MiB, WS_LPS = WS_BIG + 476 * MiB, WS_LCIN = WS_BIG + 494 * MiB;
static_assert(WS_LGUF == WS_LAF + (size_t)R * DM * 2 && WS_LAB == WS_LGUF + (size_t)R * DM * 2 && WS_LGUB == WS_LAB + (size_t)R * DM * 2, "gate outputs are consecutive");
constexpr size_t WS_PART = WS_BIG + 776 * MiB;
constexpr size_t WS_END = WS_PART + 64 * MiB;
constexpr int NCH = 136;

#define XB_TMO      128
#define XB_XCNT(j)  (256  + 64 * (j))
#define XB_XSUB(j)  (1280 + 64 * (j))
#define XB_XGEN(j)  (2304 + 64 * (j))
#define XB_TOP      3328
#define XB_TOPGEN   3392
#define XCD_BAR_WORDS 3456
#define XB_SPIN_CAP (1u << 22)
__device__ __forceinline__ unsigned xb_ld(unsigned* p)              { return __hip_atomic_load(p, __ATOMIC_RELAXED, __HIP_MEMORY_SCOPE_AGENT); }
__device__ __forceinline__ unsigned xb_add(unsigned* p, unsigned v) { return __hip_atomic_fetch_add(p, v, __ATOMIC_RELAXED, __HIP_MEMORY_SCOPE_AGENT); }
__device__ __forceinline__ unsigned xb_xcc_id() { return (unsigned)__builtin_amdgcn_s_getreg((3 << 11) | 20) & 0xFu; }
#define XB_SPIN(cond, bar) do { unsigned _sp = 0; while (cond) { __builtin_amdgcn_s_sleep(1); \
    if ((++_sp & 255u) == 0u) { if (xb_ld(&(bar)[XB_TMO])) break; if (_sp > XB_SPIN_CAP) { atomicAdd(&(bar)[XB_TMO], 1u); break; } } } } while (0)
struct XcdBarrier { unsigned* bar; unsigned x; volatile LAS unsigned* st; };
__device__ __forceinline__ XcdBarrier xcd_barrier_post(unsigned* bar, volatile LAS unsigned* st) {
    XcdBarrier b; b.bar = bar; b.x = xb_xcc_id(); b.st = st;
    if (threadIdx.x == 0) (void)xb_add(&bar[XB_XCNT(b.x)], 1u);
    return b;
}
__device__ __forceinline__ void xcd_barrier_complete(unsigned* bar, unsigned x, unsigned& nloc, unsigned& nx) {
    const unsigned G = gridDim.x * gridDim.y * gridDim.z;
    unsigned sum, cnt, mine, sp = 0u;
    for (;;) {
        sum = 0u; cnt = 0u; mine = 0u;
#pragma unroll
        for (unsigned j = 0; j < 16; ++j) { const unsigned c = xb_ld(&bar[XB_XCNT(j)]); sum += c; cnt += (c > 0u) ? 1u : 0u; mine = (j == x) ? c : mine; }
        if (sum == G) break;
        __builtin_amdgcn_s_sleep(1);
        if ((++sp & 255u) == 0u) { if (xb_ld(&bar[XB_TMO])) break; if (sp > XB_SPIN_CAP) { atomicAdd(&bar[XB_TMO], 1u); break; } }
    }
    nloc = mine > 0u ? mine : 1u; nx = cnt > 0u ? cnt : 1u;
}
__device__ __forceinline__ void xcd_barrier(const XcdBarrier& b) {
    asm volatile("s_waitcnt vmcnt(0)" ::: "memory");
    __syncthreads();
    if (threadIdx.x == 0) {
        unsigned* bar = b.bar;
        __builtin_amdgcn_s_waitcnt(0);
        unsigned nloc = b.st[0], nx = b.st[1];
        if (nloc == 0u) { xcd_barrier_complete(bar, b.x, nloc, nx); b.st[0] = nloc; b.st[1] = nx; }
        const unsigned old = xb_add(&bar[XB_XSUB(b.x)], 1u);
        const unsigned gen = old / nloc;
        if (old + 1u == (gen + 1u) * nloc) {
            __builtin_amdgcn_fence(__ATOMIC_RELEASE, "agent");
            asm volatile("s_waitcnt vmcnt(0)" ::: "memory");
            const unsigned og = xb_add(&bar[XB_TOP], 1u);
            const unsigned tg = og / nx;
            if (og + 1u == (tg + 1u) * nx) xb_add(&bar[XB_TOPGEN], 1u);
            else XB_SPIN(xb_ld(&bar[XB_TOPGEN]) == tg, bar);
            __builtin_amdgcn_fence(__ATOMIC_ACQUIRE, "agent");
            xb_add(&bar[XB_XGEN(b.x)], 1u);
            asm volatile("s_waitcnt vmcnt(0)" ::: "memory");
        } else {
            XB_SPIN(xb_ld(&bar[XB_XGEN(b.x)]) == gen, bar);
            __builtin_amdgcn_fence(__ATOMIC_ACQUIRE, "agent");
            asm volatile("s_waitcnt vmcnt(0)" ::: "memory");
        }
    }
    __syncthreads();
}

#ifndef PROBE_N
#define PROBE_N 2
#endif
__device__ __forceinline__ int probe_count() { int n = PROBE_N; asm volatile("" : "+s"(n)); return n; }
#ifdef PROBE_GEMM
#define PROBE_REPEAT_GEMM for (int rep_ = 0, nrep_ = probe_count(); rep_ < nrep_; ++rep_)
#else
#define PROBE_REPEAT_GEMM
#endif
#ifdef PROBE_ATTN
#define PROBE_REPEAT_ATTN for (int rep_ = 0, nrep_ = probe_count(); rep_ < nrep_; ++rep_)
#else
#define PROBE_REPEAT_ATTN
#endif
struct Args {
    const float *x, *c, *ctx, *c_ctx, *ada_w, *ada_b, *ln_g, *ln_b, *mlp_w1, *mlp_w2;
    const float *gqa_wq, *gqa_wk, *gqa_wv, *gqa_wo, *gqa_q_g, *gqa_k_g;
    const float *lru_wx, *lru_wy, *lru_conv_w, *lru_conv_b, *lru_ra_w, *lru_ra_b, *lru_ix_w, *lru_ix_b, *lru_lam, *lru_wo;
    const float *mla_wq_a, *mla_q_a_g, *mla_wq_b, *mla_wkv_a, *mla_kv_a_g, *mla_wkv_b, *mla_wo;
    float* out; unsigned char* ws; int ph_lo, ph_hi;
};

typedef const __attribute__((address_space(4))) Args CArgs;
__device__ __forceinline__ CArgs* kargs() { CArgs* p = (CArgs*)__builtin_amdgcn_kernarg_segment_ptr(); asm volatile("" : "+s"(p)); return p; }
constexpr int NWAVES = 8;
constexpr int RING_BYTES = 131072, LDSCTL_OFF = RING_BYTES, LDS_BYTES = 147456;

__device__ __forceinline__ float wave_sum(float v) {
#pragma unroll
    for (int o = 1; o < 64; o <<= 1) v += __shfl_xor(v, o);
    return v;
}
__device__ __forceinline__ float sigmoidf_(float v) { return __builtin_amdgcn_rcpf(1.0f + __builtin_amdgcn_exp2f(-1.4426950408889634f * v)); }

__device__ __forceinline__ int tid_opaque() { int t = threadIdx.x; asm volatile("" : "+v"(t)); return t; }
__device__ __forceinline__ void ph_mods(CArgs& a, LAS unsigned char* lds, int vcu, int G) {
    LAS float* S = (LAS float*)lds; LAS float* red = (LAS float*)(lds + 40960);
    const int tid = tid_opaque(), wave = tid >> 6, lane = tid & 63;
    for (int i = tid; i < 5 * DM; i += 512) { const int bi = i / DM, k = i % DM; const float v = bi < 4 ? a.c[bi * DM + k] : a.c_ctx[k]; S[i] = v / (1.0f + expf(-v)); }
    __syncthreads();
    float* mods = (float*)(a.ws + WS_MODS);
    for (int item = vcu; item < 768; item += G) {
        const int l = item / 192, n0 = (item % 192) * 64, ksub = wave * 4 + (lane >> 4), cl = lane & 15;
        const float* wp = a.ada_w + ((size_t)l * DM + ksub) * 12288 + n0 + cl * 4;
        float acc[5][4];
#pragma unroll
        for (int i = 0; i < 5; ++i)
#pragma unroll
            for (int j = 0; j < 4; ++j) acc[i][j] = 0.f;
#pragma unroll 8
        for (int it = 0; it < 64; ++it) {
            const f32x4 w = __builtin_nontemporal_load((const f32x4*)(wp + (size_t)it * 32 * 12288)); const int k = ksub + 32 * it;
#pragma unroll
            for (int i = 0; i < 5; ++i) { const float s = S[i * DM + k];
#pragma unroll
                for (int j = 0; j < 4; ++j) acc[i][j] += s * w[j]; }
        }
#pragma unroll
        for (int i = 0; i < 5; ++i)
#pragma unroll
            for (int j = 0; j < 4; ++j) red[(ksub * 5 + i) * 64 + cl * 4 + j] = acc[i][j];
        __syncthreads();
        if (tid < 320) { const int i = tid / 64, cc = tid % 64; float s = 0.f;
            for (int ks = 0; ks < 32; ++ks) s += red[(ks * 5 + i) * 64 + cc];
            mods[(size_t)(l * 5 + i) * 12288 + n0 + cc] = s + a.ada_b[l * 12288 + n0 + cc]; }
        __syncthreads();
    }
}
__device__ __forceinline__ void tr_item(const float* __restrict__ W, int ldw, int k0, int n0, bf16_t* __restrict__ WT, int ldt, int drow0, LAS float* scr, int lane) {
#pragma unroll 8
    for (int i = 0; i < 32; ++i) { const int kk = 2 * i + (lane >> 5); scr[kk * 33 + (lane & 31)] = __builtin_nontemporal_load(W + (size_t)(k0 + kk) * ldw + n0 + (lane & 31)); }
    asm volatile("s_waitcnt lgkmcnt(0)" ::: "memory");
    const int c = lane & 7;
#pragma unroll
    for (int j = 0; j < 4; ++j) { const int n = (lane >> 3) + 8 * j; const LAS float* s = scr + (8 * c) * 33 + n;
        u32x4 o; o.x = cvt_pk_bf16(s[0 * 33], s[1 * 33]); o.y = cvt_pk_bf16(s[2 * 33], s[3 * 33]); o.z = cvt_pk_bf16(s[4 * 33], s[5 * 33]); o.w = cvt_pk_bf16(s[6 * 33], s[7 * 33]);
        *(u32x4*)(WT + (size_t)(drow0 + n) * ldt + k0 + 8 * c) = o; }
    asm volatile("s_waitcnt lgkmcnt(0)" ::: "memory");
}
__device__ __forceinline__ void ph_transposes(CArgs& a, LAS unsigned char* lds, int vcu, int G) {
    const int tid = tid_opaque(), wave = tid >> 6, lane = tid & 63;
    LAS float* scr = (LAS float*)(lds + wave * 8704);
    const int gw = vcu * NWAVES + wave, NGW = G * NWAVES;
    unsigned char* ws = a.ws;
    constexpr int NITEMS = 87872;
    for (int it = gw; it < NITEMS; it += NGW) {
        int r = it;
#define TR_DO(src, K_, N_, dst, drow) do { const int nblk = (N_) / 32, kb = ri / nblk, nb = ri % nblk; tr_item((src), (N_), 64 * kb, 32 * nb, (dst), (K_), (drow) + 32 * nb, scr, lane); } while (0)
        if (r < 32768) { const int l = r / 8192, ri = r % 8192; TR_DO(a.mlp_w1 + (size_t)l * DM * DFF, DM, DFF, (bf16_t*)(ws + WS_W1T) + (size_t)l * DFF * DM, 0); continue; } r -= 32768;
        if (r < 32768) { const int l = r / 8192, ri = r % 8192; TR_DO(a.mlp_w2 + (size_t)l * DFF * DM, DFF, DM, (bf16_t*)(ws + WS_W2T) + (size_t)l * DM * DFF, 0); continue; } r -= 32768;
        if (r < 4096) { const int s = r / 2048, ri = r % 2048; TR_DO(a.gqa_wq + (size_t)s * DM * DM, DM, DM, (bf16_t*)(ws + WS_GQAW + s * 20 * MiB), 0); continue; } r -= 4096;
        if (r < 1024) { const int s = r / 512, ri = r % 512; TR_DO(a.gqa_wk + (size_t)s * DM * 512, DM, 512, (bf16_t*)(ws + WS_GQAW + s * 20 * MiB), 2048); continue; } r -= 1024;
        if (r < 1024) { const int s = r / 512, ri = r % 512; TR_DO(a.gqa_wv + (size_t)s * DM * 512, DM, 512, (bf16_t*)(ws + WS_GQAW + s * 20 * MiB), 2560); continue; } r -= 1024;
        if (r < 4096) { const int s = r / 2048, ri = r % 2048; TR_DO(a.gqa_wo + (size_t)s * DM * DM, DM, DM, (bf16_t*)(ws + WS_GQAW + s * 20 * MiB + 12 * MiB), 0); continue; } r -= 4096;
        if (r < 2048) { const int ri = r; TR_DO(a.lru_wx, DM, DM, (bf16_t*)(ws + WS_LRUW), 0); continue; } r -= 2048;
        if (r < 2048) { const int ri = r; TR_DO(a.lru_wy, DM, DM, (bf16_t*)(ws + WS_LRUW), 2048); continue; } r -= 2048;
        if (r < 1024) { const int blk = r / 32, ri = r % 32, ty = blk / 16, d = (blk % 16) / 8, n = blk % 8, which = d * 2 + ty;
            const float* src = (ty == 0 ? a.lru_ra_w : a.lru_ix_w) + (size_t)(d * 8 + n) * 65536;
            TR_DO(src, 256, 256, (bf16_t*)(ws + WS_LRUW + 16 * MiB), (which * 8 + n) * 256); continue; } r -= 1024;
        if (r < 2048) { const int ri = r; TR_DO(a.lru_wo, DM, DM, (bf16_t*)(ws + WS_LRUW + 20 * MiB), 0); continue; } r -= 2048;
        if (r < 512) { const int ri = r; TR_DO(a.mla_wq_a, DM, 512, (bf16_t*)(ws + WS_MLAW), 0); continue; } r -= 512;
        if (r < 576) { const int ri = r; TR_DO(a.mla_wkv_a, DM, 576, (bf16_t*)(ws + WS_MLAW), 512); continue; } r -= 576;
        if (r < 768) { const int ri = r; TR_DO(a.mla_wq_b, 512, 3072, (bf16_t*)(ws + WS_MLAW + 5 * MiB), 0); continue; } r -= 768;
        if (r < 1024) { const int ri = r, nb = ri % 128, kb = ri / 128, n0 = 32 * nb, h = n0 >> 8, j0 = n0 & 255;
            const int drow = j0 < 128 ? h * 128 + j0 : 2048 + h * 128 + (j0 - 128);
            tr_item(a.mla_wkv_b, 4096, 64 * kb, n0, (bf16_t*)(ws + WS_MLAW + 8 * MiB), 512, drow, scr, lane); continue; } r -= 1024;
        { const int ri = r; TR_DO(a.mla_wo, DM, DM, (bf16_t*)(ws + WS_MLAW + 12 * MiB), 0); }
#undef TR_DO
    }
    { u32x4* z = (u32x4*)(ws + WS_MLAW + (size_t)1088 * DM * 2); const int gt = vcu * 512 + tid;
      for (int i = gt; i < 49152; i += G * 512) z[i] = (u32x4){0u, 0u, 0u, 0u}; }
    if (vcu == 1 % G) { float* ll = (float*)(ws + WS_TAB + 32768); for (int i = tid; i < 2 * DM; i += 512) ll[i] = -8.0f * log1pf(expf(-a.lru_lam[i])); }
    if (vcu == 0) {
        f32x2* tg = (f32x2*)(ws + WS_TAB); f32x2* tm = (f32x2*)(ws + WS_TAB + 16384);
        for (int i = tid; i < 64 * 32; i += 512) { const int pos = i / 32, f = i % 32; const float inv = powf(10000.0f, -((float)f * 2.0f) / 64.0f); const float ang = (float)pos * inv; tg[i] = (f32x2){cosf(ang), sinf(ang)}; }
        for (int i = tid; i < 64 * 16; i += 512) { const int pos = i / 16, f = i % 16; const float inv = powf(10000.0f, -((float)f * 2.0f) / 32.0f); const float ang = (float)pos * inv; tm[i] = (f32x2){cosf(ang), sinf(ang)}; }
    }
}

#define ROW_DECODE(r) const int b_ = (r) / TB, p_ = (r) % TB; const bool isctx_ = p_ < CTX; const int mi_ = isctx_ ? 4 : b_; (void)b_; (void)mi_
__device__ __forceinline__ const float* mods_ptr(CArgs& a, int l, int mi) { return (const float*)(a.ws + WS_MODS) + (size_t)(l * 5 + mi) * 12288; }

__device__ __forceinline__ void ph_init(CArgs& a, int vcu, int G) {
    const int tid_ = tid_opaque(), lane = tid_ & 63, gw = vcu * NWAVES + (tid_ >> 6), NGW = G * NWAVES; (void)lane;
    bf16_t* X = (bf16_t*)(a.ws + WS_X); bf16_t* H = (bf16_t*)(a.ws + WS_H);
    for (int r = gw; r < R; r += NGW) {
        ROW_DECODE(r);
        const float* src = isctx_ ? a.ctx + ((size_t)b_ * CTX + p_) * DM : a.x + ((size_t)b_ * SEQ + (p_ - CTX)) * DM;
        const float* m = mods_ptr(a, 0, mi_);
#pragma unroll
        for (int it = 0; it < 8; ++it) { const int idx = it * 256 + lane * 4;
            const f32x4 v = __builtin_nontemporal_load((const f32x4*)(src + idx)), m0 = *(const f32x4*)(m + idx), m1 = *(const f32x4*)(m + DM + idx);
            *(u32x2*)(X + (size_t)r * DM + idx) = (u32x2){cvt_pk_bf16(v[0], v[1]), cvt_pk_bf16(v[2], v[3])};
            const f32x4 h = v * (1.0f + m1) + m0;
            *(u32x2*)(H + (size_t)r * DM + idx) = (u32x2){cvt_pk_bf16(h[0], h[1]), cvt_pk_bf16(h[2], h[3])}; }
    }
}
__device__ __forceinline__ void ln_stage_vecs(CArgs& a, LAS float* vec, int l, int which, int mi, bool last, int tid) {
    const float* lg = a.ln_g + (size_t)(l * 2 + which) * DM; const float* lb = a.ln_b + (size_t)(l * 2 + which) * DM;
    const float* m = mods_ptr(a, l, mi);
    const float* gate = m + (which == 0 ? 2 : 5) * DM;
    const float* sc = which == 0 ? m + 4 * DM : mods_ptr(a, last ? l : l + 1, mi) + 1 * DM;
    const float* sh = which == 0 ? m + 3 * DM : mods_ptr(a, last ? l : l + 1, mi);
    { const int i = tid * 4; const f32x4 g = *(const f32x4*)(gate + i), s4 = *(const f32x4*)(sc + i);
      *(LAS f32x4*)(vec + i) = 1.0f + g; *(LAS f32x4*)(vec + DM + i) = *(const f32x4*)(lg + i); *(LAS f32x4*)(vec + 2 * DM + i) = *(const f32x4*)(lb + i);
      *(LAS f32x4*)(vec + 3 * DM + i) = 1.0f + s4; *(LAS f32x4*)(vec + 4 * DM + i) = *(const f32x4*)(sh + i); }
}
template <bool LAST, int NR, bool FROM_PART>
__device__ __forceinline__ void ln_rows(CArgs& a, const LAS float* vec, int r, int lane) {
    bf16_t* X = (bf16_t*)(a.ws + WS_X); bf16_t* H = (bf16_t*)(a.ws + WS_H); const bf16_t* O = (const bf16_t*)(a.ws + WS_OUTF); const bf16_t* PART = (const bf16_t*)(a.ws + WS_PART);
    ROW_DECODE(r);
    float v[NR][4][8]; float s[NR];
#pragma unroll
    for (int rr = 0; rr < NR; ++rr) s[rr] = 0.f;
#pragma unroll
    for (int it = 0; it < 4; ++it) { const int idx = it * 512 + lane * 8;
        const f32x4 g0 = *(const LAS f32x4*)(vec + idx), g1 = *(const LAS f32x4*)(vec + idx + 4);
#pragma unroll
        for (int rr = 0; rr < NR; ++rr) {
            float xv[8], ov[8]; att::unpack8(__builtin_nontemporal_load((const bf16x8*)(X + (size_t)(r + rr) * DM + idx)), xv);
            if (FROM_PART) { const bf16_t* pp = PART + ((size_t)b_ * CTX + p_ + rr) * DM + idx;
                att::unpack8(__builtin_nontemporal_load((const bf16x8*)pp), ov);
#pragma unroll
                for (int sl = 1; sl < 8; ++sl) { float t8[8]; att::unpack8(__builtin_nontemporal_load((const bf16x8*)(pp + (size_t)sl * (NB * CTX) * DM)), t8);
#pragma unroll
                    for (int j = 0; j < 8; ++j) ov[j] += t8[j]; } }
            else att::unpack8(__builtin_nontemporal_load((const bf16x8*)(O + (size_t)(r + rr) * DM + idx)), ov);
#pragma unroll
            for (int j = 0; j < 8; ++j) { v[rr][it][j] = DN_ALPHA * xv[j] + (j < 4 ? g0[j] : g1[j - 4]) * ov[j]; s[rr] += v[rr][it][j]; } }
        __builtin_amdgcn_sched_barrier(0);
    }
    float rstd[NR];
#pragma unroll
    for (int rr = 0; rr < NR; ++rr) { const float mean = wave_sum(s[rr]) * (1.0f / DM); float q = 0.f;
#pragma unroll
        for (int it = 0; it < 4; ++it)
#pragma unroll
            for (int j = 0; j < 8; ++j) { v[rr][it][j] -= mean; q += v[rr][it][j] * v[rr][it][j]; }
        rstd[rr] = 1.0f / sqrtf(wave_sum(q) * (1.0f / DM) + LN_EPS); }
#pragma unroll
    for (int it = 0; it < 4; ++it) { const int idx = it * 512 + lane * 8;
        const f32x4 lg0 = *(const LAS f32x4*)(vec + DM + idx), lg1 = *(const LAS f32x4*)(vec + DM + idx + 4), lb0 = *(const LAS f32x4*)(vec + 2 * DM + idx), lb1 = *(const LAS f32x4*)(vec + 2 * DM + idx + 4);
        f32x4 sc0 = {0.f, 0.f, 0.f, 0.f}, sc1 = sc0, sh0 = sc0, sh1 = sc0;
        if (!LAST) { sc0 = *(const LAS f32x4*)(vec + 3 * DM + idx); sc1 = *(const LAS f32x4*)(vec + 3 * DM + idx + 4); sh0 = *(const LAS f32x4*)(vec + 4 * DM + idx); sh1 = *(const LAS f32x4*)(vec + 4 * DM + idx + 4); }
#pragma unroll
        for (int rr = 0; rr < NR; ++rr) {
            float xn[8];
#pragma unroll
            for (int j = 0; j < 8; ++j) xn[j] = v[rr][it][j] * rstd[rr] * (j < 4 ? lg0[j] : lg1[j - 4]) + (j < 4 ? lb0[j] : lb1[j - 4]);
            if (LAST) { float* op = a.out + ((size_t)b_ * SEQ + (p_ + rr - CTX)) * DM + idx; *(f32x4*)op = (f32x4){xn[0], xn[1], xn[2], xn[3]}; *(f32x4*)(op + 4) = (f32x4){xn[4], xn[5], xn[6], xn[7]}; }
            else { *(bf16x8*)(X + (size_t)(r + rr) * DM + idx) = att::pack8(xn);
                float hh[8];
#pragma unroll
                for (int j = 0; j < 8; ++j) hh[j] = xn[j] * (j < 4 ? sc0[j] : sc1[j - 4]) + (j < 4 ? sh0[j] : sh1[j - 4]);
                *(bf16x8*)(H + (size_t)(r + rr) * DM + idx) = att::pack8(hh); } }
        __builtin_amdgcn_sched_barrier(0); }
}
template <bool LAST, int CTXMODE>
__device__ __forceinline__ void ph_ln(CArgs& a, LAS unsigned char* lds, int l, int which, int vcu, int G) {
    const int tid = tid_opaque(), lane = tid & 63, wave = tid >> 6;
    LAS float* vec = (LAS float*)lds;
    constexpr int NR = 2;
    const int b = (int)(((long)vcu * NB) / G), vlo = (b * G + NB - 1) / NB, vhi = ((b + 1) * G + NB - 1) / NB, wpb = vhi - vlo, w = vcu - vlo;
    ln_stage_vecs(a, vec, l, which, b, LAST, tid);
    __syncthreads();
    for (int k = w * NWAVES + wave; k < SEQ / NR; k += wpb * NWAVES) ln_rows<LAST, NR, false>(a, vec, b * TB + CTX + k * NR, lane);
    if (CTXMODE == 1 && !LAST) {
        __syncthreads();
        ln_stage_vecs(a, vec, l, which, 4, LAST, tid);
        __syncthreads();
        for (int k = wave * G + vcu; k < NB * CTX; k += G * NWAVES) ln_rows<false, 1, true>(a, vec, (k / CTX) * TB + (k % CTX), lane);
    }
    __syncthreads();
}
__device__ __forceinline__ void ph_knorm(CArgs& a, const float* kg, int vcu, int G) {
    const int tid_ = tid_opaque(), lane = tid_ & 63, gw = vcu * NWAVES + (tid_ >> 6), NGW = G * NWAVES; (void)lane;
    bf16_t* K = (bf16_t*)(a.ws + WS_GK); const f32x2* tab = (const f32x2*)(a.ws + WS_TAB);
    const int li = lane & 15;
    float g[8];
#pragma unroll
    for (int j = 0; j < 8; ++j) g[j] = kg[li * 8 + j];
    for (int r = gw; r < R; r += NGW) {
        ROW_DECODE(r);
        bf16x8 raw = *(const bf16x8*)(K + (size_t)r * 512 + lane * 8);
        float f[8]; att::unpack8(raw, f);
        float ss = 0.f;
#pragma unroll
        for (int j = 0; j < 8; ++j) ss += f[j] * f[j];
        ss += __shfl_xor(ss, 1); ss += __shfl_xor(ss, 2); ss += __shfl_xor(ss, 4); ss += __shfl_xor(ss, 8);
        const float rstd = 1.0f / sqrtf(ss * (1.0f / 128.0f) + 1e-6f);
#pragma unroll
        for (int j = 0; j < 8; ++j) f[j] = f[j] * rstd * g[j];
        if (!isctx_) {
            const int t = p_ - CTX, pos = (li & 8) ? (t & 63) : (t >> 6);
            const f32x2* tp = tab + pos * 32 + (li & 3) * 8;
            const bool second = (li & 4) != 0;
#pragma unroll
            for (int j = 0; j < 8; ++j) { const float other = __shfl_xor(f[j], 4); const f32x2 cs = tp[j];
                f[j] = second ? f[j] * cs.x + other * cs.y : f[j] * cs.x - other * cs.y; }
        }
        *(bf16x8*)(K + (size_t)r * 512 + lane * 8) = att::pack8(f);
    }
}
__device__ __forceinline__ void ph_mla_norm(CArgs& a, int vcu, int G) {
    const int tid_ = tid_opaque(), lane = tid_ & 63, gw = vcu * NWAVES + (tid_ >> 6), NGW = G * NWAVES; (void)lane;
    const bf16_t* AP = (const bf16_t*)(a.ws + WS_MAP); bf16_t* QAN = (bf16_t*)(a.ws + WS_MQAN); bf16_t* CKVN = (bf16_t*)(a.ws + WS_MCKVN); bf16_t* K = (bf16_t*)(a.ws + WS_MK);
    const f32x2* tab = (const f32x2*)(a.ws + WS_TAB + 16384);
    for (int r = gw; r < R; r += NGW) {
        ROW_DECODE(r);
        const bf16_t* ap = AP + (size_t)r * 1280;
#pragma unroll
        for (int part = 0; part < 2; ++part) {
            float f8_[8]; att::unpack8(__builtin_nontemporal_load((const bf16x8*)(ap + part * 512 + lane * 8)), f8_);
            const f32x4 v0 = {f8_[0], f8_[1], f8_[2], f8_[3]}, v1 = {f8_[4], f8_[5], f8_[6], f8_[7]};
            float ss = (v0[0] * v0[0] + v0[1] * v0[1]) + (v0[2] * v0[2] + v0[3] * v0[3]) + (v1[0] * v1[0] + v1[1] * v1[1]) + (v1[2] * v1[2] + v1[3] * v1[3]);
            const float rstd = 1.0f / sqrtf(wave_sum(ss) * (1.0f / 512.0f) + 1e-6f);
            const float* gp = (part == 0 ? a.mla_q_a_g : a.mla_kv_a_g) + lane * 8;
            const f32x4 g0 = *(const f32x4*)gp, g1 = *(const f32x4*)(gp + 4);
            const f32x4 o0 = v0 * rstd * g0, o1 = v1 * rstd * g1;
            u32x4 w = {cvt_pk_bf16(o0[0], o0[1]), cvt_pk_bf16(o0[2], o0[3]), cvt_pk_bf16(o1[0], o1[1]), cvt_pk_bf16(o1[2], o1[3])};
            *(u32x4*)((part == 0 ? QAN : CKVN) + (size_t)r * 512 + lane * 8) = w;
        }
        float v = bf2f(ap[1024 + lane]);
        if (!isctx_) {
            const int t = p_ - CTX, pos = (lane & 32) ? (t & 63) : (t >> 6);
            const f32x2 cs = tab[pos * 16 + (lane & 15)];
            const float other = __shfl_xor(v, 16);
            v = (lane & 16) ? v * cs.x + other * cs.y : v * cs.x - other * cs.y;
        }
        const bf16_t kb = f2bf(v);
#pragma unroll
        for (int h = 0; h < 16; ++h) K[(size_t)r * 3072 + h * 192 + 128 + lane] = kb;
    }
}
__device__ __forceinline__ void ph_conv(CArgs& a, int vcu, int G) {
    const int tid_ = tid_opaque(), lane = tid_ & 63, gw = vcu * NWAVES + (tid_ >> 6), NGW = G * NWAVES; (void)lane;
    const bf16_t* UP = (const bf16_t*)(a.ws + WS_LUP); bf16_t* U = (bf16_t*)(a.ws + WS_LU);
    for (int r = gw; r < R; r += NGW) {
        ROW_DECODE(r);
        const int lo = isctx_ ? 0 : CTX, hi = isctx_ ? CTX : TB;
#pragma unroll
        for (int it = 0; it < 4; ++it) { const int idx = it * 512 + lane * 8;
            float acc[8];
            { const f32x4 b0 = *(const f32x4*)(a.lru_conv_b + idx), b1 = *(const f32x4*)(a.lru_conv_b + idx + 4);
              acc[0] = b0[0]; acc[1] = b0[1]; acc[2] = b0[2]; acc[3] = b0[3]; acc[4] = b1[0]; acc[5] = b1[1]; acc[6] = b1[2]; acc[7] = b1[3]; }
#pragma unroll
            for (int j = 0; j < 4; ++j) { const int pp = p_ + j - 2;
                if (pp >= lo && pp < hi) {
                    float f[8]; att::unpack8(*(const bf16x8*)(UP + (size_t)(r + j - 2) * DM + idx), f);
                    const f32x4 w0 = *(const f32x4*)(a.lru_conv_w + j * DM + idx), w1 = *(const f32x4*)(a.lru_conv_w + j * DM + idx + 4);
                    acc[0] += f[0] * w0[0]; acc[1] += f[1] * w0[1]; acc[2] += f[2] * w0[2]; acc[3] += f[3] * w0[3];
                    acc[4] += f[4] * w1[0]; acc[5] += f[5] * w1[1]; acc[6] += f[6] * w1[2]; acc[7] += f[7] * w1[3]; } }
            *(bf16x8*)(U + (size_t)r * DM + idx) = att::pack8(acc); }
    }
}
__device__ __forceinline__ void scan_step(f32x4& h, u32x2 la, u32x2 gu, f32x4* Pacc) {
    f32x4 av = {__builtin_amdgcn_exp2f(bf_lo(la.x)), __builtin_amdgcn_exp2f(bf_hi(la.x)), __builtin_amdgcn_exp2f(bf_lo(la.y)), __builtin_amdgcn_exp2f(bf_hi(la.y))};
    const f32x4 gv = {bf_lo(gu.x), bf_hi(gu.x), bf_lo(gu.y), bf_hi(gu.y)};
    f32x4 s; s[0] = sqrtf(fmaxf(1.0f - av[0] * av[0], 0.f)); s[1] = sqrtf(fmaxf(1.0f - av[1] * av[1], 0.f)); s[2] = sqrtf(fmaxf(1.0f - av[2] * av[2], 0.f)); s[3] = sqrtf(fmaxf(1.0f - av[3] * av[3], 0.f));
    h = av * h + s * gv; if (Pacc) *Pacc = *Pacc * av;
}
__device__ __forceinline__ void ph_scan1(CArgs& a, int vcu, int G) {
    const int tid_ = tid_opaque(), lane = tid_ & 63, gw = vcu * NWAVES + (tid_ >> 6), NGW = G * NWAVES; (void)lane;
    float* PS = (float*)(a.ws + WS_LPS);
    for (int item = gw; item < NB * NCH * 2 * 8; item += NGW) {
        const int cg = item & 7, dir = (item >> 3) & 1, bq = item >> 4, b = bq / NCH, q = bq % NCH;
        const bf16_t* A = (const bf16_t*)(a.ws + (dir ? WS_LAB : WS_LAF)); const bf16_t* GU = (const bf16_t*)(a.ws + (dir ? WS_LGUB : WS_LGUF));
        const size_t base = ((size_t)b * TB + q * 32) * DM + cg * 256 + lane * 4;
        f32x4 h = {0.f, 0.f, 0.f, 0.f}, P = {1.f, 1.f, 1.f, 1.f};
#pragma unroll 8
        for (int i = 0; i < 32; ++i) { const int rr = dir ? 31 - i : i;
            scan_step(h, *(const u32x2*)(A + base + (size_t)rr * DM), *(const u32x2*)(GU + base + (size_t)rr * DM), &P); }
        float* o = PS + ((size_t)(bq * 2 + dir) * 2) * DM + cg * 256 + lane * 4;
        *(f32x4*)o = P; *(f32x4*)(o + DM) = h;
    }
}
__device__ __forceinline__ void ph_scan2(CArgs& a, LAS unsigned char* lds, int vcu, int G) {
    const float* PS = (const float*)(a.ws + WS_LPS); float* CIN = (float*)(a.ws + WS_LCIN);
    const int tid = tid_opaque(), lane = tid & 63, seg = tid >> 6;
    LAS float* sm = (LAS float*)lds;
    for (int v = vcu; v < NB * 2 * (DM / 64); v += G) {
        const int cb = v % (DM / 64), dir = (v / (DM / 64)) & 1, b = v / (2 * (DM / 64)), c = cb * 64 + lane;
        float P[17], S[17];
#pragma unroll
        for (int k = 0; k < 17; ++k) { const int i = seg * 17 + k, q = dir == 0 ? i : (i < 8 ? 7 - i : NCH - 1 - (i - 8)); const size_t bq = (size_t)b * NCH + q;
            P[k] = PS[((bq * 2 + dir) * 2) * DM + c]; S[k] = PS[((bq * 2 + dir) * 2 + 1) * DM + c]; }
        float pp = 1.f, ss = 0.f;
#pragma unroll
        for (int k = 0; k < 17; ++k) { ss = P[k] * ss + S[k]; pp *= P[k]; }
        sm[(seg * 2 + 0) * 64 + lane] = pp; sm[(seg * 2 + 1) * 64 + lane] = ss;
        __syncthreads();
        float carry = 0.f;
        for (int s2 = 0; s2 < seg; ++s2) carry = sm[(s2 * 2 + 0) * 64 + lane] * carry + sm[(s2 * 2 + 1) * 64 + lane];
#pragma unroll
        for (int k = 0; k < 17; ++k) { const int i = seg * 17 + k, q = dir == 0 ? i : (i < 8 ? 7 - i : NCH - 1 - (i - 8)); const size_t bq = (size_t)b * NCH + q;
            CIN[(bq * 2 + dir) * DM + c] = carry; carry = P[k] * carry + S[k]; }
        __syncthreads();
    }
}
__device__ __forceinline__ void ph_scan3(CArgs& a, int vcu, int G) {
    const int tid_ = tid_opaque(), lane = tid_ & 63, gw = vcu * NWAVES + (tid_ >> 6), NGW = G * NWAVES; (void)lane;
    const float* CIN = (const float*)(a.ws + WS_LCIN); const bf16_t* GY = (const bf16_t*)(a.ws + WS_LGY); bf16_t* Gout = (bf16_t*)(a.ws + WS_LG);
    const bf16_t* AF = (const bf16_t*)(a.ws + WS_LAF); const bf16_t* GUF = (const bf16_t*)(a.ws + WS_LGUF); const bf16_t* AB = (const bf16_t*)(a.ws + WS_LAB); const bf16_t* GUB = (const bf16_t*)(a.ws + WS_LGUB);
    for (int item = gw; item < NB * NCH * 8; item += NGW) {
        const int cg = item & 7, bq = item >> 3, b = bq / NCH, q = bq % NCH;
        const size_t base = ((size_t)b * TB + q * 32) * DM + cg * 256 + lane * 4;
        f32x4 hf[32];
        f32x4 h = *(const f32x4*)(CIN + ((size_t)bq * 2 + 0) * DM + cg * 256 + lane * 4);
#pragma unroll
        for (int i = 0; i < 32; ++i) { scan_step(h, __builtin_nontemporal_load((const u32x2*)(AF + base + (size_t)i * DM)), __builtin_nontemporal_load((const u32x2*)(GUF + base + (size_t)i * DM)), nullptr); hf[i] = h;
            if ((i & 7) == 7) __builtin_amdgcn_sched_barrier(0); }
        h = *(const f32x4*)(CIN + ((size_t)bq * 2 + 1) * DM + cg * 256 + lane * 4);
#pragma unroll
        for (int i = 31; i >= 0; --i) {
            scan_step(h, __builtin_nontemporal_load((const u32x2*)(AB + base + (size_t)i * DM)), __builtin_nontemporal_load((const u32x2*)(GUB + base + (size_t)i * DM)), nullptr);
            const u32x2 gy = __builtin_nontemporal_load((const u32x2*)(GY + base + (size_t)i * DM));
            const f32x4 o = (hf[i] + h) * (f32x4){bf_lo(gy.x), bf_hi(gy.x), bf_lo(gy.y), bf_hi(gy.y)};
            *(u32x2*)(Gout + base + (size_t)i * DM) = (u32x2){cvt_pk_bf16(o[0], o[1]), cvt_pk_bf16(o[2], o[3])};
            if ((i & 7) == 0) __builtin_amdgcn_sched_barrier(0); }
    }
}
__device__ __forceinline__ void st_bf16x8(bf16_t* p, f32x4 v0, f32x4 v1) {
    u32x4 w = {cvt_pk_bf16(v0[0], v0[1]), cvt_pk_bf16(v0[2], v0[3]), cvt_pk_bf16(v1[0], v1[1]), cvt_pk_bf16(v1[2], v1[3])}; *(u32x4*)p = w; }
struct FStoreF32 { float* O; int ld;
    __device__ __forceinline__ void begin(const pg8::Unit&, int) {}
    __device__ __forceinline__ void row8(int row, int, int col, f32x4 v0, f32x4 v1) { float* p = O + (size_t)row * ld + col; *(f32x4*)p = v0; *(f32x4*)(p + 4) = v1; } };
struct FOut { bf16_t* O; bf16_t* PART; bf16_t* dst; int rowadj;
    __device__ __forceinline__ void begin(const pg8::Unit& u, int) {
        if (u.slice >= 0) { dst = PART + (size_t)u.slice * (NB * CTX) * DM; rowadj = (u.pm / 17) * CTX - u.pm * 256; } else { dst = O; rowadj = 0; } }
    __device__ __forceinline__ void row8(int row, int, int col, f32x4 v0, f32x4 v1) { st_bf16x8(dst + (size_t)(row + rowadj) * DM + col, v0, v1); } };
struct FBf16 { bf16_t* O; int ld;
    __device__ __forceinline__ void begin(const pg8::Unit&, int) {}
    __device__ __forceinline__ void row8(int row, int, int col, f32x4 v0, f32x4 v1) { st_bf16x8(O + (size_t)row * ld + col, v0, v1); } };
struct FQkv { bf16_t *Q, *K, *V; bf16_t* base; int ld, coff;
    __device__ __forceinline__ void begin(const pg8::Unit& u, int) { if (u.pn < 8) { base = Q; ld = 2048; coff = 0; } else if (u.pn < 10) { base = K; ld = 512; coff = 2048; } else { base = V; ld = 512; coff = 2560; } }
    __device__ __forceinline__ void row8(int row, int, int col, f32x4 v0, f32x4 v1) { st_bf16x8(base + (size_t)row * ld + (col - coff), v0, v1); } };
struct FRelu2 { bf16_t* O;
    __device__ __forceinline__ void begin(const pg8::Unit&, int) {}
    __device__ __forceinline__ void row8(int row, int, int col, f32x4 v0, f32x4 v1) {
#pragma unroll
        for (int i = 0; i < 4; ++i) { const float a = fmaxf(v0[i], 0.f), b = fmaxf(v1[i], 0.f); v0[i] = a * a; v1[i] = b * b; }
        st_bf16x8(O + (size_t)row * DFF + col, v0, v1); } };
__device__ __forceinline__ float gelu_tanh(float x) { const float z = 1.5957691216057308f * (x + 0.044715f * x * x * x); return x * __builtin_amdgcn_rcpf(1.0f + __builtin_amdgcn_exp2f(-1.4426950408889634f * z)); }
struct FLruXY { bf16_t *UP, *GY; bool gy;
    __device__ __forceinline__ void begin(const pg8::Unit& u, int) { gy = u.pn >= 8; }
    __device__ __forceinline__ void row8(int row, int, int col, f32x4 v0, f32x4 v1) {
        if (gy) {
#pragma unroll
            for (int i = 0; i < 4; ++i) { v0[i] = gelu_tanh(v0[i]); v1[i] = gelu_tanh(v1[i]); }
            st_bf16x8(GY + (size_t)row * DM + (col - 2048), v0, v1);
        } else st_bf16x8(UP + (size_t)row * DM + col, v0, v1); } };
struct EpiGates {
    static constexpr bool PERM = true;
    bf16_t* OUT4; const bf16_t* U; const float *ra_b, *ix_b, *lam;
    __device__ __forceinline__ void operator()(const f32x4 (&acc)[2][2][4][2], const pg8::Unit& u, int wr, int wc, int fr, int fq) const {
        const int which = u.pn >> 3, dir = which >> 1, ty = which & 1, ch0 = (u.pn & 7) * 256 + wc * 32 + 8 * fq, row0 = u.pm * 256 + wr * 64 + fr;
        bf16_t* dst = OUT4 + (size_t)which * ((size_t)R * DM);
        const float* bp = (ty == 0 ? ra_b : ix_b) + dir * DM;
#pragma unroll
        for (int bj = 0; bj < 2; ++bj) {
            const int ch = ch0 + bj * 128;
            const f32x4 b0 = *(const f32x4*)(bp + ch), b1 = *(const f32x4*)(bp + ch + 4);
            f32x4 l0 = {0.f, 0.f, 0.f, 0.f}, l1 = {0.f, 0.f, 0.f, 0.f};
            if (ty == 0) { l0 = *(const f32x4*)(lam + dir * DM + ch) * 1.4426950408889634f; l1 = *(const f32x4*)(lam + dir * DM + ch + 4) * 1.4426950408889634f; }
#pragma unroll
            for (int ai = 0; ai < 2; ++ai)
#pragma unroll
                for (int m = 0; m < 4; ++m) {
                    const int row = row0 + ai * 128 + m * 16;
                    const f32x4 x0 = acc[ai][bj][m][0] + b0, x1 = acc[ai][bj][m][1] + b1; f32x4 o0, o1;
                    if (ty == 0) {
#pragma unroll
                        for (int j = 0; j < 4; ++j) { o0[j] = l0[j] * sigmoidf_(x0[j]); o1[j] = l1[j] * sigmoidf_(x1[j]); }
                    } else {
                        const u32x4 uw = *(const u32x4*)(U + (size_t)row * DM + ch);
                        o0[0] = sigmoidf_(x0[0]) * bf_lo(uw.x); o0[1] = sigmoidf_(x0[1]) * bf_hi(uw.x); o0[2] = sigmoidf_(x0[2]) * bf_lo(uw.y); o0[3] = sigmoidf_(x0[3]) * bf_hi(uw.y);
                        o1[0] = sigmoidf_(x1[0]) * bf_lo(uw.z); o1[1] = sigmoidf_(x1[1]) * bf_hi(uw.z); o1[2] = sigmoidf_(x1[2]) * bf_lo(uw.w); o1[3] = sigmoidf_(x1[3]) * bf_hi(uw.w);
                    }
                    st_bf16x8(dst + (size_t)row * DM + ch, o0, o1);
                    __builtin_amdgcn_sched_barrier(0);
                }
        }
    } };
struct FKvb { bf16_t *K, *V;
    __device__ __forceinline__ void begin(const pg8::Unit&, int) {}
    __device__ __forceinline__ void row8(int row, int, int col, f32x4 v0, f32x4 v1) {
        bf16_t* p = col < 2048 ? K + (size_t)row * 3072 + (col >> 7) * 192 + (col & 127) : V + (size_t)row * DM + (col - 2048);
        st_bf16x8(p, v0, v1); } };

template <class F>
__device__ __forceinline__ void run_gemm(LAS unsigned char* lds, const bf16_t* A, int lda, const bf16_t* Bt, int ldb, int N, int K, int a_blk, F f, int G, int rot = 0) {
    pg8::Gemm g{A, Bt, R, N, K, lda, ldb, a_blk}; pg8::StaticOrder S; S.init(R, N, K, G, ((int)blockIdx.x + rot) % G);
    pg8::EpiRow8<F> E{f};
    PROBE_REPEAT_GEMM
    pg8::gemm_phase<pg8::EpiRow8<F>, pg8::StaticOrder, true, true>(lds, g, S, E);
}

__device__ __forceinline__ void run_gemm_out(LAS unsigned char* lds, const bf16_t* A, int lda, const bf16_t* Bt, int K, int SK, bf16_t* OUTF, bf16_t* PART, int G) {
    pg8::Gemm g{A, Bt, R, DM, K, lda, K, 0}; pg8::LatOrder S; S.init(DM, K, G, (int)blockIdx.x, SK, K == DFF ? 1 : 0);
    pg8::EpiRow8<FOut> E{FOut{OUTF, PART, nullptr, 0}};
    PROBE_REPEAT_GEMM
    pg8::gemm_phase<pg8::EpiRow8<FOut>, pg8::LatOrder, true, true>(lds, g, S, E);
}
template <class F>
__device__ __forceinline__ void run_gemm_lat(LAS unsigned char* lds, const bf16_t* A, int lda, const bf16_t* Bt, int ldb, int N, int K, F f, int G) {
    pg8::Gemm g{A, Bt, R, N, K, lda, ldb, 0}; pg8::LatOrder S; S.init(N, K, G, (int)blockIdx.x, 0);
    pg8::EpiRow8<F> E{f};
    PROBE_REPEAT_GEMM
    pg8::gemm_phase<pg8::EpiRow8<F>, pg8::LatOrder, true, true>(lds, g, S, E);
}

__device__ __forceinline__ void ph_attn_gqa(CArgs& a, char* lds, const float* qg, const float* kg, bool ctx_units, int vcu, int G) {
    const bf16_t* Q = (const bf16_t*)(a.ws + WS_GQ); const bf16_t* K = (const bf16_t*)(a.ws + WS_GK); const bf16_t* V = (const bf16_t*)(a.ws + WS_GV); bf16_t* O = (bf16_t*)(a.ws + WS_GO);
    const f32x2* tab = (const f32x2*)(a.ws + WS_TAB);
    const int nun = ctx_units ? 1088 : 1024;
    bool fast;
    { const int lane = tid_opaque() & 63; float gq = fmaxf(fabsf(qg[lane]), fabsf(qg[lane + 64])), gk = fmaxf(fabsf(kg[lane]), fabsf(kg[lane + 64]));
#pragma unroll
      for (int o = 1; o < 64; o <<= 1) { gq = fmaxf(gq, __shfl_xor(gq, o)); gk = fmaxf(gk, __shfl_xor(gk, o)); }
      fast = __builtin_amdgcn_readfirstlane((16.3224f * gq * gk <= 40.0f) ? 1 : 0) != 0; }
#define GQA_UNITS(NM) \
    for (int id = vcu; id < nun; id += G) { \
        int b, h, row0, seq, tok0; bool rope; \
        if (id < 1024) { const int bk = id >> 6; b = bk >> 2; h = (bk & 3) * 4 + ((id & 63) >> 4); const int qb = id & 15; row0 = b * TB + CTX + qb * 256; seq = TB; tok0 = qb * 256; rope = true; } \
        else { const int j = id - 1024; b = j >> 4; h = j & 15; row0 = b * TB; seq = CTX; tok0 = 0; rope = false; } \
        const int kvh = h >> 2; \
        att::attn_body_dma<128, 2048, 512, 512, 2048, NM>(Q + (size_t)row0 * 2048 + h * 128, K + (size_t)b * TB * 512 + kvh * 128, V + (size_t)b * TB * 512 + kvh * 128, \
                                                  O + (size_t)row0 * 2048 + h * 128, seq, lds, qg, tab, rope, tok0); }
    PROBE_REPEAT_ATTN
    { if (fast) { GQA_UNITS(true) } else { GQA_UNITS(false) } }
#undef GQA_UNITS
}
__device__ __forceinline__ void ph_attn_mla(CArgs& a, char* lds, bool ctx_units, int vcu, int G) {
    const bf16_t* Q = (const bf16_t*)(a.ws + WS_MQ); const bf16_t* K = (const bf16_t*)(a.ws + WS_MK); const bf16_t* V = (const bf16_t*)(a.ws + WS_MV); bf16_t* O = (bf16_t*)(a.ws + WS_MO);
    const f32x2* tab = (const f32x2*)(a.ws + WS_TAB + 16384);
    const int nun = ctx_units ? 1088 : 1024;
    PROBE_REPEAT_ATTN
    for (int id = vcu; id < nun; id += G) {
        int b, h, row0, seq, tok0; bool rope;
        if (id < 1024) { const int bh = id >> 4; b = bh >> 4; h = bh & 15; const int qb = id & 15; row0 = b * TB + CTX + qb * 256; seq = TB; tok0 = qb * 256; rope = true; }
        else { const int j = id - 1024; b = j >> 4; h = j & 15; row0 = b * TB; seq = CTX; tok0 = 0; rope = false; }
        att::attn_body_dma<192, 3072, 3072, 2048, 2048>(Q + (size_t)row0 * 3072 + h * 192, K + (size_t)b * TB * 3072 + h * 192, V + (size_t)b * TB * DM + h * 128,
                                                    O + (size_t)row0 * DM + h * 128, seq, lds, nullptr, tab, rope, tok0);
    }
}

constexpr int NPHASES = 38;
__global__ void __launch_bounds__(NWAVES * 64, 2) trunk_fwd(Args a_unused) {
#define a (*kargs())
    extern __shared__ __attribute__((aligned(16))) unsigned char lds_raw[];
    LAS unsigned char* lds = (LAS unsigned char*)lds_raw;
    const int tid = threadIdx.x;
    const int G = gridDim.x; const int bx = blockIdx.x; const int vcu = (G % 8 == 0) ? (bx % 8) * (G / 8) + bx / 8 : bx;
#define ws (a.ws)
    for (int u = tid; u < (LDS_BYTES - LDSCTL_OFF) / 4; u += NWAVES * 64) ((LAS unsigned*)(lds + LDSCTL_OFF))[u] = 0u;
    __syncthreads();
    if (a.ph_hi - a.ph_lo > 1) (void)xcd_barrier_post((unsigned*)(ws + WS_CTL) + 1024, (volatile LAS unsigned*)(lds + LDSCTL_OFF + 64));
    int ph = 0;
#ifndef PH_FILTER
#define PH_FILTER(p) true
#endif
#ifdef PROBE_STAMP_A
    unsigned long long st_prev = __builtin_amdgcn_s_memrealtime(), st_a = 0, st_b = 0; int st_cls = 0;
#define ST_CLS(c) st_cls = (c);
#define ST_ACC { const unsigned long long now_ = __builtin_amdgcn_s_memrealtime(); if (st_cls == PROBE_STAMP_A) st_a += now_ - st_prev; if (st_cls == PROBE_STAMP_B) st_b += now_ - st_prev; st_prev = now_; }
#else
#define ST_CLS(c)
#define ST_ACC
#endif
#define PH_BEGIN if (PH_FILTER(ph) && ph >= a.ph_lo && ph < a.ph_hi) {
#define MKBAR() XcdBarrier{(unsigned*)(ws + WS_CTL) + 1024, xb_xcc_id(), (volatile LAS unsigned*)(lds + LDSCTL_OFF + 64)}
#define PH_END   if (ph + 1 < a.ph_hi) xcd_barrier(MKBAR()); ST_ACC } ++ph;

    ST_CLS(0) PH_BEGIN ph_mods(a, lds, vcu, G); __syncthreads(); ph_transposes(a, lds, vcu, G); PH_END
    ST_CLS(1) PH_BEGIN ph_init(a, vcu, G); PH_END

#define Hb ((bf16_t*)(ws + WS_H))
#define OUTF ((bf16_t*)(ws + WS_OUTF))
#define ACT ((bf16_t*)(ws + WS_ACT))

#define PARTB ((bf16_t*)(ws + WS_PART))
#define MLP_PHASES(L) \
    ST_CLS(4) PH_BEGIN ph_ln<false, 1>(a, lds, L, 0, vcu, G); PH_END \
    ST_CLS(5) PH_BEGIN run_gemm(lds, Hb, DM, (const bf16_t*)(ws + WS_W1T) + (size_t)(L) * DFF * DM, DM, DFF, DM, 0, FRelu2{ACT}, G); PH_END \
    ST_CLS(6) PH_BEGIN run_gemm_out(lds, ACT, DFF, (const bf16_t*)(ws + WS_W2T) + (size_t)(L) * DM * DFF, DFF, 8, OUTF, PARTB, G); PH_END \
    ST_CLS(4) PH_BEGIN ph_ln<false, 1>(a, lds, L, 1, vcu, G); PH_END
#define MLP_PHASES_LAST(L) \
    ST_CLS(4) PH_BEGIN ph_ln<false, 2>(a, lds, L, 0, vcu, G); PH_END \
    ST_CLS(5) PH_BEGIN run_gemm_lat(lds, Hb, DM, (const bf16_t*)(ws + WS_W1T) + (size_t)(L) * DFF * DM, DM, DFF, DM, FRelu2{ACT}, G); PH_END \
    ST_CLS(6) PH_BEGIN run_gemm_out(lds, ACT, DFF, (const bf16_t*)(ws + WS_W2T) + (size_t)(L) * DM * DFF, DFF, 0, OUTF, PARTB, G); PH_END \
    ST_CLS(4) PH_BEGIN ph_ln<true, 2>(a, lds, L, 1, vcu, G); PH_END

#define GQA_LAYER(L, SLOT, LASTL) \
    ST_CLS(2) PH_BEGIN run_gemm(lds, Hb, DM, (const bf16_t*)(ws + WS_GQAW + (SLOT) * 20 * MiB), DM, 3072, DM, 0, FQkv{(bf16_t*)(ws + WS_GQ), (bf16_t*)(ws + WS_GK), (bf16_t*)(ws + WS_GV), nullptr, 0, 0}, G); PH_END \
    ST_CLS(1) PH_BEGIN ph_knorm(a, a.gqa_k_g + (SLOT) * 128, vcu, G); PH_END \
    ST_CLS(3) PH_BEGIN ph_attn_gqa(a, (char*)lds_raw, a.gqa_q_g + (SLOT) * 128, a.gqa_k_g + (SLOT) * 128, !(LASTL), vcu, G); PH_END \
    ST_CLS(2) PH_BEGIN run_gemm_out(lds, (const bf16_t*)(ws + WS_GO), DM, (const bf16_t*)(ws + WS_GQAW + (SLOT) * 20 * MiB + 12 * MiB), DM, (LASTL) ? 0 : 8, OUTF, PARTB, G); PH_END

    GQA_LAYER(0, 0, false)
    MLP_PHASES(0)
    ST_CLS(2) PH_BEGIN run_gemm(lds, Hb, DM, (const bf16_t*)(ws + WS_LRUW), DM, 4096, DM, 0, FLruXY{(bf16_t*)(ws + WS_LUP), (bf16_t*)(ws + WS_LGY), false}, G); PH_END
    ST_CLS(1) PH_BEGIN ph_conv(a, vcu, G); PH_END
    ST_CLS(2) PH_BEGIN { EpiGates eg{(bf16_t*)(ws + WS_LAF), (const bf16_t*)(ws + WS_LU), a.lru_ra_b, a.lru_ix_b, (const float*)(ws + WS_TAB + 32768)};
               pg8::Gemm g{(const bf16_t*)(ws + WS_LU), (const bf16_t*)(ws + WS_LRUW + 16 * MiB), R, 8192, 256, DM, 256, 1}; pg8::StaticOrder S; S.init(R, 8192, 256, G, (int)blockIdx.x);
               PROBE_REPEAT_GEMM
               pg8::gemm_phase<EpiGates, pg8::StaticOrder, true, true>(lds, g, S, eg); } PH_END
    ST_CLS(7) PH_BEGIN ph_scan1(a, vcu, G); PH_END
    PH_BEGIN ph_scan2(a, lds, vcu, G); PH_END
    PH_BEGIN ph_scan3(a, vcu, G); PH_END
    ST_CLS(2) PH_BEGIN run_gemm_out(lds, (const bf16_t*)(ws + WS_LG), DM, (const bf16_t*)(ws + WS_LRUW + 20 * MiB), DM, 8, OUTF, PARTB, G); PH_END
    MLP_PHASES(1)
    ST_CLS(2) PH_BEGIN run_gemm(lds, Hb, DM, (const bf16_t*)(ws + WS_MLAW), DM, 1280, DM, 0, FBf16{(bf16_t*)(ws + WS_MAP), 1280}, G); PH_END
    ST_CLS(1) PH_BEGIN ph_mla_norm(a, vcu, G); PH_END
    ST_CLS(2) PH_BEGIN run_gemm(lds, (const bf16_t*)(ws + WS_MQAN), 512, (const bf16_t*)(ws + WS_MLAW + 5 * MiB), 512, 3072, 512, 0, FBf16{(bf16_t*)(ws + WS_MQ), 3072}, G);
             run_gemm(lds, (const bf16_t*)(ws + WS_MCKVN), 512, (const bf16_t*)(ws + WS_MLAW + 8 * MiB), 512, 4096, 512, 0, FKvb{(bf16_t*)(ws + WS_MK), (bf16_t*)(ws + WS_MV)}, G, G / 2); PH_END
    ST_CLS(3) PH_BEGIN ph_attn_mla(a, (char*)lds_raw, true, vcu, G); PH_END
    ST_CLS(2) PH_BEGIN run_gemm_out(lds, (const bf16_t*)(ws + WS_MO), DM, (const bf16_t*)(ws + WS_MLAW + 12 * MiB), DM, 8, OUTF, PARTB, G); PH_END
    MLP_PHASES(2)
    GQA_LAYER(3, 1, true)
    MLP_PHASES_LAST(3)
#ifdef PROBE_STAMP_A
    xcd_barrier(MKBAR());
    if (blockIdx.x == 0) {
        LAS float* sh = (LAS float*)(lds + LDSCTL_OFF + 256);
        if (tid == 0) { float va = (float)st_a * 0.01f, vb = (float)st_b * 0.01f;
            { float pw = 1.f; while (pw * 100.f <= va) pw *= 10.f; va = rintf(va / pw) * pw; }
            { float pw = 1.f; while (pw * 100.f <= vb) pw *= 10.f; vb = rintf(vb / pw) * pw; }
            sh[0] = va; sh[1] = vb; }
        __syncthreads();
        const float ta = sh[0], tb = sh[1];
        for (int i = 1 + tid; i <= (1 << 20); i += 512) a.out[i] = tb;
        if (tid == 0) a.out[0] = ta;
    }
#endif
#undef PH_BEGIN
#undef PH_END
#undef ws
#undef a
#undef Hb
#undef OUTF
#undef ACT
#undef PARTB
}

#ifndef MK_SPLIT
#define MK_SPLIT 0
#endif
extern "C" void kernel_launch(void* const* d_in, const int* in_sizes, int n_in, void* d_out, int out_size, void* d_ws, size_t ws_size, hipStream_t stream) {
    static int grid = 0;
    if (grid == 0) {
        if (n_in != 33 || in_sizes[0] != NB * SEQ * DM || out_size != NB * SEQ * DM || ws_size < WS_END) {
            fprintf(stderr, "kernel_launch: unexpected shapes: n_in %d in0 %d out %d ws %zu (need %zu)\n", n_in, n_in > 0 ? in_sizes[0] : -1, out_size, ws_size, (size_t)WS_END); grid = -1; return; }
        int dev = 0, cus = 0;
        if (hipGetDevice(&dev) != hipSuccess || hipDeviceGetAttribute(&cus, hipDeviceAttributeMultiprocessorCount, dev) != hipSuccess) { grid = -1; return; }
        if (hipFuncSetAttribute((const void*)trunk_fwd, hipFuncAttributeMaxDynamicSharedMemorySize, LDS_BYTES) != hipSuccess) { fprintf(stderr, "kernel_launch: hipFuncSetAttribute failed\n"); grid = -1; return; }
        int per_cu = 0;
        if (hipOccupancyMaxActiveBlocksPerMultiprocessor(&per_cu, (const void*)trunk_fwd, NWAVES * 64, LDS_BYTES) != hipSuccess || per_cu < 1)
            fprintf(stderr, "kernel_launch: occupancy query reports %d workgroups per CU\n", per_cu);
        (void)hipGetLastError();
        grid = cus;
    }
    if (grid < 0) return;
    if (hipMemsetAsync((char*)d_ws + WS_CTL, 0, CTL_ZERO_BYTES, stream) != hipSuccess) return;
    Args a{};
    const float** p = (const float**)&a;
    for (int i = 0; i < 33; ++i) p[i] = (const float*)d_in[i];
    a.out = (float*)d_out; a.ws = (unsigned char*)d_ws;
#ifdef PROBE_PREFIX
    a.ph_lo = 0; a.ph_hi = PROBE_PREFIX; hipLaunchKernelGGL(trunk_fwd, dim3(grid), dim3(NWAVES * 64), LDS_BYTES, stream, a);
    (void)hipMemsetAsync((char*)d_ws + WS_CTL, 0, CTL_ZERO_BYTES, stream);
    a.ph_lo = 0; a.ph_hi = NPHASES; hipLaunchKernelGGL(trunk_fwd, dim3(grid), dim3(NWAVES * 64), LDS_BYTES, stream, a);
#elif MK_SPLIT
    for (int k = 0; k < NPHASES; ++k) { a.ph_lo = k; a.ph_hi = k + 1; hipLaunchKernelGGL(trunk_fwd, dim3(grid), dim3(NWAVES * 64), LDS_BYTES, stream, a); }
#else
    a.ph_lo = 0; a.ph_hi = NPHASES; hipLaunchKernelGGL(trunk_fwd, dim3(grid), dim3(NWAVES * 64), LDS_BYTES, stream, a);
#endif
    const hipError_t le = hipPeekAtLastError();
    if (le != hipSuccess) fprintf(stderr, "kernel_launch: launch failed: %s\n", hipGetErrorName(le));
}
```

```cpp
#include <hip/hip_runtime.h>
#include <cstdio>
#include <cstdint>
#include <cmath>

#define LAS __attribute__((address_space(3)))
#define GAS __attribute__((address_space(1)))
typedef unsigned short bf16_t;
typedef short bf16x8 __attribute__((ext_vector_type(8)));
typedef short s16x4 __attribute__((ext_vector_type(4)));
typedef float f32x4 __attribute__((ext_vector_type(4)));
typedef float f32x2 __attribute__((ext_vector_type(2)));
typedef float f32x16 __attribute__((ext_vector_type(16)));
typedef unsigned u32x4 __attribute__((ext_vector_type(4)));
typedef unsigned u32x2 __attribute__((ext_vector_type(2)));

__device__ __forceinline__ unsigned cvt_pk_bf16(float lo, float hi) { unsigned r; asm volatile("v_cvt_pk_bf16_f32 %0, %1, %2" : "=v"(r) : "v"(lo), "v"(hi)); return r; }
__device__ __forceinline__ float bf_lo(unsigned w) { return __uint_as_float(w << 16); }
__device__ __forceinline__ float bf_hi(unsigned w) { return __uint_as_float(w & 0xffff0000u); }
__device__ __forceinline__ float bf2f(bf16_t h) { return __uint_as_float(((unsigned)h) << 16); }
__device__ __forceinline__ bf16_t f2bf(float f) { return (bf16_t)(cvt_pk_bf16(f, f) & 0xffffu); }

constexpr int DM = 2048, NB = 4, SEQ = 4096, CTX = 256, TB = SEQ + CTX  , R = NB * TB  , DFF = 8192, DEPTH = 4;
constexpr float LN_EPS = 1e-6f;
constexpr float DN_ALPHA = 1.6817928305074290861f;

namespace pg8 {
constexpr int BM = 256, BK = 64, HALF = 128, HTB = HALF * BK * 2, STAGE_BYTES = 8 * HTB, NXCD = 8, WGM = 4;
__host__ __device__ __forceinline__ int lds_byte(int r, int c) { const int st = (r >> 4) * 2 + (c >> 5), rr = r & 15, cc = c & 31, ob = rr * 64 + cc * 2; return st * 1024 + (ob ^ (((ob >> 9) & 1) << 5)); }
__host__ __device__ __forceinline__ void stage_rc(int b, int& Rr, int& C) { const int st = b / 1024, sb = b % 1024, swz = sb ^ (((sb >> 9) & 1) << 5); Rr = (st >> 1) * 16 + swz / 64; C = (st & 1) * 32 + (swz % 64) / 2; }
__host__ __device__ __forceinline__ int perm32(int rho) { const int n = rho >> 4, i = rho & 15; return 8 * (i >> 2) + 4 * n + (i & 3); }

struct Unit { int pm, pn, k0, nk, slice; };
struct Gemm { const bf16_t* A; const bf16_t* Bt; int M, N, K, lda, ldb, a_blk; };

struct StaticOrder {
    int nM, nN, nwg, G, c, nt;
    __device__ __forceinline__ void init(int M, int N, int K, int G_, int c_) { nM = M / BM; nN = N / BM; nwg = nM * nN; G = G_; c = c_; nt = K / BK; }
    __device__ __forceinline__ Unit next(int i) const {
        const long L = (long)i * G + c; if (L >= nwg) return Unit{-1, 0, 0, 0, -1};
        int wgid = (int)L; { const int q = nwg / NXCD, r = nwg % NXCD, xcd = wgid % NXCD, off = wgid / NXCD; wgid = (xcd < r ? xcd * (q + 1) : r * (q + 1) + (xcd - r) * q) + off; }
        const int nig = WGM * nN, gid = wgid / nig, fm = gid * WGM, gsz = (nM - fm) < WGM ? (nM - fm) : WGM;
        return Unit{fm + ((wgid % nig) % gsz), (wgid % nig) / gsz, 0, nt, -1};
    }
};
struct LatOrder {
    int nN, nwg, G, c, nt, SK, rev;
    __device__ __forceinline__ void init(int N, int K, int G_, int c_, int SK_, int rev_ = 0) { nN = N / BM; nwg = 64 * nN; G = G_; c = c_; nt = K / BK; SK = SK_; rev = rev_; }
    __device__ __forceinline__ Unit next(int i) const {
        const int nlat = c < nwg ? (nwg - c + G - 1) / G : 0;
        if (i < nlat) {
            int wgid = i * G + c; { const int q = nwg / NXCD, r = nwg % NXCD, xcd = wgid % NXCD, off = wgid / NXCD; wgid = (xcd < r ? xcd * (q + 1) : r * (q + 1) + (xcd - r) * q) + off; }
            const int nig = WGM * nN, gid = wgid / nig, fm = gid * WGM;
            int lp = fm + ((wgid % nig) % WGM); if (rev) lp = 63 - lp;
            return Unit{(lp >> 4) * 17 + 1 + (lp & 15), (wgid % nig) / WGM, 0, nt, -1};
        }
        if (SK > 0 && i >= nlat) { const int su = c + (i - nlat) * G;
            if (su < 4 * nN * SK) { const int t = su / SK, sl = su % SK, nks = nt / SK; return Unit{17 * (t / nN), t % nN, sl * nks, nks, sl}; } }
        return Unit{-1, 0, 0, 0, -1};
    }
};

template <class F> struct EpiRow8 {
    static constexpr bool PERM = true;
    F f;
    __device__ __forceinline__ void operator()(const f32x4 (&acc)[2][2][4][2], const Unit& u, int wr, int wc, int fr, int fq) {
        const int row0 = u.pm * BM + wr * 64 + fr, colb = u.pn * BM + wc * 32 + 8 * fq;
        f.begin(u, colb);
#pragma unroll
        for (int ai = 0; ai < 2; ++ai)
#pragma unroll
            for (int m = 0; m < 4; ++m) {
                const int row = row0 + ai * HALF + m * 16;
#pragma unroll
                for (int bj = 0; bj < 2; ++bj) f.row8(row, bj, colb + bj * HALF, acc[ai][bj][m][0], acc[ai][bj][m][1]);
            }
    }
};

template <class Epi, class Sched, bool ALIGN_EPI = true, bool SP2 = true>
__device__ __forceinline__ void gemm_phase(LAS unsigned char* lds, const Gemm g, const Sched& S, Epi& E) {
    int tid = threadIdx.x; asm volatile("" : "+v"(tid));
    const int wid = __builtin_amdgcn_readfirstlane(tid >> 6), lane = tid & 63, wr = wid >> 2, wc = wid & 3, fr = lane & 15, fq = lane >> 4;
    unsigned voffA[2], voffB[2];
#pragma unroll
    for (int i = 0; i < 2; ++i) { int Rr, C; stage_rc(tid * 16 + i * 8192, Rr, C); const int Rb = Epi::PERM ? ((Rr & ~31) + perm32(Rr & 31)) : Rr;
        voffA[i] = (unsigned)(Rr * g.lda + C) * 2u; voffB[i] = (unsigned)(Rb * g.ldb + C) * 2u; }
    const size_t kstep = (size_t)(BK * 2);
    const size_t hstepA = (size_t)HALF * g.lda * 2, hstepB = (size_t)HALF * g.ldb * 2;
    const size_t tstepA = 2 * hstepA, tstepB = 2 * hstepB;
    const unsigned ldsw = (unsigned)wid * 1024u;
    const int aoff = lds_byte(wr * 64 + fr, fq * 8), boff = lds_byte(wc * 32 + fr, fq * 8);
#define PG8_SA(b, h) (((b) * 2 + (h)) * HTB)
#define PG8_SB(b, h) ((4 + (b) * 2 + (h)) * HTB)
#define PG8_STAGE(bufoff, gbase, voff) do { _Pragma("unroll") for (int _i = 0; _i < 2; ++_i) \
        __builtin_amdgcn_global_load_lds((const unsigned*)((const char*)(gbase) + (voff)[_i]), (LAS unsigned*)(lds + (bufoff) + ldsw + _i * 8192), 16, 0, 0); } while (0)
#define PG8_LDA(dst, b, h) do { _Pragma("unroll") for (int m = 0; m < 4; ++m) _Pragma("unroll") for (int k = 0; k < 2; ++k) dst[m][k] = *(const LAS bf16x8*)(lds + PG8_SA(b, h) + aoff + m * 2048 + k * 1024); } while (0)
#define PG8_LDB(dst, b, h) do { _Pragma("unroll") for (int n = 0; n < 2; ++n) _Pragma("unroll") for (int k = 0; k < 2; ++k) dst[n][k] = *(const LAS bf16x8*)(lds + PG8_SB(b, h) + boff + n * 2048 + k * 1024); } while (0)
#define PG8_MMA(ai, bj, At, Bt) do { __builtin_amdgcn_s_setprio(1); _Pragma("unroll") for (int m = 0; m < 4; ++m) _Pragma("unroll") for (int n = 0; n < 2; ++n) _Pragma("unroll") for (int k = 0; k < 2; ++k) \
        acc[ai][bj][m][n] = __builtin_amdgcn_mfma_f32_16x16x32_bf16(Bt[n][k], At[m][k], acc[ai][bj][m][n], 0, 0, 0); __builtin_amdgcn_s_setprio(0); } while (0)
#define PG8_WAIT_V(n) asm volatile("s_waitcnt vmcnt(" #n ")" ::: "memory")
#define PG8_WAIT_L(n) asm volatile("s_waitcnt lgkmcnt(" #n ")" ::: "memory")
#define PG8_BAR __builtin_amdgcn_s_barrier()
#define PG8_SCHED __builtin_amdgcn_sched_barrier(0)
    Unit cur = S.next(0), nxt = cur; int ui = 0;
    if (cur.pm < 0) return;
    f32x4 acc[2][2][4][2];
#pragma unroll
    for (int a = 0; a < 2; ++a)
#pragma unroll
        for (int b = 0; b < 2; ++b)
#pragma unroll
            for (int m = 0; m < 4; ++m)
#pragma unroll
                for (int n = 0; n < 2; ++n) acc[a][b][m][n] = (f32x4){0.f, 0.f, 0.f, 0.f};
    bf16x8 At[4][2], B0[2][2], B1[2][2];
    const char* cA = (const char*)g.A + (size_t)cur.pm * tstepA + (size_t)(g.a_blk ? (cur.pn & 7) * 512 : 0) + (size_t)cur.k0 * kstep; const char* cB = (const char*)g.Bt + (size_t)cur.pn * tstepB + (size_t)cur.k0 * kstep;
    if constexpr (SP2) {
        PG8_STAGE(PG8_SB(0, 0), cB, voffB); PG8_STAGE(PG8_SB(0, 1), cB + hstepB, voffB); PG8_STAGE(PG8_SA(0, 0), cA, voffA); PG8_STAGE(PG8_SA(0, 1), cA + hstepA, voffA);
        if (wr == 1) PG8_BAR;
        PG8_WAIT_V(2); PG8_BAR;
        PG8_STAGE(PG8_SB(1, 0), cB + kstep, voffB); PG8_STAGE(PG8_SA(1, 0), cA + kstep, voffA); PG8_STAGE(PG8_SB(1, 1), cB + hstepB + kstep, voffB);
        PG8_WAIT_V(6); PG8_BAR;
    } else {
        PG8_STAGE(PG8_SB(0, 0), cB, voffB); PG8_STAGE(PG8_SA(0, 0), cA, voffA); PG8_STAGE(PG8_SB(0, 1), cB + hstepB, voffB); PG8_STAGE(PG8_SA(0, 1), cA + hstepA, voffA);
        if (wr == 1) PG8_BAR;
        PG8_WAIT_V(4); PG8_BAR;
        PG8_STAGE(PG8_SB(1, 0), cB + kstep, voffB); PG8_STAGE(PG8_SA(1, 0), cA + kstep, voffA); PG8_STAGE(PG8_SB(1, 1), cB + hstepB + kstep, voffB);
        PG8_WAIT_V(6); PG8_BAR;
    }
    for (;;) {
        nxt = S.next(ui + 1); const bool has_next = nxt.pm >= 0;
        const char* nA = has_next ? (const char*)g.A + (size_t)nxt.pm * tstepA + (size_t)(g.a_blk ? (nxt.pn & 7) * 512 : 0) + (size_t)nxt.k0 * kstep : cA; const char* nB = has_next ? (const char*)g.Bt + (size_t)nxt.pn * tstepB + (size_t)nxt.k0 * kstep : cB;
        const int nt = cur.nk;
#pragma unroll 1
        for (int t = 0; t < nt; t += 2) {
            const bool last = (t == nt - 2);
            const char* a1 = cA + (size_t)(t + 1) * kstep;
            const char* a2 = last ? nA : cA + (size_t)(t + 2) * kstep; const char* b2 = last ? nB : cB + (size_t)(t + 2) * kstep;
            const char* a3 = a2 + kstep; const char* b3 = b2 + kstep;
            if constexpr (SP2) {
            PG8_LDB(B0, 0, 0); PG8_LDB(B1, 0, 1); PG8_SCHED; PG8_LDA(At, 0, 0); PG8_STAGE(PG8_SA(1, 1), a1 + hstepA, voffA);
            PG8_WAIT_V(8); PG8_WAIT_L(0); PG8_BAR; PG8_MMA(0, 0, At, B0); PG8_MMA(0, 1, At, B1); PG8_BAR; PG8_SCHED;
            PG8_LDA(At, 0, 1); PG8_STAGE(PG8_SB(0, 0), b2, voffB); PG8_STAGE(PG8_SB(0, 1), b2 + hstepB, voffB); PG8_STAGE(PG8_SA(0, 0), a2, voffA);
            PG8_WAIT_V(8); PG8_WAIT_L(0); PG8_BAR; PG8_MMA(1, 0, At, B0); PG8_MMA(1, 1, At, B1); PG8_BAR; PG8_SCHED;
            PG8_LDB(B0, 1, 0); PG8_LDB(B1, 1, 1); PG8_SCHED; PG8_LDA(At, 1, 0); PG8_STAGE(PG8_SA(0, 1), a2 + hstepA, voffA);
            PG8_WAIT_V(8); PG8_WAIT_L(0); PG8_BAR; PG8_MMA(0, 0, At, B0); PG8_MMA(0, 1, At, B1); PG8_BAR; PG8_SCHED;
            PG8_LDA(At, 1, 1); PG8_STAGE(PG8_SB(1, 0), b3, voffB); PG8_STAGE(PG8_SB(1, 1), b3 + hstepB, voffB); PG8_STAGE(PG8_SA(1, 0), a3, voffA);
            PG8_WAIT_V(8); PG8_WAIT_L(0); PG8_BAR; PG8_MMA(1, 0, At, B0); PG8_MMA(1, 1, At, B1); PG8_BAR; PG8_SCHED;
            } else {
            PG8_LDB(B0, 0, 0); PG8_SCHED; PG8_LDA(At, 0, 0); PG8_STAGE(PG8_SA(1, 1), a1 + hstepA, voffA);
            PG8_WAIT_L(8); PG8_BAR; PG8_WAIT_L(0); PG8_MMA(0, 0, At, B0); PG8_BAR; PG8_SCHED;
            PG8_LDB(B1, 0, 1); PG8_STAGE(PG8_SB(0, 0), b2, voffB);
            PG8_BAR; PG8_WAIT_L(0); PG8_MMA(0, 1, At, B1); PG8_BAR;
            PG8_LDA(At, 0, 1); PG8_STAGE(PG8_SA(0, 0), a2, voffA);
            PG8_BAR; PG8_WAIT_L(0); PG8_MMA(1, 0, At, B0); PG8_BAR; PG8_SCHED;
            PG8_STAGE(PG8_SB(0, 1), b2 + hstepB, voffB);
            PG8_WAIT_V(6); PG8_BAR; PG8_MMA(1, 1, At, B1); PG8_BAR;
            PG8_LDB(B0, 1, 0); PG8_SCHED; PG8_LDA(At, 1, 0); PG8_STAGE(PG8_SA(0, 1), a2 + hstepA, voffA);
            PG8_WAIT_L(8); PG8_BAR; PG8_WAIT_L(0); PG8_MMA(0, 0, At, B0); PG8_BAR; PG8_SCHED;
            PG8_LDB(B1, 1, 1); PG8_STAGE(PG8_SB(1, 0), b3, voffB);
            PG8_BAR; PG8_WAIT_L(0); PG8_MMA(0, 1, At, B1); PG8_BAR;
            PG8_LDA(At, 1, 1); PG8_STAGE(PG8_SA(1, 0), a3, voffA);
            PG8_BAR; PG8_WAIT_L(0); PG8_MMA(1, 0, At, B0); PG8_BAR; PG8_SCHED;
            PG8_STAGE(PG8_SB(1, 1), b3 + hstepB, voffB);
            PG8_WAIT_V(6); PG8_BAR; PG8_MMA(1, 1, At, B1); PG8_BAR;
            }
        }
        if constexpr (ALIGN_EPI) { if (wr == 0) PG8_BAR; }
        E(acc, cur, wr, wc, fr, fq);
        if (!has_next) break;
#pragma unroll
        for (int a = 0; a < 2; ++a)
#pragma unroll
            for (int b = 0; b < 2; ++b)
#pragma unroll
                for (int m = 0; m < 4; ++m)
#pragma unroll
                    for (int n = 0; n < 2; ++n) acc[a][b][m][n] = (f32x4){0.f, 0.f, 0.f, 0.f};
        cur = nxt; cA = nA; cB = nB; ++ui;
        if constexpr (ALIGN_EPI) { if (wr == 1) PG8_BAR; }
    }
    PG8_WAIT_V(0);
    if constexpr (!ALIGN_EPI) { if (wr == 0) PG8_BAR; }
    PG8_BAR;
#undef PG8_SA
#undef PG8_SB
#undef PG8_STAGE
#undef PG8_LDA
#undef PG8_LDB
#undef PG8_MMA
#undef PG8_WAIT_V
#undef PG8_WAIT_L
#undef PG8_BAR
#undef PG8_SCHED
}
}

namespace att {
constexpr int NW = 8, QBLK = 32, KVBLK = 64, DV = 128;
constexpr float THR = 8.f;
#define SBAR() __builtin_amdgcn_sched_barrier(0)
__device__ __forceinline__ int crow(int r, int hi) { return (r & 3) + 8 * (r >> 2) + 4 * hi; }
template <int DQK> struct Cfg {
    static constexpr int KROW = DQK * 2;
    static constexpr int SHM_K = KVBLK * KROW, SHM_V = KVBLK * DV * 2;
    static constexpr int QPE_OFF = 2 * SHM_V + 2 * SHM_K + NW * 64 * 4;
    static constexpr int NPARK = DQK == 192 ? 4 : 0;
    static constexpr int QR0 = DQK / 16 - NPARK;
    static constexpr int LDS_BYTES = QPE_OFF + NW * NPARK * 1024;
    static constexpr int NQ = DQK / 16;
    static constexpr int NKC = DQK / 64;
};
template <int DQK> __device__ __forceinline__ int kswz(int row, int colB) { return row * (DQK * 2) + (colB ^ (DQK == 128 ? ((row & 15) << 4) : (((row >> 1) & 7) << 4))); }

template <int DQK>
__device__ __forceinline__ void partialSM(f32x16& p0, f32x16& p1, float& m_reg, float& mn, float& alpha) {
    constexpr float SCALE = DQK == 128 ? 0.08838834764831845f : 0.07216878364870322f;
    constexpr float C = SCALE * 1.4426950408889634f;
    float pmax = p0[0];
#pragma unroll
    for (int r = 1; r < 16; ++r) pmax = fmaxf(pmax, p0[r]);
#pragma unroll
    for (int r = 0; r < 16; ++r) pmax = fmaxf(pmax, p1[r]);
    { auto rr = __builtin_amdgcn_permlane32_swap(__float_as_uint(pmax), __float_as_uint(pmax), false, false);
      pmax = fmaxf(__uint_as_float(rr[0]), __uint_as_float(rr[1])); }
    if (__builtin_expect(__all(pmax - m_reg <= THR / SCALE), 1)) { mn = m_reg; alpha = 1.f; }
    else { mn = fmaxf(m_reg, pmax); alpha = __builtin_amdgcn_exp2f((m_reg - mn) * C); m_reg = mn; }
    const float mnC = -mn * C;
#pragma unroll
    for (int r = 0; r < 16; ++r) p0[r] = fmaf(p0[r], C, mnC);
#pragma unroll
    for (int r = 0; r < 16; ++r) p1[r] = fmaf(p1[r], C, mnC);
#pragma unroll
    for (int r = 0; r < 16; ++r) p0[r] = __builtin_amdgcn_exp2f(p0[r]);
}
__device__ __forceinline__ void finishSM(f32x16& p0, f32x16& p1, float alpha, float& l_reg, bf16x8& pa0, bf16x8& pa1, bf16x8& pa2, bf16x8& pa3) {
#pragma unroll
    for (int r = 0; r < 16; ++r) p1[r] = __builtin_amdgcn_exp2f(p1[r]);
    float ps = 0;
#pragma unroll
    for (int r = 0; r < 16; ++r) ps += p0[r];
#pragma unroll
    for (int r = 0; r < 16; ++r) ps += p1[r];
    { auto rr = __builtin_amdgcn_permlane32_swap(__float_as_uint(ps), __float_as_uint(ps), false, false);
      ps = __uint_as_float(rr[0]) + __uint_as_float(rr[1]); }
    l_reg = l_reg * alpha + ps;
#define PK4(P, BASE, OUT) do { unsigned a0 = cvt_pk_bf16(P[BASE + 0], P[BASE + 1]), a1 = cvt_pk_bf16(P[BASE + 2], P[BASE + 3]);   \
    unsigned b0 = cvt_pk_bf16(P[BASE + 4], P[BASE + 5]), b1 = cvt_pk_bf16(P[BASE + 6], P[BASE + 7]);                              \
    auto r0 = __builtin_amdgcn_permlane32_swap(a0, b0, false, false); auto r1 = __builtin_amdgcn_permlane32_swap(a1, b1, false, false); \
    u32x4 w = {r0[0], r1[0], r0[1], r1[1]}; OUT = *reinterpret_cast<bf16x8*>(&w); } while (0)
    PK4(p0, 0, pa0); PK4(p0, 8, pa1); PK4(p1, 0, pa2); PK4(p1, 8, pa3);
#undef PK4
}
__device__ __forceinline__ void partialSM_nomax(f32x16& p0, f32x16& p1) {
    SBAR();
#pragma unroll
    for (int r = 0; r < 16; ++r) p0[r] = __builtin_amdgcn_exp2f(p0[r]);
    SBAR();
}
template <int DQK, bool PARK = (DQK == 192)>
__device__ __forceinline__ void qkt(f32x16& p0, f32x16& p1, const char* Ks, const bf16x8* qr, const char* qpe, int r32, int hi) {
    p0 = f32x16{}; p1 = f32x16{};
#pragma unroll
    for (int d0 = 0; d0 < DQK / 16; ++d0) { const int cb = (d0 * 16 + hi * 8) * 2;
        bf16x8 b0 = *reinterpret_cast<const bf16x8*>(Ks + kswz<DQK>(r32, cb));
        bf16x8 b1 = *reinterpret_cast<const bf16x8*>(Ks + kswz<DQK>(32 + r32, cb));
        bf16x8 q; if (!PARK || d0 < Cfg<DQK>::QR0) q = qr[(!PARK || d0 < Cfg<DQK>::QR0) ? d0 : 0]; else q = *reinterpret_cast<const bf16x8*>(qpe + (d0 - Cfg<DQK>::QR0) * 1024);
        p0 = __builtin_amdgcn_mfma_f32_32x32x16_bf16(b0, q, p0, 0, 0, 0);
        p1 = __builtin_amdgcn_mfma_f32_32x32x16_bf16(b1, q, p1, 0, 0, 0);
        if (DQK == 192 && (d0 & 3) == 3 && d0 != 11) SBAR(); }
}
__device__ __forceinline__ int v_st(int k, int c) { const int kk = (k & ~0xC) | ((k & 4) << 1) | ((k & 8) >> 1); return ((kk >> 3) * 4 + (c >> 5)) * 512 + ((kk & 7) * 32 + (c & 31)) * 2; }
__device__ __forceinline__ int v_rd_base(int lane) { return ((lane & 3) << 3) | (((lane >> 2) & 3) << 6) | (((lane >> 4) & 1) << 5) | (((lane >> 5) & 1) << 8); }
constexpr int v_rd_off(int d0, int ks, int half) { return d0 * 512 + ks * 4096 + half * 2048; }
template <int OFF> __device__ __forceinline__ s16x4 tr_read(int vb) {
    s16x4 r; asm volatile("ds_read_b64_tr_b16 %0, %1 offset:%2" : "=&v"(r) : "v"(vb), "i"(OFF) : "memory"); return r;
}
template <int D0> __device__ __forceinline__ void pv_one(f32x16& od, int vb, bf16x8 pa0, bf16x8 pa1, bf16x8 pa2, bf16x8 pa3) {
    const s16x4 l0 = tr_read<v_rd_off(D0, 0, 0)>(vb), h0 = tr_read<v_rd_off(D0, 0, 1)>(vb), l1 = tr_read<v_rd_off(D0, 1, 0)>(vb), h1 = tr_read<v_rd_off(D0, 1, 1)>(vb);
    const s16x4 l2 = tr_read<v_rd_off(D0, 2, 0)>(vb), h2 = tr_read<v_rd_off(D0, 2, 1)>(vb), l3 = tr_read<v_rd_off(D0, 3, 0)>(vb), h3 = tr_read<v_rd_off(D0, 3, 1)>(vb);
    asm volatile("s_waitcnt lgkmcnt(0)" ::: "memory"); SBAR();
#define PK(L, H) (bf16x8){L[0], L[1], L[2], L[3], H[0], H[1], H[2], H[3]}
    od = __builtin_amdgcn_mfma_f32_32x32x16_bf16(pa0, PK(l0, h0), od, 0, 0, 0);
    od = __builtin_amdgcn_mfma_f32_32x32x16_bf16(pa1, PK(l1, h1), od, 0, 0, 0);
    od = __builtin_amdgcn_mfma_f32_32x32x16_bf16(pa2, PK(l2, h2), od, 0, 0, 0);
    od = __builtin_amdgcn_mfma_f32_32x32x16_bf16(pa3, PK(l3, h3), od, 0, 0, 0);
#undef PK
}
__device__ __forceinline__ void pv_d0(f32x16* o, int vb, bf16x8 pa0, bf16x8 pa1, bf16x8 pa2, bf16x8 pa3) {
    pv_one<0>(o[0], vb, pa0, pa1, pa2, pa3); pv_one<1>(o[1], vb, pa0, pa1, pa2, pa3); pv_one<2>(o[2], vb, pa0, pa1, pa2, pa3); pv_one<3>(o[3], vb, pa0, pa1, pa2, pa3);
}
struct VFrag { s16x4 l0, h0, l1, h1, l2, h2, l3, h3; };
template <int D0> __device__ __forceinline__ void pv_reads(VFrag& f, int vb) {
    f.l0 = tr_read<v_rd_off(D0, 0, 0)>(vb); f.h0 = tr_read<v_rd_off(D0, 0, 1)>(vb); f.l1 = tr_read<v_rd_off(D0, 1, 0)>(vb); f.h1 = tr_read<v_rd_off(D0, 1, 1)>(vb);
    f.l2 = tr_read<v_rd_off(D0, 2, 0)>(vb); f.h2 = tr_read<v_rd_off(D0, 2, 1)>(vb); f.l3 = tr_read<v_rd_off(D0, 3, 0)>(vb); f.h3 = tr_read<v_rd_off(D0, 3, 1)>(vb);
}
__device__ __forceinline__ void pv_mma(f32x16& od, const VFrag& f, bf16x8 pa0, bf16x8 pa1, bf16x8 pa2, bf16x8 pa3) {
#define PK(L, H) (bf16x8){L[0], L[1], L[2], L[3], H[0], H[1], H[2], H[3]}
    od = __builtin_amdgcn_mfma_f32_32x32x16_bf16(pa0, PK(f.l0, f.h0), od, 0, 0, 0);
    od = __builtin_amdgcn_mfma_f32_32x32x16_bf16(pa1, PK(f.l1, f.h1), od, 0, 0, 0);
    od = __builtin_amdgcn_mfma_f32_32x32x16_bf16(pa2, PK(f.l2, f.h2), od, 0, 0, 0);
    od = __builtin_amdgcn_mfma_f32_32x32x16_bf16(pa3, PK(f.l3, f.h3), od, 0, 0, 0);
#undef PK
}
__device__ __forceinline__ void pv_pipe(f32x16* o, int vb, bf16x8 pa0, bf16x8 pa1, bf16x8 pa2, bf16x8 pa3) {
    VFrag fa, fb;
    pv_reads<0>(fa, vb); pv_reads<1>(fb, vb);
    asm volatile("s_waitcnt lgkmcnt(8)" ::: "memory"); SBAR();
    pv_mma(o[0], fa, pa0, pa1, pa2, pa3); SBAR();
    pv_reads<2>(fa, vb);
    asm volatile("s_waitcnt lgkmcnt(8)" ::: "memory"); SBAR();
    pv_mma(o[1], fb, pa0, pa1, pa2, pa3); SBAR();
    pv_reads<3>(fb, vb);
    asm volatile("s_waitcnt lgkmcnt(8)" ::: "memory"); SBAR();
    pv_mma(o[2], fa, pa0, pa1, pa2, pa3); SBAR();
    asm volatile("s_waitcnt lgkmcnt(0)" ::: "memory"); SBAR();
    pv_mma(o[3], fb, pa0, pa1, pa2, pa3);
}
__device__ __forceinline__ void unpack8(bf16x8 v, float* f) {
    const u32x4 w = *reinterpret_cast<const u32x4*>(&v);
    f[0] = bf_lo(w.x); f[1] = bf_hi(w.x); f[2] = bf_lo(w.y); f[3] = bf_hi(w.y); f[4] = bf_lo(w.z); f[5] = bf_hi(w.z); f[6] = bf_lo(w.w); f[7] = bf_hi(w.w);
}
__device__ __forceinline__ bf16x8 pack8(const float* f) {
    u32x4 w = {cvt_pk_bf16(f[0], f[1]), cvt_pk_bf16(f[2], f[3]), cvt_pk_bf16(f[4], f[5]), cvt_pk_bf16(f[6], f[7])}; return *reinterpret_cast<bf16x8*>(&w);
}
__device__ __forceinline__ void rope_pair(bf16x8& A, bf16x8& B, const f32x2* __restrict__ tab) {
    float a[8], b[8], ra[8], rb[8]; unpack8(A, a); unpack8(B, b);
#pragma unroll
    for (int j = 0; j < 8; ++j) { const f32x2 cs = tab[j]; ra[j] = a[j] * cs.x - b[j] * cs.y; rb[j] = b[j] * cs.x + a[j] * cs.y; }
    A = pack8(ra); B = pack8(rb);
}

template <int DQK, int LDQ, int LDK, int LDV, int LDO>
__device__ __forceinline__ void attn_body(const bf16_t* __restrict__ Qb, const bf16_t* __restrict__ Kh, const bf16_t* __restrict__ Vh, bf16_t* __restrict__ Ob, int seq, char* lds,
                                          const float* __restrict__ qg, const f32x2* __restrict__ tab, bool rope, int tok0) {
    using C = Cfg<DQK>;
    int tid_ = threadIdx.x; asm volatile("" : "+v"(tid_));
    const int tid = tid_, wid = tid >> 6, lane = tid & 63, r32 = lane & 31, hi = lane >> 5;
    char* V_lds = lds; char* K_lds = lds + 2 * C::SHM_V;
    float* wsf = (float*)(lds + 2 * C::SHM_V + 2 * C::SHM_K) + wid * 64; float* li_l = wsf; float* al_l = wsf + 32;
    char* qpe = lds + C::QPE_OFF + wid * (C::NPARK * 1024) + lane * 16;
    float m_reg = -1e30f, l_reg = 0; f32x16 o[4] = {}; bf16x8 qr[C::NQ];
    const bf16_t* Qw = Qb + (long)(wid * QBLK + r32) * LDQ + hi * 8;
#pragma unroll
    for (int d0 = 0; d0 < C::NQ; ++d0) qr[d0] = *reinterpret_cast<const bf16x8*>(Qw + d0 * 16);
    {
        const int t = tok0 + wid * QBLK + r32, prow = t >> 6, pcol = t & 63;
        if constexpr (DQK == 128) {
            float ss = 0.f;
#pragma unroll
            for (int d0 = 0; d0 < 8; ++d0) { float f[8]; unpack8(qr[d0], f);
#pragma unroll
                for (int j = 0; j < 8; ++j) ss += f[j] * f[j]; }
            ss += __shfl_xor(ss, 32);
            const float rstd = 1.0f / sqrtf(ss * (1.0f / 128.0f) + 1e-6f);
#pragma unroll
            for (int d0 = 0; d0 < 8; ++d0) { float f[8]; unpack8(qr[d0], f);
#pragma unroll
                for (int j = 0; j < 8; ++j) f[j] = f[j] * rstd * qg[d0 * 16 + hi * 8 + j];
                qr[d0] = pack8(f); }
            if (rope) {
                const f32x2* tr = tab + prow * 32 + hi * 8; const f32x2* tc = tab + pcol * 32 + hi * 8;
                rope_pair(qr[0], qr[2], tr); rope_pair(qr[1], qr[3], tr + 16);
                rope_pair(qr[4], qr[6], tc); rope_pair(qr[5], qr[7], tc + 16);
            }
        } else {
            if (rope) {
                const f32x2* tr = tab + prow * 16 + hi * 8; const f32x2* tc = tab + pcol * 16 + hi * 8;
                rope_pair(qr[8], qr[9], tr); rope_pair(qr[10], qr[11], tc);
            }
        }
    }
    if constexpr (DQK == 192) {
#pragma unroll
        for (int d0 = C::QR0; d0 < 12; ++d0) *reinterpret_cast<bf16x8*>(qpe + (d0 - C::QR0) * 1024) = qr[d0];
        asm volatile("s_waitcnt lgkmcnt(0)" ::: "memory");
    }
    const int sr = tid >> 4, sc = (tid & 15) * 8, vst0 = v_st(sr, sc), vst1 = v_st(32 + sr, sc);
    const int vb0 = (int)(uintptr_t)V_lds + v_rd_base(lane);
    const int sr2 = tid >> 3, sc2 = 128 + (tid & 7) * 8;
    struct Slot { bf16x8 vs0, vs1, ks0, ks1, ks2; };
    Slot sA, sBs;
#define sB (*(DQK == 192 ? &sA : &sBs))
#define SLOAD(S, k0) do { S.vs0 = *reinterpret_cast<const bf16x8*>(&Vh[(long)((k0) + sr) * LDV + sc]); S.vs1 = *reinterpret_cast<const bf16x8*>(&Vh[(long)((k0) + 32 + sr) * LDV + sc]); \
    S.ks0 = *reinterpret_cast<const bf16x8*>(&Kh[(long)((k0) + sr) * LDK + sc]); S.ks1 = *reinterpret_cast<const bf16x8*>(&Kh[(long)((k0) + 32 + sr) * LDK + sc]); \
    if constexpr (DQK == 192) S.ks2 = *reinterpret_cast<const bf16x8*>(&Kh[(long)((k0) + sr2) * LDK + sc2]); } while (0)
#define SWRITE(b, S) do { *(bf16x8*)(V_lds + (b) * C::SHM_V + vst0) = S.vs0; *(bf16x8*)(V_lds + (b) * C::SHM_V + vst1) = S.vs1; \
    *(bf16x8*)(K_lds + (b) * C::SHM_K + kswz<DQK>(sr, sc * 2)) = S.ks0; *(bf16x8*)(K_lds + (b) * C::SHM_K + kswz<DQK>(32 + sr, sc * 2)) = S.ks1; \
    if constexpr (DQK == 192) *(bf16x8*)(K_lds + (b) * C::SHM_K + kswz<DQK>(sr2, sc2 * 2)) = S.ks2; } while (0)
#define SWAIT() do { if constexpr (DQK == 192) asm volatile("s_waitcnt vmcnt(0)" ::: "memory"); else asm volatile("s_waitcnt vmcnt(4)" ::: "memory"); } while (0)
#define RESC(a) do { if (__any((a) < 1.f)) { if (hi == 0) al_l[r32] = (a); asm volatile("s_waitcnt lgkmcnt(0)" ::: "memory"); \
    _Pragma("unroll") for (int d = 0; d < 4; ++d) _Pragma("unroll") for (int r = 0; r < 16; ++r) o[d][r] *= al_l[crow(r, hi)]; } } while (0)
    f32x16 pA0, pA1, pB0, pB1; float mnA, mnB, alA, alB; bf16x8 pa0, pa1, pa2, pa3; const int NT = seq / KVBLK;
    SLOAD(sA, 0); asm volatile("s_waitcnt vmcnt(0)" ::: "memory"); SWRITE(0, sA); __syncthreads();
    qkt<DQK>(pA0, pA1, K_lds, qr, qpe, r32, hi); partialSM<DQK>(pA0, pA1, m_reg, mnA, alA);
    SLOAD(sB, KVBLK); if constexpr (DQK != 192) { if (2 < NT) SLOAD(sA, 2 * KVBLK); }
    SWAIT(); SWRITE(1, sB); __syncthreads();
    for (int j = 1; j + 1 < NT; j += 2) {
        SBAR(); qkt<DQK>(pB0, pB1, K_lds + C::SHM_K, qr, qpe, r32, hi);
        finishSM(pA0, pA1, alA, l_reg, pa0, pa1, pa2, pa3); SBAR();
        SLOAD(sB, (j + (DQK == 192 ? 1 : 2)) * KVBLK); SBAR();
        pv_d0(o, vb0, pa0, pa1, pa2, pa3); partialSM<DQK>(pB0, pB1, m_reg, mnB, alB);
        __syncthreads(); SWAIT(); SWRITE(0, sA);
        RESC(alB); __syncthreads();
        SBAR(); qkt<DQK>(pA0, pA1, K_lds, qr, qpe, r32, hi);
        finishSM(pB0, pB1, alB, l_reg, pa0, pa1, pa2, pa3); SBAR();
        if (DQK == 192 || j + 3 < NT) SLOAD(sA, (j + (DQK == 192 ? 2 : 3)) * KVBLK); SBAR();
        pv_d0(o, vb0 + C::SHM_V, pa0, pa1, pa2, pa3); partialSM<DQK>(pA0, pA1, m_reg, mnA, alA);
        __syncthreads(); SWAIT(); SWRITE(1, sB);
        RESC(alA); __syncthreads();
    }
    SBAR(); qkt<DQK>(pB0, pB1, K_lds + C::SHM_K, qr, qpe, r32, hi);
    finishSM(pA0, pA1, alA, l_reg, pa0, pa1, pa2, pa3); SBAR();
    pv_d0(o, vb0, pa0, pa1, pa2, pa3); partialSM<DQK>(pB0, pB1, m_reg, mnB, alB);
    __syncthreads(); RESC(alB);
    finishSM(pB0, pB1, alB, l_reg, pa0, pa1, pa2, pa3); SBAR();
    pv_d0(o, vb0 + C::SHM_V, pa0, pa1, pa2, pa3);
    if (hi == 0) li_l[r32] = l_reg; asm volatile("s_waitcnt lgkmcnt(0)" ::: "memory");
    float rli[16];
#pragma unroll
    for (int r = 0; r < 16; ++r) rli[r] = __builtin_amdgcn_rcpf(li_l[crow(r, hi)]);
    bf16_t* Ow = Ob + (long)(wid * QBLK) * LDO;
#pragma unroll
    for (int r = 0; r < 16; ++r) { const int orow = crow(r, hi);
#pragma unroll
        for (int d0 = 0; d0 < 4; ++d0) Ow[(long)orow * LDO + d0 * 32 + r32] = f2bf(o[d0][r] * rli[r]); }
    __syncthreads();
#undef sB
#undef SLOAD
#undef SWRITE
#undef SWAIT
#undef RESC
}

__device__ __forceinline__ void glds16(const void* g, unsigned lds_base) {
    unsigned sv; asm volatile("s_mov_b32 %0, m0\n\ts_mov_b32 m0, %2\n\ts_nop 0\n\tglobal_load_lds_dwordx4 %1, off\n\ts_mov_b32 m0, %0" : "=&s"(sv) : "v"(g), "s"(lds_base) : "memory"); }
template <int DQK> struct CfgD {
    static constexpr int SHM_K = KVBLK * DQK * 2, SHM_V = KVBLK * DV * 2;
    static constexpr int KR = 0, VR = 3 * SHM_K, SCR = VR + 3 * SHM_V, LDS_BYTES = SCR + NW * 64 * 4;
    static constexpr int NPK = DQK / 64, NPV = 2;
};
template <int DQK, int LDQ, int LDK, int LDV, int LDO, bool NOMAX = false>
__device__ __forceinline__ void attn_body_dma(const bf16_t* __restrict__ Qb, const bf16_t* __restrict__ Kh, const bf16_t* __restrict__ Vh, bf16_t* __restrict__ Ob, int seq, char* lds,
                                              const float* __restrict__ qg, const f32x2* __restrict__ tab, bool rope, int tok0) {
    using C = CfgD<DQK>;
    int tid_ = threadIdx.x; asm volatile("" : "+v"(tid_));
    const int tid = tid_, wid = __builtin_amdgcn_readfirstlane(tid >> 6), lane = tid & 63, r32 = lane & 31, hi = lane >> 5;
    const unsigned lds0 = (unsigned)__builtin_amdgcn_readfirstlane((int)(uintptr_t)lds);
    char* K_lds = lds + C::KR;
    float* wsf = (float*)(lds + C::SCR) + wid * 64; float* li_l = wsf; float* al_l = wsf + 32;
    unsigned kvoff[C::NPK], vvoff[C::NPV];
#pragma unroll
    for (int i = 0; i < C::NPK; ++i) { const int b = (wid + 8 * i) * 1024 + lane * 16, row = b / (DQK * 2), pos = b % (DQK * 2);
        const int colB = pos ^ (DQK == 128 ? ((row & 15) << 4) : (((row >> 1) & 7) << 4)); kvoff[i] = (unsigned)(row * LDK * 2 + colB); }
#pragma unroll
    for (int i = 0; i < C::NPV; ++i) { const int sbt = (wid + 8 * i) * 2 + (lane >> 5), rowin = (lane & 31) >> 2, cch = lane & 3, kk = (sbt >> 2) * 8 + rowin;
        const int k = (kk & ~0xC) | ((kk & 4) << 1) | ((kk & 8) >> 1), c = (sbt & 3) * 32 + cch * 8; vvoff[i] = (unsigned)(k * LDV * 2 + c * 2); }
#define ISSUE_K(J, SL) do { const char* g_ = (const char*)Kh + (size_t)(J) * (KVBLK * LDK * 2); _Pragma("unroll") for (int i_ = 0; i_ < C::NPK; ++i_) \
        glds16(g_ + kvoff[i_], lds0 + C::KR + (SL) * C::SHM_K + (wid + 8 * i_) * 1024); } while (0)
#define ISSUE_V(J, SL) do { const char* g_ = (const char*)Vh + (size_t)(J) * (KVBLK * LDV * 2); _Pragma("unroll") for (int i_ = 0; i_ < C::NPV; ++i_) \
        glds16(g_ + vvoff[i_], lds0 + C::VR + (SL) * C::SHM_V + (wid + 8 * i_) * 1024); } while (0)
#define WAIT_BAR(N) asm volatile("s_waitcnt vmcnt(" #N ") lgkmcnt(0)\n\ts_barrier" ::: "memory")
    const int NT = seq / KVBLK;
    ISSUE_K(0, 0); ISSUE_V(0, 0); ISSUE_K(1, 1);
    float m_reg = -1e30f, l_reg = 0; f32x16 o[4] = {}; bf16x8 qr[DQK / 16];
    const bf16_t* Qw = Qb + (long)(wid * QBLK + r32) * LDQ + hi * 8;
#pragma unroll
    for (int d0 = 0; d0 < DQK / 16; ++d0) qr[d0] = *reinterpret_cast<const bf16x8*>(Qw + d0 * 16);
    {
        const int t = tok0 + wid * QBLK + r32, prow = t >> 6, pcol = t & 63;
        if constexpr (DQK == 128) {
            float ss = 0.f;
#pragma unroll
            for (int d0 = 0; d0 < 8; ++d0) { float f[8]; unpack8(qr[d0], f);
#pragma unroll
                for (int j = 0; j < 8; ++j) ss += f[j] * f[j]; }
            ss += __shfl_xor(ss, 32);
            const float rstd = 1.0f / sqrtf(ss * (1.0f / 128.0f) + 1e-6f);
#pragma unroll
            for (int d0 = 0; d0 < 8; ++d0) { float f[8]; unpack8(qr[d0], f);
#pragma unroll
                for (int j = 0; j < 8; ++j) f[j] = f[j] * rstd * qg[d0 * 16 + hi * 8 + j] * (NOMAX ? 0.08838834764831845f * 1.4426950408889634f : 1.0f);
                qr[d0] = pack8(f); }
            if (rope) {
                const f32x2* tr = tab + prow * 32 + hi * 8; const f32x2* tc = tab + pcol * 32 + hi * 8;
                rope_pair(qr[0], qr[2], tr); rope_pair(qr[1], qr[3], tr + 16);
                rope_pair(qr[4], qr[6], tc); rope_pair(qr[5], qr[7], tc + 16);
            }
        } else {
            if (rope) {
                const f32x2* tr = tab + prow * 16 + hi * 8; const f32x2* tc = tab + pcol * 16 + hi * 8;
                rope_pair(qr[8], qr[9], tr); rope_pair(qr[10], qr[11], tc);
            }
        }
    }
    SBAR();
    const int vb0 = (int)lds0 + C::VR + v_rd_base(lane);
#define RESC(a) do { if (__any((a) < 1.f)) { if (hi == 0) al_l[r32] = (a); asm volatile("s_waitcnt lgkmcnt(0)" ::: "memory"); \
    _Pragma("unroll") for (int d = 0; d < 4; ++d) _Pragma("unroll") for (int r = 0; r < 16; ++r) o[d][r] *= al_l[crow(r, hi)]; } } while (0)
    f32x16 pA0, pA1, pB0, pB1; float mnA = 0.f, mnB = 0.f, alA = 1.f, alB = 1.f; bf16x8 pa0, pa1, pa2, pa3;
#define PSM(P0, P1, MN, AL) do { if constexpr (NOMAX) partialSM_nomax(P0, P1); else partialSM<DQK>(P0, P1, m_reg, MN, AL); } while (0)
#define RESCX(a) do { if constexpr (!NOMAX) RESC(a); else SBAR(); } while (0)
    WAIT_BAR(0);
    qkt<DQK, false>(pA0, pA1, K_lds, qr, nullptr, r32, hi); PSM(pA0, pA1, mnA, alA);
    ISSUE_K(2, 2); ISSUE_V(1, 1);
    if constexpr (C::NPK + C::NPV == 4) WAIT_BAR(4); else WAIT_BAR(5);
    int sa = 1, sb = 2, sc = 0;
#define STEP(PX0, PX1, PY0, PY1, MNX, ALX, ALY, J) do { \
    SBAR(); qkt<DQK, false>(PX0, PX1, K_lds + sa * C::SHM_K, qr, nullptr, r32, hi); \
    finishSM(PY0, PY1, ALY, l_reg, pa0, pa1, pa2, pa3); SBAR(); \
    const bool gk_ = (J) + 2 < NT, gv_ = (J) + 1 < NT; \
    if (gk_) ISSUE_K((J) + 2, sc); if (gv_) ISSUE_V((J) + 1, sb); SBAR(); \
    pv_pipe(o, vb0 + sc * C::SHM_V, pa0, pa1, pa2, pa3); PSM(PX0, PX1, MNX, ALX); \
    RESCX(ALX); \
    if (gk_) { if constexpr (C::NPK + C::NPV == 4) WAIT_BAR(4); else WAIT_BAR(5); } else if (gv_) WAIT_BAR(2); else WAIT_BAR(0); \
    { const int t_ = sa; sa = sb; sb = sc; sc = t_; } } while (0)
    int j = 1;
    for (; j + 1 < NT; j += 2) {
        STEP(pB0, pB1, pA0, pA1, mnB, alB, alA, j);
        STEP(pA0, pA1, pB0, pB1, mnA, alA, alB, j + 1);
    }
    STEP(pB0, pB1, pA0, pA1, mnB, alB, alA, j);
    finishSM(pB0, pB1, alB, l_reg, pa0, pa1, pa2, pa3); SBAR();
    pv_d0(o, vb0 + sc * C::SHM_V, pa0, pa1, pa2, pa3);
    if (hi == 0) li_l[r32] = l_reg; asm volatile("s_waitcnt lgkmcnt(0)" ::: "memory");
    float rli[16];
#pragma unroll
    for (int r = 0; r < 16; ++r) rli[r] = __builtin_amdgcn_rcpf(li_l[crow(r, hi)]);
    bf16_t* Ow = Ob + (long)(wid * QBLK) * LDO;
#pragma unroll
    for (int r = 0; r < 16; ++r) { const int orow = crow(r, hi);
#pragma unroll
        for (int d0 = 0; d0 < 4; ++d0) Ow[(long)orow * LDO + d0 * 32 + r32] = f2bf(o[d0][r] * rli[r]); }
    WAIT_BAR(0);
#undef ISSUE_K
#undef ISSUE_V
#undef WAIT_BAR
#undef RESC
#undef STEP
#undef PSM
#undef RESCX
}
}

constexpr size_t MiB = 1u << 20;
constexpr size_t WS_CTL = 0, CTL_ZERO_BYTES = 1 * MiB;
constexpr size_t WS_MODS = 1 * MiB;
constexpr size_t WS_TAB = 2 * MiB;
constexpr size_t WS_X = 4 * MiB;
constexpr size_t WS_H = 140 * MiB;
constexpr size_t WS_OUTF = 208 * MiB;
constexpr size_t WS_W1T = 344 * MiB, WS_W2T = 472 * MiB;
constexpr size_t WS_GQAW = 600 * MiB;
constexpr size_t WS_LRUW = 640 * MiB;
constexpr size_t WS_MLAW = 668 * MiB;
constexpr size_t WS_BIG = 688 * MiB;
constexpr size_t WS_ACT = WS_BIG;
constexpr size_t WS_GQ = WS_BIG, WS_GK = WS_BIG + 68 * MiB, WS_GV = WS_BIG + 85 * MiB, WS_GO = WS_BIG + 102 * MiB;
constexpr size_t WS_MAP = WS_BIG, WS_MQAN = WS_BIG + 85 * MiB, WS_MCKVN = WS_BIG + 102 * MiB, WS_MQ = WS_BIG + 119 * MiB, WS_MK = WS_BIG + 221 * MiB, WS_MV = WS_BIG + 323 * MiB, WS_MO = WS_BIG + 391 * MiB;
constexpr size_t WS_LUP = WS_BIG, WS_LG = WS_BIG  , WS_LGY = WS_BIG + 68 * MiB, WS_LU = WS_BIG + 136 * MiB, WS_LAF = WS_BIG + 204 * MiB, WS_LGUF = WS_BIG + 272 * MiB,
                 WS_LAB = WS_BIG + 340 * MiB, WS_LGUB = WS_BIG + 408 * MiB, WS_LPS = WS_BIG + 476 * MiB, WS_LCIN = WS_BIG + 494 * MiB;
static_assert(WS_LGUF == WS_LAF + (size_t)R * DM * 2 && WS_LAB == WS_LGUF + (size_t)R * DM * 2 && WS_LGUB == WS_LAB + (size_t)R * DM * 2, "gate outputs are consecutive");
constexpr size_t WS_PART = WS_BIG + 776 * MiB;
constexpr size_t WS_END = WS_PART + 64 * MiB;
constexpr int NCH = 136;

#define XB_TMO      128
#define XB_XCNT(j)  (256  + 64 * (j))
#define XB_XSUB(j)  (1280 + 64 * (j))
#define XB_XGEN(j)  (2304 + 64 * (j))
#define XB_TOP      3328
#define XB_TOPGEN   3392
#define XCD_BAR_WORDS 3456
#define XB_SPIN_CAP (1u << 22)
__device__ __forceinline__ unsigned xb_ld(unsigned* p)              { return __hip_atomic_load(p, __ATOMIC_RELAXED, __HIP_MEMORY_SCOPE_AGENT); }
__device__ __forceinline__ unsigned xb_add(unsigned* p, unsigned v) { return __hip_atomic_fetch_add(p, v, __ATOMIC_RELAXED, __HIP_MEMORY_SCOPE_AGENT); }
__device__ __forceinline__ unsigned xb_xcc_id() { return (unsigned)__builtin_amdgcn_s_getreg((3 << 11) | 20) & 0xFu; }
#define XB_SPIN(cond, bar) do { unsigned _sp = 0; while (cond) { __builtin_amdgcn_s_sleep(1); \
    if ((++_sp & 255u) == 0u) { if (xb_ld(&(bar)[XB_TMO])) break; if (_sp > XB_SPIN_CAP) { atomicAdd(&(bar)[XB_TMO], 1u); break; } } } } while (0)
struct XcdBarrier { unsigned* bar; unsigned x; volatile LAS unsigned* st; };
__device__ __forceinline__ XcdBarrier xcd_barrier_post(unsigned* bar, volatile LAS unsigned* st) {
    XcdBarrier b; b.bar = bar; b.x = xb_xcc_id(); b.st = st;
    if (threadIdx.x == 0) (void)xb_add(&bar[XB_XCNT(b.x)], 1u);
    return b;
}
__device__ __forceinline__ void xcd_barrier_complete(unsigned* bar, unsigned x, unsigned& nloc, unsigned& nx) {
    const unsigned G = gridDim.x * gridDim.y * gridDim.z;
    unsigned sum, cnt, mine, sp = 0u;
    for (;;) {
        sum = 0u; cnt = 0u; mine = 0u;
#pragma unroll
        for (unsigned j = 0; j < 16; ++j) { const unsigned c = xb_ld(&bar[XB_XCNT(j)]); sum += c; cnt += (c > 0u) ? 1u : 0u; mine = (j == x) ? c : mine; }
        if (sum == G) break;
        __builtin_amdgcn_s_sleep(1);
        if ((++sp & 255u) == 0u) { if (xb_ld(&bar[XB_TMO])) break; if (sp > XB_SPIN_CAP) { atomicAdd(&bar[XB_TMO], 1u); break; } }
    }
    nloc = mine > 0u ? mine : 1u; nx = cnt > 0u ? cnt : 1u;
}
__device__ __forceinline__ void xcd_barrier(const XcdBarrier& b) {
    asm volatile("s_waitcnt vmcnt(0)" ::: "memory");
    __syncthreads();
    if (threadIdx.x == 0) {
        unsigned* bar = b.bar;
        __builtin_amdgcn_s_waitcnt(0);
        unsigned nloc = b.st[0], nx = b.st[1];
        if (nloc == 0u) { xcd_barrier_complete(bar, b.x, nloc, nx); b.st[0] = nloc; b.st[1] = nx; }
        const unsigned old = xb_add(&bar[XB_XSUB(b.x)], 1u);
        const unsigned gen = old / nloc;
        if (old + 1u == (gen + 1u) * nloc) {
            __builtin_amdgcn_fence(__ATOMIC_RELEASE, "agent");
            asm volatile("s_waitcnt vmcnt(0)" ::: "memory");
            const unsigned og = xb_add(&bar[XB_TOP], 1u);
            const unsigned tg = og / nx;
            if (og + 1u == (tg + 1u) * nx) xb_add(&bar[XB_TOPGEN], 1u);
            else XB_SPIN(xb_ld(&bar[XB_TOPGEN]) == tg, bar);
            __builtin_amdgcn_fence(__ATOMIC_ACQUIRE, "agent");
            xb_add(&bar[XB_XGEN(b.x)], 1u);
            asm volatile("s_waitcnt vmcnt(0)" ::: "memory");
        } else {
            XB_SPIN(xb_ld(&bar[XB_XGEN(b.x)]) == gen, bar);
            __builtin_amdgcn_fence(__ATOMIC_ACQUIRE, "agent");
            asm volatile("s_waitcnt vmcnt(0)" ::: "memory");
        }
    }
    __syncthreads();
}

#ifndef PROBE_N
#define PROBE_N 2
#endif
__device__ __forceinline__ int probe_count() { int n = PROBE_N; asm volatile("" : "+s"(n)); return n; }
#ifdef PROBE_GEMM
#define PROBE_REPEAT_GEMM for (int rep_ = 0, nrep_ = probe_count(); rep_ < nrep_; ++rep_)
#else
#define PROBE_REPEAT_GEMM
#endif
#ifdef PROBE_ATTN
#define PROBE_REPEAT_ATTN for (int rep_ = 0, nrep_ = probe_count(); rep_ < nrep_; ++rep_)
#else
#define PROBE_REPEAT_ATTN
#endif
struct Args {
    const float *x, *c, *ctx, *c_ctx, *ada_w, *ada_b, *ln_g, *ln_b, *mlp_w1, *mlp_w2;
    const float *gqa_wq, *gqa_wk, *gqa_wv, *gqa_wo, *gqa_q_g, *gqa_k_g;
    const float *lru_wx, *lru_wy, *lru_conv_w, *lru_conv_b, *lru_ra_w, *lru_ra_b, *lru_ix_w, *lru_ix_b, *lru_lam, *lru_wo;
    const float *mla_wq_a, *mla_q_a_g, *mla_wq_b, *mla_wkv_a, *mla_kv_a_g, *mla_wkv_b, *mla_wo;
    float* out; unsigned char* ws; int ph_lo, ph_hi;
};

typedef const __attribute__((address_space(4))) Args CArgs;
__device__ __forceinline__ CArgs* kargs() { CArgs* p = (CArgs*)__builtin_amdgcn_kernarg_segment_ptr(); asm volatile("" : "+s"(p)); return p; }
constexpr int NWAVES = 8;
constexpr int RING_BYTES = 131072, LDSCTL_OFF = RING_BYTES, LDS_BYTES = 147456;

__device__ __forceinline__ float wave_sum(float v) {
#pragma unroll
    for (int o = 1; o < 64; o <<= 1) v += __shfl_xor(v, o);
    return v;
}
__device__ __forceinline__ float sigmoidf_(float v) { return __builtin_amdgcn_rcpf(1.0f + __builtin_amdgcn_exp2f(-1.4426950408889634f * v)); }

__device__ __forceinline__ int tid_opaque() { int t = threadIdx.x; asm volatile("" : "+v"(t)); return t; }
__device__ __forceinline__ void ph_mods(CArgs& a, LAS unsigned char* lds, int vcu, int G) {
    LAS float* S = (LAS float*)lds; LAS float* red = (LAS float*)(lds + 40960);
    const int tid = tid_opaque(), wave = tid >> 6, lane = tid & 63;
    for (int i = tid; i < 5 * DM; i += 512) { const int bi = i / DM, k = i % DM; const float v = bi < 4 ? a.c[bi * DM + k] : a.c_ctx[k]; S[i] = v / (1.0f + expf(-v)); }
    __syncthreads();
    float* mods = (float*)(a.ws + WS_MODS);
    for (int item = vcu; item < 768; item += G) {
        const int l = item / 192, n0 = (item % 192) * 64, ksub = wave * 4 + (lane >> 4), cl = lane & 15;
        const float* wp = a.ada_w + ((size_t)l * DM + ksub) * 12288 + n0 + cl * 4;
        float acc[5][4];
#pragma unroll
        for (int i = 0; i < 5; ++i)
#pragma unroll
            for (int j = 0; j < 4; ++j) acc[i][j] = 0.f;
#pragma unroll 8
        for (int it = 0; it < 64; ++it) {
            const f32x4 w = __builtin_nontemporal_load((const f32x4*)(wp + (size_t)it * 32 * 12288)); const int k = ksub + 32 * it;
#pragma unroll
            for (int i = 0; i < 5; ++i) { const float s = S[i * DM + k];
#pragma unroll
                for (int j = 0; j < 4; ++j) acc[i][j] += s * w[j]; }
        }
#pragma unroll
        for (int i = 0; i < 5; ++i)
#pragma unroll
            for (int j = 0; j < 4; ++j) red[(ksub * 5 + i) * 64 + cl * 4 + j] = acc[i][j];
        __syncthreads();
        if (tid < 320) { const int i = tid / 64, cc = tid % 64; float s = 0.f;
            for (int ks = 0; ks < 32; ++ks) s += red[(ks * 5 + i) * 64 + cc];
            mods[(size_t)(l * 5 + i) * 12288 + n0 + cc] = s + a.ada_b[l * 12288 + n0 + cc]; }
        __syncthreads();
    }
}
__device__ __forceinline__ void tr_item(const float* __restrict__ W, int ldw, int k0, int n0, bf16_t* __restrict__ WT, int ldt, int drow0, LAS float* scr, int lane) {
#pragma unroll 8
    for (int i = 0; i < 32; ++i) { const int kk = 2 * i + (lane >> 5); scr[kk * 33 + (lane & 31)] = __builtin_nontemporal_load(W + (size_t)(k0 + kk) * ldw + n0 + (lane & 31)); }
    asm volatile("s_waitcnt lgkmcnt(0)" ::: "memory");
    const int c = lane & 7;
#pragma unroll
    for (int j = 0; j < 4; ++j) { const int n = (lane >> 3) + 8 * j; const LAS float* s = scr + (8 * c) * 33 + n;
        u32x4 o; o.x = cvt_pk_bf16(s[0 * 33], s[1 * 33]); o.y = cvt_pk_bf16(s[2 * 33], s[3 * 33]); o.z = cvt_pk_bf16(s[4 * 33], s[5 * 33]); o.w = cvt_pk_bf16(s[6 * 33], s[7 * 33]);
        *(u32x4*)(WT + (size_t)(drow0 + n) * ldt + k0 + 8 * c) = o; }
    asm volatile("s_waitcnt lgkmcnt(0)" ::: "memory");
}
__device__ __forceinline__ void ph_transposes(CArgs& a, LAS unsigned char* lds, int vcu, int G) {
    const int tid = tid_opaque(), wave = tid >> 6, lane = tid & 63;
    LAS float* scr = (LAS float*)(lds + wave * 8704);
    const int gw = vcu * NWAVES + wave, NGW = G * NWAVES;
    unsigned char* ws = a.ws;
    constexpr int NITEMS = 87872;
    for (int it = gw; it < NITEMS; it += NGW) {
        int r = it;
#define TR_DO(src, K_, N_, dst, drow) do { const int nblk = (N_) / 32, kb = ri / nblk, nb = ri % nblk; tr_item((src), (N_), 64 * kb, 32 * nb, (dst), (K_), (drow) + 32 * nb, scr, lane); } while (0)
        if (r < 32768) { const int l = r / 8192, ri = r % 8192; TR_DO(a.mlp_w1 + (size_t)l * DM * DFF, DM, DFF, (bf16_t*)(ws + WS_W1T) + (size_t)l * DFF * DM, 0); continue; } r -= 32768;
        if (r < 32768) { const int l = r / 8192, ri = r % 8192; TR_DO(a.mlp_w2 + (size_t)l * DFF * DM, DFF, DM, (bf16_t*)(ws + WS_W2T) + (size_t)l * DM * DFF, 0); continue; } r -= 32768;
        if (r < 4096) { const int s = r / 2048, ri = r % 2048; TR_DO(a.gqa_wq + (size_t)s * DM * DM, DM, DM, (bf16_t*)(ws + WS_GQAW + s * 20 * MiB), 0); continue; } r -= 4096;
        if (r < 1024) { const int s = r / 512, ri = r % 512; TR_DO(a.gqa_wk + (size_t)s * DM * 512, DM, 512, (bf16_t*)(ws + WS_GQAW + s * 20 * MiB), 2048); continue; } r -= 1024;
        if (r < 1024) { const int s = r / 512, ri = r % 512; TR_DO(a.gqa_wv + (size_t)s * DM * 512, DM, 512, (bf16_t*)(ws + WS_GQAW + s * 20 * MiB), 2560); continue; } r -= 1024;
        if (r < 4096) { const int s = r / 2048, ri = r % 2048; TR_DO(a.gqa_wo + (size_t)s * DM * DM, DM, DM, (bf16_t*)(ws + WS_GQAW + s * 20 * MiB + 12 * MiB), 0); continue; } r -= 4096;
        if (r < 2048) { const int ri = r; TR_DO(a.lru_wx, DM, DM, (bf16_t*)(ws + WS_LRUW), 0); continue; } r -= 2048;
        if (r < 2048) { const int ri = r; TR_DO(a.lru_wy, DM, DM, (bf16_t*)(ws + WS_LRUW), 2048); continue; } r -= 2048;
        if (r < 1024) { const int blk = r / 32, ri = r % 32, ty = blk / 16, d = (blk % 16) / 8, n = blk % 8, which = d * 2 + ty;
            const float* src = (ty == 0 ? a.lru_ra_w : a.lru_ix_w) + (size_t)(d * 8 + n) * 65536;
            TR_DO(src, 256, 256, (bf16_t*)(ws + WS_LRUW + 16 * MiB), (which * 8 + n) * 256); continue; } r -= 1024;
        if (r < 2048) { const int ri = r; TR_DO(a.lru_wo, DM, DM, (bf16_t*)(ws + WS_LRUW + 20 * MiB), 0); continue; } r -= 2048;
        if (r < 512) { const int ri = r; TR_DO(a.mla_wq_a, DM, 512, (bf16_t*)(ws + WS_MLAW), 0); continue; } r -= 512;
        if (r < 576) { const int ri = r; TR_DO(a.mla_wkv_a, DM, 576, (bf16_t*)(ws + WS_MLAW), 512); continue; } r -= 576;
        if (r < 768) { const int ri = r; TR_DO(a.mla_wq_b, 512, 3072, (bf16_t*)(ws + WS_MLAW + 5 * MiB), 0); continue; } r -= 768;
        if (r < 1024) { const int ri = r, nb = ri % 128, kb = ri / 128, n0 = 32 * nb, h = n0 >> 8, j0 = n0 & 255;
            const int drow = j0 < 128 ? h * 128 + j0 : 2048 + h * 128 + (j0 - 128);
            tr_item(a.mla_wkv_b, 4096, 64 * kb, n0, (bf16_t*)(ws + WS_MLAW + 8 * MiB), 512, drow, scr, lane); continue; } r -= 1024;
        { const int ri = r; TR_DO(a.mla_wo, DM, DM, (bf16_t*)(ws + WS_MLAW + 12 * MiB), 0); }
#undef TR_DO
    }
    { u32x4* z = (u32x4*)(ws + WS_MLAW + (size_t)1088 * DM * 2); const int gt = vcu * 512 + tid;
      for (int i = gt; i < 49152; i += G * 512) z[i] = (u32x4){0u, 0u, 0u, 0u}; }
    if (vcu == 1 % G) { float* ll = (float*)(ws + WS_TAB + 32768); for (int i = tid; i < 2 * DM; i += 512) ll[i] = -8.0f * log1pf(expf(-a.lru_lam[i])); }
    if (vcu == 0) {
        f32x2* tg = (f32x2*)(ws + WS_TAB); f32x2* tm = (f32x2*)(ws + WS_TAB + 16384);
        for (int i = tid; i < 64 * 32; i += 512) { const int pos = i / 32, f = i % 32; const float inv = powf(10000.0f, -((float)f * 2.0f) / 64.0f); const float ang = (float)pos * inv; tg[i] = (f32x2){cosf(ang), sinf(ang)}; }
        for (int i = tid; i < 64 * 16; i += 512) { const int pos = i / 16, f = i % 16; const float inv = powf(10000.0f, -((float)f * 2.0f) / 32.0f); const float ang = (float)pos * inv; tm[i] = (f32x2){cosf(ang), sinf(ang)}; }
    }
}

#define ROW_DECODE(r) const int b_ = (r) / TB, p_ = (r) % TB; const bool isctx_ = p_ < CTX; const int mi_ = isctx_ ? 4 : b_; (void)b_; (void)mi_
__device__ __forceinline__ const float* mods_ptr(CArgs& a, int l, int mi) { return (const float*)(a.ws + WS_MODS) + (size_t)(l * 5 + mi) * 12288; }

__device__ __forceinline__ void ph_init(CArgs& a, int vcu, int G) {
    const int tid_ = tid_opaque(), lane = tid_ & 63, gw = vcu * NWAVES + (tid_ >> 6), NGW = G * NWAVES; (void)lane;
    bf16_t* X = (bf16_t*)(a.ws + WS_X); bf16_t* H = (bf16_t*)(a.ws + WS_H);
    for (int r = gw; r < R; r += NGW) {
        ROW_DECODE(r);
        const float* src = isctx_ ? a.ctx + ((size_t)b_ * CTX + p_) * DM : a.x + ((size_t)b_ * SEQ + (p_ - CTX)) * DM;
        const float* m = mods_ptr(a, 0, mi_);
#pragma unroll
        for (int it = 0; it < 8; ++it) { const int idx = it * 256 + lane * 4;
            const f32x4 v = __builtin_nontemporal_load((const f32x4*)(src + idx)), m0 = *(const f32x4*)(m + idx), m1 = *(const f32x4*)(m + DM + idx);
            __builtin_nontemporal_store((u32x2){cvt_pk_bf16(v[0], v[1]), cvt_pk_bf16(v[2], v[3])}, (u32x2*)(X + (size_t)r * DM + idx));
            const f32x4 h = v * (1.0f + m1) + m0;
            *(u32x2*)(H + (size_t)r * DM + idx) = (u32x2){cvt_pk_bf16(h[0], h[1]), cvt_pk_bf16(h[2], h[3])}; }
    }
}
__device__ __forceinline__ void ln_stage_vecs(CArgs& a, LAS float* vec, int l, int which, int mi, bool last, int tid) {
    const float* lg = a.ln_g + (size_t)(l * 2 + which) * DM; const float* lb = a.ln_b + (size_t)(l * 2 + which) * DM;
    const float* m = mods_ptr(a, l, mi);
    const float* gate = m + (which == 0 ? 2 : 5) * DM;
    const float* sc = which == 0 ? m + 4 * DM : mods_ptr(a, last ? l : l + 1, mi) + 1 * DM;
    const float* sh = which == 0 ? m + 3 * DM : mods_ptr(a, last ? l : l + 1, mi);
    { const int i = tid * 4; const f32x4 g = *(const f32x4*)(gate + i), s4 = *(const f32x4*)(sc + i);
      *(LAS f32x4*)(vec + i) = 1.0f + g; *(LAS f32x4*)(vec + DM + i) = *(const f32x4*)(lg + i); *(LAS f32x4*)(vec + 2 * DM + i) = *(const f32x4*)(lb + i);
      *(LAS f32x4*)(vec + 3 * DM + i) = 1.0f + s4; *(LAS f32x4*)(vec + 4 * DM + i) = *(const f32x4*)(sh + i); }
}
template <bool LAST, int NR, bool FROM_PART>
__device__ __forceinline__ void ln_rows(CArgs& a, const LAS float* vec, int r, int lane) {
    bf16_t* X = (bf16_t*)(a.ws + WS_X); bf16_t* H = (bf16_t*)(a.ws + WS_H); const bf16_t* O = (const bf16_t*)(a.ws + WS_OUTF); const bf16_t* PART = (const bf16_t*)(a.ws + WS_PART);
    ROW_DECODE(r);
    float v[NR][4][8]; float s[NR];
#pragma unroll
    for (int rr = 0; rr < NR; ++rr) s[rr] = 0.f;
#pragma unroll
    for (int it = 0; it < 4; ++it) { const int idx = it * 512 + lane * 8;
        const f32x4 g0 = *(const LAS f32x4*)(vec + idx), g1 = *(const LAS f32x4*)(vec + idx + 4);
#pragma unroll
        for (int rr = 0; rr < NR; ++rr) {
            float xv[8], ov[8]; att::unpack8(__builtin_nontemporal_load((const bf16x8*)(X + (size_t)(r + rr) * DM + idx)), xv);
            if (FROM_PART) { const bf16_t* pp = PART + ((size_t)b_ * CTX + p_ + rr) * DM + idx;
                att::unpack8(__builtin_nontemporal_load((const bf16x8*)pp), ov);
#pragma unroll
                for (int sl = 1; sl < 8; ++sl) { float t8[8]; att::unpack8(__builtin_nontemporal_load((const bf16x8*)(pp + (size_t)sl * (NB * CTX) * DM)), t8);
#pragma unroll
                    for (int j = 0; j < 8; ++j) ov[j] += t8[j]; } }
            else att::unpack8(__builtin_nontemporal_load((const bf16x8*)(O + (size_t)(r + rr) * DM + idx)), ov);
#pragma unroll
            for (int j = 0; j < 8; ++j) { v[rr][it][j] = DN_ALPHA * xv[j] + (j < 4 ? g0[j] : g1[j - 4]) * ov[j]; s[rr] += v[rr][it][j]; } }
        __builtin_amdgcn_sched_barrier(0);
    }
    float rstd[NR];
#pragma unroll
    for (int rr = 0; rr < NR; ++rr) { const float mean = wave_sum(s[rr]) * (1.0f / DM); float q = 0.f;
#pragma unroll
        for (int it = 0; it < 4; ++it)
#pragma unroll
            for (int j = 0; j < 8; ++j) { v[rr][it][j] -= mean; q += v[rr][it][j] * v[rr][it][j]; }
        rstd[rr] = 1.0f / sqrtf(wave_sum(q) * (1.0f / DM) + LN_EPS); }
#pragma unroll
    for (int it = 0; it < 4; ++it) { const int idx = it * 512 + lane * 8;
        const f32x4 lg0 = *(const LAS f32x4*)(vec + DM + idx), lg1 = *(const LAS f32x4*)(vec + DM + idx + 4), lb0 = *(const LAS f32x4*)(vec + 2 * DM + idx), lb1 = *(const LAS f32x4*)(vec + 2 * DM + idx + 4);
        f32x4 sc0 = {0.f, 0.f, 0.f, 0.f}, sc1 = sc0, sh0 = sc0, sh1 = sc0;
        if (!LAST) { sc0 = *(const LAS f32x4*)(vec + 3 * DM + idx); sc1 = *(const LAS f32x4*)(vec + 3 * DM + idx + 4); sh0 = *(const LAS f32x4*)(vec + 4 * DM + idx); sh1 = *(const LAS f32x4*)(vec + 4 * DM + idx + 4); }
#pragma unroll
        for (int rr = 0; rr < NR; ++rr) {
            float xn[8];
#pragma unroll
            for (int j = 0; j < 8; ++j) xn[j] = v[rr][it][j] * rstd[rr] * (j < 4 ? lg0[j] : lg1[j - 4]) + (j < 4 ? lb0[j] : lb1[j - 4]);
            if (LAST) { float* op = a.out + ((size_t)b_ * SEQ + (p_ + rr - CTX)) * DM + idx; __builtin_nontemporal_store((f32x4){xn[0], xn[1], xn[2], xn[3]}, (f32x4*)op); __builtin_nontemporal_store((f32x4){xn[4], xn[5], xn[6], xn[7]}, (f32x4*)(op + 4)); }
            else { __builtin_nontemporal_store(att::pack8(xn), (bf16x8*)(X + (size_t)(r + rr) * DM + idx));
                float hh[8];
#pragma unroll
                for (int j = 0; j < 8; ++j) hh[j] = xn[j] * (j < 4 ? sc0[j] : sc1[j - 4]) + (j < 4 ? sh0[j] : sh1[j - 4]);
                *(bf16x8*)(H + (size_t)(r + rr) * DM + idx) = att::pack8(hh); } }
        __builtin_amdgcn_sched_barrier(0); }
}
template <bool LAST, int CTXMODE>
__device__ __forceinline__ void ph_ln(CArgs& a, LAS unsigned char* lds, int l, int which, int vcu, int G) {
    const int tid = tid_opaque(), lane = tid & 63, wave = tid >> 6;
    LAS float* vec = (LAS float*)lds;
    constexpr int NR = 2;
    const int b = (int)(((long)vcu * NB) / G), vlo = (b * G + NB - 1) / NB, vhi = ((b + 1) * G + NB - 1) / NB, wpb = vhi - vlo, w = vcu - vlo;
    ln_stage_vecs(a, vec, l, which, b, LAST, tid);
    __syncthreads();
    for (int k = w * NWAVES + wave; k < SEQ / NR; k += wpb * NWAVES) ln_rows<LAST, NR, false>(a, vec, b * TB + CTX + k * NR, lane);
    if (CTXMODE == 1 && !LAST) {
        __syncthreads();
        ln_stage_vecs(a, vec, l, which, 4, LAST, tid);
        __syncthreads();
        for (int k = wave * G + vcu; k < NB * CTX; k += G * NWAVES) ln_rows<false, 1, true>(a, vec, (k / CTX) * TB + (k % CTX), lane);
    }
    __syncthreads();
}
__device__ __forceinline__ void ph_knorm(CArgs& a, const float* kg, int vcu, int G) {
    const int tid_ = tid_opaque(), lane = tid_ & 63, gw = vcu * NWAVES + (tid_ >> 6), NGW = G * NWAVES; (void)lane;
    bf16_t* K = (bf16_t*)(a.ws + WS_GK); const f32x2* tab = (const f32x2*)(a.ws + WS_TAB);
    const int li = lane & 15;
    float g[8];
#pragma unroll
    for (int j = 0; j < 8; ++j) g[j] = kg[li * 8 + j];
    for (int r = gw; r < R; r += NGW) {
        ROW_DECODE(r);
        bf16x8 raw = *(const bf16x8*)(K + (size_t)r * 512 + lane * 8);
        float f[8]; att::unpack8(raw, f);
        float ss = 0.f;
#pragma unroll
        for (int j = 0; j < 8; ++j) ss += f[j] * f[j];
        ss += __shfl_xor(ss, 1); ss += __shfl_xor(ss, 2); ss += __shfl_xor(ss, 4); ss += __shfl_xor(ss, 8);
        const float rstd = 1.0f / sqrtf(ss * (1.0f / 128.0f) + 1e-6f);
#pragma unroll
        for (int j = 0; j < 8; ++j) f[j] = f[j] * rstd * g[j];
        if (!isctx_) {
            const int t = p_ - CTX, pos = (li & 8) ? (t & 63) : (t >> 6);
            const f32x2* tp = tab + pos * 32 + (li & 3) * 8;
            const bool second = (li & 4) != 0;
#pragma unroll
            for (int j = 0; j < 8; ++j) { const float other = __shfl_xor(f[j], 4); const f32x2 cs = tp[j];
                f[j] = second ? f[j] * cs.x + other * cs.y : f[j] * cs.x - other * cs.y; }
        }
        *(bf16x8*)(K + (size_t)r * 512 + lane * 8) = att::pack8(f);
    }
}
__device__ __forceinline__ void ph_mla_norm(CArgs& a, int vcu, int G) {
    const int tid_ = tid_opaque(), lane = tid_ & 63, gw = vcu * NWAVES + (tid_ >> 6), NGW = G * NWAVES; (void)lane;
    const bf16_t* AP = (const bf16_t*)(a.ws + WS_MAP); bf16_t* QAN = (bf16_t*)(a.ws + WS_MQAN); bf16_t* CKVN = (bf16_t*)(a.ws + WS_MCKVN); bf16_t* K = (bf16_t*)(a.ws + WS_MK);
    const f32x2* tab = (const f32x2*)(a.ws + WS_TAB + 16384);
    for (int r = gw; r < R; r += NGW) {
        ROW_DECODE(r);
        const bf16_t* ap = AP + (size_t)r * 1280;
#pragma unroll
        for (int part = 0; part < 2; ++part) {
            float f8_[8]; att::unpack8(__builtin_nontemporal_load((const bf16x8*)(ap + part * 512 + lane * 8)), f8_);
            const f32x4 v0 = {f8_[0], f8_[1], f8_[2], f8_[3]}, v1 = {f8_[4], f8_[5], f8_[6], f8_[7]};
            float ss = (v0[0] * v0[0] + v0[1] * v0[1]) + (v0[2] * v0[2] + v0[3] * v0[3]) + (v1[0] * v1[0] + v1[1] * v1[1]) + (v1[2] * v1[2] + v1[3] * v1[3]);
            const float rstd = 1.0f / sqrtf(wave_sum(ss) * (1.0f / 512.0f) + 1e-6f);
            const float* gp = (part == 0 ? a.mla_q_a_g : a.mla_kv_a_g) + lane * 8;
            const f32x4 g0 = *(const f32x4*)gp, g1 = *(const f32x4*)(gp + 4);
            const f32x4 o0 = v0 * rstd * g0, o1 = v1 * rstd * g1;
            u32x4 w = {cvt_pk_bf16(o0[0], o0[1]), cvt_pk_bf16(o0[2], o0[3]), cvt_pk_bf16(o1[0], o1[1]), cvt_pk_bf16(o1[2], o1[3])};
            *(u32x4*)((part == 0 ? QAN : CKVN) + (size_t)r * 512 + lane * 8) = w;
        }
        float v = bf2f(ap[1024 + lane]);
        if (!isctx_) {
            const int t = p_ - CTX, pos = (lane & 32) ? (t & 63) : (t >> 6);
            const f32x2 cs = tab[pos * 16 + (lane & 15)];
            const float other = __shfl_xor(v, 16);
            v = (lane & 16) ? v * cs.x + other * cs.y : v * cs.x - other * cs.y;
        }
        const bf16_t kb = f2bf(v);
#pragma unroll
        for (int h = 0; h < 16; ++h) K[(size_t)r * 3072 + h * 192 + 128 + lane] = kb;
    }
}
__device__ __forceinline__ void ph_conv(CArgs& a, int vcu, int G) {
    const int tid_ = tid_opaque(), lane = tid_ & 63, gw = vcu * NWAVES + (tid_ >> 6), NGW = G * NWAVES; (void)lane;
    const bf16_t* UP = (const bf16_t*)(a.ws + WS_LUP); bf16_t* U = (bf16_t*)(a.ws + WS_LU);
    for (int r = gw; r < R; r += NGW) {
        ROW_DECODE(r);
        const int lo = isctx_ ? 0 : CTX, hi = isctx_ ? CTX : TB;
#pragma unroll
        for (int it = 0; it < 4; ++it) { const int idx = it * 512 + lane * 8;
            float acc[8];
            { const f32x4 b0 = *(const f32x4*)(a.lru_conv_b + idx), b1 = *(const f32x4*)(a.lru_conv_b + idx + 4);
              acc[0] = b0[0]; acc[1] = b0[1]; acc[2] = b0[2]; acc[3] = b0[3]; acc[4] = b1[0]; acc[5] = b1[1]; acc[6] = b1[2]; acc[7] = b1[3]; }
#pragma unroll
            for (int j = 0; j < 4; ++j) { const int pp = p_ + j - 2;
                if (pp >= lo && pp < hi) {
                    float f[8]; att::unpack8(*(const bf16x8*)(UP + (size_t)(r + j - 2) * DM + idx), f);
                    const f32x4 w0 = *(const f32x4*)(a.lru_conv_w + j * DM + idx), w1 = *(const f32x4*)(a.lru_conv_w + j * DM + idx + 4);
                    acc[0] += f[0] * w0[0]; acc[1] += f[1] * w0[1]; acc[2] += f[2] * w0[2]; acc[3] += f[3] * w0[3];
                    acc[4] += f[4] * w1[0]; acc[5] += f[5] * w1[1]; acc[6] += f[6] * w1[2]; acc[7] += f[7] * w1[3]; } }
            *(bf16x8*)(U + (size_t)r * DM + idx) = att::pack8(acc); }
    }
}
__device__ __forceinline__ void scan_step(f32x4& h, u32x2 la, u32x2 gu, f32x4* Pacc) {
    f32x4 av = {__builtin_amdgcn_exp2f(bf_lo(la.x)), __builtin_amdgcn_exp2f(bf_hi(la.x)), __builtin_amdgcn_exp2f(bf_lo(la.y)), __builtin_amdgcn_exp2f(bf_hi(la.y))};
    const f32x4 gv = {bf_lo(gu.x), bf_hi(gu.x), bf_lo(gu.y), bf_hi(gu.y)};
    f32x4 s; s[0] = sqrtf(fmaxf(1.0f - av[0] * av[0], 0.f)); s[1] = sqrtf(fmaxf(1.0f - av[1] * av[1], 0.f)); s[2] = sqrtf(fmaxf(1.0f - av[2] * av[2], 0.f)); s[3] = sqrtf(fmaxf(1.0f - av[3] * av[3], 0.f));
    h = av * h + s * gv; if (Pacc) *Pacc = *Pacc * av;
}
__device__ __forceinline__ void ph_scan1(CArgs& a, int vcu, int G) {
    const int tid_ = tid_opaque(), lane = tid_ & 63, gw = vcu * NWAVES + (tid_ >> 6), NGW = G * NWAVES; (void)lane;
    float* PS = (float*)(a.ws + WS_LPS);
    for (int item = gw; item < NB * NCH * 2 * 8; item += NGW) {
        const int cg = item & 7, dir = (item >> 3) & 1, bq = item >> 4, b = bq / NCH, q = bq % NCH;
        const bf16_t* A = (const bf16_t*)(a.ws + (dir ? WS_LAB : WS_LAF)); const bf16_t* GU = (const bf16_t*)(a.ws + (dir ? WS_LGUB : WS_LGUF));
        const size_t base = ((size_t)b * TB + q * 32) * DM + cg * 256 + lane * 4;
        f32x4 h = {0.f, 0.f, 0.f, 0.f}, P = {1.f, 1.f, 1.f, 1.f};
#pragma unroll 8
        for (int i = 0; i < 32; ++i) { const int rr = dir ? 31 - i : i;
            scan_step(h, *(const u32x2*)(A + base + (size_t)rr * DM), *(const u32x2*)(GU + base + (size_t)rr * DM), &P); }
        float* o = PS + ((size_t)(bq * 2 + dir) * 2) * DM + cg * 256 + lane * 4;
        *(f32x4*)o = P; *(f32x4*)(o + DM) = h;
    }
}
__device__ __forceinline__ void ph_scan2(CArgs& a, LAS unsigned char* lds, int vcu, int G) {
    const float* PS = (const float*)(a.ws + WS_LPS); float* CIN = (float*)(a.ws + WS_LCIN);
    const int tid = tid_opaque(), lane = tid & 63, seg = tid >> 6;
    LAS float* sm = (LAS float*)lds;
    for (int v = vcu; v < NB * 2 * (DM / 64); v += G) {
        const int cb = v % (DM / 64), dir = (v / (DM / 64)) & 1, b = v / (2 * (DM / 64)), c = cb * 64 + lane;
        float P[17], S[17];
#pragma unroll
        for (int k = 0; k < 17; ++k) { const int i = seg * 17 + k, q = dir == 0 ? i : (i < 8 ? 7 - i : NCH - 1 - (i - 8)); const size_t bq = (size_t)b * NCH + q;
            P[k] = PS[((bq * 2 + dir) * 2) * DM + c]; S[k] = PS[((bq * 2 + dir) * 2 + 1) * DM + c]; }
        float pp = 1.f, ss = 0.f;
#pragma unroll
        for (int k = 0; k < 17; ++k) { ss = P[k] * ss + S[k]; pp *= P[k]; }
        sm[(seg * 2 + 0) * 64 + lane] = pp; sm[(seg * 2 + 1) * 64 + lane] = ss;
        __syncthreads();
        float carry = 0.f;
        for (int s2 = 0; s2 < seg; ++s2) carry = sm[(s2 * 2 + 0) * 64 + lane] * carry + sm[(s2 * 2 + 1) * 64 + lane];
#pragma unroll
        for (int k = 0; k < 17; ++k) { const int i = seg * 17 + k, q = dir == 0 ? i : (i < 8 ? 7 - i : NCH - 1 - (i - 8)); const size_t bq = (size_t)b * NCH + q;
            CIN[(bq * 2 + dir) * DM + c] = carry; carry = P[k] * carry + S[k]; }
        __syncthreads();
    }
}
__device__ __forceinline__ void ph_scan3(CArgs& a, int vcu, int G) {
    const int tid_ = tid_opaque(), lane = tid_ & 63, gw = vcu * NWAVES + (tid_ >> 6), NGW = G * NWAVES; (void)lane;
    const float* CIN = (const float*)(a.ws + WS_LCIN); const bf16_t* GY = (const bf16_t*)(a.ws + WS_LGY); bf16_t* Gout = (bf16_t*)(a.ws + WS_LG);
    const bf16_t* AF = (const bf16_t*)(a.ws + WS_LAF); const bf16_t* GUF = (const bf16_t*)(a.ws + WS_LGUF); const bf16_t* AB = (const bf16_t*)(a.ws + WS_LAB); const bf16_t* GUB = (const bf16_t*)(a.ws + WS_LGUB);
    for (int item = gw; item < NB * NCH * 8; item += NGW) {
        const int cg = item & 7, bq = item >> 3, b = bq / NCH, q = bq % NCH;
        const size_t base = ((size_t)b * TB + q * 32) * DM + cg * 256 + lane * 4;
        f32x4 hf[32];
        f32x4 h = *(const f32x4*)(CIN + ((size_t)bq * 2 + 0) * DM + cg * 256 + lane * 4);
#pragma unroll
        for (int i = 0; i < 32; ++i) { scan_step(h, __builtin_nontemporal_load((const u32x2*)(AF + base + (size_t)i * DM)), __builtin_nontemporal_load((const u32x2*)(GUF + base + (size_t)i * DM)), nullptr); hf[i] = h;
            if ((i & 7) == 7) __builtin_amdgcn_sched_barrier(0); }
        h = *(const f32x4*)(CIN + ((size_t)bq * 2 + 1) * DM + cg * 256 + lane * 4);
#pragma unroll
        for (int i = 31; i >= 0; --i) {
            scan_step(h, __builtin_nontemporal_load((const u32x2*)(AB + base + (size_t)i * DM)), __builtin_nontemporal_load((const u32x2*)(GUB + base + (size_t)i * DM)), nullptr);
            const u32x2 gy = __builtin_nontemporal_load((const u32x2*)(GY + base + (size_t)i * DM));
            const f32x4 o = (hf[i] + h) * (f32x4){bf_lo(gy.x), bf_hi(gy.x), bf_lo(gy.y), bf_hi(gy.y)};
            *(u32x2*)(Gout + base + (size_t)i * DM) = (u32x2){cvt_pk_bf16(o[0], o[1]), cvt_pk_bf16(o[2], o[3])};
            if ((i & 7) == 0) __builtin_amdgcn_sched_barrier(0); }
    }
}
__device__ __forceinline__ void st_bf16x8(bf16_t* p, f32x4 v0, f32x4 v1) {
    u32x4 w = {cvt_pk_bf16(v0[0], v0[1]), cvt_pk_bf16(v0[2], v0[3]), cvt_pk_bf16(v1[0], v1[1]), cvt_pk_bf16(v1[2], v1[3])}; *(u32x4*)p = w; }
struct FStoreF32 { float* O; int ld;
    __device__ __forceinline__ void begin(const pg8::Unit&, int) {}
    __device__ __forceinline__ void row8(int row, int, int col, f32x4 v0, f32x4 v1) { float* p = O + (size_t)row * ld + col; *(f32x4*)p = v0; *(f32x4*)(p + 4) = v1; } };
struct FOut { bf16_t* O; bf16_t* PART; bf16_t* dst; int rowadj;
    __device__ __forceinline__ void begin(const pg8::Unit& u, int) {
        if (u.slice >= 0) { dst = PART + (size_t)u.slice * (NB * CTX) * DM; rowadj = (u.pm / 17) * CTX - u.pm * 256; } else { dst = O; rowadj = 0; } }
    __device__ __forceinline__ void row8(int row, int, int col, f32x4 v0, f32x4 v1) { st_bf16x8(dst + (size_t)(row + rowadj) * DM + col, v0, v1); } };
struct FBf16 { bf16_t* O; int ld;
    __device__ __forceinline__ void begin(const pg8::Unit&, int) {}
    __device__ __forceinline__ void row8(int row, int, int col, f32x4 v0, f32x4 v1) { st_bf16x8(O + (size_t)row * ld + col, v0, v1); } };
struct FQkv { bf16_t *Q, *K, *V; bf16_t* base; int ld, coff;
    __device__ __forceinline__ void begin(const pg8::Unit& u, int) { if (u.pn < 8) { base = Q; ld = 2048; coff = 0; } else if (u.pn < 10) { base = K; ld = 512; coff = 2048; } else { base = V; ld = 512; coff = 2560; } }
    __device__ __forceinline__ void row8(int row, int, int col, f32x4 v0, f32x4 v1) { st_bf16x8(base + (size_t)row * ld + (col - coff), v0, v1); } };
struct FRelu2 { bf16_t* O;
    __device__ __forceinline__ void begin(const pg8::Unit&, int) {}
    __device__ __forceinline__ void row8(int row, int, int col, f32x4 v0, f32x4 v1) {
#pragma unroll
        for (int i = 0; i < 4; ++i) { const float a = fmaxf(v0[i], 0.f), b = fmaxf(v1[i], 0.f); v0[i] = a * a; v1[i] = b * b; }
        st_bf16x8(O + (size_t)row * DFF + col, v0, v1); } };
__device__ __forceinline__ float gelu_tanh(float x) { const float z = 1.5957691216057308f * (x + 0.044715f * x * x * x); return x * __builtin_amdgcn_rcpf(1.0f + __builtin_amdgcn_exp2f(-1.4426950408889634f * z)); }
struct FLruXY { bf16_t *UP, *GY; bool gy;
    __device__ __forceinline__ void begin(const pg8::Unit& u, int) { gy = u.pn >= 8; }
    __device__ __forceinline__ void row8(int row, int, int col, f32x4 v0, f32x4 v1) {
        if (gy) {
#pragma unroll
            for (int i = 0; i < 4; ++i) { v0[i] = gelu_tanh(v0[i]); v1[i] = gelu_tanh(v1[i]); }
            st_bf16x8(GY + (size_t)row * DM + (col - 2048), v0, v1);
        } else st_bf16x8(UP + (size_t)row * DM + col, v0, v1); } };
struct EpiGates {
    static constexpr bool PERM = true;
    bf16_t* OUT4; const bf16_t* U; const float *ra_b, *ix_b, *lam;
    __device__ __forceinline__ void operator()(const f32x4 (&acc)[2][2][4][2], const pg8::Unit& u, int wr, int wc, int fr, int fq) const {
        const int which = u.pn >> 3, dir = which >> 1, ty = which & 1, ch0 = (u.pn & 7) * 256 + wc * 32 + 8 * fq, row0 = u.pm * 256 + wr * 64 + fr;
        bf16_t* dst = OUT4 + (size_t)which * ((size_t)R * DM);
        const float* bp = (ty == 0 ? ra_b : ix_b) + dir * DM;
#pragma unroll
        for (int bj = 0; bj < 2; ++bj) {
            const int ch = ch0 + bj * 128;
            const f32x4 b0 = *(const f32x4*)(bp + ch), b1 = *(const f32x4*)(bp + ch + 4);
            f32x4 l0 = {0.f, 0.f, 0.f, 0.f}, l1 = {0.f, 0.f, 0.f, 0.f};
            if (ty == 0) { l0 = *(const f32x4*)(lam + dir * DM + ch) * 1.4426950408889634f; l1 = *(const f32x4*)(lam + dir * DM + ch + 4) * 1.4426950408889634f; }
#pragma unroll
            for (int ai = 0; ai < 2; ++ai)
#pragma unroll
                for (int m = 0; m < 4; ++m) {
                    const int row = row0 + ai * 128 + m * 16;
                    const f32x4 x0 = acc[ai][bj][m][0] + b0, x1 = acc[ai][bj][m][1] + b1; f32x4 o0, o1;
                    if (ty == 0) {
#pragma unroll
                        for (int j = 0; j < 4; ++j) { o0[j] = l0[j] * sigmoidf_(x0[j]); o1[j] = l1[j] * sigmoidf_(x1[j]); }
                    } else {
                        const u32x4 uw = *(const u32x4*)(U + (size_t)row * DM + ch);
                        o0[0] = sigmoidf_(x0[0]) * bf_lo(uw.x); o0[1] = sigmoidf_(x0[1]) * bf_hi(uw.x); o0[2] = sigmoidf_(x0[2]) * bf_lo(uw.y); o0[3] = sigmoidf_(x0[3]) * bf_hi(uw.y);
                        o1[0] = sigmoidf_(x1[0]) * bf_lo(uw.z); o1[1] = sigmoidf_(x1[1]) * bf_hi(uw.z); o1[2] = sigmoidf_(x1[2]) * bf_lo(uw.w); o1[3] = sigmoidf_(x1[3]) * bf_hi(uw.w);
                    }
                    st_bf16x8(dst + (size_t)row * DM + ch, o0, o1);
                    __builtin_amdgcn_sched_barrier(0);
                }
        }
    } };
struct FKvb { bf16_t *K, *V;
    __device__ __forceinline__ void begin(const pg8::Unit&, int) {}
    __device__ __forceinline__ void row8(int row, int, int col, f32x4 v0, f32x4 v1) {
        bf16_t* p = col < 2048 ? K + (size_t)row * 3072 + (col >> 7) * 192 + (col & 127) : V + (size_t)row * DM + (col - 2048);
        st_bf16x8(p, v0, v1); } };

template <class F>
__device__ __forceinline__ void run_gemm(LAS unsigned char* lds, const bf16_t* A, int lda, const bf16_t* Bt, int ldb, int N, int K, int a_blk, F f, int G, int rot = 0) {
    pg8::Gemm g{A, Bt, R, N, K, lda, ldb, a_blk}; pg8::StaticOrder S; S.init(R, N, K, G, ((int)blockIdx.x + rot) % G);
    pg8::EpiRow8<F> E{f};
    PROBE_REPEAT_GEMM
    pg8::gemm_phase<pg8::EpiRow8<F>, pg8::StaticOrder, true, true>(lds, g, S, E);
}

__device__ __forceinline__ void run_gemm_out(LAS unsigned char* lds, const bf16_t* A, int lda, const bf16_t* Bt, int K, int SK, bf16_t* OUTF, bf16_t* PART, int G) {
    pg8::Gemm g{A, Bt, R, DM, K, lda, K, 0}; pg8::LatOrder S; S.init(DM, K, G, (int)blockIdx.x, SK, K == DFF ? 1 : 0);
    pg8::EpiRow8<FOut> E{FOut{OUTF, PART, nullptr, 0}};
    PROBE_REPEAT_GEMM
    pg8::gemm_phase<pg8::EpiRow8<FOut>, pg8::LatOrder, true, true>(lds, g, S, E);
}
template <class F>
__device__ __forceinline__ void run_gemm_lat(LAS unsigned char* lds, const bf16_t* A, int lda, const bf16_t* Bt, int ldb, int N, int K, F f, int G) {
    pg8::Gemm g{A, Bt, R, N, K, lda, ldb, 0}; pg8::LatOrder S; S.init(N, K, G, (int)blockIdx.x, 0);
    pg8::EpiRow8<F> E{f};
    PROBE_REPEAT_GEMM
    pg8::gemm_phase<pg8::EpiRow8<F>, pg8::LatOrder, true, true>(lds, g, S, E);
}

__device__ __forceinline__ void ph_attn_gqa(CArgs& a, char* lds, const float* qg, const float* kg, bool ctx_units, int vcu, int G) {
    const bf16_t* Q = (const bf16_t*)(a.ws + WS_GQ); const bf16_t* K = (const bf16_t*)(a.ws + WS_GK); const bf16_t* V = (const bf16_t*)(a.ws + WS_GV); bf16_t* O = (bf16_t*)(a.ws + WS_GO);
    const f32x2* tab = (const f32x2*)(a.ws + WS_TAB);
    const int nun = ctx_units ? 1088 : 1024;
    bool fast;
    { const int lane = tid_opaque() & 63; float gq = fmaxf(fabsf(qg[lane]), fabsf(qg[lane + 64])), gk = fmaxf(fabsf(kg[lane]), fabsf(kg[lane + 64]));
#pragma unroll
      for (int o = 1; o < 64; o <<= 1) { gq = fmaxf(gq, __shfl_xor(gq, o)); gk = fmaxf(gk, __shfl_xor(gk, o)); }
      fast = __builtin_amdgcn_readfirstlane((16.3224f * gq * gk <= 40.0f) ? 1 : 0) != 0; }
#define GQA_UNITS(NM) \
    for (int id = vcu; id < nun; id += G) { \
        int b, h, row0, seq, tok0; bool rope; \
        if (id < 1024) { const int bk = id >> 6; b = bk >> 2; h = (bk & 3) * 4 + ((id & 63) >> 4); const int qb = id & 15; row0 = b * TB + CTX + qb * 256; seq = TB; tok0 = qb * 256; rope = true; } \
        else { const int j = id - 1024; b = j >> 4; h = j & 15; row0 = b * TB; seq = CTX; tok0 = 0; rope = false; } \
        const int kvh = h >> 2; \
        att::attn_body_dma<128, 2048, 512, 512, 2048, NM>(Q + (size_t)row0 * 2048 + h * 128, K + (size_t)b * TB * 512 + kvh * 128, V + (size_t)b * TB * 512 + kvh * 128, \
                                                  O + (size_t)row0 * 2048 + h * 128, seq, lds, qg, tab, rope, tok0); }
    PROBE_REPEAT_ATTN
    { if (fast) { GQA_UNITS(true) } else { GQA_UNITS(false) } }
#undef GQA_UNITS
}
__device__ __forceinline__ void ph_attn_mla(CArgs& a, char* lds, bool ctx_units, int vcu, int G) {
    const bf16_t* Q = (const bf16_t*)(a.ws + WS_MQ); const bf16_t* K = (const bf16_t*)(a.ws + WS_MK); const bf16_t* V = (const bf16_t*)(a.ws + WS_MV); bf16_t* O = (bf16_t*)(a.ws + WS_MO);
    const f32x2* tab = (const f32x2*)(a.ws + WS_TAB + 16384);
    const int nun = ctx_units ? 1088 : 1024;
    PROBE_REPEAT_ATTN
    for (int id = vcu; id < nun; id += G) {
        int b, h, row0, seq, tok0; bool rope;
        if (id < 1024) { const int bh = id >> 4; b = bh >> 4; h = bh & 15; const int qb = id & 15; row0 = b * TB + CTX + qb * 256; seq = TB; tok0 = qb * 256; rope = true; }
        else { const int j = id - 1024; b = j >> 4; h = j & 15; row0 = b * TB; seq = CTX; tok0 = 0; rope = false; }
        att::attn_body_dma<192, 3072, 3072, 2048, 2048>(Q + (size_t)row0 * 3072 + h * 192, K + (size_t)b * TB * 3072 + h * 192, V + (size_t)b * TB * DM + h * 128,
                                                    O + (size_t)row0 * DM + h * 128, seq, lds, nullptr, tab, rope, tok0);
    }
}

constexpr int NPHASES = 38;
__global__ void __launch_bounds__(NWAVES * 64, 2) trunk_fwd(Args a_unused) {
#define a (*kargs())
    extern __shared__ __attribute__((aligned(16))) unsigned char lds_raw[];
    LAS unsigned char* lds = (LAS unsigned char*)lds_raw;
    const int tid = threadIdx.x;
    const int G = gridDim.x; const int bx = blockIdx.x; const int vcu = (G % 8 == 0) ? (bx % 8) * (G / 8) + bx / 8 : bx;
#define ws (a.ws)
    for (int u = tid; u < (LDS_BYTES - LDSCTL_OFF) / 4; u += NWAVES * 64) ((LAS unsigned*)(lds + LDSCTL_OFF))[u] = 0u;
    __syncthreads();
    if (a.ph_hi - a.ph_lo > 1) (void)xcd_barrier_post((unsigned*)(ws + WS_CTL) + 1024, (volatile LAS unsigned*)(lds + LDSCTL_OFF + 64));
    int ph = 0;
#ifndef PH_FILTER
#define PH_FILTER(p) true
#endif
#ifdef PROBE_STAMP_A
    unsigned long long st_prev = __builtin_amdgcn_s_memrealtime(), st_a = 0, st_b = 0; int st_cls = 0;
#define ST_CLS(c) st_cls = (c);
#define ST_ACC { const unsigned long long now_ = __builtin_amdgcn_s_memrealtime(); if (st_cls == PROBE_STAMP_A) st_a += now_ - st_prev; if (st_cls == PROBE_STAMP_B) st_b += now_ - st_prev; st_prev = now_; }
#else
#define ST_CLS(c)
#define ST_ACC
#endif
#define PH_BEGIN if (PH_FILTER(ph) && ph >= a.ph_lo && ph < a.ph_hi) {
#define MKBAR() XcdBarrier{(unsigned*)(ws + WS_CTL) + 1024, xb_xcc_id(), (volatile LAS unsigned*)(lds + LDSCTL_OFF + 64)}
#define PH_END   if (ph + 1 < a.ph_hi) xcd_barrier(MKBAR()); ST_ACC } ++ph;

    ST_CLS(0) PH_BEGIN ph_mods(a, lds, vcu, G); __syncthreads(); ph_transposes(a, lds, vcu, G); PH_END
    ST_CLS(1) PH_BEGIN ph_init(a, vcu, G); PH_END

#define Hb ((bf16_t*)(ws + WS_H))
#define OUTF ((bf16_t*)(ws + WS_OUTF))
#define ACT ((bf16_t*)(ws + WS_ACT))

#define PARTB ((bf16_t*)(ws + WS_PART))
#define MLP_PHASES(L) \
    ST_CLS(4) PH_BEGIN ph_ln<false, 1>(a, lds, L, 0, vcu, G); PH_END \
    ST_CLS(5) PH_BEGIN run_gemm(lds, Hb, DM, (const bf16_t*)(ws + WS_W1T) + (size_t)(L) * DFF * DM, DM, DFF, DM, 0, FRelu2{ACT}, G); PH_END \
    ST_CLS(6) PH_BEGIN run_gemm_out(lds, ACT, DFF, (const bf16_t*)(ws + WS_W2T) + (size_t)(L) * DM * DFF, DFF, 8, OUTF, PARTB, G); PH_END \
    ST_CLS(4) PH_BEGIN ph_ln<false, 1>(a, lds, L, 1, vcu, G); PH_END
#define MLP_PHASES_LAST(L) \
    ST_CLS(4) PH_BEGIN ph_ln<false, 2>(a, lds, L, 0, vcu, G); PH_END \
    ST_CLS(5) PH_BEGIN run_gemm_lat(lds, Hb, DM, (const bf16_t*)(ws + WS_W1T) + (size_t)(L) * DFF * DM, DM, DFF, DM, FRelu2{ACT}, G); PH_END \
    ST_CLS(6) PH_BEGIN run_gemm_out(lds, ACT, DFF, (const bf16_t*)(ws + WS_W2T) + (size_t)(L) * DM * DFF, DFF, 0, OUTF, PARTB, G); PH_END \
    ST_CLS(4) PH_BEGIN ph_ln<true, 2>(a, lds, L, 1, vcu, G); PH_END

#define GQA_LAYER(L, SLOT, LASTL) \
    ST_CLS(2) PH_BEGIN run_gemm(lds, Hb, DM, (const bf16_t*)(ws + WS_GQAW + (SLOT) * 20 * MiB), DM, 3072, DM, 0, FQkv{(bf16_t*)(ws + WS_GQ), (bf16_t*)(ws + WS_GK), (bf16_t*)(ws + WS_GV), nullptr, 0, 0}, G); PH_END \
    ST_CLS(1) PH_BEGIN ph_knorm(a, a.gqa_k_g + (SLOT) * 128, vcu, G); PH_END \
    ST_CLS(3) PH_BEGIN ph_attn_gqa(a, (char*)lds_raw, a.gqa_q_g + (SLOT) * 128, a.gqa_k_g + (SLOT) * 128, !(LASTL), vcu, G); PH_END \
    ST_CLS(2) PH_BEGIN run_gemm_out(lds, (const bf16_t*)(ws + WS_GO), DM, (const bf16_t*)(ws + WS_GQAW + (SLOT) * 20 * MiB + 12 * MiB), DM, (LASTL) ? 0 : 8, OUTF, PARTB, G); PH_END

    GQA_LAYER(0, 0, false)
    MLP_PHASES(0)
    ST_CLS(2) PH_BEGIN run_gemm(lds, Hb, DM, (const bf16_t*)(ws + WS_LRUW), DM, 4096, DM, 0, FLruXY{(bf16_t*)(ws + WS_LUP), (bf16_t*)(ws + WS_LGY), false}, G); PH_END
    ST_CLS(1) PH_BEGIN ph_conv(a, vcu, G); PH_END
    ST_CLS(2) PH_BEGIN { EpiGates eg{(bf16_t*)(ws + WS_LAF), (const bf16_t*)(ws + WS_LU), a.lru_ra_b, a.lru_ix_b, (const float*)(ws + WS_TAB + 32768)};
               pg8::Gemm g{(const bf16_t*)(ws + WS_LU), (const bf16_t*)(ws + WS_LRUW + 16 * MiB), R, 8192, 256, DM, 256, 1}; pg8::StaticOrder S; S.init(R, 8192, 256, G, (int)blockIdx.x);
               PROBE_REPEAT_GEMM
               pg8::gemm_phase<EpiGates, pg8::StaticOrder, true, true>(lds, g, S, eg); } PH_END
    ST_CLS(7) PH_BEGIN ph_scan1(a, vcu, G); PH_END
    PH_BEGIN ph_scan2(a, lds, vcu, G); PH_END
    PH_BEGIN ph_scan3(a, vcu, G); PH_END
    ST_CLS(2) PH_BEGIN run_gemm_out(lds, (const bf16_t*)(ws + WS_LG), DM, (const bf16_t*)(ws + WS_LRUW + 20 * MiB), DM, 8, OUTF, PARTB, G); PH_END
    MLP_PHASES(1)
    ST_CLS(2) PH_BEGIN run_gemm(lds, Hb, DM, (const bf16_t*)(ws + WS_MLAW), DM, 1280, DM, 0, FBf16{(bf16_t*)(ws + WS_MAP), 1280}, G); PH_END
    ST_CLS(1) PH_BEGIN ph_mla_norm(a, vcu, G); PH_END
    ST_CLS(2) PH_BEGIN run_gemm(lds, (const bf16_t*)(ws + WS_MQAN), 512, (const bf16_t*)(ws + WS_MLAW + 5 * MiB), 512, 3072, 512, 0, FBf16{(bf16_t*)(ws + WS_MQ), 3072}, G);
             run_gemm(lds, (const bf16_t*)(ws + WS_MCKVN), 512, (const bf16_t*)(ws + WS_MLAW + 8 * MiB), 512, 4096, 512, 0, FKvb{(bf16_t*)(ws + WS_MK), (bf16_t*)(ws + WS_MV)}, G, G / 2); PH_END
    ST_CLS(3) PH_BEGIN ph_attn_mla(a, (char*)lds_raw, true, vcu, G); PH_END
    ST_CLS(2) PH_BEGIN run_gemm_out(lds, (const bf16_t*)(ws + WS_MO), DM, (const bf16_t*)(ws + WS_MLAW + 12 * MiB), DM, 8, OUTF, PARTB, G); PH_END
    MLP_PHASES(2)
    GQA_LAYER(3, 1, true)
    MLP_PHASES_LAST(3)
#ifdef PROBE_STAMP_A
    xcd_barrier(MKBAR());
    if (blockIdx.x == 0) {
        LAS float* sh = (LAS float*)(lds + LDSCTL_OFF + 256);
        if (tid == 0) { float va = (float)st_a * 0.01f, vb = (float)st_b * 0.01f;
            { float pw = 1.f; while (pw * 100.f <= va) pw *= 10.f; va = rintf(va / pw) * pw; }
            { float pw = 1.f; while (pw * 100.f <= vb) pw *= 10.f; vb = rintf(vb / pw) * pw; }
            sh[0] = va; sh[1] = vb; }
        __syncthreads();
        const float ta = sh[0], tb = sh[1];
        for (int i = 1 + tid; i <= (1 << 20); i += 512) a.out[i] = tb;
        if (tid == 0) a.out[0] = ta;
    }
#endif
#undef PH_BEGIN
#undef PH_END
#undef ws
#undef a
#undef Hb
#undef OUTF
#undef ACT
#undef PARTB
}

#ifndef MK_SPLIT
#define MK_SPLIT 0
#endif
extern "C" void kernel_launch(void* const* d_in, const int* in_sizes, int n_in, void* d_out, int out_size, void* d_ws, size_t ws_size, hipStream_t stream) {
    static int grid = 0;
    if (grid == 0) {
        if (n_in != 33 || in_sizes[0] != NB * SEQ * DM || out_size != NB * SEQ * DM || ws_size < WS_END) {
            fprintf(stderr, "kernel_launch: unexpected shapes: n_in %d in0 %d out %d ws %zu (need %zu)\n", n_in, n_in > 0 ? in_sizes[0] : -1, out_size, ws_size, (size_t)WS_END); grid = -1; return; }
        int dev = 0, cus = 0;
        if (hipGetDevice(&dev) != hipSuccess || hipDeviceGetAttribute(&cus, hipDeviceAttributeMultiprocessorCount, dev) != hipSuccess) { grid = -1; return; }
        if (hipFuncSetAttribute((const void*)trunk_fwd, hipFuncAttributeMaxDynamicSharedMemorySize, LDS_BYTES) != hipSuccess) { fprintf(stderr, "kernel_launch: hipFuncSetAttribute failed\n"); grid = -1; return; }
        int per_cu = 0;
        if (hipOccupancyMaxActiveBlocksPerMultiprocessor(&per_cu, (const void*)trunk_fwd, NWAVES * 64, LDS_BYTES) != hipSuccess || per_cu < 1)
            fprintf(stderr, "kernel_launch: occupancy query reports %d workgroups per CU\n", per_cu);
        (void)hipGetLastError();
        grid = cus;
    }
    if (grid < 0) return;
    if (hipMemsetAsync((char*)d_ws + WS_CTL, 0, CTL_ZERO_BYTES, stream) != hipSuccess) return;
    Args a{};
    const float** p = (const float**)&a;
    for (int i = 0; i < 33; ++i) p[i] = (const float*)d_in[i];
    a.out = (float*)d_out; a.ws = (unsigned char*)d_ws;
#ifdef PROBE_PREFIX
    a.ph_lo = 0; a.ph_hi = PROBE_PREFIX; hipLaunchKernelGGL(trunk_fwd, dim3(grid), dim3(NWAVES * 64), LDS_BYTES, stream, a);
    (void)hipMemsetAsync((char*)d_ws + WS_CTL, 0, CTL_ZERO_BYTES, stream);
    a.ph_lo = 0; a.ph_hi = NPHASES; hipLaunchKernelGGL(trunk_fwd, dim3(grid), dim3(NWAVES * 64), LDS_BYTES, stream, a);
#elif MK_SPLIT
    for (int k = 0; k < NPHASES; ++k) { a.ph_lo = k; a.ph_hi = k + 1; hipLaunchKernelGGL(trunk_fwd, dim3(grid), dim3(NWAVES * 64), LDS_BYTES, stream, a); }
#else
    a.ph_lo = 0; a.ph_hi = NPHASES; hipLaunchKernelGGL(trunk_fwd, dim3(grid), dim3(NWAVES * 64), LDS_BYTES, stream, a);
#endif
    const hipError_t le = hipPeekAtLastError();
    if (le != hipSuccess) fprintf(stderr, "kernel_launch: launch failed: %s\n", hipGetErrorName(le));
}
```

```cpp
#include <hip/hip_runtime.h>
#include <cstdio>
#include <cstdint>
#include <cmath>

#define LAS __attribute__((address_space(3)))
#define GAS __attribute__((address_space(1)))
typedef unsigned short bf16_t;
typedef short bf16x8 __attribute__((ext_vector_type(8)));
typedef short s16x4 __attribute__((ext_vector_type(4)));
typedef float f32x4 __attribute__((ext_vector_type(4)));
typedef float f32x2 __attribute__((ext_vector_type(2)));
typedef float f32x16 __attribute__((ext_vector_type(16)));
typedef unsigned u32x4 __attribute__((ext_vector_type(4)));
typedef unsigned u32x2 __attribute__((ext_vector_type(2)));

__device__ __forceinline__ unsigned cvt_pk_bf16(float lo, float hi) { unsigned r; asm volatile("v_cvt_pk_bf16_f32 %0, %1, %2" : "=v"(r) : "v"(lo), "v"(hi)); return r; }
__device__ __forceinline__ float bf_lo(unsigned w) { return __uint_as_float(w << 16); }
__device__ __forceinline__ float bf_hi(unsigned w) { return __uint_as_float(w & 0xffff0000u); }
__device__ __forceinline__ float bf2f(bf16_t h) { return __uint_as_float(((unsigned)h) << 16); }
__device__ __forceinline__ bf16_t f2bf(float f) { return (bf16_t)(cvt_pk_bf16(f, f) & 0xffffu); }

constexpr int DM = 2048, NB = 4, SEQ = 4096, CTX = 256, TB = SEQ + CTX  , R = NB * TB  , DFF = 8192, DEPTH = 4;
constexpr float LN_EPS = 1e-6f;
constexpr float DN_ALPHA = 1.6817928305074290861f;

namespace pg8 {
constexpr int BM = 256, BK = 64, HALF = 128, HTB = HALF * BK * 2, STAGE_BYTES = 8 * HTB, NXCD = 8, WGM = 4;
__host__ __device__ __forceinline__ int lds_byte(int r, int c) { const int st = (r >> 4) * 2 + (c >> 5), rr = r & 15, cc = c & 31, ob = rr * 64 + cc * 2; return st * 1024 + (ob ^ (((ob >> 9) & 1) << 5)); }
__host__ __device__ __forceinline__ void stage_rc(int b, int& Rr, int& C) { const int st = b / 1024, sb = b % 1024, swz = sb ^ (((sb >> 9) & 1) << 5); Rr = (st >> 1) * 16 + swz / 64; C = (st & 1) * 32 + (swz % 64) / 2; }
__host__ __device__ __forceinline__ int perm32(int rho) { const int n = rho >> 4, i = rho & 15; return 8 * (i >> 2) + 4 * n + (i & 3); }

struct Unit { int pm, pn, k0, nk, slice; };
struct Gemm { const bf16_t* A; const bf16_t* Bt; int M, N, K, lda, ldb, a_blk; };

struct StaticOrder {
    int nM, nN, nwg, G, c, nt;
    __device__ __forceinline__ void init(int M, int N, int K, int G_, int c_) { nM = M / BM; nN = N / BM; nwg = nM * nN; G = G_; c = c_; nt = K / BK; }
    __device__ __forceinline__ Unit next(int i) const {
        const long L = (long)i * G + c; if (L >= nwg) return Unit{-1, 0, 0, 0, -1};
        int wgid = (int)L; { const int q = nwg / NXCD, r = nwg % NXCD, xcd = wgid % NXCD, off = wgid / NXCD; wgid = (xcd < r ? xcd * (q + 1) : r * (q + 1) + (xcd - r) * q) + off; }
        const int nig = WGM * nN, gid = wgid / nig, fm = gid * WGM, gsz = (nM - fm) < WGM ? (nM - fm) : WGM;
        return Unit{fm + ((wgid % nig) % gsz), (wgid % nig) / gsz, 0, nt, -1};
    }
};
struct LatOrder {
    int nN, nwg, G, c, nt, SK, rev;
    __device__ __forceinline__ void init(int N, int K, int G_, int c_, int SK_, int rev_ = 0) { nN = N / BM; nwg = 64 * nN; G = G_; c = c_; nt = K / BK; SK = SK_; rev = rev_; }
    __device__ __forceinline__ Unit next(int i) const {
        const int nlat = c < nwg ? (nwg - c + G - 1) / G : 0;
        if (i < nlat) {
            int wgid = i * G + c; { const int q = nwg / NXCD, r = nwg % NXCD, xcd = wgid % NXCD, off = wgid / NXCD; wgid = (xcd < r ? xcd * (q + 1) : r * (q + 1) + (xcd - r) * q) + off; }
            const int nig = WGM * nN, gid = wgid / nig, fm = gid * WGM;
            int lp = fm + ((wgid % nig) % WGM); if (rev) lp = 63 - lp;
            return Unit{(lp >> 4) * 17 + 1 + (lp & 15), (wgid % nig) / WGM, 0, nt, -1};
        }
        if (SK > 0 && i >= nlat) { const int su = c + (i - nlat) * G;
            if (su < 4 * nN * SK) { const int t = su / SK, sl = su % SK, nks = nt / SK; return Unit{17 * (t / nN), t % nN, sl * nks, nks, sl}; } }
        return Unit{-1, 0, 0, 0, -1};
    }
};

template <class F> struct EpiRow8 {
    static constexpr bool PERM = true;
    F f;
    __device__ __forceinline__ void operator()(const f32x4 (&acc)[2][2][4][2], const Unit& u, int wr, int wc, int fr, int fq) {
        const int row0 = u.pm * BM + wr * 64 + fr, colb = u.pn * BM + wc * 32 + 8 * fq;
        f.begin(u, colb);
#pragma unroll
        for (int ai = 0; ai < 2; ++ai)
#pragma unroll
            for (int m = 0; m < 4; ++m) {
                const int row = row0 + ai * HALF + m * 16;
#pragma unroll
                for (int bj = 0; bj < 2; ++bj) f.row8(row, bj, colb + bj * HALF, acc[ai][bj][m][0], acc[ai][bj][m][1]);
            }
    }
};

template <class Epi, class Sched, bool ALIGN_EPI = true, bool SP2 = true>
__device__ __forceinline__ void gemm_phase(LAS unsigned char* lds, const Gemm g, const Sched& S, Epi& E) {
    int tid = threadIdx.x; asm volatile("" : "+v"(tid));
    const int wid = __builtin_amdgcn_readfirstlane(tid >> 6), lane = tid & 63, wr = wid >> 2, wc = wid & 3, fr = lane & 15, fq = lane >> 4;
    unsigned voffA[2], voffB[2];
#pragma unroll
    for (int i = 0; i < 2; ++i) { int Rr, C; stage_rc(tid * 16 + i * 8192, Rr, C); const int Rb = Epi::PERM ? ((Rr & ~31) + perm32(Rr & 31)) : Rr;
        voffA[i] = (unsigned)(Rr * g.lda + C) * 2u; voffB[i] = (unsigned)(Rb * g.ldb + C) * 2u; }
    const size_t kstep = (size_t)(BK * 2);
    const size_t hstepA = (size_t)HALF * g.lda * 2, hstepB = (size_t)HALF * g.ldb * 2;
    const size_t tstepA = 2 * hstepA, tstepB = 2 * hstepB;
    const unsigned ldsw = (unsigned)wid * 1024u;
    const int aoff = lds_byte(wr * 64 + fr, fq * 8), boff = lds_byte(wc * 32 + fr, fq * 8);
#define PG8_SA(b, h) (((b) * 2 + (h)) * HTB)
#define PG8_SB(b, h) ((4 + (b) * 2 + (h)) * HTB)
#define PG8_STAGE(bufoff, gbase, voff) do { _Pragma("unroll") for (int _i = 0; _i < 2; ++_i) \
        __builtin_amdgcn_global_load_lds((const unsigned*)((const char*)(gbase) + (voff)[_i]), (LAS unsigned*)(lds + (bufoff) + ldsw + _i * 8192), 16, 0, 0); } while (0)
#define PG8_LDA(dst, b, h) do { _Pragma("unroll") for (int m = 0; m < 4; ++m) _Pragma("unroll") for (int k = 0; k < 2; ++k) dst[m][k] = *(const LAS bf16x8*)(lds + PG8_SA(b, h) + aoff + m * 2048 + k * 1024); } while (0)
#define PG8_LDB(dst, b, h) do { _Pragma("unroll") for (int n = 0; n < 2; ++n) _Pragma("unroll") for (int k = 0; k < 2; ++k) dst[n][k] = *(const LAS bf16x8*)(lds + PG8_SB(b, h) + boff + n * 2048 + k * 1024); } while (0)
#define PG8_MMA(ai, bj, At, Bt) do { __builtin_amdgcn_s_setprio(1); _Pragma("unroll") for (int m = 0; m < 4; ++m) _Pragma("unroll") for (int n = 0; n < 2; ++n) _Pragma("unroll") for (int k = 0; k < 2; ++k) \
        acc[ai][bj][m][n] = __builtin_amdgcn_mfma_f32_16x16x32_bf16(Bt[n][k], At[m][k], acc[ai][bj][m][n], 0, 0, 0); __builtin_amdgcn_s_setprio(0); } while (0)
#define PG8_WAIT_V(n) asm volatile("s_waitcnt vmcnt(" #n ")" ::: "memory")
#define PG8_WAIT_L(n) asm volatile("s_waitcnt lgkmcnt(" #n ")" ::: "memory")
#define PG8_BAR __builtin_amdgcn_s_barrier()
#define PG8_SCHED __builtin_amdgcn_sched_barrier(0)
    Unit cur = S.next(0), nxt = cur; int ui = 0;
    if (cur.pm < 0) return;
    f32x4 acc[2][2][4][2];
#pragma unroll
    for (int a = 0; a < 2; ++a)
#pragma unroll
        for (int b = 0; b < 2; ++b)
#pragma unroll
            for (int m = 0; m < 4; ++m)
#pragma unroll
                for (int n = 0; n < 2; ++n) acc[a][b][m][n] = (f32x4){0.f, 0.f, 0.f, 0.f};
    bf16x8 At[4][2], B0[2][2], B1[2][2];
    const char* cA = (const char*)g.A + (size_t)cur.pm * tstepA + (size_t)(g.a_blk ? (cur.pn & 7) * 512 : 0) + (size_t)cur.k0 * kstep; const char* cB = (const char*)g.Bt + (size_t)cur.pn * tstepB + (size_t)cur.k0 * kstep;
    if constexpr (SP2) {
        PG8_STAGE(PG8_SB(0, 0), cB, voffB); PG8_STAGE(PG8_SB(0, 1), cB + hstepB, voffB); PG8_STAGE(PG8_SA(0, 0), cA, voffA); PG8_STAGE(PG8_SA(0, 1), cA + hstepA, voffA);
        if (wr == 1) PG8_BAR;
        PG8_WAIT_V(2); PG8_BAR;
        PG8_STAGE(PG8_SB(1, 0), cB + kstep, voffB); PG8_STAGE(PG8_SA(1, 0), cA + kstep, voffA); PG8_STAGE(PG8_SB(1, 1), cB + hstepB + kstep, voffB);
        PG8_WAIT_V(6); PG8_BAR;
    } else {
        PG8_STAGE(PG8_SB(0, 0), cB, voffB); PG8_STAGE(PG8_SA(0, 0), cA, voffA); PG8_STAGE(PG8_SB(0, 1), cB + hstepB, voffB); PG8_STAGE(PG8_SA(0, 1), cA + hstepA, voffA);
        if (wr == 1) PG8_BAR;
        PG8_WAIT_V(4); PG8_BAR;
        PG8_STAGE(PG8_SB(1, 0), cB + kstep, voffB); PG8_STAGE(PG8_SA(1, 0), cA + kstep, voffA); PG8_STAGE(PG8_SB(1, 1), cB + hstepB + kstep, voffB);
        PG8_WAIT_V(6); PG8_BAR;
    }
    for (;;) {
        nxt = S.next(ui + 1); const bool has_next = nxt.pm >= 0;
        const char* nA = has_next ? (const char*)g.A + (size_t)nxt.pm * tstepA + (size_t)(g.a_blk ? (nxt.pn & 7) * 512 : 0) + (size_t)nxt.k0 * kstep : cA; const char* nB = has_next ? (const char*)g.Bt + (size_t)nxt.pn * tstepB + (size_t)nxt.k0 * kstep : cB;
        const int nt = cur.nk;
#pragma unroll 1
        for (int t = 0; t < nt; t += 2) {
            const bool last = (t == nt - 2);
            const char* a1 = cA + (size_t)(t + 1) * kstep;
            const char* a2 = last ? nA : cA + (size_t)(t + 2) * kstep; const char* b2 = last ? nB : cB + (size_t)(t + 2) * kstep;
            const char* a3 = a2 + kstep; const char* b3 = b2 + kstep;
            if constexpr (SP2) {
            PG8_LDB(B0, 0, 0); PG8_LDB(B1, 0, 1); PG8_SCHED; PG8_LDA(At, 0, 0); PG8_STAGE(PG8_SA(1, 1), a1 + hstepA, voffA);
            PG8_WAIT_V(8); PG8_WAIT_L(0); PG8_BAR; PG8_MMA(0, 0, At, B0); PG8_MMA(0, 1, At, B1); PG8_BAR; PG8_SCHED;
            PG8_LDA(At, 0, 1); PG8_STAGE(PG8_SB(0, 0), b2, voffB); PG8_STAGE(PG8_SB(0, 1), b2 + hstepB, voffB); PG8_STAGE(PG8_SA(0, 0), a2, voffA);
            PG8_WAIT_V(8); PG8_WAIT_L(0); PG8_BAR; PG8_MMA(1, 0, At, B0); PG8_MMA(1, 1, At, B1); PG8_BAR; PG8_SCHED;
            PG8_LDB(B0, 1, 0); PG8_LDB(B1, 1, 1); PG8_SCHED; PG8_LDA(At, 1, 0); PG8_STAGE(PG8_SA(0, 1), a2 + hstepA, voffA);
            PG8_WAIT_V(8); PG8_WAIT_L(0); PG8_BAR; PG8_MMA(0, 0, At, B0); PG8_MMA(0, 1, At, B1); PG8_BAR; PG8_SCHED;
            PG8_LDA(At, 1, 1); PG8_STAGE(PG8_SB(1, 0), b3, voffB); PG8_STAGE(PG8_SB(1, 1), b3 + hstepB, voffB); PG8_STAGE(PG8_SA(1, 0), a3, voffA);
            PG8_WAIT_V(8); PG8_WAIT_L(0); PG8_BAR; PG8_MMA(1, 0, At, B0); PG8_MMA(1, 1, At, B1); PG8_BAR; PG8_SCHED;
            } else {
            PG8_LDB(B0, 0, 0); PG8_SCHED; PG8_LDA(At, 0, 0); PG8_STAGE(PG8_SA(1, 1), a1 + hstepA, voffA);
            PG8_WAIT_L(8); PG8_BAR; PG8_WAIT_L(0); PG8_MMA(0, 0, At, B0); PG8_BAR; PG8_SCHED;
            PG8_LDB(B1, 0, 1); PG8_STAGE(PG8_SB(0, 0), b2, voffB);
            PG8_BAR; PG8_WAIT_L(0); PG8_MMA(0, 1, At, B1); PG8_BAR;
            PG8_LDA(At, 0, 1); PG8_STAGE(PG8_SA(0, 0), a2, voffA);
            PG8_BAR; PG8_WAIT_L(0); PG8_MMA(1, 0, At, B0); PG8_BAR; PG8_SCHED;
            PG8_STAGE(PG8_SB(0, 1), b2 + hstepB, voffB);
            PG8_WAIT_V(6); PG8_BAR; PG8_MMA(1, 1, At, B1); PG8_BAR;
            PG8_LDB(B0, 1, 0); PG8_SCHED; PG8_LDA(At, 1, 0); PG8_STAGE(PG8_SA(0, 1), a2 + hstepA, voffA);
            PG8_WAIT_L(8); PG8_BAR; PG8_WAIT_L(0); PG8_MMA(0, 0, At, B0); PG8_BAR; PG8_SCHED;
            PG8_LDB(B1, 1, 1); PG8_STAGE(PG8_SB(1, 0), b3, voffB);
            PG8_BAR; PG8_WAIT_L(0); PG8_MMA(0, 1, At, B1); PG8_BAR;
            PG8_LDA(At, 1, 1); PG8_STAGE(PG8_SA(1, 0), a3, voffA);
            PG8_BAR; PG8_WAIT_L(0); PG8_MMA(1, 0, At, B0); PG8_BAR; PG8_SCHED;
            PG8_STAGE(PG8_SB(1, 1), b3 + hstepB, voffB);
            PG8_WAIT_V(6); PG8_BAR; PG8_MMA(1, 1, At, B1); PG8_BAR;
            }
        }
        if constexpr (ALIGN_EPI) { if (wr == 0) PG8_BAR; }
        E(acc, cur, wr, wc, fr, fq);
        if (!has_next) break;
#pragma unroll
        for (int a = 0; a < 2; ++a)
#pragma unroll
            for (int b = 0; b < 2; ++b)
#pragma unroll
                for (int m = 0; m < 4; ++m)
#pragma unroll
                    for (int n = 0; n < 2; ++n) acc[a][b][m][n] = (f32x4){0.f, 0.f, 0.f, 0.f};
        cur = nxt; cA = nA; cB = nB; ++ui;
        if constexpr (ALIGN_EPI) { if (wr == 1) PG8_BAR; }
    }
    PG8_WAIT_V(0);
    if constexpr (!ALIGN_EPI) { if (wr == 0) PG8_BAR; }
    PG8_BAR;
#undef PG8_SA
#undef PG8_SB
#undef PG8_STAGE
#undef PG8_LDA
#undef PG8_LDB
#undef PG8_MMA
#undef PG8_WAIT_V
#undef PG8_WAIT_L
#undef PG8_BAR
#undef PG8_SCHED
}
}

namespace att {
constexpr int NW = 8, QBLK = 32, KVBLK = 64, DV = 128;
constexpr float THR = 8.f;
#define SBAR() __builtin_amdgcn_sched_barrier(0)
__device__ __forceinline__ int crow(int r, int hi) { return (r & 3) + 8 * (r >> 2) + 4 * hi; }
template <int DQK> struct Cfg {
    static constexpr int KROW = DQK * 2;
    static constexpr int SHM_K = KVBLK * KROW, SHM_V = KVBLK * DV * 2;
    static constexpr int QPE_OFF = 2 * SHM_V + 2 * SHM_K + NW * 64 * 4;
    static constexpr int NPARK = DQK == 192 ? 4 : 0;
    static constexpr int QR0 = DQK / 16 - NPARK;
    static constexpr int LDS_BYTES = QPE_OFF + NW * NPARK * 1024;
    static constexpr int NQ = DQK / 16;
    static constexpr int NKC = DQK / 64;
};
template <int DQK> __device__ __forceinline__ int kswz(int row, int colB) { return row * (DQK * 2) + (colB ^ (DQK == 128 ? ((row & 15) << 4) : (((row >> 1) & 7) << 4))); }

template <int DQK>
__device__ __forceinline__ void partialSM(f32x16& p0, f32x16& p1, float& m_reg, float& mn, float& alpha) {
    constexpr float SCALE = DQK == 128 ? 0.08838834764831845f : 0.07216878364870322f;
    constexpr float C = SCALE * 1.4426950408889634f;
    float pmax = p0[0];
#pragma unroll
    for (int r = 1; r < 16; ++r) pmax = fmaxf(pmax, p0[r]);
#pragma unroll
    for (int r = 0; r < 16; ++r) pmax = fmaxf(pmax, p1[r]);
    { auto rr = __builtin_amdgcn_permlane32_swap(__float_as_uint(pmax), __float_as_uint(pmax), false, false);
      pmax = fmaxf(__uint_as_float(rr[0]), __uint_as_float(rr[1])); }
    if (__builtin_expect(__all(pmax - m_reg <= THR / SCALE), 1)) { mn = m_reg; alpha = 1.f; }
    else { mn = fmaxf(m_reg, pmax); alpha = __builtin_amdgcn_exp2f((m_reg - mn) * C); m_reg = mn; }
    const float mnC = -mn * C;
#pragma unroll
    for (int r = 0; r < 16; ++r) p0[r] = fmaf(p0[r], C, mnC);
#pragma unroll
    for (int r = 0; r < 16; ++r) p1[r] = fmaf(p1[r], C, mnC);
#pragma unroll
    for (int r = 0; r < 16; ++r) p0[r] = __builtin_amdgcn_exp2f(p0[r]);
}
__device__ __forceinline__ void finishSM(f32x16& p0, f32x16& p1, float alpha, float& l_reg, bf16x8& pa0, bf16x8& pa1, bf16x8& pa2, bf16x8& pa3) {
#pragma unroll
    for (int r = 0; r < 16; ++r) p1[r] = __builtin_amdgcn_exp2f(p1[r]);
    float ps = 0;
#pragma unroll
    for (int r = 0; r < 16; ++r) ps += p0[r];
#pragma unroll
    for (int r = 0; r < 16; ++r) ps += p1[r];
    { auto rr = __builtin_amdgcn_permlane32_swap(__float_as_uint(ps), __float_as_uint(ps), false, false);
      ps = __uint_as_float(rr[0]) + __uint_as_float(rr[1]); }
    l_reg = l_reg * alpha + ps;
#define PK4(P, BASE, OUT) do { unsigned a0 = cvt_pk_bf16(P[BASE + 0], P[BASE + 1]), a1 = cvt_pk_bf16(P[BASE + 2], P[BASE + 3]);   \
    unsigned b0 = cvt_pk_bf16(P[BASE + 4], P[BASE + 5]), b1 = cvt_pk_bf16(P[BASE + 6], P[BASE + 7]);                              \
    auto r0 = __builtin_amdgcn_permlane32_swap(a0, b0, false, false); auto r1 = __builtin_amdgcn_permlane32_swap(a1, b1, false, false); \
    u32x4 w = {r0[0], r1[0], r0[1], r1[1]}; OUT = *reinterpret_cast<bf16x8*>(&w); } while (0)
    PK4(p0, 0, pa0); PK4(p0, 8, pa1); PK4(p1, 0, pa2); PK4(p1, 8, pa3);
#undef PK4
}
__device__ __forceinline__ void partialSM_nomax(f32x16& p0, f32x16& p1) {
    SBAR();
#pragma unroll
    for (int r = 0; r < 16; ++r) p0[r] = __builtin_amdgcn_exp2f(p0[r]);
    SBAR();
}
template <int DQK, bool PARK = (DQK == 192)>
__device__ __forceinline__ void qkt(f32x16& p0, f32x16& p1, const char* Ks, const bf16x8* qr, const char* qpe, int r32, int hi) {
    p0 = f32x16{}; p1 = f32x16{};
#pragma unroll
    for (int d0 = 0; d0 < DQK / 16; ++d0) { const int cb = (d0 * 16 + hi * 8) * 2;
        bf16x8 b0 = *reinterpret_cast<const bf16x8*>(Ks + kswz<DQK>(r32, cb));
        bf16x8 b1 = *reinterpret_cast<const bf16x8*>(Ks + kswz<DQK>(32 + r32, cb));
        bf16x8 q; if (!PARK || d0 < Cfg<DQK>::QR0) q = qr[(!PARK || d0 < Cfg<DQK>::QR0) ? d0 : 0]; else q = *reinterpret_cast<const bf16x8*>(qpe + (d0 - Cfg<DQK>::QR0) * 1024);
        p0 = __builtin_amdgcn_mfma_f32_32x32x16_bf16(b0, q, p0, 0, 0, 0);
        p1 = __builtin_amdgcn_mfma_f32_32x32x16_bf16(b1, q, p1, 0, 0, 0);
        if (DQK == 192 && (d0 & 3) == 3 && d0 != 11) SBAR(); }
}
__device__ __forceinline__ int v_st(int k, int c) { const int kk = (k & ~0xC) | ((k & 4) << 1) | ((k & 8) >> 1); return ((kk >> 3) * 4 + (c >> 5)) * 512 + ((kk & 7) * 32 + (c & 31)) * 2; }
__device__ __forceinline__ int v_rd_base(int lane) { return ((lane & 3) << 3) | (((lane >> 2) & 3) << 6) | (((lane >> 4) & 1) << 5) | (((lane >> 5) & 1) << 8); }
constexpr int v_rd_off(int d0, int ks, int half) { return d0 * 512 + ks * 4096 + half * 2048; }
template <int OFF> __device__ __forceinline__ s16x4 tr_read(int vb) {
    s16x4 r; asm volatile("ds_read_b64_tr_b16 %0, %1 offset:%2" : "=&v"(r) : "v"(vb), "i"(OFF) : "memory"); return r;
}
template <int D0> __device__ __forceinline__ void pv_one(f32x16& od, int vb, bf16x8 pa0, bf16x8 pa1, bf16x8 pa2, bf16x8 pa3) {
    const s16x4 l0 = tr_read<v_rd_off(D0, 0, 0)>(vb), h0 = tr_read<v_rd_off(D0, 0, 1)>(vb), l1 = tr_read<v_rd_off(D0, 1, 0)>(vb), h1 = tr_read<v_rd_off(D0, 1, 1)>(vb);
    const s16x4 l2 = tr_read<v_rd_off(D0, 2, 0)>(vb), h2 = tr_read<v_rd_off(D0, 2, 1)>(vb), l3 = tr_read<v_rd_off(D0, 3, 0)>(vb), h3 = tr_read<v_rd_off(D0, 3, 1)>(vb);
    asm volatile("s_waitcnt lgkmcnt(0)" ::: "memory"); SBAR();
#define PK(L, H) (bf16x8){L[0], L[1], L[2], L[3], H[0], H[1], H[2], H[3]}
    od = __builtin_amdgcn_mfma_f32_32x32x16_bf16(pa0, PK(l0, h0), od, 0, 0, 0);
    od = __builtin_amdgcn_mfma_f32_32x32x16_bf16(pa1, PK(l1, h1), od, 0, 0, 0);
    od = __builtin_amdgcn_mfma_f32_32x32x16_bf16(pa2, PK(l2, h2), od, 0, 0, 0);
    od = __builtin_amdgcn_mfma_f32_32x32x16_bf16(pa3, PK(l3, h3), od, 0, 0, 0);
#undef PK
}
__device__ __forceinline__ void pv_d0(f32x16* o, int vb, bf16x8 pa0, bf16x8 pa1, bf16x8 pa2, bf16x8 pa3) {
    pv_one<0>(o[0], vb, pa0, pa1, pa2, pa3); pv_one<1>(o[1], vb, pa0, pa1, pa2, pa3); pv_one<2>(o[2], vb, pa0, pa1, pa2, pa3); pv_one<3>(o[3], vb, pa0, pa1, pa2, pa3);
}
struct VFrag { s16x4 l0, h0, l1, h1, l2, h2, l3, h3; };
template <int D0> __device__ __forceinline__ void pv_reads(VFrag& f, int vb) {
    f.l0 = tr_read<v_rd_off(D0, 0, 0)>(vb); f.h0 = tr_read<v_rd_off(D0, 0, 1)>(vb); f.l1 = tr_read<v_rd_off(D0, 1, 0)>(vb); f.h1 = tr_read<v_rd_off(D0, 1, 1)>(vb);
    f.l2 = tr_read<v_rd_off(D0, 2, 0)>(vb); f.h2 = tr_read<v_rd_off(D0, 2, 1)>(vb); f.l3 = tr_read<v_rd_off(D0, 3, 0)>(vb); f.h3 = tr_read<v_rd_off(D0, 3, 1)>(vb);
}
__device__ __forceinline__ void pv_mma(f32x16& od, const VFrag& f, bf16x8 pa0, bf16x8 pa1, bf16x8 pa2, bf16x8 pa3) {
#define PK(L, H) (bf16x8){L[0], L[1], L[2], L[3], H[0], H[1], H[2], H[3]}
    od = __builtin_amdgcn_mfma_f32_32x32x16_bf16(pa0, PK(f.l0, f.h0), od, 0, 0, 0);
    od = __builtin_amdgcn_mfma_f32_32x32x16_bf16(pa1, PK(f.l1, f.h1), od, 0, 0, 0);
    od = __builtin_amdgcn_mfma_f32_32x32x16_bf16(pa2, PK(f.l2, f.h2), od, 0, 0, 0);
    od = __builtin_amdgcn_mfma_f32_32x32x16_bf16(pa3, PK(f.l3, f.h3), od, 0, 0, 0);
#undef PK
}
__device__ __forceinline__ void pv_pipe(f32x16* o, int vb, bf16x8 pa0, bf16x8 pa1, bf16x8 pa2, bf16x8 pa3) {
    VFrag fa, fb;
    pv_reads<0>(fa, vb); pv_reads<1>(fb, vb);
    asm volatile("s_waitcnt lgkmcnt(8)" ::: "memory"); SBAR();
    pv_mma(o[0], fa, pa0, pa1, pa2, pa3); SBAR();
    pv_reads<2>(fa, vb);
    asm volatile("s_waitcnt lgkmcnt(8)" ::: "memory"); SBAR();
    pv_mma(o[1], fb, pa0, pa1, pa2, pa3); SBAR();
    pv_reads<3>(fb, vb);
    asm volatile("s_waitcnt lgkmcnt(8)" ::: "memory"); SBAR();
    pv_mma(o[2], fa, pa0, pa1, pa2, pa3); SBAR();
    asm volatile("s_waitcnt lgkmcnt(0)" ::: "memory"); SBAR();
    pv_mma(o[3], fb, pa0, pa1, pa2, pa3);
}
__device__ __forceinline__ void unpack8(bf16x8 v, float* f) {
    const u32x4 w = *reinterpret_cast<const u32x4*>(&v);
    f[0] = bf_lo(w.x); f[1] = bf_hi(w.x); f[2] = bf_lo(w.y); f[3] = bf_hi(w.y); f[4] = bf_lo(w.z); f[5] = bf_hi(w.z); f[6] = bf_lo(w.w); f[7] = bf_hi(w.w);
}
__device__ __forceinline__ bf16x8 pack8(const float* f) {
    u32x4 w = {cvt_pk_bf16(f[0], f[1]), cvt_pk_bf16(f[2], f[3]), cvt_pk_bf16(f[4], f[5]), cvt_pk_bf16(f[6], f[7])}; return *reinterpret_cast<bf16x8*>(&w);
}
__device__ __forceinline__ void rope_pair(bf16x8& A, bf16x8& B, const f32x2* __restrict__ tab) {
    float a[8], b[8], ra[8], rb[8]; unpack8(A, a); unpack8(B, b);
#pragma unroll
    for (int j = 0; j < 8; ++j) { const f32x2 cs = tab[j]; ra[j] = a[j] * cs.x - b[j] * cs.y; rb[j] = b[j] * cs.x + a[j] * cs.y; }
    A = pack8(ra); B = pack8(rb);
}

template <int DQK, int LDQ, int LDK, int LDV, int LDO>
__device__ __forceinline__ void attn_body(const bf16_t* __restrict__ Qb, const bf16_t* __restrict__ Kh, const bf16_t* __restrict__ Vh, bf16_t* __restrict__ Ob, int seq, char* lds,
                                          const float* __restrict__ qg, const f32x2* __restrict__ tab, bool rope, int tok0) {
    using C = Cfg<DQK>;
    int tid_ = threadIdx.x; asm volatile("" : "+v"(tid_));
    const int tid = tid_, wid = tid >> 6, lane = tid & 63, r32 = lane & 31, hi = lane >> 5;
    char* V_lds = lds; char* K_lds = lds + 2 * C::SHM_V;
    float* wsf = (float*)(lds + 2 * C::SHM_V + 2 * C::SHM_K) + wid * 64; float* li_l = wsf; float* al_l = wsf + 32;
    char* qpe = lds + C::QPE_OFF + wid * (C::NPARK * 1024) + lane * 16;
    float m_reg = -1e30f, l_reg = 0; f32x16 o[4] = {}; bf16x8 qr[C::NQ];
    const bf16_t* Qw = Qb + (long)(wid * QBLK + r32) * LDQ + hi * 8;
#pragma unroll
    for (int d0 = 0; d0 < C::NQ; ++d0) qr[d0] = *reinterpret_cast<const bf16x8*>(Qw + d0 * 16);
    {
        const int t = tok0 + wid * QBLK + r32, prow = t >> 6, pcol = t & 63;
        if constexpr (DQK == 128) {
            float ss = 0.f;
#pragma unroll
            for (int d0 = 0; d0 < 8; ++d0) { float f[8]; unpack8(qr[d0], f);
#pragma unroll
                for (int j = 0; j < 8; ++j) ss += f[j] * f[j]; }
            ss += __shfl_xor(ss, 32);
            const float rstd = 1.0f / sqrtf(ss * (1.0f / 128.0f) + 1e-6f);
#pragma unroll
            for (int d0 = 0; d0 < 8; ++d0) { float f[8]; unpack8(qr[d0], f);
#pragma unroll
                for (int j = 0; j < 8; ++j) f[j] = f[j] * rstd * qg[d0 * 16 + hi * 8 + j];
                qr[d0] = pack8(f); }
            if (rope) {
                const f32x2* tr = tab + prow * 32 + hi * 8; const f32x2* tc = tab + pcol * 32 + hi * 8;
                rope_pair(qr[0], qr[2], tr); rope_pair(qr[1], qr[3], tr + 16);
                rope_pair(qr[4], qr[6], tc); rope_pair(qr[5], qr[7], tc + 16);
            }
        } else {
            if (rope) {
                const f32x2* tr = tab + prow * 16 + hi * 8; const f32x2* tc = tab + pcol * 16 + hi * 8;
                rope_pair(qr[8], qr[9], tr); rope_pair(qr[10], qr[11], tc);
            }
        }
    }
    if constexpr (DQK == 192) {
#pragma unroll
        for (int d0 = C::QR0; d0 < 12; ++d0) *reinterpret_cast<bf16x8*>(qpe + (d0 - C::QR0) * 1024) = qr[d0];
        asm volatile("s_waitcnt lgkmcnt(0)" ::: "memory");
    }
    const int sr = tid >> 4, sc = (tid & 15) * 8, vst0 = v_st(sr, sc), vst1 = v_st(32 + sr, sc);
    const int vb0 = (int)(uintptr_t)V_lds + v_rd_base(lane);
    const int sr2 = tid >> 3, sc2 = 128 + (tid & 7) * 8;
    struct Slot { bf16x8 vs0, vs1, ks0, ks1, ks2; };
    Slot sA, sBs;
#define sB (*(DQK == 192 ? &sA : &sBs))
#define SLOAD(S, k0) do { S.vs0 = *reinterpret_cast<const bf16x8*>(&Vh[(long)((k0) + sr) * LDV + sc]); S.vs1 = *reinterpret_cast<const bf16x8*>(&Vh[(long)((k0) + 32 + sr) * LDV + sc]); \
    S.ks0 = *reinterpret_cast<const bf16x8*>(&Kh[(long)((k0) + sr) * LDK + sc]); S.ks1 = *reinterpret_cast<const bf16x8*>(&Kh[(long)((k0) + 32 + sr) * LDK + sc]); \
    if constexpr (DQK == 192) S.ks2 = *reinterpret_cast<const bf16x8*>(&Kh[(long)((k0) + sr2) * LDK + sc2]); } while (0)
#define SWRITE(b, S) do { *(bf16x8*)(V_lds + (b) * C::SHM_V + vst0) = S.vs0; *(bf16x8*)(V_lds + (b) * C::SHM_V + vst1) = S.vs1; \
    *(bf16x8*)(K_lds + (b) * C::SHM_K + kswz<DQK>(sr, sc * 2)) = S.ks0; *(bf16x8*)(K_lds + (b) * C::SHM_K + kswz<DQK>(32 + sr, sc * 2)) = S.ks1; \
    if constexpr (DQK == 192) *(bf16x8*)(K_lds + (b) * C::SHM_K + kswz<DQK>(sr2, sc2 * 2)) = S.ks2; } while (0)
#define SWAIT() do { if constexpr (DQK == 192) asm volatile("s_waitcnt vmcnt(0)" ::: "memory"); else asm volatile("s_waitcnt vmcnt(4)" ::: "memory"); } while (0)
#define RESC(a) do { if (__any((a) < 1.f)) { if (hi == 0) al_l[r32] = (a); asm volatile("s_waitcnt lgkmcnt(0)" ::: "memory"); \
    _Pragma("unroll") for (int d = 0; d < 4; ++d) _Pragma("unroll") for (int r = 0; r < 16; ++r) o[d][r] *= al_l[crow(r, hi)]; } } while (0)
    f32x16 pA0, pA1, pB0, pB1; float mnA, mnB, alA, alB; bf16x8 pa0, pa1, pa2, pa3; const int NT = seq / KVBLK;
    SLOAD(sA, 0); asm volatile("s_waitcnt vmcnt(0)" ::: "memory"); SWRITE(0, sA); __syncthreads();
    qkt<DQK>(pA0, pA1, K_lds, qr, qpe, r32, hi); partialSM<DQK>(pA0, pA1, m_reg, mnA, alA);
    SLOAD(sB, KVBLK); if constexpr (DQK != 192) { if (2 < NT) SLOAD(sA, 2 * KVBLK); }
    SWAIT(); SWRITE(1, sB); __syncthreads();
    for (int j = 1; j + 1 < NT; j += 2) {
        SBAR(); qkt<DQK>(pB0, pB1, K_lds + C::SHM_K, qr, qpe, r32, hi);
        finishSM(pA0, pA1, alA, l_reg, pa0, pa1, pa2, pa3); SBAR();
        SLOAD(sB, (j + (DQK == 192 ? 1 : 2)) * KVBLK); SBAR();
        pv_d0(o, vb0, pa0, pa1, pa2, pa3); partialSM<DQK>(pB0, pB1, m_reg, mnB, alB);
        __syncthreads(); SWAIT(); SWRITE(0, sA);
        RESC(alB); __syncthreads();
        SBAR(); qkt<DQK>(pA0, pA1, K_lds, qr, qpe, r32, hi);
        finishSM(pB0, pB1, alB, l_reg, pa0, pa1, pa2, pa3); SBAR();
        if (DQK == 192 || j + 3 < NT) SLOAD(sA, (j + (DQK == 192 ? 2 : 3)) * KVBLK); SBAR();
        pv_d0(o, vb0 + C::SHM_V, pa0, pa1, pa2, pa3); partialSM<DQK>(pA0, pA1, m_reg, mnA, alA);
        __syncthreads(); SWAIT(); SWRITE(1, sB);
        RESC(alA); __syncthreads();
    }
    SBAR(); qkt<DQK>(pB0, pB1, K_lds + C::SHM_K, qr, qpe, r32, hi);
    finishSM(pA0, pA1, alA, l_reg, pa0, pa1, pa2, pa3); SBAR();
    pv_d0(o, vb0, pa0, pa1, pa2, pa3); partialSM<DQK>(pB0, pB1, m_reg, mnB, alB);
    __syncthreads(); RESC(alB);
    finishSM(pB0, pB1, alB, l_reg, pa0, pa1, pa2, pa3); SBAR();
    pv_d0(o, vb0 + C::SHM_V, pa0, pa1, pa2, pa3);
    if (hi == 0) li_l[r32] = l_reg; asm volatile("s_waitcnt lgkmcnt(0)" ::: "memory");
    float rli[16];
#pragma unroll
    for (int r = 0; r < 16; ++r) rli[r] = __builtin_amdgcn_rcpf(li_l[crow(r, hi)]);
    bf16_t* Ow = Ob + (long)(wid * QBLK) * LDO;
#pragma unroll
    for (int r = 0; r < 16; ++r) { const int orow = crow(r, hi);
#pragma unroll
        for (int d0 = 0; d0 < 4; ++d0) Ow[(long)orow * LDO + d0 * 32 + r32] = f2bf(o[d0][r] * rli[r]); }
    __syncthreads();
#undef sB
#undef SLOAD
#undef SWRITE
#undef SWAIT
#undef RESC
}

__device__ __forceinline__ void glds16(const void* g, unsigned lds_base) {
    unsigned sv; asm volatile("s_mov_b32 %0, m0\n\ts_mov_b32 m0, %2\n\ts_nop 0\n\tglobal_load_lds_dwordx4 %1, off\n\ts_mov_b32 m0, %0" : "=&s"(sv) : "v"(g), "s"(lds_base) : "memory"); }
template <int DQK> struct CfgD {
    static constexpr int SHM_K = KVBLK * DQK * 2, SHM_V = KVBLK * DV * 2;
    static constexpr int KR = 0, VR = 3 * SHM_K, SCR = VR + 3 * SHM_V, LDS_BYTES = SCR + NW * 64 * 4;
    static constexpr int NPK = DQK / 64, NPV = 2;
};
template <int DQK, int LDQ, int LDK, int LDV, int LDO, bool NOMAX = false>
__device__ __forceinline__ void attn_body_dma(const bf16_t* __restrict__ Qb, const bf16_t* __restrict__ Kh, const bf16_t* __restrict__ Vh, bf16_t* __restrict__ Ob, int seq, char* lds,
                                              const float* __restrict__ qg, const f32x2* __restrict__ tab, bool rope, int tok0) {
    using C = CfgD<DQK>;
    int tid_ = threadIdx.x; asm volatile("" : "+v"(tid_));
    const int tid = tid_, wid = __builtin_amdgcn_readfirstlane(tid >> 6), lane = tid & 63, r32 = lane & 31, hi = lane >> 5;
    const unsigned lds0 = (unsigned)__builtin_amdgcn_readfirstlane((int)(uintptr_t)lds);
    char* K_lds = lds + C::KR;
    float* wsf = (float*)(lds + C::SCR) + wid * 64; float* li_l = wsf; float* al_l = wsf + 32;
    unsigned kvoff[C::NPK], vvoff[C::NPV];
#pragma unroll
    for (int i = 0; i < C::NPK; ++i) { const int b = (wid + 8 * i) * 1024 + lane * 16, row = b / (DQK * 2), pos = b % (DQK * 2);
        const int colB = pos ^ (DQK == 128 ? ((row & 15) << 4) : (((row >> 1) & 7) << 4)); kvoff[i] = (unsigned)(row * LDK * 2 + colB); }
#pragma unroll
    for (int i = 0; i < C::NPV; ++i) { const int sbt = (wid + 8 * i) * 2 + (lane >> 5), rowin = (lane & 31) >> 2, cch = lane & 3, kk = (sbt >> 2) * 8 + rowin;
        const int k = (kk & ~0xC) | ((kk & 4) << 1) | ((kk & 8) >> 1), c = (sbt & 3) * 32 + cch * 8; vvoff[i] = (unsigned)(k * LDV * 2 + c * 2); }
#define ISSUE_K(J, SL) do { const char* g_ = (const char*)Kh + (size_t)(J) * (KVBLK * LDK * 2); _Pragma("unroll") for (int i_ = 0; i_ < C::NPK; ++i_) \
        glds16(g_ + kvoff[i_], lds0 + C::KR + (SL) * C::SHM_K + (wid + 8 * i_) * 1024); } while (0)
#define ISSUE_V(J, SL) do { const char* g_ = (const char*)Vh + (size_t)(J) * (KVBLK * LDV * 2); _Pragma("unroll") for (int i_ = 0; i_ < C::NPV; ++i_) \
        glds16(g_ + vvoff[i_], lds0 + C::VR + (SL) * C::SHM_V + (wid + 8 * i_) * 1024); } while (0)
#define WAIT_BAR(N) asm volatile("s_waitcnt vmcnt(" #N ") lgkmcnt(0)\n\ts_barrier" ::: "memory")
    const int NT = seq / KVBLK;
    ISSUE_K(0, 0); ISSUE_V(0, 0); ISSUE_K(1, 1);
    float m_reg = -1e30f, l_reg = 0; f32x16 o[4] = {}; bf16x8 qr[DQK / 16];
    const bf16_t* Qw = Qb + (long)(wid * QBLK + r32) * LDQ + hi * 8;
#pragma unroll
    for (int d0 = 0; d0 < DQK / 16; ++d0) qr[d0] = *reinterpret_cast<const bf16x8*>(Qw + d0 * 16);
    {
        const int t = tok0 + wid * QBLK + r32, prow = t >> 6, pcol = t & 63;
        if constexpr (DQK == 128) {
            float ss = 0.f;
#pragma unroll
            for (int d0 = 0; d0 < 8; ++d0) { float f[8]; unpack8(qr[d0], f);
#pragma unroll
                for (int j = 0; j < 8; ++j) ss += f[j] * f[j]; }
            ss += __shfl_xor(ss, 32);
            const float rstd = 1.0f / sqrtf(ss * (1.0f / 128.0f) + 1e-6f);
#pragma unroll
            for (int d0 = 0; d0 < 8; ++d0) { float f[8]; unpack8(qr[d0], f);
#pragma unroll
                for (int j = 0; j < 8; ++j) f[j] = f[j] * rstd * qg[d0 * 16 + hi * 8 + j] * (NOMAX ? 0.08838834764831845f * 1.4426950408889634f : 1.0f);
                qr[d0] = pack8(f); }
            if (rope) {
                const f32x2* tr = tab + prow * 32 + hi * 8; const f32x2* tc = tab + pcol * 32 + hi * 8;
                rope_pair(qr[0], qr[2], tr); rope_pair(qr[1], qr[3], tr + 16);
                rope_pair(qr[4], qr[6], tc); rope_pair(qr[5], qr[7], tc + 16);
            }
        } else {
            if (rope) {
                const f32x2* tr = tab + prow * 16 + hi * 8; const f32x2* tc = tab + pcol * 16 + hi * 8;
                rope_pair(qr[8], qr[9], tr); rope_pair(qr[10], qr[11], tc);
            }
        }
    }
    SBAR();
    const int vb0 = (int)lds0 + C::VR + v_rd_base(lane);
#define RESC(a) do { if (__any((a) < 1.f)) { if (hi == 0) al_l[r32] = (a); asm volatile("s_waitcnt lgkmcnt(0)" ::: "memory"); \
    _Pragma("unroll") for (int d = 0; d < 4; ++d) _Pragma("unroll") for (int r = 0; r < 16; ++r) o[d][r] *= al_l[crow(r, hi)]; } } while (0)
    f32x16 pA0, pA1, pB0, pB1; float mnA = 0.f, mnB = 0.f, alA = 1.f, alB = 1.f; bf16x8 pa0, pa1, pa2, pa3;
#define PSM(P0, P1, MN, AL) do { if constexpr (NOMAX) partialSM_nomax(P0, P1); else partialSM<DQK>(P0, P1, m_reg, MN, AL); } while (0)
#define RESCX(a) do { if constexpr (!NOMAX) RESC(a); else SBAR(); } while (0)
    WAIT_BAR(0);
    qkt<DQK, false>(pA0, pA1, K_lds, qr, nullptr, r32, hi); PSM(pA0, pA1, mnA, alA);
    ISSUE_K(2, 2); ISSUE_V(1, 1);
    if constexpr (C::NPK + C::NPV == 4) WAIT_BAR(4); else WAIT_BAR(5);
    int sa = 1, sb = 2, sc = 0;
#define STEP(PX0, PX1, PY0, PY1, MNX, ALX, ALY, J) do { \
    SBAR(); qkt<DQK, false>(PX0, PX1, K_lds + sa * C::SHM_K, qr, nullptr, r32, hi); \
    finishSM(PY0, PY1, ALY, l_reg, pa0, pa1, pa2, pa3); SBAR(); \
    const bool gk_ = (J) + 2 < NT, gv_ = (J) + 1 < NT; \
    if (gk_) ISSUE_K((J) + 2, sc); if (gv_) ISSUE_V((J) + 1, sb); SBAR(); \
    pv_pipe(o, vb0 + sc * C::SHM_V, pa0, pa1, pa2, pa3); PSM(PX0, PX1, MNX, ALX); \
    RESCX(ALX); \
    if (gk_) { if constexpr (C::NPK + C::NPV == 4) WAIT_BAR(4); else WAIT_BAR(5); } else if (gv_) WAIT_BAR(2); else WAIT_BAR(0); \
    { const int t_ = sa; sa = sb; sb = sc; sc = t_; } } while (0)
    int j = 1;
    for (; j + 1 < NT; j += 2) {
        STEP(pB0, pB1, pA0, pA1, mnB, alB, alA, j);
        STEP(pA0, pA1, pB0, pB1, mnA, alA, alB, j + 1);
    }
    STEP(pB0, pB1, pA0, pA1, mnB, alB, alA, j);
    finishSM(pB0, pB1, alB, l_reg, pa0, pa1, pa2, pa3); SBAR();
    pv_d0(o, vb0 + sc * C::SHM_V, pa0, pa1, pa2, pa3);
    if (hi == 0) li_l[r32] = l_reg; asm volatile("s_waitcnt lgkmcnt(0)" ::: "memory");
    float rli[16];
#pragma unroll
    for (int r = 0; r < 16; ++r) rli[r] = __builtin_amdgcn_rcpf(li_l[crow(r, hi)]);
    bf16_t* Ow = Ob + (long)(wid * QBLK) * LDO;
#pragma unroll
    for (int r = 0; r < 16; ++r) { const int orow = crow(r, hi);
#pragma unroll
        for (int d0 = 0; d0 < 4; ++d0) Ow[(long)orow * LDO + d0 * 32 + r32] = f2bf(o[d0][r] * rli[r]); }
    WAIT_BAR(0);
#undef ISSUE_K
#undef ISSUE_V
#undef WAIT_BAR
#undef RESC
#undef STEP
#undef PSM
#undef RESCX
}
}

constexpr size_t MiB = 1u << 20;
constexpr size_t WS_CTL = 0, CTL_ZERO_BYTES = 1 * MiB;
constexpr size_t WS_MODS = 1 * MiB;
constexpr size_t WS_TAB = 2 * MiB;
constexpr size_t WS_X = 4 * MiB;
constexpr size_t WS_H = 140 * MiB;
constexpr size_t WS_OUTF = 208 * MiB;
constexpr size_t WS_W1T = 344 * MiB, WS_W2T = 472 * MiB;
constexpr size_t WS_GQAW = 600 * MiB;
constexpr size_t WS_LRUW = 640 * MiB;
constexpr size_t WS_MLAW = 668 * MiB;
constexpr size_t WS_BIG = 688 * MiB;
constexpr size_t WS_ACT = WS_BIG;
constexpr size_t WS_GQ = WS_BIG, WS_GK = WS_BIG + 68 * MiB, WS_GV = WS_BIG + 85 * MiB, WS_GO = WS_BIG + 102 * MiB;
constexpr size_t WS_MAP = WS_BIG, WS_MQAN = WS_BIG + 85 * MiB, WS_MCKVN = WS_BIG + 102 * MiB, WS_MQ = WS_BIG + 119 * MiB, WS_MK = WS_BIG + 221 * MiB, WS_MV = WS_BIG + 323 * MiB, WS_MO = WS_BIG + 391 * MiB;
constexpr size_t WS_LUP = WS_BIG, WS_LG = WS_BIG  , WS_LGY = WS_BIG + 68 * MiB, WS_LU = WS_BIG + 136 * MiB, WS_LAF = WS_BIG + 204 * MiB, WS_LGUF = WS_BIG + 272 * MiB,
                 WS_LAB = WS_BIG + 340 * MiB, WS_LGUB = WS_BIG + 408 * MiB, WS_LPS = WS_BIG + 476 * MiB, WS_LCIN = WS_BIG + 494 * MiB;
static_assert(WS_LGUF == WS_LAF + (size_t)R * DM * 2 && WS_LAB == WS_LGUF + (size_t)R * DM * 2 && WS_LGUB == WS_LAB + (size_t)R * DM * 2, "gate outputs are consecutive");
constexpr size_t WS_PART = WS_BIG + 776 * MiB;
constexpr size_t WS_END = WS_PART + 64 * MiB;
constexpr int NCH = 136;

#define XB_TMO      128
#define XB_XCNT(j)  (256  + 64 * (j))
#define XB_XSUB(j)  (1280 + 64 * (j))
#define XB_XGEN(j)  (2304 + 64 * (j))
#define XB_TOP      3328
#define XB_TOPGEN   3392
#define XCD_BAR_WORDS 3456
#define XB_SPIN_CAP (1u << 22)
__device__ __forceinline__ unsigned xb_ld(unsigned* p)              { return __hip_atomic_load(p, __ATOMIC_RELAXED, __HIP_MEMORY_SCOPE_AGENT); }
__device__ __forceinline__ unsigned xb_add(unsigned* p, unsigned v) { return __hip_atomic_fetch_add(p, v, __ATOMIC_RELAXED, __HIP_MEMORY_SCOPE_AGENT); }
__device__ __forceinline__ unsigned xb_xcc_id() { return (unsigned)__builtin_amdgcn_s_getreg((3 << 11) | 20) & 0xFu; }
#define XB_SPIN(cond, bar) do { unsigned _sp = 0; while (cond) { __builtin_amdgcn_s_sleep(1); \
    if ((++_sp & 255u) == 0u) { if (xb_ld(&(bar)[XB_TMO])) break; if (_sp > XB_SPIN_CAP) { atomicAdd(&(bar)[XB_TMO], 1u); break; } } } } while (0)
struct XcdBarrier { unsigned* bar; unsigned x; volatile LAS unsigned* st; };
__device__ __forceinline__ XcdBarrier xcd_barrier_post(unsigned* bar, volatile LAS unsigned* st) {
    XcdBarrier b; b.bar = bar; b.x = xb_xcc_id(); b.st = st;
    if (threadIdx.x == 0) (void)xb_add(&bar[XB_XCNT(b.x)], 1u);
    return b;
}
__device__ __forceinline__ void xcd_barrier_complete(unsigned* bar, unsigned x, unsigned& nloc, unsigned& nx) {
    const unsigned G = gridDim.x * gridDim.y * gridDim.z;
    unsigned sum, cnt, mine, sp = 0u;
    for (;;) {
        sum = 0u; cnt = 0u; mine = 0u;
#pragma unroll
        for (unsigned j = 0; j < 16; ++j) { const unsigned c = xb_ld(&bar[XB_XCNT(j)]); sum += c; cnt += (c > 0u) ? 1u : 0u; mine = (j == x) ? c : mine; }
        if (sum == G) break;
        __builtin_amdgcn_s_sleep(1);
        if ((++sp & 255u) == 0u) { if (xb_ld(&bar[XB_TMO])) break; if (sp > XB_SPIN_CAP) { atomicAdd(&bar[XB_TMO], 1u); break; } }
    }
    nloc = mine > 0u ? mine : 1u; nx = cnt > 0u ? cnt : 1u;
}
__device__ __forceinline__ void xcd_barrier(const XcdBarrier& b) {
    asm volatile("s_waitcnt vmcnt(0)" ::: "memory");
    __syncthreads();
    if (threadIdx.x == 0) {
        unsigned* bar = b.bar;
        __builtin_amdgcn_s_waitcnt(0);
        unsigned nloc = b.st[0], nx = b.st[1];
        if (nloc == 0u) { xcd_barrier_complete(bar, b.x, nloc, nx); b.st[0] = nloc; b.st[1] = nx; }
        const unsigned old = xb_add(&bar[XB_XSUB(b.x)], 1u);
        const unsigned gen = old / nloc;
        if (old + 1u == (gen + 1u) * nloc) {
            __builtin_amdgcn_fence(__ATOMIC_RELEASE, "agent");
            asm volatile("s_waitcnt vmcnt(0)" ::: "memory");
            const unsigned og = xb_add(&bar[XB_TOP], 1u);
            const unsigned tg = og / nx;
            if (og + 1u == (tg + 1u) * nx) xb_add(&bar[XB_TOPGEN], 1u);
            else XB_SPIN(xb_ld(&bar[XB_TOPGEN]) == tg, bar);
            __builtin_amdgcn_fence(__ATOMIC_ACQUIRE, "agent");
            xb_add(&bar[XB_XGEN(b.x)], 1u);
            asm volatile("s_waitcnt vmcnt(0)" ::: "memory");
        } else {
            XB_SPIN(xb_ld(&bar[XB_XGEN(b.x)]) == gen, bar);
            __builtin_amdgcn_fence(__ATOMIC_ACQUIRE, "agent");
            asm volatile("s_waitcnt vmcnt(0)" ::: "memory");
        }
    }
    __syncthreads();
}

#ifndef PROBE_N
#define PROBE_N 2
#endif
__device__ __forceinline__ int probe_count() { int n = PROBE_N; asm volatile("" : "+s"(n)); return n; }
#ifdef PROBE_GEMM
#define PROBE_REPEAT_GEMM for (int rep_ = 0, nrep_ = probe_count(); rep_ < nrep_; ++rep_)
#else
#define PROBE_REPEAT_GEMM
#endif
#ifdef PROBE_ATTN
#define PROBE_REPEAT_ATTN for (int rep_ = 0, nrep_ = probe_count(); rep_ < nrep_; ++rep_)
#else
#define PROBE_REPEAT_ATTN
#endif
struct Args {
    const float *x, *c, *ctx, *c_ctx, *ada_w, *ada_b, *ln_g, *ln_b, *mlp_w1, *mlp_w2;
    const float *gqa_wq, *gqa_wk, *gqa_wv, *gqa_wo, *gqa_q_g, *gqa_k_g;
    const float *lru_wx, *lru_wy, *lru_conv_w, *lru_conv_b, *lru_ra_w, *lru_ra_b, *lru_ix_w, *lru_ix_b, *lru_lam, *lru_wo;
    const float *mla_wq_a, *mla_q_a_g, *mla_wq_b, *mla_wkv_a, *mla_kv_a_g, *mla_wkv_b, *mla_wo;
    float* out; unsigned char* ws; int ph_lo, ph_hi;
};

typedef const __attribute__((address_space(4))) Args CArgs;
__device__ __forceinline__ CArgs* kargs() { CArgs* p = (CArgs*)__builtin_amdgcn_kernarg_segment_ptr(); asm volatile("" : "+s"(p)); return p; }
constexpr int NWAVES = 8;
constexpr int RING_BYTES = 131072, LDSCTL_OFF = RING_BYTES, LDS_BYTES = 147456;

__device__ __forceinline__ float wave_sum(float v) {
#pragma unroll
    for (int o = 1; o < 64; o <<= 1) v += __shfl_xor(v, o);
    return v;
}
__device__ __forceinline__ float sigmoidf_(float v) { return __builtin_amdgcn_rcpf(1.0f + __builtin_amdgcn_exp2f(-1.4426950408889634f * v)); }

__device__ __forceinline__ int tid_opaque() { int t = threadIdx.x; asm volatile("" : "+v"(t)); return t; }
__device__ __forceinline__ void ph_mods(CArgs& a, LAS unsigned char* lds, int vcu, int G) {
    LAS float* S = (LAS float*)lds; LAS float* red = (LAS float*)(lds + 40960);
    const int tid = tid_opaque(), wave = tid >> 6, lane = tid & 63;
    for (int i = tid; i < 5 * DM; i += 512) { const int bi = i / DM, k = i % DM; const float v = bi < 4 ? a.c[bi * DM + k] : a.c_ctx[k]; S[i] = v / (1.0f + expf(-v)); }
    __syncthreads();
    float* mods = (float*)(a.ws + WS_MODS);
    for (int item = vcu; item < 768; item += G) {
        const int l = item / 192, n0 = (item % 192) * 64, ksub = wave * 4 + (lane >> 4), cl = lane & 15;
        const float* wp = a.ada_w + ((size_t)l * DM + ksub) * 12288 + n0 + cl * 4;
        float acc[5][4];
#pragma unroll
        for (int i = 0; i < 5; ++i)
#pragma unroll
            for (int j = 0; j < 4; ++j) acc[i][j] = 0.f;
#pragma unroll 8
        for (int it = 0; it < 64; ++it) {
            const f32x4 w = __builtin_nontemporal_load((const f32x4*)(wp + (size_t)it * 32 * 12288)); const int k = ksub + 32 * it;
#pragma unroll
            for (int i = 0; i < 5; ++i) { const float s = S[i * DM + k];
#pragma unroll
                for (int j = 0; j < 4; ++j) acc[i][j] += s * w[j]; }
        }
#pragma unroll
        for (int i = 0; i < 5; ++i)
#pragma unroll
            for (int j = 0; j < 4; ++j) red[(ksub * 5 + i) * 64 + cl * 4 + j] = acc[i][j];
        __syncthreads();
        if (tid < 320) { const int i = tid / 64, cc = tid % 64; float s = 0.f;
            for (int ks = 0; ks < 32; ++ks) s += red[(ks * 5 + i) * 64 + cc];
            mods[(size_t)(l * 5 + i) * 12288 + n0 + cc] = s + a.ada_b[l * 12288 + n0 + cc]; }
        __syncthreads();
    }
}
__device__ __forceinline__ void tr_item(const float* __restrict__ W, int ldw, int k0, int n0, bf16_t* __restrict__ WT, int ldt, int drow0, LAS float* scr, int lane) {
#pragma unroll 8
    for (int i = 0; i < 32; ++i) { const int kk = 2 * i + (lane >> 5); scr[kk * 33 + (lane & 31)] = __builtin_nontemporal_load(W + (size_t)(k0 + kk) * ldw + n0 + (lane & 31)); }
    asm volatile("s_waitcnt lgkmcnt(0)" ::: "memory");
    const int c = lane & 7;
#pragma unroll
    for (int j = 0; j < 4; ++j) { const int n = (lane >> 3) + 8 * j; const LAS float* s = scr + (8 * c) * 33 + n;
        u32x4 o; o.x = cvt_pk_bf16(s[0 * 33], s[1 * 33]); o.y = cvt_pk_bf16(s[2 * 33], s[3 * 33]); o.z = cvt_pk_bf16(s[4 * 33], s[5 * 33]); o.w = cvt_pk_bf16(s[6 * 33], s[7 * 33]);
        *(u32x4*)(WT + (size_t)(drow0 + n) * ldt + k0 + 8 * c) = o; }
    asm volatile("s_waitcnt lgkmcnt(0)" ::: "memory");
}
__device__ __forceinline__ void ph_transposes(CArgs& a, LAS unsigned char* lds, int vcu, int G) {
    const int tid = tid_opaque(), wave = tid >> 6, lane = tid & 63;
    LAS float* scr = (LAS float*)(lds + wave * 8704);
    const int gw = vcu * NWAVES + wave, NGW = G * NWAVES;
    unsigned char* ws = a.ws;
    constexpr int NITEMS = 87872;
    for (int it = gw; it < NITEMS; it += NGW) {
        int r = it;
#define TR_DO(src, K_, N_, dst, drow) do { const int nblk = (N_) / 32, kb = ri / nblk, nb = ri % nblk; tr_item((src), (N_), 64 * kb, 32 * nb, (dst), (K_), (drow) + 32 * nb, scr, lane); } while (0)
        if (r < 32768) { const int l = r / 8192, ri = r % 8192; TR_DO(a.mlp_w1 + (size_t)l * DM * DFF, DM, DFF, (bf16_t*)(ws + WS_W1T) + (size_t)l * DFF * DM, 0); continue; } r -= 32768;
        if (r < 32768) { const int l = r / 8192, ri = r % 8192; TR_DO(a.mlp_w2 + (size_t)l * DFF * DM, DFF, DM, (bf16_t*)(ws + WS_W2T) + (size_t)l * DM * DFF, 0); continue; } r -= 32768;
        if (r < 4096) { const int s = r / 2048, ri = r % 2048; TR_DO(a.gqa_wq + (size_t)s * DM * DM, DM, DM, (bf16_t*)(ws + WS_GQAW + s * 20 * MiB), 0); continue; } r -= 4096;
        if (r < 1024) { const int s = r / 512, ri = r % 512; TR_DO(a.gqa_wk + (size_t)s * DM * 512, DM, 512, (bf16_t*)(ws + WS_GQAW + s * 20 * MiB), 2048); continue; } r -= 1024;
        if (r < 1024) { const int s = r / 512, ri = r % 512; TR_DO(a.gqa_wv + (size_t)s * DM * 512, DM, 512, (bf16_t*)(ws + WS_GQAW + s * 20 * MiB), 2560); continue; } r -= 1024;
        if (r < 4096) { const int s = r / 2048, ri = r % 2048; TR_DO(a.gqa_wo + (size_t)s * DM * DM, DM, DM, (bf16_t*)(ws + WS_GQAW + s * 20 * MiB + 12 * MiB), 0); continue; } r -= 4096;
        if (r < 2048) { const int ri = r; TR_DO(a.lru_wx, DM, DM, (bf16_t*)(ws + WS_LRUW), 0); continue; } r -= 2048;
        if (r < 2048) { const int ri = r; TR_DO(a.lru_wy, DM, DM, (bf16_t*)(ws + WS_LRUW), 2048); continue; } r -= 2048;
        if (r < 1024) { const int blk = r / 32, ri = r % 32, ty = blk / 16, d = (blk % 16) / 8, n = blk % 8, which = d * 2 + ty;
            const float* src = (ty == 0 ? a.lru_ra_w : a.lru_ix_w) + (size_t)(d * 8 + n) * 65536;
            TR_DO(src, 256, 256, (bf16_t*)(ws + WS_LRUW + 16 * MiB), (which * 8 + n) * 256); continue; } r -= 1024;
        if (r < 2048) { const int ri = r; TR_DO(a.lru_wo, DM, DM, (bf16_t*)(ws + WS_LRUW + 20 * MiB), 0); continue; } r -= 2048;
        if (r < 512) { const int ri = r; TR_DO(a.mla_wq_a, DM, 512, (bf16_t*)(ws + WS_MLAW), 0); continue; } r -= 512;
        if (r < 576) { const int ri = r; TR_DO(a.mla_wkv_a, DM, 576, (bf16_t*)(ws + WS_MLAW), 512); continue; } r -= 576;
        if (r < 768) { const int ri = r; TR_DO(a.mla_wq_b, 512, 3072, (bf16_t*)(ws + WS_MLAW + 5 * MiB), 0); continue; } r -= 768;
        if (r < 1024) { const int ri = r, nb = ri % 128, kb = ri / 128, n0 = 32 * nb, h = n0 >> 8, j0 = n0 & 255;
            const int drow = j0 < 128 ? h * 128 + j0 : 2048 + h * 128 + (j0 - 128);
            tr_item(a.mla_wkv_b, 4096, 64 * kb, n0, (bf16_t*)(ws + WS_MLAW + 8 * MiB), 512, drow, scr, lane); continue; } r -= 1024;
        { const int ri = r; TR_DO(a.mla_wo, DM, DM, (bf16_t*)(ws + WS_MLAW + 12 * MiB), 0); }
#undef TR_DO
    }
    { u32x4* z = (u32x4*)(ws + WS_MLAW + (size_t)1088 * DM * 2); const int gt = vcu * 512 + tid;
      for (int i = gt; i < 49152; i += G * 512) z[i] = (u32x4){0u, 0u, 0u, 0u}; }
    if (vcu == 1 % G) { float* ll = (float*)(ws + WS_TAB + 32768); for (int i = tid; i < 2 * DM; i += 512) ll[i] = -8.0f * log1pf(expf(-a.lru_lam[i])); }
    if (vcu == 0) {
        f32x2* tg = (f32x2*)(ws + WS_TAB); f32x2* tm = (f32x2*)(ws + WS_TAB + 16384);
        for (int i = tid; i < 64 * 32; i += 512) { const int pos = i / 32, f = i % 32; const float inv = powf(10000.0f, -((float)f * 2.0f) / 64.0f); const float ang = (float)pos * inv; tg[i] = (f32x2){cosf(ang), sinf(ang)}; }
        for (int i = tid; i < 64 * 16; i += 512) { const int pos = i / 16, f = i % 16; const float inv = powf(10000.0f, -((float)f * 2.0f) / 32.0f); const float ang = (float)pos * inv; tm[i] = (f32x2){cosf(ang), sinf(ang)}; }
    }
}

#define ROW_DECODE(r) const int b_ = (r) / TB, p_ = (r) % TB; const bool isctx_ = p_ < CTX; const int mi_ = isctx_ ? 4 : b_; (void)b_; (void)mi_
__device__ __forceinline__ const float* mods_ptr(CArgs& a, int l, int mi) { return (const float*)(a.ws + WS_MODS) + (size_t)(l * 5 + mi) * 12288; }

__device__ __forceinline__ void ph_init(CArgs& a, int vcu, int G) {
    const int tid_ = tid_opaque(), lane = tid_ & 63, gw = vcu * NWAVES + (tid_ >> 6), NGW = G * NWAVES; (void)lane;
    bf16_t* X = (bf16_t*)(a.ws + WS_X); bf16_t* H = (bf16_t*)(a.ws + WS_H);
    for (int r = gw; r < R; r += NGW) {
        ROW_DECODE(r);
        const float* src = isctx_ ? a.ctx + ((size_t)b_ * CTX + p_) * DM : a.x + ((size_t)b_ * SEQ + (p_ - CTX)) * DM;
        const float* m = mods_ptr(a, 0, mi_);
#pragma unroll
        for (int it = 0; it < 8; ++it) { const int idx = it * 256 + lane * 4;
            const f32x4 v = __builtin_nontemporal_load((const f32x4*)(src + idx)), m0 = *(const f32x4*)(m + idx), m1 = *(const f32x4*)(m + DM + idx);
            __builtin_nontemporal_store((u32x2){cvt_pk_bf16(v[0], v[1]), cvt_pk_bf16(v[2], v[3])}, (u32x2*)(X + (size_t)r * DM + idx));
            const f32x4 h = v * (1.0f + m1) + m0;
            *(u32x2*)(H + (size_t)r * DM + idx) = (u32x2){cvt_pk_bf16(h[0], h[1]), cvt_pk_bf16(h[2], h[3])}; }
    }
}
__device__ __forceinline__ void ln_stage_vecs(CArgs& a, LAS float* vec, int l, int which, int mi, bool last, int tid) {
    const float* lg = a.ln_g + (size_t)(l * 2 + which) * DM; const float* lb = a.ln_b + (size_t)(l * 2 + which) * DM;
    const float* m = mods_ptr(a, l, mi);
    const float* gate = m + (which == 0 ? 2 : 5) * DM;
    const float* sc = which == 0 ? m + 4 * DM : mods_ptr(a, last ? l : l + 1, mi) + 1 * DM;
    const float* sh = which == 0 ? m + 3 * DM : mods_ptr(a, last ? l : l + 1, mi);
    { const int i = tid * 4; const f32x4 g = *(const f32x4*)(gate + i), s4 = *(const f32x4*)(sc + i);
      *(LAS f32x4*)(vec + i) = 1.0f + g; *(LAS f32x4*)(vec + DM + i) = *(const f32x4*)(lg + i); *(LAS f32x4*)(vec + 2 * DM + i) = *(const f32x4*)(lb + i);
      *(LAS f32x4*)(vec + 3 * DM + i) = 1.0f + s4; *(LAS f32x4*)(vec + 4 * DM + i) = *(const f32x4*)(sh + i); }
}
template <bool LAST, int NR, bool FROM_PART>
__device__ __forceinline__ void ln_rows(CArgs& a, const LAS float* vec, int r, int lane) {
    bf16_t* X = (bf16_t*)(a.ws + WS_X); bf16_t* H = (bf16_t*)(a.ws + WS_H); const bf16_t* O = (const bf16_t*)(a.ws + WS_OUTF); const bf16_t* PART = (const bf16_t*)(a.ws + WS_PART);
    ROW_DECODE(r);
    float v[NR][4][8]; float s[NR];
#pragma unroll
    for (int rr = 0; rr < NR; ++rr) s[rr] = 0.f;
#pragma unroll
    for (int it = 0; it < 4; ++it) { const int idx = it * 512 + lane * 8;
        const f32x4 g0 = *(const LAS f32x4*)(vec + idx), g1 = *(const LAS f32x4*)(vec + idx + 4);
#pragma unroll
        for (int rr = 0; rr < NR; ++rr) {
            float xv[8], ov[8]; att::unpack8(__builtin_nontemporal_load((const bf16x8*)(X + (size_t)(r + rr) * DM + idx)), xv);
            if (FROM_PART) { const bf16_t* pp = PART + ((size_t)b_ * CTX + p_ + rr) * DM + idx;
                att::unpack8(__builtin_nontemporal_load((const bf16x8*)pp), ov);
#pragma unroll
                for (int sl = 1; sl < 8; ++sl) { float t8[8]; att::unpack8(__builtin_nontemporal_load((const bf16x8*)(pp + (size_t)sl * (NB * CTX) * DM)), t8);
#pragma unroll
                    for (int j = 0; j < 8; ++j) ov[j] += t8[j]; } }
            else att::unpack8(__builtin_nontemporal_load((const bf16x8*)(O + (size_t)(r + rr) * DM + idx)), ov);
#pragma unroll
            for (int j = 0; j < 8; ++j) { v[rr][it][j] = DN_ALPHA * xv[j] + (j < 4 ? g0[j] : g1[j - 4]) * ov[j]; s[rr] += v[rr][it][j]; } }
        __builtin_amdgcn_sched_barrier(0);
    }
    float rstd[NR];
#pragma unroll
    for (int rr = 0; rr < NR; ++rr) { const float mean = wave_sum(s[rr]) * (1.0f / DM); float q = 0.f;
#pragma unroll
        for (int it = 0; it < 4; ++it)
#pragma unroll
            for (int j = 0; j < 8; ++j) { v[rr][it][j] -= mean; q += v[rr][it][j] * v[rr][it][j]; }
        rstd[rr] = 1.0f / sqrtf(wave_sum(q) * (1.0f / DM) + LN_EPS); }
#pragma unroll
    for (int it = 0; it < 4; ++it) { const int idx = it * 512 + lane * 8;
        const f32x4 lg0 = *(const LAS f32x4*)(vec + DM + idx), lg1 = *(const LAS f32x4*)(vec + DM + idx + 4), lb0 = *(const LAS f32x4*)(vec + 2 * DM + idx), lb1 = *(const LAS f32x4*)(vec + 2 * DM + idx + 4);
        f32x4 sc0 = {0.f, 0.f, 0.f, 0.f}, sc1 = sc0, sh0 = sc0, sh1 = sc0;
        if (!LAST) { sc0 = *(const LAS f32x4*)(vec + 3 * DM + idx); sc1 = *(const LAS f32x4*)(vec + 3 * DM + idx + 4); sh0 = *(const LAS f32x4*)(vec + 4 * DM + idx); sh1 = *(const LAS f32x4*)(vec + 4 * DM + idx + 4); }
#pragma unroll
        for (int rr = 0; rr < NR; ++rr) {
            float xn[8];
#pragma unroll
            for (int j = 0; j < 8; ++j) xn[j] = v[rr][it][j] * rstd[rr] * (j < 4 ? lg0[j] : lg1[j - 4]) + (j < 4 ? lb0[j] : lb1[j - 4]);
            if (LAST) { float* op = a.out + ((size_t)b_ * SEQ + (p_ + rr - CTX)) * DM + idx; __builtin_nontemporal_store((f32x4){xn[0], xn[1], xn[2], xn[3]}, (f32x4*)op); __builtin_nontemporal_store((f32x4){xn[4], xn[5], xn[6], xn[7]}, (f32x4*)(op + 4)); }
            else { __builtin_nontemporal_store(att::pack8(xn), (bf16x8*)(X + (size_t)(r + rr) * DM + idx));
                float hh[8];
#pragma unroll
                for (int j = 0; j < 8; ++j) hh[j] = xn[j] * (j < 4 ? sc0[j] : sc1[j - 4]) + (j < 4 ? sh0[j] : sh1[j - 4]);
                *(bf16x8*)(H + (size_t)(r + rr) * DM + idx) = att::pack8(hh); } }
        __builtin_amdgcn_sched_barrier(0); }
}
template <bool LAST, int CTXMODE>
__device__ __forceinline__ void ph_ln(CArgs& a, LAS unsigned char* lds, int l, int which, int vcu, int G) {
    const int tid = tid_opaque(), lane = tid & 63, wave = tid >> 6;
    LAS float* vec = (LAS float*)lds;
    constexpr int NR = 2;
    const int b = (int)(((long)vcu * NB) / G), vlo = (b * G + NB - 1) / NB, vhi = ((b + 1) * G + NB - 1) / NB, wpb = vhi - vlo, w = vcu - vlo;
    ln_stage_vecs(a, vec, l, which, b, LAST, tid);
    __syncthreads();
    for (int k = w * NWAVES + wave; k < SEQ / NR; k += wpb * NWAVES) ln_rows<LAST, NR, false>(a, vec, b * TB + CTX + k * NR, lane);
    if (CTXMODE == 1 && !LAST) {
        __syncthreads();
        ln_stage_vecs(a, vec, l, which, 4, LAST, tid);
        __syncthreads();
        for (int k = wave * G + vcu; k < NB * CTX; k += G * NWAVES) ln_rows<false, 1, true>(a, vec, (k / CTX) * TB + (k % CTX), lane);
    }
    __syncthreads();
}
__device__ __forceinline__ void ph_knorm(CArgs& a, const float* kg, int vcu, int G) {
    const int tid_ = tid_opaque(), lane = tid_ & 63, gw = vcu * NWAVES + (tid_ >> 6), NGW = G * NWAVES; (void)lane;
    bf16_t* K = (bf16_t*)(a.ws + WS_GK); const f32x2* tab = (const f32x2*)(a.ws + WS_TAB);
    const int li = lane & 15;
    float g[8];
#pragma unroll
    for (int j = 0; j < 8; ++j) g[j] = kg[li * 8 + j];
    for (int i = gw; i < NB * SEQ; i += NGW) {
        const int t = i & (SEQ - 1), r = (i >> 12) * TB + CTX + t;
        bf16x8 raw = *(const bf16x8*)(K + (size_t)r * 512 + lane * 8);
        float f[8]; att::unpack8(raw, f);
        float ss = 0.f;
#pragma unroll
        for (int j = 0; j < 8; ++j) ss += f[j] * f[j];
        ss += __shfl_xor(ss, 1); ss += __shfl_xor(ss, 2); ss += __shfl_xor(ss, 4); ss += __shfl_xor(ss, 8);
        const float rstd = 1.0f / sqrtf(ss * (1.0f / 128.0f) + 1e-6f);
#pragma unroll
        for (int j = 0; j < 8; ++j) f[j] = f[j] * rstd * g[j];
        {
            const int pos = (li & 8) ? (t & 63) : (t >> 6);
            const f32x2* tp = tab + pos * 32 + (li & 3) * 8;
            const bool second = (li & 4) != 0;
#pragma unroll
            for (int j = 0; j < 8; ++j) { const float other = __shfl_xor(f[j], 4); const f32x2 cs = tp[j];
                f[j] = second ? f[j] * cs.x + other * cs.y : f[j] * cs.x - other * cs.y; }
        }
        *(bf16x8*)(K + (size_t)r * 512 + lane * 8) = att::pack8(f);
    }
    const bf16_t* PART = (const bf16_t*)(a.ws + WS_PART); bf16_t* Q = (bf16_t*)(a.ws + WS_GQ); bf16_t* V = (bf16_t*)(a.ws + WS_GV);
    for (int it = NGW - 1 - gw; it < NB * CTX * 6; it += NGW) {
        const int cr = it / 6, part = it - cr * 6, r = (cr >> 8) * TB + (cr & (CTX - 1));
        float f[8];
#pragma unroll
        for (int j = 0; j < 8; ++j) f[j] = 0.f;
#pragma unroll
        for (int sl = 0; sl < 4; ++sl) { const bf16x8 raw = __builtin_nontemporal_load((const bf16x8*)(PART + ((size_t)sl * (NB * CTX) + cr) * 3072 + part * 512 + lane * 8));
            float t8[8]; att::unpack8(raw, t8);
#pragma unroll
            for (int j = 0; j < 8; ++j) f[j] += t8[j]; }
        if (part == 4) {
            float ss = 0.f;
#pragma unroll
            for (int j = 0; j < 8; ++j) ss += f[j] * f[j];
            ss += __shfl_xor(ss, 1); ss += __shfl_xor(ss, 2); ss += __shfl_xor(ss, 4); ss += __shfl_xor(ss, 8);
            const float rstd = 1.0f / sqrtf(ss * (1.0f / 128.0f) + 1e-6f);
#pragma unroll
            for (int j = 0; j < 8; ++j) f[j] = f[j] * rstd * g[j];
        }
        bf16_t* dst = part < 4 ? Q + (size_t)r * 2048 + part * 512 : (part == 4 ? K : V) + (size_t)r * 512;
        *(bf16x8*)(dst + lane * 8) = att::pack8(f);
    }
}
__device__ __forceinline__ void ph_mla_norm(CArgs& a, int vcu, int G) {
    const int tid_ = tid_opaque(), lane = tid_ & 63, gw = vcu * NWAVES + (tid_ >> 6), NGW = G * NWAVES; (void)lane;
    const bf16_t* AP = (const bf16_t*)(a.ws + WS_MAP); bf16_t* QAN = (bf16_t*)(a.ws + WS_MQAN); bf16_t* CKVN = (bf16_t*)(a.ws + WS_MCKVN); bf16_t* K = (bf16_t*)(a.ws + WS_MK);
    const f32x2* tab = (const f32x2*)(a.ws + WS_TAB + 16384);
    for (int r = gw; r < R; r += NGW) {
        ROW_DECODE(r);
        const bf16_t* ap = AP + (size_t)r * 1280;
#pragma unroll
        for (int part = 0; part < 2; ++part) {
            float f8_[8]; att::unpack8(__builtin_nontemporal_load((const bf16x8*)(ap + part * 512 + lane * 8)), f8_);
            const f32x4 v0 = {f8_[0], f8_[1], f8_[2], f8_[3]}, v1 = {f8_[4], f8_[5], f8_[6], f8_[7]};
            float ss = (v0[0] * v0[0] + v0[1] * v0[1]) + (v0[2] * v0[2] + v0[3] * v0[3]) + (v1[0] * v1[0] + v1[1] * v1[1]) + (v1[2] * v1[2] + v1[3] * v1[3]);
            const float rstd = 1.0f / sqrtf(wave_sum(ss) * (1.0f / 512.0f) + 1e-6f);
            const float* gp = (part == 0 ? a.mla_q_a_g : a.mla_kv_a_g) + lane * 8;
            const f32x4 g0 = *(const f32x4*)gp, g1 = *(const f32x4*)(gp + 4);
            const f32x4 o0 = v0 * rstd * g0, o1 = v1 * rstd * g1;
            u32x4 w = {cvt_pk_bf16(o0[0], o0[1]), cvt_pk_bf16(o0[2], o0[3]), cvt_pk_bf16(o1[0], o1[1]), cvt_pk_bf16(o1[2], o1[3])};
            *(u32x4*)((part == 0 ? QAN : CKVN) + (size_t)r * 512 + lane * 8) = w;
        }
        float v = bf2f(ap[1024 + lane]);
        if (!isctx_) {
            const int t = p_ - CTX, pos = (lane & 32) ? (t & 63) : (t >> 6);
            const f32x2 cs = tab[pos * 16 + (lane & 15)];
            const float other = __shfl_xor(v, 16);
            v = (lane & 16) ? v * cs.x + other * cs.y : v * cs.x - other * cs.y;
        }
        const bf16_t kb = f2bf(v);
#pragma unroll
        for (int h = 0; h < 16; ++h) K[(size_t)r * 3072 + h * 192 + 128 + lane] = kb;
    }
}
__device__ __forceinline__ void ph_conv(CArgs& a, int vcu, int G) {
    const int tid_ = tid_opaque(), lane = tid_ & 63, gw = vcu * NWAVES + (tid_ >> 6), NGW = G * NWAVES; (void)lane;
    const bf16_t* UP = (const bf16_t*)(a.ws + WS_LUP); bf16_t* U = (bf16_t*)(a.ws + WS_LU);
    for (int r = gw; r < R; r += NGW) {
        ROW_DECODE(r);
        const int lo = isctx_ ? 0 : CTX, hi = isctx_ ? CTX : TB;
#pragma unroll
        for (int it = 0; it < 4; ++it) { const int idx = it * 512 + lane * 8;
            float acc[8];
            { const f32x4 b0 = *(const f32x4*)(a.lru_conv_b + idx), b1 = *(const f32x4*)(a.lru_conv_b + idx + 4);
              acc[0] = b0[0]; acc[1] = b0[1]; acc[2] = b0[2]; acc[3] = b0[3]; acc[4] = b1[0]; acc[5] = b1[1]; acc[6] = b1[2]; acc[7] = b1[3]; }
#pragma unroll
            for (int j = 0; j < 4; ++j) { const int pp = p_ + j - 2;
                if (pp >= lo && pp < hi) {
                    float f[8]; att::unpack8(*(const bf16x8*)(UP + (size_t)(r + j - 2) * DM + idx), f);
                    const f32x4 w0 = *(const f32x4*)(a.lru_conv_w + j * DM + idx), w1 = *(const f32x4*)(a.lru_conv_w + j * DM + idx + 4);
                    acc[0] += f[0] * w0[0]; acc[1] += f[1] * w0[1]; acc[2] += f[2] * w0[2]; acc[3] += f[3] * w0[3];
                    acc[4] += f[4] * w1[0]; acc[5] += f[5] * w1[1]; acc[6] += f[6] * w1[2]; acc[7] += f[7] * w1[3]; } }
            *(bf16x8*)(U + (size_t)r * DM + idx) = att::pack8(acc); }
    }
}
__device__ __forceinline__ void scan_step(f32x4& h, u32x2 la, u32x2 gu, f32x4* Pacc) {
    f32x4 av = {__builtin_amdgcn_exp2f(bf_lo(la.x)), __builtin_amdgcn_exp2f(bf_hi(la.x)), __builtin_amdgcn_exp2f(bf_lo(la.y)), __builtin_amdgcn_exp2f(bf_hi(la.y))};
    const f32x4 gv = {bf_lo(gu.x), bf_hi(gu.x), bf_lo(gu.y), bf_hi(gu.y)};
    f32x4 s; s[0] = sqrtf(fmaxf(1.0f - av[0] * av[0], 0.f)); s[1] = sqrtf(fmaxf(1.0f - av[1] * av[1], 0.f)); s[2] = sqrtf(fmaxf(1.0f - av[2] * av[2], 0.f)); s[3] = sqrtf(fmaxf(1.0f - av[3] * av[3], 0.f));
    h = av * h + s * gv; if (Pacc) *Pacc = *Pacc * av;
}
__device__ __forceinline__ void ph_scan1(CArgs& a, int vcu, int G) {
    const int tid_ = tid_opaque(), lane = tid_ & 63, gw = vcu * NWAVES + (tid_ >> 6), NGW = G * NWAVES; (void)lane;
    float* PS = (float*)(a.ws + WS_LPS);
    for (int item = gw; item < NB * NCH * 2 * 8; item += NGW) {
        const int cg = item & 7, dir = (item >> 3) & 1, bq = item >> 4, b = bq / NCH, q = bq % NCH;
        const bf16_t* A = (const bf16_t*)(a.ws + (dir ? WS_LAB : WS_LAF)); const bf16_t* GU = (const bf16_t*)(a.ws + (dir ? WS_LGUB : WS_LGUF));
        const size_t base = ((size_t)b * TB + q * 32) * DM + cg * 256 + lane * 4;
        f32x4 h = {0.f, 0.f, 0.f, 0.f}, P = {1.f, 1.f, 1.f, 1.f};
#pragma unroll 8
        for (int i = 0; i < 32; ++i) { const int rr = dir ? 31 - i : i;
            scan_step(h, *(const u32x2*)(A + base + (size_t)rr * DM), *(const u32x2*)(GU + base + (size_t)rr * DM), &P); }
        float* o = PS + ((size_t)(bq * 2 + dir) * 2) * DM + cg * 256 + lane * 4;
        *(f32x4*)o = P; *(f32x4*)(o + DM) = h;
    }
}
__device__ __forceinline__ void ph_scan2(CArgs& a, LAS unsigned char* lds, int vcu, int G) {
    const float* PS = (const float*)(a.ws + WS_LPS); float* CIN = (float*)(a.ws + WS_LCIN);
    const int tid = tid_opaque(), lane = tid & 63, seg = tid >> 6;
    LAS float* sm = (LAS float*)lds;
    for (int v = vcu; v < NB * 2 * (DM / 64); v += G) {
        const int cb = v % (DM / 64), dir = (v / (DM / 64)) & 1, b = v / (2 * (DM / 64)), c = cb * 64 + lane;
        float P[17], S[17];
#pragma unroll
        for (int k = 0; k < 17; ++k) { const int i = seg * 17 + k, q = dir == 0 ? i : (i < 8 ? 7 - i : NCH - 1 - (i - 8)); const size_t bq = (size_t)b * NCH + q;
            P[k] = PS[((bq * 2 + dir) * 2) * DM + c]; S[k] = PS[((bq * 2 + dir) * 2 + 1) * DM + c]; }
        float pp = 1.f, ss = 0.f;
#pragma unroll
        for (int k = 0; k < 17; ++k) { ss = P[k] * ss + S[k]; pp *= P[k]; }
        sm[(seg * 2 + 0) * 64 + lane] = pp; sm[(seg * 2 + 1) * 64 + lane] = ss;
        __syncthreads();
        float carry = 0.f;
        for (int s2 = 0; s2 < seg; ++s2) carry = sm[(s2 * 2 + 0) * 64 + lane] * carry + sm[(s2 * 2 + 1) * 64 + lane];
#pragma unroll
        for (int k = 0; k < 17; ++k) { const int i = seg * 17 + k, q = dir == 0 ? i : (i < 8 ? 7 - i : NCH - 1 - (i - 8)); const size_t bq = (size_t)b * NCH + q;
            CIN[(bq * 2 + dir) * DM + c] = carry; carry = P[k] * carry + S[k]; }
        __syncthreads();
    }
}
__device__ __forceinline__ void ph_scan3(CArgs& a, int vcu, int G) {
    const int tid_ = tid_opaque(), lane = tid_ & 63, gw = vcu * NWAVES + (tid_ >> 6), NGW = G * NWAVES; (void)lane;
    const float* CIN = (const float*)(a.ws + WS_LCIN); const bf16_t* GY = (const bf16_t*)(a.ws + WS_LGY); bf16_t* Gout = (bf16_t*)(a.ws + WS_LG);
    const bf16_t* AF = (const bf16_t*)(a.ws + WS_LAF); const bf16_t* GUF = (const bf16_t*)(a.ws + WS_LGUF); const bf16_t* AB = (const bf16_t*)(a.ws + WS_LAB); const bf16_t* GUB = (const bf16_t*)(a.ws + WS_LGUB);
    for (int item = gw; item < NB * NCH * 8; item += NGW) {
        const int cg = item & 7, bq = item >> 3, b = bq / NCH, q = bq % NCH;
        const size_t base = ((size_t)b * TB + q * 32) * DM + cg * 256 + lane * 4;
        f32x4 hf[32];
        f32x4 h = *(const f32x4*)(CIN + ((size_t)bq * 2 + 0) * DM + cg * 256 + lane * 4);
#pragma unroll
        for (int i = 0; i < 32; ++i) { scan_step(h, __builtin_nontemporal_load((const u32x2*)(AF + base + (size_t)i * DM)), __builtin_nontemporal_load((const u32x2*)(GUF + base + (size_t)i * DM)), nullptr); hf[i] = h;
            if ((i & 7) == 7) __builtin_amdgcn_sched_barrier(0); }
        h = *(const f32x4*)(CIN + ((size_t)bq * 2 + 1) * DM + cg * 256 + lane * 4);
#pragma unroll
        for (int i = 31; i >= 0; --i) {
            scan_step(h, __builtin_nontemporal_load((const u32x2*)(AB + base + (size_t)i * DM)), __builtin_nontemporal_load((const u32x2*)(GUB + base + (size_t)i * DM)), nullptr);
            const u32x2 gy = __builtin_nontemporal_load((const u32x2*)(GY + base + (size_t)i * DM));
            const f32x4 o = (hf[i] + h) * (f32x4){bf_lo(gy.x), bf_hi(gy.x), bf_lo(gy.y), bf_hi(gy.y)};
            *(u32x2*)(Gout + base + (size_t)i * DM) = (u32x2){cvt_pk_bf16(o[0], o[1]), cvt_pk_bf16(o[2], o[3])};
            if ((i & 7) == 0) __builtin_amdgcn_sched_barrier(0); }
    }
}
__device__ __forceinline__ void st_bf16x8(bf16_t* p, f32x4 v0, f32x4 v1) {
    u32x4 w = {cvt_pk_bf16(v0[0], v0[1]), cvt_pk_bf16(v0[2], v0[3]), cvt_pk_bf16(v1[0], v1[1]), cvt_pk_bf16(v1[2], v1[3])}; *(u32x4*)p = w; }
struct FStoreF32 { float* O; int ld;
    __device__ __forceinline__ void begin(const pg8::Unit&, int) {}
    __device__ __forceinline__ void row8(int row, int, int col, f32x4 v0, f32x4 v1) { float* p = O + (size_t)row * ld + col; *(f32x4*)p = v0; *(f32x4*)(p + 4) = v1; } };
struct FOut { bf16_t* O; bf16_t* PART; bf16_t* dst; int rowadj;
    __device__ __forceinline__ void begin(const pg8::Unit& u, int) {
        if (u.slice >= 0) { dst = PART + (size_t)u.slice * (NB * CTX) * DM; rowadj = (u.pm / 17) * CTX - u.pm * 256; } else { dst = O; rowadj = 0; } }
    __device__ __forceinline__ void row8(int row, int, int col, f32x4 v0, f32x4 v1) { st_bf16x8(dst + (size_t)(row + rowadj) * DM + col, v0, v1); } };
struct FBf16 { bf16_t* O; int ld;
    __device__ __forceinline__ void begin(const pg8::Unit&, int) {}
    __device__ __forceinline__ void row8(int row, int, int col, f32x4 v0, f32x4 v1) { st_bf16x8(O + (size_t)row * ld + col, v0, v1); } };
struct FQkv { bf16_t *Q, *K, *V, *PART; bf16_t* base; int ld, coff, rowadj;
    __device__ __forceinline__ void begin(const pg8::Unit& u, int) {
        if (u.slice >= 0) { base = PART + (size_t)u.slice * (NB * CTX) * 3072; ld = 3072; coff = 0; rowadj = (u.pm / 17) * CTX - u.pm * 256; }
        else { rowadj = 0; if (u.pn < 8) { base = Q; ld = 2048; coff = 0; } else if (u.pn < 10) { base = K; ld = 512; coff = 2048; } else { base = V; ld = 512; coff = 2560; } } }
    __device__ __forceinline__ void row8(int row, int, int col, f32x4 v0, f32x4 v1) { st_bf16x8(base + (size_t)(row + rowadj) * ld + (col - coff), v0, v1); } };
struct FRelu2 { bf16_t* O;
    __device__ __forceinline__ void begin(const pg8::Unit&, int) {}
    __device__ __forceinline__ void row8(int row, int, int col, f32x4 v0, f32x4 v1) {
#pragma unroll
        for (int i = 0; i < 4; ++i) { const float a = fmaxf(v0[i], 0.f), b = fmaxf(v1[i], 0.f); v0[i] = a * a; v1[i] = b * b; }
        st_bf16x8(O + (size_t)row * DFF + col, v0, v1); } };
__device__ __forceinline__ float gelu_tanh(float x) { const float z = 1.5957691216057308f * (x + 0.044715f * x * x * x); return x * __builtin_amdgcn_rcpf(1.0f + __builtin_amdgcn_exp2f(-1.4426950408889634f * z)); }
struct FLruXY { bf16_t *UP, *GY; bool gy;
    __device__ __forceinline__ void begin(const pg8::Unit& u, int) { gy = u.pn >= 8; }
    __device__ __forceinline__ void row8(int row, int, int col, f32x4 v0, f32x4 v1) {
        if (gy) {
#pragma unroll
            for (int i = 0; i < 4; ++i) { v0[i] = gelu_tanh(v0[i]); v1[i] = gelu_tanh(v1[i]); }
            st_bf16x8(GY + (size_t)row * DM + (col - 2048), v0, v1);
        } else st_bf16x8(UP + (size_t)row * DM + col, v0, v1); } };
struct EpiGates {
    static constexpr bool PERM = true;
    bf16_t* OUT4; const bf16_t* U; const float *ra_b, *ix_b, *lam;
    __device__ __forceinline__ void operator()(const f32x4 (&acc)[2][2][4][2], const pg8::Unit& u, int wr, int wc, int fr, int fq) const {
        const int which = u.pn >> 3, dir = which >> 1, ty = which & 1, ch0 = (u.pn & 7) * 256 + wc * 32 + 8 * fq, row0 = u.pm * 256 + wr * 64 + fr;
        bf16_t* dst = OUT4 + (size_t)which * ((size_t)R * DM);
        const float* bp = (ty == 0 ? ra_b : ix_b) + dir * DM;
#pragma unroll
        for (int bj = 0; bj < 2; ++bj) {
            const int ch = ch0 + bj * 128;
            const f32x4 b0 = *(const f32x4*)(bp + ch), b1 = *(const f32x4*)(bp + ch + 4);
            f32x4 l0 = {0.f, 0.f, 0.f, 0.f}, l1 = {0.f, 0.f, 0.f, 0.f};
            if (ty == 0) { l0 = *(const f32x4*)(lam + dir * DM + ch) * 1.4426950408889634f; l1 = *(const f32x4*)(lam + dir * DM + ch + 4) * 1.4426950408889634f; }
#pragma unroll
            for (int ai = 0; ai < 2; ++ai)
#pragma unroll
                for (int m = 0; m < 4; ++m) {
                    const int row = row0 + ai * 128 + m * 16;
                    const f32x4 x0 = acc[ai][bj][m][0] + b0, x1 = acc[ai][bj][m][1] + b1; f32x4 o0, o1;
                    if (ty == 0) {
#pragma unroll
                        for (int j = 0; j < 4; ++j) { o0[j] = l0[j] * sigmoidf_(x0[j]); o1[j] = l1[j] * sigmoidf_(x1[j]); }
                    } else {
                        const u32x4 uw = *(const u32x4*)(U + (size_t)row * DM + ch);
                        o0[0] = sigmoidf_(x0[0]) * bf_lo(uw.x); o0[1] = sigmoidf_(x0[1]) * bf_hi(uw.x); o0[2] = sigmoidf_(x0[2]) * bf_lo(uw.y); o0[3] = sigmoidf_(x0[3]) * bf_hi(uw.y);
                        o1[0] = sigmoidf_(x1[0]) * bf_lo(uw.z); o1[1] = sigmoidf_(x1[1]) * bf_hi(uw.z); o1[2] = sigmoidf_(x1[2]) * bf_lo(uw.w); o1[3] = sigmoidf_(x1[3]) * bf_hi(uw.w);
                    }
                    st_bf16x8(dst + (size_t)row * DM + ch, o0, o1);
                    __builtin_amdgcn_sched_barrier(0);
                }
        }
    } };
struct FKvb { bf16_t *K, *V;
    __device__ __forceinline__ void begin(const pg8::Unit&, int) {}
    __device__ __forceinline__ void row8(int row, int, int col, f32x4 v0, f32x4 v1) {
        bf16_t* p = col < 2048 ? K + (size_t)row * 3072 + (col >> 7) * 192 + (col & 127) : V + (size_t)row * DM + (col - 2048);
        st_bf16x8(p, v0, v1); } };

template <class F>
__device__ __forceinline__ void run_gemm(LAS unsigned char* lds, const bf16_t* A, int lda, const bf16_t* Bt, int ldb, int N, int K, int a_blk, F f, int G, int rot = 0) {
    pg8::Gemm g{A, Bt, R, N, K, lda, ldb, a_blk}; pg8::StaticOrder S; S.init(R, N, K, G, ((int)blockIdx.x + rot) % G);
    pg8::EpiRow8<F> E{f};
    PROBE_REPEAT_GEMM
    pg8::gemm_phase<pg8::EpiRow8<F>, pg8::StaticOrder, true, true>(lds, g, S, E);
}

__device__ __forceinline__ void run_gemm_out(LAS unsigned char* lds, const bf16_t* A, int lda, const bf16_t* Bt, int K, int SK, bf16_t* OUTF, bf16_t* PART, int G) {
    pg8::Gemm g{A, Bt, R, DM, K, lda, K, 0}; pg8::LatOrder S; S.init(DM, K, G, (int)blockIdx.x, SK, K == DFF ? 1 : 0);
    pg8::EpiRow8<FOut> E{FOut{OUTF, PART, nullptr, 0}};
    PROBE_REPEAT_GEMM
    pg8::gemm_phase<pg8::EpiRow8<FOut>, pg8::LatOrder, true, true>(lds, g, S, E);
}
template <class F>
__device__ __forceinline__ void run_gemm_lat(LAS unsigned char* lds, const bf16_t* A, int lda, const bf16_t* Bt, int ldb, int N, int K, F f, int G, int SK = 0) {
    pg8::Gemm g{A, Bt, R, N, K, lda, ldb, 0}; pg8::LatOrder S; S.init(N, K, G, (int)blockIdx.x, SK);
    pg8::EpiRow8<F> E{f};
    PROBE_REPEAT_GEMM
    pg8::gemm_phase<pg8::EpiRow8<F>, pg8::LatOrder, true, true>(lds, g, S, E);
}

__device__ __forceinline__ void ph_attn_gqa(CArgs& a, char* lds, const float* qg, const float* kg, bool ctx_units, int vcu, int G) {
    const bf16_t* Q = (const bf16_t*)(a.ws + WS_GQ); const bf16_t* K = (const bf16_t*)(a.ws + WS_GK); const bf16_t* V = (const bf16_t*)(a.ws + WS_GV); bf16_t* O = (bf16_t*)(a.ws + WS_GO);
    const f32x2* tab = (const f32x2*)(a.ws + WS_TAB);
    const int nun = ctx_units ? 1088 : 1024;
    bool fast;
    { const int lane = tid_opaque() & 63; float gq = fmaxf(fabsf(qg[lane]), fabsf(qg[lane + 64])), gk = fmaxf(fabsf(kg[lane]), fabsf(kg[lane + 64]));
#pragma unroll
      for (int o = 1; o < 64; o <<= 1) { gq = fmaxf(gq, __shfl_xor(gq, o)); gk = fmaxf(gk, __shfl_xor(gk, o)); }
      fast = __builtin_amdgcn_readfirstlane((16.3224f * gq * gk <= 40.0f) ? 1 : 0) != 0; }
#define GQA_UNITS(NM) \
    for (int id = vcu; id < nun; id += G) { \
        int b, h, row0, seq, tok0; bool rope; \
        if (id < 1024) { const int bk = id >> 6; b = bk >> 2; h = (bk & 3) * 4 + ((id & 63) >> 4); const int qb = id & 15; row0 = b * TB + CTX + qb * 256; seq = TB; tok0 = qb * 256; rope = true; } \
        else { const int j = id - 1024; b = j >> 4; h = j & 15; row0 = b * TB; seq = CTX; tok0 = 0; rope = false; } \
        const int kvh = h >> 2; \
        att::attn_body_dma<128, 2048, 512, 512, 2048, NM>(Q + (size_t)row0 * 2048 + h * 128, K + (size_t)b * TB * 512 + kvh * 128, V + (size_t)b * TB * 512 + kvh * 128, \
                                                  O + (size_t)row0 * 2048 + h * 128, seq, lds, qg, tab, rope, tok0); }
    PROBE_REPEAT_ATTN
    { if (fast) { GQA_UNITS(true) } else { GQA_UNITS(false) } }
#undef GQA_UNITS
}
__device__ __forceinline__ void ph_attn_mla(CArgs& a, char* lds, bool ctx_units, int vcu, int G) {
    const bf16_t* Q = (const bf16_t*)(a.ws + WS_MQ); const bf16_t* K = (const bf16_t*)(a.ws + WS_MK); const bf16_t* V = (const bf16_t*)(a.ws + WS_MV); bf16_t* O = (bf16_t*)(a.ws + WS_MO);
    const f32x2* tab = (const f32x2*)(a.ws + WS_TAB + 16384);
    const int nun = ctx_units ? 1088 : 1024;
    PROBE_REPEAT_ATTN
    for (int id = vcu; id < nun; id += G) {
        int b, h, row0, seq, tok0; bool rope;
        if (id < 1024) { const int bh = id >> 4; b = bh >> 4; h = bh & 15; const int qb = id & 15; row0 = b * TB + CTX + qb * 256; seq = TB; tok0 = qb * 256; rope = true; }
        else { const int j = id - 1024; b = j >> 4; h = j & 15; row0 = b * TB; seq = CTX; tok0 = 0; rope = false; }
        att::attn_body_dma<192, 3072, 3072, 2048, 2048>(Q + (size_t)row0 * 3072 + h * 192, K + (size_t)b * TB * 3072 + h * 192, V + (size_t)b * TB * DM + h * 128,
                                                    O + (size_t)row0 * DM + h * 128, seq, lds, nullptr, tab, rope, tok0);
    }
}

constexpr int NPHASES = 38;
__global__ void __launch_bounds__(NWAVES * 64, 2) trunk_fwd(Args a_unused) {
#define a (*kargs())
    extern __shared__ __attribute__((aligned(16))) unsigned char lds_raw[];
    LAS unsigned char* lds = (LAS unsigned char*)lds_raw;
    const int tid = threadIdx.x;
    const int G = gridDim.x; const int bx = blockIdx.x; const int vcu = (G % 8 == 0) ? (bx % 8) * (G / 8) + bx / 8 : bx;
#define ws (a.ws)
    for (int u = tid; u < (LDS_BYTES - LDSCTL_OFF) / 4; u += NWAVES * 64) ((LAS unsigned*)(lds + LDSCTL_OFF))[u] = 0u;
    __syncthreads();
    if (a.ph_hi - a.ph_lo > 1) (void)xcd_barrier_post((unsigned*)(ws + WS_CTL) + 1024, (volatile LAS unsigned*)(lds + LDSCTL_OFF + 64));
    int ph = 0;
#ifndef PH_FILTER
#define PH_FILTER(p) true
#endif
#ifdef PROBE_STAMP_A
    unsigned long long st_prev = __builtin_amdgcn_s_memrealtime(), st_a = 0, st_b = 0; int st_cls = 0;
#define ST_CLS(c) st_cls = (c);
#define ST_ACC { const unsigned long long now_ = __builtin_amdgcn_s_memrealtime(); if (st_cls == PROBE_STAMP_A) st_a += now_ - st_prev; if (st_cls == PROBE_STAMP_B) st_b += now_ - st_prev; st_prev = now_; }
#else
#define ST_CLS(c)
#define ST_ACC
#endif
#define PH_BEGIN if (PH_FILTER(ph) && ph >= a.ph_lo && ph < a.ph_hi) {
#define MKBAR() XcdBarrier{(unsigned*)(ws + WS_CTL) + 1024, xb_xcc_id(), (volatile LAS unsigned*)(lds + LDSCTL_OFF + 64)}
#define PH_END   if (ph + 1 < a.ph_hi) xcd_barrier(MKBAR()); ST_ACC } ++ph;

    ST_CLS(0) PH_BEGIN ph_mods(a, lds, vcu, G); __syncthreads(); ph_transposes(a, lds, vcu, G); PH_END
    ST_CLS(1) PH_BEGIN ph_init(a, vcu, G); PH_END

#define Hb ((bf16_t*)(ws + WS_H))
#define OUTF ((bf16_t*)(ws + WS_OUTF))
#define ACT ((bf16_t*)(ws + WS_ACT))

#define PARTB ((bf16_t*)(ws + WS_PART))
#define MLP_PHASES(L) \
    ST_CLS(4) PH_BEGIN ph_ln<false, 1>(a, lds, L, 0, vcu, G); PH_END \
    ST_CLS(5) PH_BEGIN run_gemm(lds, Hb, DM, (const bf16_t*)(ws + WS_W1T) + (size_t)(L) * DFF * DM, DM, DFF, DM, 0, FRelu2{ACT}, G); PH_END \
    ST_CLS(6) PH_BEGIN run_gemm_out(lds, ACT, DFF, (const bf16_t*)(ws + WS_W2T) + (size_t)(L) * DM * DFF, DFF, 8, OUTF, PARTB, G); PH_END \
    ST_CLS(4) PH_BEGIN ph_ln<false, 1>(a, lds, L, 1, vcu, G); PH_END
#define MLP_PHASES_LAST(L) \
    ST_CLS(4) PH_BEGIN ph_ln<false, 2>(a, lds, L, 0, vcu, G); PH_END \
    ST_CLS(5) PH_BEGIN run_gemm_lat(lds, Hb, DM, (const bf16_t*)(ws + WS_W1T) + (size_t)(L) * DFF * DM, DM, DFF, DM, FRelu2{ACT}, G); PH_END \
    ST_CLS(6) PH_BEGIN run_gemm_out(lds, ACT, DFF, (const bf16_t*)(ws + WS_W2T) + (size_t)(L) * DM * DFF, DFF, 0, OUTF, PARTB, G); PH_END \
    ST_CLS(4) PH_BEGIN ph_ln<true, 2>(a, lds, L, 1, vcu, G); PH_END

#define GQA_LAYER(L, SLOT, LASTL) \
    ST_CLS(2) PH_BEGIN run_gemm_lat(lds, Hb, DM, (const bf16_t*)(ws + WS_GQAW + (SLOT) * 20 * MiB), DM, 3072, DM, FQkv{(bf16_t*)(ws + WS_GQ), (bf16_t*)(ws + WS_GK), (bf16_t*)(ws + WS_GV), (bf16_t*)(ws + WS_PART), nullptr, 0, 0, 0}, G, 4); PH_END \
    ST_CLS(1) PH_BEGIN ph_knorm(a, a.gqa_k_g + (SLOT) * 128, vcu, G); PH_END \
    ST_CLS(3) PH_BEGIN ph_attn_gqa(a, (char*)lds_raw, a.gqa_q_g + (SLOT) * 128, a.gqa_k_g + (SLOT) * 128, !(LASTL), vcu, G); PH_END \
    ST_CLS(2) PH_BEGIN run_gemm_out(lds, (const bf16_t*)(ws + WS_GO), DM, (const bf16_t*)(ws + WS_GQAW + (SLOT) * 20 * MiB + 12 * MiB), DM, (LASTL) ? 0 : 8, OUTF, PARTB, G); PH_END

    GQA_LAYER(0, 0, false)
    MLP_PHASES(0)
    ST_CLS(2) PH_BEGIN run_gemm(lds, Hb, DM, (const bf16_t*)(ws + WS_LRUW), DM, 4096, DM, 0, FLruXY{(bf16_t*)(ws + WS_LUP), (bf16_t*)(ws + WS_LGY), false}, G); PH_END
    ST_CLS(1) PH_BEGIN ph_conv(a, vcu, G); PH_END
    ST_CLS(2) PH_BEGIN { EpiGates eg{(bf16_t*)(ws + WS_LAF), (const bf16_t*)(ws + WS_LU), a.lru_ra_b, a.lru_ix_b, (const float*)(ws + WS_TAB + 32768)};
               pg8::Gemm g{(const bf16_t*)(ws + WS_LU), (const bf16_t*)(ws + WS_LRUW + 16 * MiB), R, 8192, 256, DM, 256, 1}; pg8::StaticOrder S; S.init(R, 8192, 256, G, (int)blockIdx.x);
               PROBE_REPEAT_GEMM
               pg8::gemm_phase<EpiGates, pg8::StaticOrder, true, true>(lds, g, S, eg); } PH_END
    ST_CLS(7) PH_BEGIN ph_scan1(a, vcu, G); PH_END
    PH_BEGIN ph_scan2(a, lds, vcu, G); PH_END
    PH_BEGIN ph_scan3(a, vcu, G); PH_END
    ST_CLS(2) PH_BEGIN run_gemm_out(lds, (const bf16_t*)(ws + WS_LG), DM, (const bf16_t*)(ws + WS_LRUW + 20 * MiB), DM, 8, OUTF, PARTB, G); PH_END
    MLP_PHASES(1)
    ST_CLS(2) PH_BEGIN run_gemm(lds, Hb, DM, (const bf16_t*)(ws + WS_MLAW), DM, 1280, DM, 0, FBf16{(bf16_t*)(ws + WS_MAP), 1280}, G); PH_END
    ST_CLS(1) PH_BEGIN ph_mla_norm(a, vcu, G); PH_END
    ST_CLS(2) PH_BEGIN run_gemm(lds, (const bf16_t*)(ws + WS_MQAN), 512, (const bf16_t*)(ws + WS_MLAW + 5 * MiB), 512, 3072, 512, 0, FBf16{(bf16_t*)(ws + WS_MQ), 3072}, G);
             run_gemm(lds, (const bf16_t*)(ws + WS_MCKVN), 512, (const bf16_t*)(ws + WS_MLAW + 8 * MiB), 512, 4096, 512, 0, FKvb{(bf16_t*)(ws + WS_MK), (bf16_t*)(ws + WS_MV)}, G, G / 2); PH_END
    ST_CLS(3) PH_BEGIN ph_attn_mla(a, (char*)lds_raw, true, vcu, G); PH_END
    ST_CLS(2) PH_BEGIN run_gemm_out(lds, (const bf16_t*)(ws + WS_MO), DM, (const bf16_t*)(ws + WS_MLAW + 12 * MiB), DM, 8, OUTF, PARTB, G); PH_END
    MLP_PHASES(2)
    GQA_LAYER(3, 1, true)
    MLP_PHASES_LAST(3)
#ifdef PROBE_STAMP_A
    xcd_barrier(MKBAR());
    if (blockIdx.x == 0) {
        LAS float* sh = (LAS float*)(lds + LDSCTL_OFF + 256);
        if (tid == 0) { float va = (float)st_a * 0.01f, vb = (float)st_b * 0.01f;
            { float pw = 1.f; while (pw * 100.f <= va) pw *= 10.f; va = rintf(va / pw) * pw; }
            { float pw = 1.f; while (pw * 100.f <= vb) pw *= 10.f; vb = rintf(vb / pw) * pw; }
            sh[0] = va; sh[1] = vb; }
        __syncthreads();
        const float ta = sh[0], tb = sh[1];
        for (int i = 1 + tid; i <= (1 << 20); i += 512) a.out[i] = tb;
        if (tid == 0) a.out[0] = ta;
    }
#endif
#undef PH_BEGIN
#undef PH_END
#undef ws
#undef a
#undef Hb
#undef OUTF
#undef ACT
#undef PARTB
}

#ifndef MK_SPLIT
#define MK_SPLIT 0
#endif
extern "C" void kernel_launch(void* const* d_in, const int* in_sizes, int n_in, void* d_out, int out_size, void* d_ws, size_t ws_size, hipStream_t stream) {
    static int grid = 0;
    if (grid == 0) {
        if (n_in != 33 || in_sizes[0] != NB * SEQ * DM || out_size != NB * SEQ * DM || ws_size < WS_END) {
            fprintf(stderr, "kernel_launch: unexpected shapes: n_in %d in0 %d out %d ws %zu (need %zu)\n", n_in, n_in > 0 ? in_sizes[0] : -1, out_size, ws_size, (size_t)WS_END); grid = -1; return; }
        int dev = 0, cus = 0;
        if (hipGetDevice(&dev) != hipSuccess || hipDeviceGetAttribute(&cus, hipDeviceAttributeMultiprocessorCount, dev) != hipSuccess) { grid = -1; return; }
        if (hipFuncSetAttribute((const void*)trunk_fwd, hipFuncAttributeMaxDynamicSharedMemorySize, LDS_BYTES) != hipSuccess) { fprintf(stderr, "kernel_launch: hipFuncSetAttribute failed\n"); grid = -1; return; }
        int per_cu = 0;
        if (hipOccupancyMaxActiveBlocksPerMultiprocessor(&per_cu, (const void*)trunk_fwd, NWAVES * 64, LDS_BYTES) != hipSuccess || per_cu < 1)
            fprintf(stderr, "kernel_launch: occupancy query reports %d workgroups per CU\n", per_cu);
        (void)hipGetLastError();
        grid = cus;
    }
    if (grid < 0) return;
    if (hipMemsetAsync((char*)d_ws + WS_CTL, 0, CTL_ZERO_BYTES, stream) != hipSuccess) return;
    Args a{};
    const float** p = (const float**)&a;
    for (int i = 0; i < 33; ++i) p[i] = (const float*)d_in[i];
    a.out = (float*)d_out; a.ws = (unsigned char*)d_ws;
#ifdef PROBE_PREFIX
    a.ph_lo = 0; a.ph_hi = PROBE_PREFIX; hipLaunchKernelGGL(trunk_fwd, dim3(grid), dim3(NWAVES * 64), LDS_BYTES, stream, a);
    (void)hipMemsetAsync((char*)d_ws + WS_CTL, 0, CTL_ZERO_BYTES, stream);
    a.ph_lo = 0; a.ph_hi = NPHASES; hipLaunchKernelGGL(trunk_fwd, dim3(grid), dim3(NWAVES * 64), LDS_BYTES, stream, a);
#elif MK_SPLIT
    for (int k = 0; k < NPHASES; ++k) { a.ph_lo = k; a.ph_hi = k + 1; hipLaunchKernelGGL(trunk_fwd, dim3(grid), dim3(NWAVES * 64), LDS_BYTES, stream, a); }
#else
    a.ph_lo = 0; a.ph_hi = NPHASES; hipLaunchKernelGGL(trunk_fwd, dim3(grid), dim3(NWAVES * 64), LDS_BYTES, stream, a);
#endif
    const hipError_t le = hipPeekAtLastError();
    if (le != hipSuccess) fprintf(stderr, "kernel_launch: launch failed: %s\n", hipGetErrorName(le));
}
```
